# Optimizing an MI355X kernel written in HIP

```python
import math, functools
import jax, jax.numpy as jnp
from jax import lax
import numpy as np

D_MODEL = 1024
BATCH = 16
SEQ = 256
DEPTH = 2
DEC_BATCH = 2
DEC_SEQ = 4096
PAST_LEN = 512

GRID_W = 64
Q_BLOCK = 128
ROPE_BASE = 10000.0
NORM_EPS = 1e-6
HA = 4
DA = 64
HB = 4
NOPE = 64
ROPE_B = 32
VB = 128
Q_LORA = 192
KV_LORA = 128
HC = 8
NC = 64
W_LORA = 64
A_LORA = 64
G_LORA = 128
WKV_LN_EPS = 64e-5
WKV_DECAY_SCALE = 0.606531
HD = 8
PD = 64
G_SSM = 2
NS = 64
CHUNK = 128
D_INNER = HD * PD
CONV_CH = D_INNER + 2 * G_SSM * NS
F_FF = 2816
A_COLS = 3 * HA * 2 * DA
B_COLS = Q_LORA + KV_LORA + ROPE_B
C_COLS = 3 * HC * NC + 2 * W_LORA + 2 * A_LORA + G_LORA
D_COLS = D_INNER + CONV_CH + HD
MIX_WIDTH = HA * 2 * DA + HB * VB

kernel_name = 'hybrid_diffusion_trunk_step'


def rmsnorm(x, g, eps=NORM_EPS):
    xf = x.astype(jnp.float32)
    y = xf * lax.rsqrt(jnp.mean(xf * xf, axis=-1, keepdims=True) + eps)
    return (y * g).astype(x.dtype)


def head_layernorm(y, w, b, eps):
    yf = y.astype(jnp.float32)
    mu = jnp.mean(yf, axis=-1, keepdims=True)
    var = jnp.mean(jnp.square(yf - mu), axis=-1, keepdims=True)
    return ((yf - mu) * lax.rsqrt(var + eps) * w + b).astype(y.dtype)


def dwconv3(x, w, b):
    xp = jnp.pad(x, ((0, 0), (1, 1), (0, 0)))
    return xp[:, :-2] * w[0] + xp[:, 1:-1] * w[1] + xp[:, 2:] * w[2] + b


def centred_shift(x):
    xp = jnp.pad(x, ((0, 0), (1, 1), (0, 0)))
    return 0.5 * (xp[:, :-2] + xp[:, 2:])


def axial_rope_tables(length, dim):
    rows = length // GRID_W
    quarter = dim // 4
    inv = ROPE_BASE ** (-jnp.arange(quarter, dtype=jnp.float32) / quarter)
    pos = jnp.arange(rows * GRID_W)
    row = (pos // GRID_W).astype(jnp.float32)
    col = (pos % GRID_W).astype(jnp.float32)
    ang_r = row[:, None] * inv
    ang_c = col[:, None] * inv
    return jnp.cos(ang_r), jnp.sin(ang_r), jnp.cos(ang_c), jnp.sin(ang_c)


def rope_2d(x, tables):
    cr, sr, cc, sc = tables

    def rot(xh, c, s):
        x1, x2 = jnp.split(xh, 2, axis=-1)
        return jnp.concatenate([x1 * c - x2 * s, x1 * s + x2 * c], axis=-1)

    xr, xc = jnp.split(x, 2, axis=-1)
    return jnp.concatenate([rot(xr, cr, sr), rot(xc, cc, sc)], axis=-1).astype(x.dtype)


def attend(q, k, v, scale):
    b, h, lq, dq = q.shape
    nblk = lq // Q_BLOCK
    qb = q.reshape(b, h, nblk, Q_BLOCK, dq).transpose(2, 0, 1, 3, 4)

    def one(qblk):
        s = jnp.einsum('bhqd,bhkd->bhqk', qblk, k).astype(jnp.float32) * scale
        p = jax.nn.softmax(s, axis=-1).astype(v.dtype)
        return jnp.einsum('bhqk,bhkd->bhqd', p, v)

    o = lax.map(one, qb)
    return o.transpose(1, 2, 0, 3, 4).reshape(b, h, lq, v.shape[-1])


def wkv_scan(r, w, kk, a, k, v, S0, reverse):
    f32 = jnp.float32
    tm = lambda t: jnp.moveaxis(t.astype(f32), 1, 0)
    xs = (tm(r), tm(w), tm(-kk), tm(kk * a), tm(k), tm(v))

    def step(S, inp):
        r_t, w_t, a_t, b_t, k_t, v_t = inp
        sa = jnp.einsum('bhvk,bhk->bhv', S, a_t)
        S = S * w_t[:, :, None, :] + sa[..., None] * b_t[:, :, None, :] + v_t[..., None] * k_t[:, :, None, :]
        return S, jnp.einsum('bhvk,bhk->bhv', S, r_t)

    S, ys = lax.scan(step, S0.astype(f32), xs, reverse=reverse)
    return jnp.moveaxis(ys, 0, 1).astype(r.dtype), S


def ssd_scan(x, dt, A, Bm, Cm, S0):
    f32 = jnp.float32
    b, L, H, P = x.shape
    nc = L // CHUNK
    rep = H // Bm.shape[2]
    Bh = jnp.repeat(Bm.astype(f32), rep, axis=2).reshape(b, nc, CHUNK, H, -1)
    Ch = jnp.repeat(Cm.astype(f32), rep, axis=2).reshape(b, nc, CHUNK, H, -1)
    dtf = dt.astype(f32)
    xdt = (x.astype(f32) * dtf[..., None]).reshape(b, nc, CHUNK, H, P)
    acum = jnp.cumsum((dtf * A.astype(f32)).reshape(b, nc, CHUNK, H), axis=2)
    causal = jnp.tril(jnp.ones((CHUNK, CHUNK), dtype=bool))[None, None, :, :, None]
    seg = acum[:, :, :, None, :] - acum[:, :, None, :, :]
    decay_in = jnp.where(causal, jnp.exp(jnp.where(causal, seg, 0.0)), 0.0)
    scores = jnp.einsum('bcihn,bcjhn->bcijh', Ch, Bh) * decay_in
    y_intra = jnp.einsum('bcijh,bcjhp->bcihp', scores, xdt)
    decay_end = jnp.exp(acum[:, :, -1:, :] - acum)
    chunk_states = jnp.einsum('bcjhn,bcjhp->bchpn', Bh * decay_end[..., None], xdt)
    chunk_decay = jnp.exp(acum[:, :, -1, :])

    def step(S, inp):
        dec, st = inp
        return S * dec[:, :, None, None] + st, S

    S_fin, S_start = lax.scan(step, S0.astype(f32),
                              (jnp.moveaxis(chunk_decay, 1, 0), jnp.moveaxis(chunk_states, 1, 0)))
    S_start = jnp.moveaxis(S_start, 0, 1)
    y_inter = jnp.einsum('bcihn,bchpn->bcihp', Ch * jnp.exp(acum)[..., None], S_start)
    return (y_intra + y_inter).reshape(b, L, H, P).astype(x.dtype), S_fin


def even_mixer(hn, p, ctx, layer_idx):
    b, L, _ = hn.shape
    latent = ctx is not None
    proj = hn @ p['w_in']
    qa, ka, va, q_down, ckv, kpe = jnp.split(
        proj, [HA * 2 * DA, 2 * HA * 2 * DA, A_COLS, A_COLS + Q_LORA, A_COLS + Q_LORA + KV_LORA], axis=-1)
    heads = lambda t, n: t.reshape(t.shape[0], t.shape[1], n, -1).transpose(0, 2, 1, 3)
    qa, ka, va = heads(qa, HA), heads(ka, HA), heads(va, HA)
    q1, q2 = jnp.split(qa, 2, axis=-1)
    k1, k2 = jnp.split(ka, 2, axis=-1)
    qb = heads(rmsnorm(q_down, p['q_norm']) @ p['w_uq'], HB)
    q_nope, q_pe = jnp.split(qb, [NOPE], axis=-1)
    ckv = rmsnorm(ckv, p['kv_norm'])
    if latent:
        ta = axial_rope_tables(L, DA)
        tb = axial_rope_tables(L, ROPE_B)
        q1, q2, k1, k2 = rope_2d(q1, ta), rope_2d(q2, ta), rope_2d(k1, ta), rope_2d(k2, ta)
        q_pe, kpe = rope_2d(q_pe, tb), rope_2d(kpe, tb)
    own = (jnp.concatenate([k1, k2], axis=-1), va, ckv, kpe)
    if latent:
        k_all, v_all, ckv_all, kpe_all = (jnp.concatenate([cc.astype(oo.dtype), oo], axis=-2)
                                          for cc, oo in zip(ctx, own))
    else:
        k_all, v_all, ckv_all, kpe_all = own
    lambda_init = 0.8 - 0.6 * math.exp(-0.3 * layer_idx)
    f32 = jnp.float32
    lam = (jnp.exp(jnp.sum(p['lambda_q1'].astype(f32) * p['lambda_k1'].astype(f32)))
           - jnp.exp(jnp.sum(p['lambda_q2'].astype(f32) * p['lambda_k2'].astype(f32))) + lambda_init)
    k1a, k2a = jnp.split(k_all, 2, axis=-1)
    sa = DA ** -0.5
    oa = attend(q1, k1a, v_all, sa) - lam.astype(hn.dtype) * attend(q2, k2a, v_all, sa)
    oa = rmsnorm(oa, p['subln']) * (1.0 - lambda_init)
    Lk = ckv_all.shape[1]
    kv = (ckv_all @ p['w_ukv']).reshape(b, Lk, HB, NOPE + VB).transpose(0, 2, 1, 3)
    k_nope, vb = jnp.split(kv, [NOPE], axis=-1)
    kpe_h = jnp.broadcast_to(kpe_all[:, None], (b, HB, Lk, ROPE_B))
    ob = attend(jnp.concatenate([q_nope, q_pe], axis=-1), jnp.concatenate([k_nope, kpe_h], axis=-1),
                vb, (NOPE + ROPE_B) ** -0.5)
    merged = jnp.concatenate([oa.transpose(0, 2, 1, 3).reshape(b, L, -1),
                              ob.transpose(0, 2, 1, 3).reshape(b, L, -1)], axis=-1)
    return merged @ p['w_out'], own


def odd_mixer(hn, p, ctx):
    b, L, _ = hn.shape
    f32 = jnp.float32
    proj = hn @ p['w_in']
    zc, zd = jnp.split(proj, [C_COLS], axis=-1)
    zc = zc + p['mu'] * (centred_shift(zc) - zc)
    r, k, v, wd, ad, gd = jnp.split(
        zc, [HC * NC, 2 * HC * NC, 3 * HC * NC, 3 * HC * NC + 2 * W_LORA, 3 * HC * NC + 2 * W_LORA + 2 * A_LORA],
        axis=-1)
    hsplit = lambda t: t.reshape(b, L, HC, NC)
    r, k, v = hsplit(r), hsplit(k), hsplit(v)
    kkf = (k * p['k_k'].reshape(HC, NC)).astype(f32)
    kk = (kkf * lax.rsqrt(jnp.sum(kkf * kkf, axis=-1, keepdims=True) + 1e-12)).astype(k.dtype)
    g = jax.nn.sigmoid(gd) @ p['g2']
    wds = jnp.split(wd, 2, axis=-1)
    ads = jnp.split(ad, 2, axis=-1)
    k_a = p['k_a'].reshape(HC, NC)
    if ctx is None:
        wkv0 = (jnp.zeros((b, HC, NC, NC), f32), jnp.zeros((b, HC, NC, NC), f32))
        ssm0 = (jnp.zeros((b, HD, PD, NS), f32), jnp.zeros((b, HD, PD, NS), f32))
    else:
        wkv0 = (ctx[0], ctx[1])
        ssm0 = (ctx[2], ctx[3])

    def wkv_direction(i):
        logw = -WKV_DECAY_SCALE * jax.nn.sigmoid(p['w0'][i] + jnp.tanh(wds[i]) @ p['w2'][i])
        a = hsplit(jax.nn.sigmoid(p['a0'][i] + ads[i] @ p['a2'][i]))
        k_i = k * (1.0 + (a - 1.0) * k_a)
        return wkv_scan(r, jnp.exp(hsplit(logw)), kk, a, k_i, v, wkv0[i], reverse=(i == 1))

    y_f, S_f = wkv_direction(0)
    y_b, S_b = wkv_direction(1)
    y = head_layernorm(y_f + y_b, p['ln_w'].reshape(HC, NC), p['ln_b'].reshape(HC, NC), WKV_LN_EPS)
    y = y + jnp.sum(r * k * p['r_k'], axis=-1, keepdims=True) * v
    oc = y.reshape(b, L, HC * NC) * g
    zg, xbc, dt_raw = jnp.split(zd, [D_INNER, D_INNER + CONV_CH], axis=-1)
    xbc = jax.nn.silu(dwconv3(xbc, p['conv_w'], p['conv_b']))
    xs, Bs, Cs = jnp.split(xbc, [D_INNER, D_INNER + G_SSM * NS], axis=-1)
    xs = xs.reshape(b, L, HD, PD)
    Bs = Bs.reshape(b, L, G_SSM, NS)
    Cs = Cs.reshape(b, L, G_SSM, NS)

    def ssd_direction(i):
        dt = jax.nn.softplus(dt_raw + p['dt_bias'][i])
        A = -jnp.exp(p['A_log'][i].astype(f32))
        if i == 1:
            fl = lambda t: jnp.flip(t, axis=1)
            yy, S = ssd_scan(fl(xs), fl(dt), A, fl(Bs), fl(Cs), ssm0[i])
            yy = fl(yy)
        else:
            yy, S = ssd_scan(xs, dt, A, Bs, Cs, ssm0[i])
        return yy + p['D'][i][:, None] * xs, S

    yd_f, H_f = ssd_direction(0)
    yd_b, H_b = ssd_direction(1)
    od = rmsnorm((yd_f + yd_b).reshape(b, L, D_INNER) * jax.nn.silu(zg), p['gnorm'])
    merged = jnp.concatenate([oc, od], axis=-1)
    return merged @ p['w_out'], (S_f, S_b, H_f, H_b)


def conv_ffn(x, p):
    u = dwconv3(x @ p['ffn_up'], p['ffn_conv_w'], p['ffn_conv_b'])
    gate, val = jnp.split(u, 2, axis=-1)
    return (jax.nn.silu(gate) * val) @ p['ffn_down']


def trunk_layer(h, cond, p, mixer, ctx):
    sh1, sc1, g1, sh2, sc2, g2 = jnp.split(jax.nn.silu(cond) @ p['ada_w'] + p['ada_b'], 6, axis=-1)
    hn = rmsnorm(h, p['norm1']) * (1.0 + sc1) + sh1
    m, ctx_out = mixer(hn, p['mix'], ctx)
    h = h + g1 * m
    hn = rmsnorm(h, p['norm2']) * (1.0 + sc2) + sh2
    h = h + g2 * conv_ffn(hn, p)
    return h, ctx_out


def setup_inputs(seed: int = 0) -> dict:
    key = jax.random.key(seed)
    ks = iter(jax.random.split(key, 96))
    nrm = lambda shape, s=1.0: jax.random.normal(next(ks), shape, jnp.float32) * s
    gain = lambda n: 1.0 + 0.02 * jax.random.normal(next(ks), (n,), jnp.float32)
    inp = {}
    inp['x_prompt'] = nrm((BATCH, SEQ, D_MODEL))
    inp['x_sample'] = nrm((DEC_BATCH, DEC_SEQ, D_MODEL))
    inp['cache_l0_k'] = nrm((DEC_BATCH, HA, PAST_LEN, 2 * DA))
    inp['cache_l0_v'] = nrm((DEC_BATCH, HA, PAST_LEN, 2 * DA))
    inp['cache_l0_ckv'] = nrm((DEC_BATCH, PAST_LEN, KV_LORA))
    inp['cache_l0_kpe'] = nrm((DEC_BATCH, PAST_LEN, ROPE_B))
    inp['state_l1_wkv_fwd'] = nrm((DEC_BATCH, HC, NC, NC), 0.5)
    inp['state_l1_wkv_bwd'] = nrm((DEC_BATCH, HC, NC, NC), 0.5)
    inp['state_l1_ssm_fwd'] = nrm((DEC_BATCH, HD, PD, NS), 0.5)
    inp['state_l1_ssm_bwd'] = nrm((DEC_BATCH, HD, PD, NS), 0.5)
    inp['c'] = nrm((DEC_BATCH, D_MODEL))
    inp['c_ctx'] = nrm((D_MODEL,))

    def common(i):
        inp['ada_w_%d' % i] = nrm((D_MODEL, 6 * D_MODEL), D_MODEL ** -0.5)
        inp['ada_b_%d' % i] = nrm((6 * D_MODEL,), 0.02)
        inp['norm1_%d' % i] = gain(D_MODEL)
        inp['norm2_%d' % i] = gain(D_MODEL)
        inp['ffn_up_%d' % i] = nrm((D_MODEL, 2 * F_FF), D_MODEL ** -0.5)
        inp['ffn_conv_w_%d' % i] = nrm((3, 2 * F_FF), 3 ** -0.5)
        inp['ffn_conv_b_%d' % i] = nrm((2 * F_FF,), 0.02)
        inp['ffn_down_%d' % i] = nrm((F_FF, D_MODEL), F_FF ** -0.5)

    common(0)
    inp['l0_w_in'] = nrm((D_MODEL, A_COLS + B_COLS), D_MODEL ** -0.5)
    inp['l0_lambda_q1'] = nrm((DA,), 0.1)
    inp['l0_lambda_k1'] = nrm((DA,), 0.1)
    inp['l0_lambda_q2'] = nrm((DA,), 0.1)
    inp['l0_lambda_k2'] = nrm((DA,), 0.1)
    inp['l0_subln'] = gain(2 * DA)
    inp['l0_q_norm'] = gain(Q_LORA)
    inp['l0_w_uq'] = nrm((Q_LORA, HB * (NOPE + ROPE_B)), Q_LORA ** -0.5)
    inp['l0_kv_norm'] = gain(KV_LORA)
    inp['l0_w_ukv'] = nrm((KV_LORA, HB * (NOPE + VB)), KV_LORA ** -0.5)
    inp['l0_w_out'] = nrm((MIX_WIDTH, D_MODEL), MIX_WIDTH ** -0.5)
    common(1)
    inp['l1_w_in'] = nrm((D_MODEL, C_COLS + D_COLS), D_MODEL ** -0.5)
    inp['l1_mu'] = jax.random.uniform(next(ks), (C_COLS,), jnp.float32)
    inp['l1_w0'] = nrm((2, HC * NC), 0.5)
    inp['l1_w2'] = nrm((2, W_LORA, HC * NC), W_LORA ** -0.5)
    inp['l1_a0'] = nrm((2, HC * NC), 0.5)
    inp['l1_a2'] = nrm((2, A_LORA, HC * NC), A_LORA ** -0.5)
    inp['l1_g2'] = nrm((G_LORA, HC * NC), G_LORA ** -0.5)
    inp['l1_k_k'] = 0.85 + nrm((HC * NC,), 0.05)
    inp['l1_k_a'] = 1.0 + nrm((HC * NC,), 0.05)
    inp['l1_r_k'] = nrm((HC, NC), 0.1)
    inp['l1_ln_w'] = gain(HC * NC)
    inp['l1_ln_b'] = nrm((HC * NC,), 0.02)
    inp['l1_conv_w'] = nrm((3, CONV_CH), 3 ** -0.5)
    inp['l1_conv_b'] = nrm((CONV_CH,), 0.02)
    inp['l1_A_log'] = jnp.log(jax.random.uniform(next(ks), (2, HD), jnp.float32, 1.0, 16.0))
    dt0 = jnp.exp(jax.random.uniform(next(ks), (2, HD), jnp.float32, math.log(1e-3), math.log(1e-1)))
    inp['l1_dt_bias'] = dt0 + jnp.log(-jnp.expm1(-dt0))
    inp['l1_D'] = 1.0 + nrm((2, HD), 0.1)
    inp['l1_gnorm'] = gain(D_INNER)
    inp['l1_w_out'] = nrm((MIX_WIDTH, D_MODEL), MIX_WIDTH ** -0.5)
    inp['norm_f'] = gain(D_MODEL)
    return inp


def reference(x_prompt, x_sample, cache_l0_k, cache_l0_v, cache_l0_ckv, cache_l0_kpe,
              state_l1_wkv_fwd, state_l1_wkv_bwd, state_l1_ssm_fwd, state_l1_ssm_bwd,
              c, c_ctx,
              ada_w_0, ada_b_0, norm1_0, norm2_0, ffn_up_0, ffn_conv_w_0, ffn_conv_b_0, ffn_down_0,
              l0_w_in, l0_lambda_q1, l0_lambda_k1, l0_lambda_q2, l0_lambda_k2, l0_subln,
              l0_q_norm, l0_w_uq, l0_kv_norm, l0_w_ukv, l0_w_out,
              ada_w_1, ada_b_1, norm1_1, norm2_1, ffn_up_1, ffn_conv_w_1, ffn_conv_b_1, ffn_down_1,
              l1_w_in, l1_mu, l1_w0, l1_w2, l1_a0, l1_a2, l1_g2, l1_k_k, l1_k_a, l1_r_k,
              l1_ln_w, l1_ln_b, l1_conv_w, l1_conv_b, l1_A_log, l1_dt_bias, l1_D, l1_gnorm, l1_w_out,
              norm_f):
    layers = [
        dict(ada_w=ada_w_0, ada_b=ada_b_0, norm1=norm1_0, norm2=norm2_0, ffn_up=ffn_up_0,
             ffn_conv_w=ffn_conv_w_0, ffn_conv_b=ffn_conv_b_0, ffn_down=ffn_down_0,
             mix=dict(w_in=l0_w_in, lambda_q1=l0_lambda_q1, lambda_k1=l0_lambda_k1,
                      lambda_q2=l0_lambda_q2, lambda_k2=l0_lambda_k2, subln=l0_subln,
                      q_norm=l0_q_norm, w_uq=l0_w_uq, kv_norm=l0_kv_norm, w_ukv=l0_w_ukv, w_out=l0_w_out)),
        dict(ada_w=ada_w_1, ada_b=ada_b_1, norm1=norm1_1, norm2=norm2_1, ffn_up=ffn_up_1,
             ffn_conv_w=ffn_conv_w_1, ffn_conv_b=ffn_conv_b_1, ffn_down=ffn_down_1,
             mix=dict(w_in=l1_w_in, mu=l1_mu, w0=l1_w0, w2=l1_w2, a0=l1_a0, a2=l1_a2, g2=l1_g2,
                      k_k=l1_k_k, k_a=l1_k_a, r_k=l1_r_k, ln_w=l1_ln_w, ln_b=l1_ln_b,
                      conv_w=l1_conv_w, conv_b=l1_conv_b, A_log=l1_A_log, dt_bias=l1_dt_bias,
                      D=l1_D, gnorm=l1_gnorm, w_out=l1_w_out)),
    ]
    caches = [(cache_l0_k, cache_l0_v, cache_l0_ckv, cache_l0_kpe),
              (state_l1_wkv_fwd, state_l1_wkv_bwd, state_l1_ssm_fwd, state_l1_ssm_bwd)]
    cond_ctx = c_ctx[None, None, :]
    cond_lat = c[:, None, :]
    h_ctx, h_lat = x_prompt, x_sample
    new_state = []
    for i in range(DEPTH):
        p = layers[i]
        mixer = functools.partial(even_mixer, layer_idx=i) if i % 2 == 0 else odd_mixer
        h_ctx, ctx_tensors = trunk_layer(h_ctx, cond_ctx, p, mixer, None)
        h_lat, _ = trunk_layer(h_lat, cond_lat, p, mixer, caches[i])
        new_state.append(ctx_tensors)
    y_prompt = rmsnorm(h_ctx, norm_f)
    y_sample = rmsnorm(h_lat, norm_f)
    new_l0_k, new_l0_v, new_l0_ckv, new_l0_kpe = new_state[0]
    new_l1_wkv_fwd, new_l1_wkv_bwd, new_l1_ssm_fwd, new_l1_ssm_bwd = new_state[1]
    return (y_prompt, y_sample, new_l0_k, new_l0_v, new_l0_ckv, new_l0_kpe,
            new_l1_wkv_fwd, new_l1_wkv_bwd, new_l1_ssm_fwd, new_l1_ssm_bwd)
```

```cpp
#include <hip/hip_runtime.h>
#include <math.h>

namespace {
constexpr int DM = 1024, CT = 4096, FF = 2816, FF2 = 5632;
constexpr int N0 = 1888, N1 = 3208, CC = 1920;
constexpr float EPS = 1e-6f;

__device__ __forceinline__ float silu_f(float x) { return x / (1.f + expf(-x)); }
__device__ __forceinline__ float sigmoid_f(float x) { return 1.f / (1.f + expf(-x)); }
__device__ __forceinline__ float wave_sum(float v) {
#pragma unroll
    for (int o = 32; o; o >>= 1) v += __shfl_xor(v, o);
    return v;
}
__device__ __forceinline__ float block_sum256(float v, float* sh) {
    v = wave_sum(v);
    __syncthreads();
    if ((threadIdx.x & 63) == 0) sh[threadIdx.x >> 6] = v;
    __syncthreads();
    return sh[0] + sh[1] + sh[2] + sh[3];
}

__global__ void __launch_bounds__(256) k_ada(const float* __restrict__ c, const float* __restrict__ c_ctx,
                                            const float* __restrict__ W0, const float* __restrict__ b0,
                                            const float* __restrict__ W1, const float* __restrict__ b1, float* __restrict__ mod) {
    int idx = blockIdx.x * 256 + threadIdx.x;
    int j = idx % 6144, ci = (idx / 6144) % 3, l = idx / (6144 * 3);
    const float* cond = ci == 0 ? c_ctx : c + (ci - 1) * 1024;
    const float* W = l ? W1 : W0;
    const float* b = l ? b1 : b0;
    float s = 0.f;
    for (int k = 0; k < 1024; ++k) s += silu_f(cond[k]) * W[(size_t)k * 6144 + j];
    mod[idx] = s + b[j];
}

__global__ void __launch_bounds__(256) k_normmod(const float* __restrict__ hin, const float* __restrict__ g,
                                                const float* __restrict__ sh, const float* __restrict__ sc, float* __restrict__ out) {
    __shared__ float red[4];
    int t = blockIdx.x, tid = threadIdx.x;
    float4 x = *(const float4*)(hin + (size_t)t * DM + tid * 4);
    float ss = block_sum256(x.x * x.x + x.y * x.y + x.z * x.z + x.w * x.w, red);
    float rstd = rsqrtf(ss * (1.f / DM) + EPS);
    float4 gg = *(const float4*)(g + tid * 4);
    float4 o;
    o.x = x.x * rstd * gg.x; o.y = x.y * rstd * gg.y; o.z = x.z * rstd * gg.z; o.w = x.w * rstd * gg.w;
    if (sh) {
        float4 a = *(const float4*)(sc + tid * 4), b = *(const float4*)(sh + tid * 4);
        o.x = o.x * (1.f + a.x) + b.x; o.y = o.y * (1.f + a.y) + b.y; o.z = o.z * (1.f + a.z) + b.z; o.w = o.w * (1.f + a.w) + b.w;
    }
    *(float4*)(out + (size_t)t * DM + tid * 4) = o;
}

__global__ void __launch_bounds__(256) k_resid(float* __restrict__ h, const float* __restrict__ m, const float* __restrict__ gate) {
    size_t i = ((size_t)blockIdx.x * 256 + threadIdx.x) * 4;
    int d = (int)(i & (DM - 1));
    float4 hv = *(float4*)(h + i), mv = *(const float4*)(m + i), gv = *(const float4*)(gate + d);
    hv.x += gv.x * mv.x; hv.y += gv.y * mv.y; hv.z += gv.z * mv.z; hv.w += gv.w * mv.w;
    *(float4*)(h + i) = hv;
}

__global__ void __launch_bounds__(256) k_gemm(const float* __restrict__ A, int lda, const float* __restrict__ B, int ldb,
                                             float* __restrict__ C, int ldc, int M, int N, int K) {
    __shared__ float As[16][68];
    __shared__ float Bs[16][68];
    int tid = threadIdx.x, tx = tid & 15, ty = tid >> 4;
    int m0 = blockIdx.y * 64, n0 = blockIdx.x * 64;
    float acc[4][4];
#pragma unroll
    for (int i = 0; i < 4; ++i)
#pragma unroll
        for (int j = 0; j < 4; ++j) acc[i][j] = 0.f;
    int ar = tid >> 2, ac = (tid & 3) * 4;
    int br = tid >> 4, bc = (tid & 15) * 4;
    for (int k0 = 0; k0 < K; k0 += 16) {
        float4 av = *(const float4*)(A + (size_t)(m0 + ar) * lda + k0 + ac);
        float4 bv = make_float4(0.f, 0.f, 0.f, 0.f);
        if (n0 + bc < N) bv = *(const float4*)(B + (size_t)(k0 + br) * ldb + n0 + bc);
        __syncthreads();
        As[ac + 0][ar] = av.x; As[ac + 1][ar] = av.y; As[ac + 2][ar] = av.z; As[ac + 3][ar] = av.w;
        *(float4*)&Bs[br][bc] = bv;
        __syncthreads();
#pragma unroll
        for (int k = 0; k < 16; ++k) {
            float4 a4 = *(const float4*)&As[k][ty * 4];
            float4 b4 = *(const float4*)&Bs[k][tx * 4];
            float a[4] = {a4.x, a4.y, a4.z, a4.w}, b[4] = {b4.x, b4.y, b4.z, b4.w};
#pragma unroll
            for (int i = 0; i < 4; ++i)
#pragma unroll
                for (int j = 0; j < 4; ++j) acc[i][j] += a[i] * b[j];
        }
    }
    if (n0 + tx * 4 < N) {
#pragma unroll
        for (int i = 0; i < 4; ++i)
            *(float4*)(C + (size_t)(m0 + ty * 4 + i) * ldc + n0 + tx * 4) = make_float4(acc[i][0], acc[i][1], acc[i][2], acc[i][3]);
    }
}

__global__ void __launch_bounds__(256) k_l0_post(float* __restrict__ proj, const float* __restrict__ q_norm, const float* __restrict__ kv_norm,
                                                float* __restrict__ qdn, float* __restrict__ ckv_cat, float* __restrict__ kpe_all,
                                                float* __restrict__ out_k, float* __restrict__ out_v, float* __restrict__ out_ckv, float* __restrict__ out_kpe,
                                                int latent) {
    __shared__ float red[4];
    int t = blockIdx.x, tid = threadIdx.x;
    float* p = proj + (size_t)t * N0;
    {
        float v = tid < 192 ? p[1536 + tid] : 0.f;
        float ss = block_sum256(v * v, red);
        float rstd = rsqrtf(ss * (1.f / 192.f) + EPS);
        if (tid < 192) qdn[(size_t)t * 192 + tid] = v * rstd * q_norm[tid];
    }
    {
        float v = tid < 128 ? p[1728 + tid] : 0.f;
        float ss = block_sum256(v * v, red);
        float rstd = rsqrtf(ss * (1.f / 128.f) + EPS);
        if (tid < 128) {
            float val = v * rstd * kv_norm[tid];
            ckv_cat[(size_t)t * 128 + tid] = val;
            if (!latent) out_ckv[(size_t)t * 128 + tid] = val;
        }
    }
    int row = (t & 4095) >> 6, col = t & 63;
    if (tid < 32) {
        float val;
        if (latent) {
            int i = tid & 7, part = tid >> 3;
            float inv = powf(10000.f, -(float)i / 8.f);
            float ang = (float)((part < 2) ? row : col) * inv;
            float cs = cosf(ang), sn = sinf(ang);
            int base = 1856 + (part >> 1) * 16;
            float x1 = p[base + i], x2 = p[base + 8 + i];
            val = (part & 1) ? (x1 * sn + x2 * cs) : (x1 * cs - x2 * sn);
        } else {
            val = p[1856 + tid];
        }
        kpe_all[(size_t)t * 32 + tid] = val;
        if (!latent) out_kpe[(size_t)t * 32 + tid] = val;
    }
    if (!latent) {
        int b = t >> 8, pos = t & 255;
        for (int e = tid; e < 512; e += 256) {
            int h = e >> 7, j = e & 127;
            size_t o = ((size_t)(b * 4 + h) * 256 + pos) * 128 + j;
            out_k[o] = p[512 + e];
            out_v[o] = p[1024 + e];
        }
    } else {
        for (int pr = tid; pr < 512; pr += 256) {
            int vec = pr >> 5, w = pr & 31, rc = w >> 4, i = w & 15;
            float inv = powf(10000.f, -(float)i / 16.f);
            float ang = (float)(rc ? col : row) * inv;
            float cs = cosf(ang), sn = sinf(ang);
            int i1 = vec * 64 + rc * 32 + i, i2 = i1 + 16;
            float x1 = p[i1], x2 = p[i2];
            p[i1] = x1 * cs - x2 * sn;
            p[i2] = x1 * sn + x2 * cs;
        }
    }
}

__global__ void __launch_bounds__(64) k_rope_qpe(float* __restrict__ qb) {
    int t = blockIdx.x, tid = threadIdx.x;
    int row = (t & 4095) >> 6, col = t & 63;
    int h = tid >> 4, w = tid & 15, rc = w >> 3, i = w & 7;
    float inv = powf(10000.f, -(float)i / 8.f);
    float ang = (float)(rc ? col : row) * inv;
    float cs = cosf(ang), sn = sinf(ang);
    float* p = qb + (size_t)t * 384 + h * 96 + 64 + rc * 16;
    float x1 = p[i], x2 = p[8 + i];
    p[i] = x1 * cs - x2 * sn;
    p[8 + i] = x1 * sn + x2 * cs;
}

__global__ void k_lam(const float* lq1, const float* lk1, const float* lq2, const float* lk2, float* lam) {
    int lane = threadIdx.x;
    float a = wave_sum(lq1[lane] * lk1[lane]);
    float b = wave_sum(lq2[lane] * lk2[lane]);
    if (lane == 0) lam[0] = expf(a) - expf(b) + 0.2f;
}

struct AttnP {
    const float* q; int q_ld, q_hs;
    const float* k1o; int k1o_ld, k1o_hs; const float* k1c; int k1c_ld, k1c_hs; int d1;
    const float* k2o; int k2o_ld, k2o_hs; const float* k2c; int k2c_ld, k2c_hs; int d2;
    const float* vo; int vo_ld, vo_hs; const float* vc; int vc_ld, vc_hs;
    float* o; int o_ld, o_hs;
    int L, ncache; float scale;
};
__global__ void __launch_bounds__(256) k_attn(AttnP p) {
    __shared__ float sc[8][4608];
    __shared__ float qs[8][96];
    __shared__ float rinv[8];
    int tid = threadIdx.x, h = blockIdx.y, t0 = blockIdx.x * 8;
    int seq = t0 / p.L, tok0 = seq * p.L, Lk = p.L + p.ncache;
    int dq = p.d1 + p.d2;
    for (int i = tid; i < 8 * dq; i += 256) {
        int r = i / dq, c = i % dq;
        qs[r][c] = p.q[(size_t)(t0 + r) * p.q_ld + h * p.q_hs + c];
    }
    __syncthreads();
    for (int j = tid; j < Lk; j += 256) {
        float acc[8];
#pragma unroll
        for (int r = 0; r < 8; ++r) acc[r] = 0.f;
        const float* ka = (j < p.ncache) ? p.k1c + (size_t)j * p.k1c_ld + h * p.k1c_hs
                                         : p.k1o + (size_t)(tok0 + j - p.ncache) * p.k1o_ld + h * p.k1o_hs;
        for (int c = 0; c < p.d1; c += 4) {
            float4 kv = *(const float4*)(ka + c);
#pragma unroll
            for (int r = 0; r < 8; ++r) acc[r] += qs[r][c] * kv.x + qs[r][c + 1] * kv.y + qs[r][c + 2] * kv.z + qs[r][c + 3] * kv.w;
        }
        if (p.d2) {
            const float* kb = (j < p.ncache) ? p.k2c + (size_t)j * p.k2c_ld + h * p.k2c_hs
                                             : p.k2o + (size_t)(tok0 + j - p.ncache) * p.k2o_ld + h * p.k2o_hs;
            for (int c = 0; c < p.d2; c += 4) {
                float4 kv = *(const float4*)(kb + c);
                int cc = p.d1 + c;
#pragma unroll
                for (int r = 0; r < 8; ++r) acc[r] += qs[r][cc] * kv.x + qs[r][cc + 1] * kv.y + qs[r][cc + 2] * kv.z + qs[r][cc + 3] * kv.w;
            }
        }
#pragma unroll
        for (int r = 0; r < 8; ++r) sc[r][j] = acc[r] * p.scale;
    }
    __syncthreads();
    {
        int w = tid >> 6, lane = tid & 63;
        for (int rr = 0; rr < 2; ++rr) {
            int r = w * 2 + rr;
            float mx = -3.0e38f;
            for (int j = lane; j < Lk; j += 64) mx = fmaxf(mx, sc[r][j]);
#pragma unroll
            for (int o = 32; o; o >>= 1) mx = fmaxf(mx, __shfl_xor(mx, o));
            float sm = 0.f;
            for (int j = lane; j < Lk; j += 64) { float e = expf(sc[r][j] - mx); sc[r][j] = e; sm += e; }
            sm = wave_sum(sm);
            if (lane == 0) rinv[r] = 1.f / sm;
        }
    }
    __syncthreads();
    {
        int c = tid & 127, rg = tid >> 7;
        float acc[4] = {0.f, 0.f, 0.f, 0.f};
        for (int j = 0; j < Lk; ++j) {
            const float* vr = (j < p.ncache) ? p.vc + (size_t)j * p.vc_ld + h * p.vc_hs
                                             : p.vo + (size_t)(tok0 + j - p.ncache) * p.vo_ld + h * p.vo_hs;
            float vv = vr[c];
#pragma unroll
            for (int i = 0; i < 4; ++i) acc[i] += sc[rg * 4 + i][j] * vv;
        }
#pragma unroll
        for (int i = 0; i < 4; ++i) {
            int r = rg * 4 + i;
            p.o[(size_t)(t0 + r) * p.o_ld + h * p.o_hs + c] = acc[i] * rinv[r];
        }
    }
}

__global__ void __launch_bounds__(128) k_diff_combine(const float* __restrict__ oa1, const float* __restrict__ oa2, const float* __restrict__ lam,
                                                     const float* __restrict__ subln, float* __restrict__ merged) {
    __shared__ float red[2];
    int t = blockIdx.x >> 2, h = blockIdx.x & 3, e = threadIdx.x;
    size_t i = (size_t)t * 512 + h * 128 + e;
    float x = oa1[i] - lam[0] * oa2[i];
    float ss = wave_sum(x * x);
    if ((e & 63) == 0) red[e >> 6] = ss;
    __syncthreads();
    ss = red[0] + red[1];
    merged[(size_t)t * DM + h * 128 + e] = x * rsqrtf(ss * (1.f / 128.f) + EPS) * subln[e] * 0.8f;
}

__global__ void __launch_bounds__(256) k_ffn_act(const float* __restrict__ u, const float* __restrict__ cw, const float* __restrict__ cb,
                                                float* __restrict__ act, int L) {
    size_t idx = (size_t)blockIdx.x * 256 + threadIdx.x;
    int t = (int)(idx / FF), f = (int)(idx % FF);
    int pos = t % L;
    const float* ur = u + (size_t)t * FF2;
    float g = cw[FF2 + f] * ur[f] + cb[f];
    float v = cw[FF2 + FF + f] * ur[FF + f] + cb[FF + f];
    if (pos > 0) { g += cw[f] * ur[f - FF2]; v += cw[FF + f] * ur[FF + f - FF2]; }
    if (pos < L - 1) { g += cw[2 * FF2 + f] * ur[f + FF2]; v += cw[2 * FF2 + FF + f] * ur[FF + f + FF2]; }
    act[idx] = silu_f(g) * v;
}

__global__ void __launch_bounds__(256) k_l1_post1(const float* __restrict__ proj, const float* __restrict__ mu,
                                                 const float* __restrict__ conv_w, const float* __restrict__ conv_b, const float* __restrict__ dt_bias,
                                                 float* __restrict__ zcm, float* __restrict__ tw, float* __restrict__ sg, float* __restrict__ xc, float* __restrict__ dt, int L) {
    int t = blockIdx.x, tid = threadIdx.x;
    int pos = t % L;
    const float* p = proj + (size_t)t * N1;
    bool hp = pos > 0, hn = pos < L - 1;
    for (int c = tid; c < CC; c += 256) {
        float z = p[c];
        float sh = 0.5f * ((hp ? p[c - N1] : 0.f) + (hn ? p[c + N1] : 0.f));
        float zm = z + mu[c] * (sh - z);
        zcm[(size_t)t * CC + c] = zm;
        if (c >= 1536 && c < 1664) tw[(size_t)t * 128 + (c - 1536)] = tanhf(zm);
        if (c >= 1792) sg[(size_t)t * 128 + (c - 1792)] = sigmoid_f(zm);
    }
    for (int c = tid; c < 768; c += 256) {
        int cc = CC + 512 + c;
        float x = conv_w[768 + c] * p[cc] + conv_b[c];
        if (hp) x += conv_w[c] * p[cc - N1];
        if (hn) x += conv_w[2 * 768 + c] * p[cc + N1];
        xc[(size_t)t * 768 + c] = silu_f(x);
    }
    if (tid < 16) {
        int i = tid >> 3, h = tid & 7;
        float x = p[CC + 1280 + h] + dt_bias[i * 8 + h];
        float sp = fmaxf(x, 0.f) + log1pf(expf(-fabsf(x)));
        dt[((size_t)i * CT + t) * 8 + h] = sp;
    }
}

__global__ void __launch_bounds__(256) k_l1_post2(const float* __restrict__ zcm, const float* __restrict__ k_k, const float* __restrict__ k_a,
                                                 const float* __restrict__ w0, const float* __restrict__ a0,
                                                 float* __restrict__ lw, float* __restrict__ la, float* __restrict__ ki, float* __restrict__ nkk) {
    int t = blockIdx.x, tid = threadIdx.x;
#pragma unroll
    for (int rep = 0; rep < 2; ++rep) {
        int c = tid + rep * 256;
        float k = zcm[(size_t)t * CC + 512 + c];
        float kkf = k * k_k[c];
        float ss = wave_sum(kkf * kkf);
        float kk = kkf * rsqrtf(ss + 1e-12f);
        nkk[(size_t)t * 512 + c] = -kk;
#pragma unroll
        for (int i = 0; i < 2; ++i) {
            size_t o = ((size_t)i * CT + t) * 512 + c;
            float w = expf(-0.606531f * sigmoid_f(w0[i * 512 + c] + lw[o]));
            float a = sigmoid_f(a0[i * 512 + c] + la[o]);
            lw[o] = w;
            la[o] = kk * a;
            ki[o] = k * (1.f + (a - 1.f) * k_a[c]);
        }
    }
}

__global__ void __launch_bounds__(64) k_wkv(const float* __restrict__ zcm, const float* __restrict__ w, const float* __restrict__ nkk,
                                           const float* __restrict__ bb, const float* __restrict__ ki,
                                           const float* __restrict__ S0f, const float* __restrict__ S0b,
                                           float* __restrict__ y, float* __restrict__ Sf_out, float* __restrict__ Sb_out, int L) {
    __shared__ float sh[6][16][64];
    int dir = blockIdx.x & 1, h = (blockIdx.x >> 1) & 7, seq = blockIdx.x >> 4;
    int lane = threadIdx.x;
    float S[64];
    const float* S0 = dir ? S0b : S0f;
    if (S0) {
#pragma unroll
        for (int k = 0; k < 64; ++k) S[k] = S0[(size_t)(h * 64 + lane) * 64 + k];
    } else {
#pragma unroll
        for (int k = 0; k < 64; ++k) S[k] = 0.f;
    }
    const float* wd = w + (size_t)dir * CT * 512;
    const float* bd = bb + (size_t)dir * CT * 512;
    const float* kd = ki + (size_t)dir * CT * 512;
    float* yd = y + (size_t)dir * CT * 512;
    for (int s0 = 0; s0 < L; s0 += 16) {
        __syncthreads();
#pragma unroll 4
        for (int i = 0; i < 16; ++i) {
            int s = s0 + i, pos = dir ? (L - 1 - s) : s, tok = seq * L + pos;
            size_t b5 = (size_t)tok * 512 + h * 64 + lane;
            sh[0][i][lane] = zcm[(size_t)tok * CC + h * 64 + lane];
            sh[1][i][lane] = wd[b5];
            sh[2][i][lane] = nkk[b5];
            sh[3][i][lane] = bd[b5];
            sh[4][i][lane] = kd[b5];
            sh[5][i][lane] = zcm[(size_t)tok * CC + 1024 + h * 64 + lane];
        }
        __syncthreads();
#pragma unroll 1
        for (int i = 0; i < 16; ++i) {
            int s = s0 + i, pos = dir ? (L - 1 - s) : s, tok = seq * L + pos;
            float vv = sh[5][i][lane];
            float sa = 0.f;
#pragma unroll
            for (int k = 0; k < 64; ++k) sa += S[k] * sh[2][i][k];
            float yy = 0.f;
#pragma unroll
            for (int k = 0; k < 64; ++k) {
                S[k] = S[k] * sh[1][i][k] + sa * sh[3][i][k] + vv * sh[4][i][k];
                yy += S[k] * sh[0][i][k];
            }
            yd[(size_t)tok * 512 + h * 64 + lane] = yy;
        }
    }
    float* So = dir ? Sb_out : Sf_out;
    if (So) {
#pragma unroll
        for (int k = 0; k < 64; ++k) So[((size_t)(seq * 8 + h) * 64 + lane) * 64 + k] = S[k];
    }
}

__global__ void __launch_bounds__(64) k_ssd(const float* __restrict__ xc, const float* __restrict__ dt, const float* __restrict__ A_log,
                                           const float* __restrict__ Dp, const float* __restrict__ S0f, const float* __restrict__ S0b,
                                           float* __restrict__ yd, float* __restrict__ Hf_out, float* __restrict__ Hb_out, int L) {
    __shared__ float shB[16][64];
    __shared__ float shC[16][64];
    __shared__ float shX[16][64];
    __shared__ float shDt[16];
    int dir = blockIdx.x & 1, h = (blockIdx.x >> 1) & 7, seq = blockIdx.x >> 4;
    int lane = threadIdx.x, g = h >> 2;
    float hs[64];
    const float* S0 = dir ? S0b : S0f;
    if (S0) {
#pragma unroll
        for (int n = 0; n < 64; ++n) hs[n] = S0[(size_t)(h * 64 + lane) * 64 + n];
    } else {
#pragma unroll
        for (int n = 0; n < 64; ++n) hs[n] = 0.f;
    }
    float A = -expf(A_log[dir * 8 + h]);
    float Dv = Dp[dir * 8 + h];
    const float* dtd = dt + (size_t)dir * CT * 8;
    float* yo = yd + (size_t)dir * CT * 512;
    for (int s0 = 0; s0 < L; s0 += 16) {
        __syncthreads();
#pragma unroll 4
        for (int i = 0; i < 16; ++i) {
            int s = s0 + i, pos = dir ? (L - 1 - s) : s, tok = seq * L + pos;
            const float* xr = xc + (size_t)tok * 768;
            shB[i][lane] = xr[512 + g * 64 + lane];
            shC[i][lane] = xr[640 + g * 64 + lane];
            shX[i][lane] = xr[h * 64 + lane];
            if (lane == 0) shDt[i] = dtd[(size_t)tok * 8 + h];
        }
        __syncthreads();
#pragma unroll 1
        for (int i = 0; i < 16; ++i) {
            int s = s0 + i, pos = dir ? (L - 1 - s) : s, tok = seq * L + pos;
            float d = shDt[i], x = shX[i][lane];
            float dA = expf(d * A), cf = d * x;
            float yy = 0.f;
#pragma unroll
            for (int n = 0; n < 64; ++n) {
                hs[n] = hs[n] * dA + cf * shB[i][n];
                yy += hs[n] * shC[i][n];
            }
            yo[(size_t)tok * 512 + h * 64 + lane] = yy + Dv * x;
        }
    }
    float* Ho = dir ? Hb_out : Hf_out;
    if (Ho) {
#pragma unroll
        for (int n = 0; n < 64; ++n) Ho[((size_t)(seq * 8 + h) * 64 + lane) * 64 + n] = hs[n];
    }
}

__global__ void __launch_bounds__(256) k_l1_combine(const float* __restrict__ y, const float* __restrict__ zcm, const float* __restrict__ g,
                                                   const float* __restrict__ r_k, const float* __restrict__ ln_w, const float* __restrict__ ln_b,
                                                   const float* __restrict__ yd, const float* __restrict__ proj, const float* __restrict__ gnorm,
                                                   float* __restrict__ merged) {
    __shared__ float red[4];
    int t = blockIdx.x, tid = threadIdx.x;
    float z[2];
#pragma unroll
    for (int rep = 0; rep < 2; ++rep) {
        int e = tid + rep * 256;
        size_t o = (size_t)t * 512 + e;
        float yy = y[o] + y[(size_t)CT * 512 + o];
        float mean = wave_sum(yy) * (1.f / 64.f);
        float dv = yy - mean;
        float var = wave_sum(dv * dv) * (1.f / 64.f);
        float yn = dv * rsqrtf(var + 64e-5f) * ln_w[e] + ln_b[e];
        float r = zcm[(size_t)t * CC + e], k = zcm[(size_t)t * CC + 512 + e], v = zcm[(size_t)t * CC + 1024 + e];
        float rk = wave_sum(r * k * r_k[e]);
        merged[(size_t)t * DM + e] = (yn + rk * v) * g[o];
        float zg = proj[(size_t)t * N1 + CC + e];
        z[rep] = (yd[o] + yd[(size_t)CT * 512 + o]) * silu_f(zg);
    }
    float ss = block_sum256(z[0] * z[0] + z[1] * z[1], red);
    float rstd = rsqrtf(ss * (1.f / 512.f) + EPS);
#pragma unroll
    for (int rep = 0; rep < 2; ++rep) {
        int e = tid + rep * 256;
        merged[(size_t)t * DM + 512 + e] = z[rep] * rstd * gnorm[e];
    }
}

inline void gemm(hipStream_t s, const float* A, int lda, const float* B, int ldb, float* C, int ldc, int M, int N, int K) {
    hipLaunchKernelGGL(k_gemm, dim3((N + 63) / 64, M / 64), dim3(256), 0, s, A, lda, B, ldb, C, ldc, M, N, K);
}
}

extern "C" void kernel_launch(void* const* d_in, const int* in_sizes, int n_in, void* d_out, int out_size, void* d_ws, size_t ws_size,
                              hipStream_t stream) {
    if (n_in != 59) return;
    const float* const* in = (const float* const*)d_in;
    float* out = (float*)d_out;
    float* ws = (float*)d_ws;
    float* o_yp = out;
    float* o_ys = o_yp + 16 * 256 * 1024;
    float* o_k = o_ys + 2 * 4096 * 1024;
    float* o_v = o_k + 16 * 4 * 256 * 128;
    float* o_ckv = o_v + 16 * 4 * 256 * 128;
    float* o_kpe = o_ckv + 16 * 256 * 128;
    float* o_wf = o_kpe + 16 * 256 * 32;
    float* o_wb = o_wf + 16 * 8 * 64 * 64;
    float* o_sf = o_wb + 16 * 8 * 64 * 64;
    float* o_sb = o_sf + 16 * 8 * 64 * 64;
    size_t off = 0;
    auto alloc = [&](size_t n) { float* p = ws + off; off += (n + 63) & ~(size_t)63; return p; };
    float* mod = alloc(2 * 3 * 6144);
    float* lam = alloc(64);
    float* h = alloc((size_t)CT * DM);
    float* R = ws + off;
    size_t roff = 0;
    auto ralloc = [&](size_t n) { float* p = R + roff; roff += (n + 63) & ~(size_t)63; return p; };
    float* hn = ralloc((size_t)CT * DM);
    float* proj = ralloc((size_t)CT * N1);
    float* zcm = ralloc((size_t)CT * CC);
    float* lw = ralloc((size_t)2 * CT * 512);
    float* la = ralloc((size_t)2 * CT * 512);
    float* ki = ralloc((size_t)2 * CT * 512);
    float* nkk = ralloc((size_t)CT * 512);
    float* gg = ralloc((size_t)CT * 512);
    float* yw = ralloc((size_t)2 * CT * 512);
    float* xc = ralloc((size_t)CT * 768);
    float* ydd = ralloc((size_t)2 * CT * 512);
    float* dt = ralloc((size_t)2 * CT * 8);
    float* tw = ralloc((size_t)CT * 128);
    float* sg = ralloc((size_t)CT * 128);
    float* l0base = zcm;
    size_t loff = 0;
    auto lalloc = [&](size_t n) { float* p = l0base + loff; loff += (n + 63) & ~(size_t)63; return p; };
    float* qdn = lalloc((size_t)CT * 192);
    float* qb = lalloc((size_t)CT * 384);
    float* ckv_cat = lalloc((size_t)(CT + 512) * 128);
    float* kpe_all = lalloc((size_t)(CT + 512) * 32);
    float* kv_cat = lalloc((size_t)(CT + 512) * 768);
    float* oa1 = lalloc((size_t)CT * 512);
    float* oa2 = lalloc((size_t)CT * 512);
    float* merged = hn;
    float* mm = proj;
    float* u = R;
    float* act = u + (size_t)CT * FF2;
    float* dd = act + (size_t)CT * FF;

    hipLaunchKernelGGL(k_ada, dim3(2 * 3 * 6144 / 256), dim3(256), 0, stream, in[10], in[11], in[12], in[13], in[31], in[32], mod);
    hipLaunchKernelGGL(k_lam, dim3(1), dim3(64), 0, stream, in[21], in[22], in[23], in[24], lam);

    for (int ch = 0; ch < 3; ++ch) {
        const bool latent = ch > 0;
        const int b = ch - 1;
        const int L = latent ? 4096 : 256, nseq = latent ? 1 : 16, ncache = latent ? 512 : 0;
        const float* x = latent ? in[1] + (size_t)b * CT * DM : in[0];
        float* yout = latent ? o_ys + (size_t)b * CT * DM : o_yp;
        hipMemcpyAsync(h, x, (size_t)CT * DM * 4, hipMemcpyDeviceToDevice, stream);
        for (int l = 0; l < 2; ++l) {
            const int cb = l ? 31 : 12;
            const float* md = mod + (size_t)(l * 3 + ch) * 6144;
            hipLaunchKernelGGL(k_normmod, dim3(CT), dim3(256), 0, stream, h, in[cb + 2], md + 0, md + 1024, hn);
            if (l == 0) {
                gemm(stream, hn, DM, in[20], N0, proj, N0, CT, N0, DM);
                hipLaunchKernelGGL(k_l0_post, dim3(CT), dim3(256), 0, stream, proj, in[26], in[28], qdn, ckv_cat, kpe_all, o_k, o_v, o_ckv, o_kpe, latent ? 1 : 0);
                gemm(stream, qdn, 192, in[27], 384, qb, 384, CT, 384, 192);
                if (latent) {
                    hipLaunchKernelGGL(k_rope_qpe, dim3(CT), dim3(64), 0, stream, qb);
                    hipMemcpyAsync(ckv_cat + (size_t)CT * 128, in[4] + (size_t)b * 512 * 128, 512 * 128 * 4, hipMemcpyDeviceToDevice, stream);
                    hipMemcpyAsync(kpe_all + (size_t)CT * 32, in[5] + (size_t)b * 512 * 32, 512 * 32 * 4, hipMemcpyDeviceToDevice, stream);
                }
                gemm(stream, ckv_cat, 128, in[29], 768, kv_cat, 768, CT + ncache, 768, 128);
                AttnP p{};
                p.L = L; p.ncache = ncache;
                for (int mp = 0; mp < 2; ++mp) {
                    p.q = proj + mp * 64; p.q_ld = N0; p.q_hs = 128;
                    p.k1o = proj + 512 + mp * 64; p.k1o_ld = N0; p.k1o_hs = 128;
                    p.k1c = latent ? in[2] + (size_t)b * 4 * 512 * 128 + mp * 64 : nullptr; p.k1c_ld = 128; p.k1c_hs = 512 * 128; p.d1 = 64;
                    p.k2o = nullptr; p.k2c = nullptr; p.d2 = 0; p.k2o_ld = p.k2o_hs = p.k2c_ld = p.k2c_hs = 0;
                    p.vo = proj + 1024; p.vo_ld = N0; p.vo_hs = 128;
                    p.vc = latent ? in[3] + (size_t)b * 4 * 512 * 128 : nullptr; p.vc_ld = 128; p.vc_hs = 512 * 128;
                    p.o = mp ? oa2 : oa1; p.o_ld = 512; p.o_hs = 128;
                    p.scale = 0.125f;
                    hipLaunchKernelGGL(k_attn, dim3(CT / 8, 4), dim3(256), 0, stream, p);
                }
                p.q = qb; p.q_ld = 384; p.q_hs = 96;
                p.k1o = kv_cat; p.k1o_ld = 768; p.k1o_hs = 192; p.k1c = kv_cat + (size_t)CT * 768; p.k1c_ld = 768; p.k1c_hs = 192; p.d1 = 64;
                p.k2o = kpe_all; p.k2o_ld = 32; p.k2o_hs = 0; p.k2c = kpe_all + (size_t)CT * 32; p.k2c_ld = 32; p.k2c_hs = 0; p.d2 = 32;
                p.vo = kv_cat + 64; p.vo_ld = 768; p.vo_hs = 192; p.vc = kv_cat + (size_t)CT * 768 + 64; p.vc_ld = 768; p.vc_hs = 192;
                p.o = merged + 512; p.o_ld = DM; p.o_hs = 128;
                p.scale = 0.10206207261596577f;
                hipLaunchKernelGGL(k_attn, dim3(CT / 8, 4), dim3(256), 0, stream, p);
                hipLaunchKernelGGL(k_diff_combine, dim3(CT * 4), dim3(128), 0, stream, oa1, oa2, lam, in[25], merged);
                gemm(stream, merged, DM, in[30], DM, mm, DM, CT, DM, DM);
            } else {
                gemm(stream, hn, DM, in[39], N1, proj, N1, CT, N1, DM);
                hipLaunchKernelGGL(k_l1_post1, dim3(CT), dim3(256), 0, stream, proj, in[40], in[51], in[52], in[54], zcm, tw, sg, xc, dt, L);
                for (int i = 0; i < 2; ++i) {
                    gemm(stream, tw + i * 64, 128, in[42] + (size_t)i * 64 * 512, 512, lw + (size_t)i * CT * 512, 512, CT, 512, 64);
                    gemm(stream, zcm + 1664 + i * 64, CC, in[44] + (size_t)i * 64 * 512, 512, la + (size_t)i * CT * 512, 512, CT, 512, 64);
                }
                gemm(stream, sg, 128, in[45], 512, gg, 512, CT, 512, 128);
                hipLaunchKernelGGL(k_l1_post2, dim3(CT), dim3(256), 0, stream, zcm, in[46], in[47], in[41], in[43], lw, la, ki, nkk);
                const float* s0f = latent ? in[6] + (size_t)b * 8 * 4096 : nullptr;
                const float* s0b = latent ? in[7] + (size_t)b * 8 * 4096 : nullptr;
                const float* h0f = latent ? in[8] + (size_t)b * 8 * 4096 : nullptr;
                const float* h0b = latent ? in[9] + (size_t)b * 8 * 4096 : nullptr;
                hipLaunchKernelGGL(k_wkv, dim3(nseq * 16), dim3(64), 0, stream, zcm, lw, nkk, la, ki, s0f, s0b, yw,
                                   latent ? nullptr : o_wf, latent ? nullptr : o_wb, L);
                hipLaunchKernelGGL(k_ssd, dim3(nseq * 16), dim3(64), 0, stream, xc, dt, in[53], in[55], h0f, h0b, ydd,
                                   latent ? nullptr : o_sf, latent ? nullptr : o_sb, L);
                hipLaunchKernelGGL(k_l1_combine, dim3(CT), dim3(256), 0, stream, yw, zcm, gg, in[48], in[49], in[50], ydd, proj, in[56], merged);
                gemm(stream, merged, DM, in[57], DM, mm, DM, CT, DM, DM);
            }
            hipLaunchKernelGGL(k_resid, dim3(CT * DM / 1024), dim3(256), 0, stream, h, mm, md + 2048);
            hipLaunchKernelGGL(k_normmod, dim3(CT), dim3(256), 0, stream, h, in[cb + 3], md + 3072, md + 4096, dd);
            gemm(stream, dd, DM, in[cb + 4], FF2, u, FF2, CT, FF2, DM);
            hipLaunchKernelGGL(k_ffn_act, dim3((unsigned)((size_t)CT * FF / 256)), dim3(256), 0, stream, u, in[cb + 5], in[cb + 6], act, L);
            gemm(stream, act, FF, in[cb + 7], DM, dd, DM, CT, DM, FF);
            hipLaunchKernelGGL(k_resid, dim3(CT * DM / 1024), dim3(256), 0, stream, h, dd, md + 5120);
        }
        hipLaunchKernelGGL(k_normmod, dim3(CT), dim3(256), 0, stream, h, in[58], (const float*)nullptr, (const float*)nullptr, yout);
    }
}
```

```cpp
#include <hip/hip_runtime.h>
#include <math.h>

namespace {
constexpr int DM = 1024, FF = 2816, FF2 = 5632;
constexpr int N0 = 1888, N1 = 3208, CC = 1920;
constexpr int TT = 12288;
constexpr float EPS = 1e-6f;
constexpr int LDS_BYTES = 151040;
#ifndef REP_UP
#define REP_UP 1
#endif
#ifndef REP_FLASH
#define REP_FLASH 1
#endif
#ifndef REP_W567
#define REP_W567 1
#endif
#ifndef REP_W2
#define REP_W2 1
#endif
#ifndef REP_W4
#define REP_W4 1
#endif
#ifndef REP_P0
#define REP_P0 1
#endif
#ifndef REP_SCAN
#define REP_SCAN 1
#endif

__device__ __forceinline__ int tid_opaque() { int t = threadIdx.x; asm volatile("" : "+v"(t)); return t; }
#define TIDX tid_opaque()

#define XB_TMO      128
#define XB_XCNT(j)  (256  + 64 * (j))
#define XB_XSUB(j)  (1280 + 64 * (j))
#define XB_XGEN(j)  (2304 + 64 * (j))
#define XB_TOP      3328
#define XB_TOPGEN   3392
#define XCD_BAR_WORDS 3456
#define XB_SPIN_CAP (1u << 22)
#define LAS __attribute__((address_space(3)))
__device__ __forceinline__ unsigned xb_ld(unsigned* p)              { return __hip_atomic_load(p, __ATOMIC_RELAXED, __HIP_MEMORY_SCOPE_AGENT); }
__device__ __forceinline__ unsigned xb_add(unsigned* p, unsigned v) { return __hip_atomic_fetch_add(p, v, __ATOMIC_RELAXED, __HIP_MEMORY_SCOPE_AGENT); }
__device__ __forceinline__ unsigned xb_xcc_id() { return (unsigned)__builtin_amdgcn_s_getreg((3 << 11) | 20) & 0xFu; }
#define XB_SPIN(cond, bar) do { unsigned _sp = 0; while (cond) { __builtin_amdgcn_s_sleep(1); \
    if ((++_sp & 255u) == 0u) { if (xb_ld(&(bar)[XB_TMO])) break; if (_sp > XB_SPIN_CAP) { atomicAdd(&(bar)[XB_TMO], 1u); break; } } } } while (0)
struct XcdBarrier { unsigned* bar; unsigned x; volatile LAS unsigned* st; };
__device__ __forceinline__ XcdBarrier xcd_barrier_post(unsigned* bar, volatile LAS unsigned* st) {
    XcdBarrier b; b.bar = bar; b.x = xb_xcc_id(); b.st = st;
    if (TIDX == 0) st[2] = xb_add(&bar[XB_XCNT(b.x)], 1u);
    return b;
}
__device__ __forceinline__ void xcd_barrier_complete(unsigned* bar, unsigned x, unsigned& nloc, unsigned& nx) {
    asm volatile("" : "+s"(x));
    const unsigned G = gridDim.x * gridDim.y * gridDim.z;
    unsigned sum, cnt, mine, sp = 0u;
    for (;;) {
        sum = 0u; cnt = 0u; mine = 0u;
#pragma unroll
        for (unsigned j = 0; j < 16; ++j) { const unsigned c = xb_ld(&bar[XB_XCNT(j)]); sum += c; cnt += (c > 0u) ? 1u : 0u; mine = (j == x) ? c : mine; }
        if (sum == G) break;
        __builtin_amdgcn_s_sleep(1);
        if ((++sp & 255u) == 0u) { if (xb_ld(&bar[XB_TMO])) break; if (sp > XB_SPIN_CAP) { atomicAdd(&bar[XB_TMO], 1u); break; } }
    }
    nloc = mine > 0u ? mine : 1u; nx = cnt > 0u ? cnt : 1u;
}
__device__ __forceinline__ int xcd_hw_index(const XcdBarrier& b) {
    if (TIDX == 0) {
        bool ok = gridDim.x == 256u;
#pragma unroll
        for (unsigned j = 0; j < 16; ++j) { const unsigned c = xb_ld(&b.bar[XB_XCNT(j)]); ok = ok && (j < 8u ? c == 32u : c == 0u); }
        const unsigned rank = b.st[2];
        b.st[3] = (ok && rank < 32u && b.x < 8u) ? rank * 8u + b.x : 0xFFFFFFFFu;
    }
    __syncthreads();
    const int r = (int)b.st[3];
    __syncthreads();
    return r;
}
__device__ __forceinline__ void xcd_barrier(const XcdBarrier& b) {
    asm volatile("s_waitcnt vmcnt(0)" ::: "memory");
    __syncthreads();
    if (TIDX == 0) {
        unsigned* bar = b.bar;
        __builtin_amdgcn_s_waitcnt(0);
        unsigned nloc = b.st[0], nx = b.st[1];
        if (nloc == 0u) { xcd_barrier_complete(bar, b.x, nloc, nx); b.st[0] = nloc; b.st[1] = nx; }
        const unsigned old = xb_add(&bar[XB_XSUB(b.x)], 1u);
        const unsigned gen = old / nloc;
        if (old + 1u == (gen + 1u) * nloc) {
            __builtin_amdgcn_fence(__ATOMIC_RELEASE, "agent");
            asm volatile("s_waitcnt vmcnt(0)" ::: "memory");
            const unsigned og = xb_add(&bar[XB_TOP], 1u);
            const unsigned tg = og / nx;
            if (og + 1u == (tg + 1u) * nx) xb_add(&bar[XB_TOPGEN], 1u);
            else XB_SPIN(xb_ld(&bar[XB_TOPGEN]) == tg, bar);
            __builtin_amdgcn_fence(__ATOMIC_ACQUIRE, "agent");
            xb_add(&bar[XB_XGEN(b.x)], 1u);
            asm volatile("s_waitcnt vmcnt(0)" ::: "memory");
        } else {
            XB_SPIN(xb_ld(&bar[XB_XGEN(b.x)]) == gen, bar);
            __builtin_amdgcn_fence(__ATOMIC_ACQUIRE, "agent");
            asm volatile("s_waitcnt vmcnt(0)" ::: "memory");
        }
    }
    __syncthreads();
}

__device__ __forceinline__ float silu_f(float x) { return x / (1.f + expf(-x)); }
__device__ __forceinline__ float sigmoid_f(float x) { return 1.f / (1.f + expf(-x)); }
template <int CTRL> __device__ __forceinline__ float dpp_mov(float x) {
    return __builtin_bit_cast(float, __builtin_amdgcn_mov_dpp(__builtin_bit_cast(int, x), CTRL, 0xF, 0xF, true));
}
__device__ __forceinline__ float wave_sum(float v) {
    v += dpp_mov<0xB1>(v);
    v += dpp_mov<0x4E>(v);
    v += dpp_mov<0x141>(v);
    v += dpp_mov<0x140>(v);
    v += __builtin_bit_cast(float, __builtin_amdgcn_update_dpp(0, __builtin_bit_cast(int, v), 0x142, 0xA, 0xF, false));
    v += __builtin_bit_cast(float, __builtin_amdgcn_update_dpp(0, __builtin_bit_cast(int, v), 0x143, 0xC, 0xF, false));
    return __builtin_bit_cast(float, __builtin_amdgcn_readlane(__builtin_bit_cast(int, v), 63));
}
__device__ __forceinline__ float block_sum256(float v, float* sh) {
    v = wave_sum(v);
    __syncthreads();
    if ((TIDX & 63) == 0) sh[TIDX >> 6] = v;
    __syncthreads();
    return sh[0] + sh[1] + sh[2] + sh[3];
}

template <int NT>
__device__ __forceinline__ void n_ada(const float* __restrict__ c, const float* __restrict__ c_ctx, const float* __restrict__ W0, const float* __restrict__ b0,
                                      const float* __restrict__ W1, const float* __restrict__ b1, float* __restrict__ mod, int vb, float* lds) {
    const int tid = TIDX, col = tid & 63, kp = tid >> 6;
    const int l = vb / 96, j = (vb % 96) * 64 + col;
    const float* W = (l ? W1 : W0) + j;
    float* sc = lds + 2048;
    __syncthreads();
    for (int i = tid; i < 3072; i += NT) sc[i] = silu_f(i < 1024 ? c_ctx[i] : c[i - 1024]);
    __syncthreads();
    float s0 = 0.f, s1 = 0.f, s2 = 0.f;
#pragma unroll 1
    for (int k0 = kp * 128; k0 < kp * 128 + 128; k0 += 32) {
        float w[32];
#pragma unroll
        for (int u = 0; u < 32; ++u) w[u] = W[(size_t)(k0 + u) * 6144];
#pragma unroll
        for (int u = 0; u < 32; ++u) { s0 += sc[k0 + u] * w[u]; s1 += sc[1024 + k0 + u] * w[u]; s2 += sc[2048 + k0 + u] * w[u]; }
    }
    __syncthreads();
    lds[(kp * 3 + 0) * 64 + col] = s0; lds[(kp * 3 + 1) * 64 + col] = s1; lds[(kp * 3 + 2) * 64 + col] = s2;
    __syncthreads();
    if (tid < 192) {
        const int ci = tid >> 6;
        float s = 0.f;
#pragma unroll
        for (int q = 0; q < 8; ++q) s += lds[(q * 3 + ci) * 64 + col];
        mod[(size_t)(l * 3 + ci) * 6144 + j] = s + (l ? b1 : b0)[j];
    }
}

typedef __attribute__((ext_vector_type(8))) short bf16x8;
typedef __attribute__((ext_vector_type(4))) float f32x4;
typedef __attribute__((ext_vector_type(2))) __bf16 bf16x2_t;
typedef __attribute__((ext_vector_type(2))) float f32x2_t;
typedef unsigned short bf16_t;
typedef __attribute__((ext_vector_type(4))) unsigned u32x4;
__device__ __forceinline__ unsigned pk_bf16(float a, float b) {
    bf16x2_t v = __builtin_convertvector((f32x2_t){a, b}, bf16x2_t);
    return __builtin_bit_cast(unsigned, v);
}
__device__ __forceinline__ int gt_lds_byte(int r, int c) {
    const int st = (r >> 4) * 2 + (c >> 5), ob = (r & 15) * 64 + (c & 31) * 2;
    return st * 1024 + (ob ^ (((ob >> 9) & 1) << 5));
}
template <int BM, int BN, int NT, class AL, class EP, int WN = BN / 64>
__device__ __forceinline__ void gemm_tile(const AL& al, const bf16_t* __restrict__ Wt, int K, int m0, int n0, const EP& ep, char* lds) {
    constexpr int NW = NT / 64, NJ = BN / WN / 16;
    constexpr int A_L = BM / 8 / NW, B_L = BN / 8 / NW;
    static_assert((BM / 64) * WN * 64 == NT && (NJ == 4 || NJ == 2), "wave layout");
    char* As = lds;
    char* Bs = lds + 3 * BM * 128;
    const int tid = TIDX, lane = tid & 63, wv = tid >> 6, wr = wv / WN, wc = wv % WN;
    f32x4 acc[4][NJ];
#pragma unroll
    for (int i = 0; i < 4; ++i)
#pragma unroll
        for (int j = 0; j < NJ; ++j) acc[i][j] = (f32x4){0.f, 0.f, 0.f, 0.f};
    const int sb = lane * 16, swz = sb ^ (((sb >> 9) & 1) << 5), lr = swz >> 6, lc = (swz & 63) >> 1;
    const bf16_t* ap[A_L];
    const bf16_t* bp[B_L];
#pragma unroll
    for (int i = 0; i < A_L; ++i) { const int st = wv + NW * i; ap[i] = al.ptr(m0 + (st >> 1) * 16 + lr, (st & 1) * 32 + lc); }
#pragma unroll
    for (int i = 0; i < B_L; ++i) { const int st = wv + NW * i; bp[i] = Wt + (size_t)(n0 + (st >> 1) * 16 + lr) * K + (st & 1) * 32 + lc; }
#define GT_STAGE(buf_, k0_) { \
        _Pragma("unroll") for (int i_ = 0; i_ < A_L; ++i_) \
            __builtin_amdgcn_global_load_lds((const unsigned*)(ap[i_] + (k0_)), (__attribute__((address_space(3))) unsigned*)(As + (buf_) * BM * 128 + (wv + NW * i_) * 1024), 16, 0, 0); \
        _Pragma("unroll") for (int i_ = 0; i_ < B_L; ++i_) \
            __builtin_amdgcn_global_load_lds((const unsigned*)(bp[i_] + (k0_)), (__attribute__((address_space(3))) unsigned*)(Bs + (buf_) * BN * 128 + (wv + NW * i_) * 1024), 16, 0, 0); }
    __syncthreads();
    const int nk = K / 64;
    GT_STAGE(0, 0)
    if (nk > 1) GT_STAGE(1, 64)
    const int fr = lane & 15, fq = lane >> 4;
    for (int kt = 0; kt < nk; ++kt) {
        if (kt + 1 < nk) asm volatile("s_waitcnt vmcnt(%0)" :: "n"(A_L + B_L) : "memory");
        else             asm volatile("s_waitcnt vmcnt(0)" ::: "memory");
        asm volatile("s_waitcnt lgkmcnt(0)" ::: "memory");
        __builtin_amdgcn_s_barrier();
        asm volatile("" ::: "memory");
        const int cb = kt % 3;
        if (kt + 2 < nk) { const int nb_ = (kt + 2) % 3; GT_STAGE(nb_, (kt + 2) * 64) }
        const char* Ab = As + cb * BM * 128;
        const char* Bb = Bs + cb * BN * 128;
        {
            u32x4 x0, x1, x2, x3, x4, x5, x6, x7, y0, y1, y2, y3, y4, y5, y6, y7;
            const unsigned aa0 = (unsigned)(size_t)(Ab + gt_lds_byte(wr * 64 + 0 + fr, fq * 8)), aa1 = (unsigned)(size_t)(Ab + gt_lds_byte(wr * 64 + 16 + fr, fq * 8));
            const unsigned aa2 = (unsigned)(size_t)(Ab + gt_lds_byte(wr * 64 + 32 + fr, fq * 8)), aa3 = (unsigned)(size_t)(Ab + gt_lds_byte(wr * 64 + 48 + fr, fq * 8));
            const unsigned ab0 = (unsigned)(size_t)(Bb + gt_lds_byte(wc * (16 * NJ) + 0 + fr, fq * 8)), ab1 = (unsigned)(size_t)(Bb + gt_lds_byte(wc * (16 * NJ) + 16 + fr, fq * 8));
            if constexpr (NJ == 4) {
                const unsigned ab2 = (unsigned)(size_t)(Bb + gt_lds_byte(wc * (16 * NJ) + 32 + fr, fq * 8)), ab3 = (unsigned)(size_t)(Bb + gt_lds_byte(wc * (16 * NJ) + 48 + fr, fq * 8));
                asm volatile("ds_read_b128 %0, %16\n\tds_read_b128 %1, %17\n\tds_read_b128 %2, %18\n\tds_read_b128 %3, %19\n\t"
                             "ds_read_b128 %4, %20\n\tds_read_b128 %5, %21\n\tds_read_b128 %6, %22\n\tds_read_b128 %7, %23\n\t"
                             "ds_read_b128 %8, %16 offset:1024\n\tds_read_b128 %9, %17 offset:1024\n\tds_read_b128 %10, %18 offset:1024\n\tds_read_b128 %11, %19 offset:1024\n\t"
                             "ds_read_b128 %12, %20 offset:1024\n\tds_read_b128 %13, %21 offset:1024\n\tds_read_b128 %14, %22 offset:1024\n\tds_read_b128 %15, %23 offset:1024\n\t"
                             "s_waitcnt lgkmcnt(8)"
                             : "=&v"(x0), "=&v"(x1), "=&v"(x2), "=&v"(x3), "=&v"(x4), "=&v"(x5), "=&v"(x6), "=&v"(x7),
                               "=&v"(y0), "=&v"(y1), "=&v"(y2), "=&v"(y3), "=&v"(y4), "=&v"(y5), "=&v"(y6), "=&v"(y7)
                             : "v"(aa0), "v"(aa1), "v"(aa2), "v"(aa3), "v"(ab0), "v"(ab1), "v"(ab2), "v"(ab3) : "memory");
            } else {
                asm volatile("ds_read_b128 %0, %12\n\tds_read_b128 %1, %13\n\tds_read_b128 %2, %14\n\tds_read_b128 %3, %15\n\t"
                             "ds_read_b128 %4, %16\n\tds_read_b128 %5, %17\n\t"
                             "ds_read_b128 %6, %12 offset:1024\n\tds_read_b128 %7, %13 offset:1024\n\tds_read_b128 %8, %14 offset:1024\n\tds_read_b128 %9, %15 offset:1024\n\t"
                             "ds_read_b128 %10, %16 offset:1024\n\tds_read_b128 %11, %17 offset:1024\n\t"
                             "s_waitcnt lgkmcnt(6)"
                             : "=&v"(x0), "=&v"(x1), "=&v"(x2), "=&v"(x3), "=&v"(x4), "=&v"(x5),
                               "=&v"(y0), "=&v"(y1), "=&v"(y2), "=&v"(y3), "=&v"(y4), "=&v"(y5)
                             : "v"(aa0), "v"(aa1), "v"(aa2), "v"(aa3), "v"(ab0), "v"(ab1) : "memory");
            }
            const bf16x8 a0[4] = {__builtin_bit_cast(bf16x8, x0), __builtin_bit_cast(bf16x8, x1), __builtin_bit_cast(bf16x8, x2), __builtin_bit_cast(bf16x8, x3)};
#pragma unroll
            for (int i = 0; i < 4; ++i) {
                acc[i][0] = __builtin_amdgcn_mfma_f32_16x16x32_bf16(__builtin_bit_cast(bf16x8, x4), a0[i], acc[i][0], 0, 0, 0);
                acc[i][1] = __builtin_amdgcn_mfma_f32_16x16x32_bf16(__builtin_bit_cast(bf16x8, x5), a0[i], acc[i][1], 0, 0, 0);
                if constexpr (NJ == 4) {
                    acc[i][2] = __builtin_amdgcn_mfma_f32_16x16x32_bf16(__builtin_bit_cast(bf16x8, x6), a0[i], acc[i][2], 0, 0, 0);
                    acc[i][3] = __builtin_amdgcn_mfma_f32_16x16x32_bf16(__builtin_bit_cast(bf16x8, x7), a0[i], acc[i][3], 0, 0, 0);
                }
            }
            if constexpr (NJ == 4)
                asm volatile("s_waitcnt lgkmcnt(0)" : "+v"(y0), "+v"(y1), "+v"(y2), "+v"(y3), "+v"(y4), "+v"(y5), "+v"(y6), "+v"(y7), "+v"(acc[3][3]) :: "memory");
            else
                asm volatile("s_waitcnt lgkmcnt(0)" : "+v"(y0), "+v"(y1), "+v"(y2), "+v"(y3), "+v"(y4), "+v"(y5), "+v"(acc[3][1]) :: "memory");
            const bf16x8 a1[4] = {__builtin_bit_cast(bf16x8, y0), __builtin_bit_cast(bf16x8, y1), __builtin_bit_cast(bf16x8, y2), __builtin_bit_cast(bf16x8, y3)};
#pragma unroll
            for (int i = 0; i < 4; ++i) {
                acc[i][0] = __builtin_amdgcn_mfma_f32_16x16x32_bf16(__builtin_bit_cast(bf16x8, y4), a1[i], acc[i][0], 0, 0, 0);
                acc[i][1] = __builtin_amdgcn_mfma_f32_16x16x32_bf16(__builtin_bit_cast(bf16x8, y5), a1[i], acc[i][1], 0, 0, 0);
                if constexpr (NJ == 4) {
                    acc[i][2] = __builtin_amdgcn_mfma_f32_16x16x32_bf16(__builtin_bit_cast(bf16x8, y6), a1[i], acc[i][2], 0, 0, 0);
                    acc[i][3] = __builtin_amdgcn_mfma_f32_16x16x32_bf16(__builtin_bit_cast(bf16x8, y7), a1[i], acc[i][3], 0, 0, 0);
                }
            }
        }
    }
    __syncthreads();
#undef GT_STAGE
    if constexpr (NJ == 4) ep.template run<BM, BN, NT>(acc, m0, n0, wr, wc, lane, lds);
    else ep.template run<BM, BN, NT, NJ>(acc, m0, n0, wr, wc, lane, lds);
}

template <int NT, class AL, class EP, int MH = 128>
__device__ __forceinline__ void gemm256_tile(const AL& al, const bf16_t* __restrict__ Wt, const int K, const int n0, const EP& ep, char* lds) {
    static_assert(NT == 512 && (MH == 128 || MH == 96), "gemm256_tile needs 8 waves; A halves of 128 or 96 rows");
    constexpr int NM = MH / 32;
    constexpr int HB = 128 * 64 * 2;
    const int tid = TIDX, lane = tid & 63, wid = tid >> 6, wr = wid >> 2, wc = wid & 3, fr = lane & 15, fq = lane >> 4;
    const int sb = lane * 16, swz = sb ^ (((sb >> 9) & 1) << 5);
    const int R0 = (wid >> 1) * 16 + (swz >> 6), C0 = (wid & 1) * 32 + ((swz & 63) >> 1);
    const unsigned ao00 = al.boff(R0, C0), ao10 = al.boff(R0 + MH, C0);
    const unsigned ao01 = (R0 + 64 < MH) ? al.boff(R0 + 64, C0) : ao00, ao11 = (R0 + 64 < MH) ? al.boff(R0 + MH + 64, C0) : ao10;
    const unsigned bo = (unsigned)(R0 * K + C0) * 2u;
    const char* const abase = al.ubase();
    const char* const bbase = (const char*)(Wt + (size_t)n0 * K);
    const size_t bK64 = (size_t)64 * K * 2;
    const unsigned stg = (unsigned)(size_t)lds + (unsigned)__builtin_amdgcn_readfirstlane(wid) * 1024u;
    f32x4 acc[2][2][NM][2];
#pragma unroll
    for (int a = 0; a < 2; ++a)
#pragma unroll
        for (int b = 0; b < 2; ++b)
#pragma unroll
            for (int m = 0; m < NM; ++m)
#pragma unroll
                for (int n = 0; n < 2; ++n) acc[a][b][m][n] = (f32x4){0.f, 0.f, 0.f, 0.f};
    bf16x8 At[NM][2], B0[2][2], B1[2][2];
#define G8_SA(b_, h_) (((b_) * 2 + (h_)) * HB)
#define G8_SB(b_, h_) ((4 + (b_) * 2 + (h_)) * HB)
#define G8_GLDS(vo_, sb_, m0_) asm volatile("s_mov_b32 m0, %2\n\tglobal_load_lds_dwordx4 %0, %1" :: "v"(vo_), "s"(sb_), "s"(m0_) : "memory", "m0")
#define G8_STAGE_A(b_, h_, kt_) { const char* kb_ = abase + (size_t)(kt_) * 128; \
        G8_GLDS(((h_) ? ao10 : ao00), kb_, stg + G8_SA(b_, h_)); G8_GLDS(((h_) ? ao11 : ao01), kb_, stg + G8_SA(b_, h_) + 8192); }
#define G8_STAGE_B(b_, h_, kt_) { const char* kb_ = bbase + (size_t)((h_) * 2) * bK64 + (size_t)(kt_) * 128; const char* kb2_ = kb_ + bK64; \
        G8_GLDS(bo, kb_, stg + G8_SB(b_, h_)); G8_GLDS(bo, kb2_, stg + G8_SB(b_, h_) + 8192); }
#define G8_LDA(b_, h_) { _Pragma("unroll") for (int m = 0; m < NM; ++m) _Pragma("unroll") for (int k = 0; k < 2; ++k) \
        At[m][k] = *(const bf16x8*)(lds + G8_SA(b_, h_) + gt_lds_byte(wr * (MH / 2) + m * 16 + fr, k * 32 + fq * 8)); }
#define G8_LDB(dst_, b_, h_) { _Pragma("unroll") for (int n = 0; n < 2; ++n) _Pragma("unroll") for (int k = 0; k < 2; ++k) \
        dst_[n][k] = *(const bf16x8*)(lds + G8_SB(b_, h_) + gt_lds_byte(wc * 32 + n * 16 + fr, k * 32 + fq * 8)); }
#define G8_MMA(ai_, bj_, Bx_) { __builtin_amdgcn_s_setprio(1); \
        _Pragma("unroll") for (int m = 0; m < NM; ++m) _Pragma("unroll") for (int n = 0; n < 2; ++n) _Pragma("unroll") for (int k = 0; k < 2; ++k) \
            acc[ai_][bj_][m][n] = __builtin_amdgcn_mfma_f32_16x16x32_bf16(Bx_[n][k], At[m][k], acc[ai_][bj_][m][n], 0, 0, 0); \
        __builtin_amdgcn_s_setprio(0); }
#define G8_WAIT_V(n_) asm volatile("s_waitcnt vmcnt(" #n_ ")" ::: "memory")
#define G8_WAIT_L(n_) asm volatile("s_waitcnt lgkmcnt(" #n_ ")" ::: "memory")
#define G8_WAIT_LA { if constexpr (NM == 4) { G8_WAIT_L(8); } else { G8_WAIT_L(6); } }
#define G8_BAR __builtin_amdgcn_s_barrier()
#define G8_SCHED __builtin_amdgcn_sched_barrier(0)
    const int nt = K / 64;
    __syncthreads();
    G8_STAGE_B(0, 0, 0) G8_STAGE_A(0, 0, 0) G8_STAGE_B(0, 1, 0) G8_STAGE_A(0, 1, 0)
    if (wr == 1) G8_BAR;
    G8_WAIT_V(4); G8_BAR;
    G8_STAGE_B(1, 0, 1) G8_STAGE_A(1, 0, 1) G8_STAGE_B(1, 1, 1)
    G8_WAIT_V(6); G8_BAR;
    for (int t = 0; t < nt; t += 2) {
        const bool more = t + 2 < nt;
        G8_LDB(B0, 0, 0) G8_SCHED; G8_LDA(0, 0) G8_STAGE_A(1, 1, t + 1)
        G8_WAIT_LA G8_BAR; G8_WAIT_L(0); G8_MMA(0, 0, B0) G8_BAR; G8_SCHED;
        G8_LDB(B1, 0, 1) if (more) G8_STAGE_B(0, 0, t + 2)
        G8_BAR; G8_WAIT_L(0); G8_MMA(0, 1, B1) G8_BAR;
        G8_LDA(0, 1) if (more) G8_STAGE_A(0, 0, t + 2)
        G8_BAR; G8_WAIT_L(0); G8_MMA(1, 0, B0) G8_BAR; G8_SCHED;
        if (more) { G8_STAGE_B(0, 1, t + 2) G8_WAIT_V(6); } else { G8_WAIT_V(0); }
        G8_BAR; G8_MMA(1, 1, B1) G8_BAR;
        G8_LDB(B0, 1, 0) G8_SCHED; G8_LDA(1, 0) if (more) G8_STAGE_A(0, 1, t + 2)
        G8_WAIT_LA G8_BAR; G8_WAIT_L(0); G8_MMA(0, 0, B0) G8_BAR; G8_SCHED;
        G8_LDB(B1, 1, 1) if (more) G8_STAGE_B(1, 0, t + 3)
        G8_BAR; G8_WAIT_L(0); G8_MMA(0, 1, B1) G8_BAR;
        G8_LDA(1, 1) if (more) G8_STAGE_A(1, 0, t + 3)
        G8_BAR; G8_WAIT_L(0); G8_MMA(1, 0, B0) G8_BAR; G8_SCHED;
        if (more) { G8_STAGE_B(1, 1, t + 3) G8_WAIT_V(6); }
        G8_BAR; G8_MMA(1, 1, B1) G8_BAR;
    }
    if (wr == 0) G8_BAR;
    __syncthreads();
#undef G8_SA
#undef G8_SB
#undef G8_GLDS
#undef G8_STAGE_A
#undef G8_STAGE_B
#undef G8_LDA
#undef G8_LDB
#undef G8_MMA
#undef G8_WAIT_V
#undef G8_WAIT_L
#undef G8_WAIT_LA
#undef G8_BAR
#undef G8_SCHED
    {
        const int t2 = TIDX;
        ep.template run256<NT>(acc, n0, t2 >> 8, (t2 >> 6) & 3, t2 & 63, lds);
    }
}

typedef __attribute__((ext_vector_type(16))) float f32x16;
__device__ __forceinline__ uint2 pk4(float a, float b, float c, float d) { return make_uint2(pk_bf16(a, b), pk_bf16(c, d)); }
constexpr float QSCALE_A = 0.125f * 1.4426950408889634f, QSCALE_B = 0.10206207261596577f * 1.4426950408889634f;
struct FlashP {
    const bf16_t* Q; int q_ld;
    const bf16_t* K0; const bf16_t* K1; int k_ld;
    const bf16_t* Vt; int vt_ld;
    int n0, Lk;
    float* O; bf16_t* Ob; int o_ld;
    float c;
};
template <int OFF> __device__ __forceinline__ void ds_rd128(u32x4& d, unsigned addr) { asm volatile("ds_read_b128 %0, %1 offset:%2" : "=&v"(d) : "v"(addr), "n"(OFF)); }
template <int O0, int O1> __device__ __forceinline__ void ds_rd2x64(u32x4& d, unsigned addr) { asm volatile("ds_read2_b64 %0, %1 offset0:%2 offset1:%3" : "=&v"(d) : "v"(addr), "n"(O0), "n"(O1)); }
template <int DQ, int NT, bool OBF>
__device__ __forceinline__ void flash_item(const FlashP& p, int q0, char* lds) {
    constexpr int G = NT / 256;
    constexpr int LDQ = DQ + 8, LDV = 68;
    constexpr int KCH = 64 * (DQ / 8) / 256;
    constexpr int KT_BYTES = 64 * LDQ * 2, VT_BYTES = 128 * LDV * 2, BUF_BYTES = KT_BYTES + VT_BYTES;
    const int tid = TIDX, lane = tid & 63, wv = (tid >> 6) & 3, grp = tid >> 8, gt = tid & 255;
    const int l31 = lane & 31, hh = lane >> 5;
    char* gl = lds + grp * 2 * BUF_BYTES;
    bf16x8 qf[DQ / 16];
    {
        const bf16_t* qr = p.Q + (size_t)(q0 + wv * 32 + l31) * p.q_ld + hh * 8;
#pragma unroll
        for (int ks = 0; ks < DQ / 16; ++ks) qf[ks] = *(const bf16x8*)(qr + ks * 16);
    }
    f32x16 o[4];
#pragma unroll
    for (int d = 0; d < 4; ++d)
#pragma unroll
        for (int r = 0; r < 16; ++r) o[d][r] = 0.f;
    float m_run = 0.f, l_run = 0.f;
    const u32x4 onesA = {hh == 0 ? 0x3F80u : 0u, 0u, 0u, 0u};
    const int ntile = p.Lk / 64, tpg = ntile / G, t_beg = grp * tpg, t_end = t_beg + tpg;
    uint4 rk0, rk1, rk2 = make_uint4(0u, 0u, 0u, 0u), rv0, rv1, rv2, rv3;
#define FL_KOFF(i) (unsigned)((((gt + (i) * 256) / (DQ / 8)) * p.k_ld + ((gt + (i) * 256) % (DQ / 8)) * 8) * 2)
    const unsigned ko0 = FL_KOFF(0), ko1 = FL_KOFF(1), ko2 = KCH > 2 ? FL_KOFF(2) : 0u;
    const unsigned vo0 = (unsigned)(((gt >> 3) * p.vt_ld + (gt & 7) * 8) * 2);
    const size_t vstep = (size_t)32 * p.vt_ld * 2;
#define FL_GLOAD(t) { const int j0_ = (t) * 64; \
        const char* kb_ = (const char*)((j0_ < p.n0) ? p.K0 + (size_t)j0_ * p.k_ld : p.K1 + (size_t)(j0_ - p.n0) * p.k_ld); \
        const char* vb0_ = (const char*)(p.Vt + j0_); \
        rk0 = *(const uint4*)(kb_ + (size_t)ko0); rk1 = *(const uint4*)(kb_ + (size_t)ko1); if (KCH > 2) rk2 = *(const uint4*)(kb_ + (size_t)ko2); \
        rv0 = *(const uint4*)(vb0_ + (size_t)vo0); rv1 = *(const uint4*)(vb0_ + vstep + (size_t)vo0); \
        rv2 = *(const uint4*)(vb0_ + 2 * vstep + (size_t)vo0); rv3 = *(const uint4*)(vb0_ + 3 * vstep + (size_t)vo0); }
#define FL_KST(i, R) { const int c_ = gt + (i) * 256; const int row_ = c_ / (DQ / 8), ch_ = c_ % (DQ / 8); *(uint4*)(ks_ + row_ * LDQ + ch_ * 8) = R; }
#define FL_VST(i, R) { const int c_ = gt + (i) * 256; const int row_ = c_ >> 3, ch_ = c_ & 7; bf16_t* d_ = vs_ + row_ * LDV + ch_ * 8; \
        *(uint2*)d_ = make_uint2(R.x, R.y); *(uint2*)(d_ + 4) = make_uint2(R.z, R.w); }
#define FL_SWRITE(b) { bf16_t* ks_ = (bf16_t*)(gl + (b) * BUF_BYTES); bf16_t* vs_ = (bf16_t*)(gl + (b) * BUF_BYTES + KT_BYTES); \
        FL_KST(0, rk0) FL_KST(1, rk1) if (KCH > 2) FL_KST(2, rk2) \
        FL_VST(0, rv0) FL_VST(1, rv1) FL_VST(2, rv2) FL_VST(3, rv3) }
    const int rot = (((q0 >> 7) & 31) * tpg) >> 5;
#define FL_TILE(i_) (t_beg + ((i_) + rot < tpg ? (i_) + rot : (i_) + rot - tpg))
    __syncthreads();
    FL_GLOAD(FL_TILE(0)) FL_SWRITE(0)
    __syncthreads();
    if (G == 2 && grp == 1) __builtin_amdgcn_s_barrier();
    for (int it = 0; it < tpg; ++it) {
        const int b = it & 1;
        if (it + 1 < tpg) FL_GLOAD(FL_TILE(it + 1))
        const bf16_t* ks = (const bf16_t*)(gl + b * BUF_BYTES);
        const bf16_t* vs = (const bf16_t*)(gl + b * BUF_BYTES + KT_BYTES);
        f32x16 s[2];
        {
            constexpr int NK = DQ / 16;
            const unsigned kaddr = (unsigned)(size_t)ks + (unsigned)((l31 * LDQ + hh * 8) * 2);
            u32x4 kf[2][NK];
#define FL_KR(kb_, kk_) ds_rd128<((kb_) * 32 * LDQ + (kk_) * 16) * 2>(kf[kb_][kk_], kaddr);
            FL_KR(0, 0) FL_KR(1, 0) FL_KR(0, 1) FL_KR(1, 1) FL_KR(0, 2) FL_KR(1, 2) FL_KR(0, 3) FL_KR(1, 3)
            if constexpr (NK > 4) { FL_KR(0, 4) FL_KR(1, 4) FL_KR(0, 5) FL_KR(1, 5) }
#undef FL_KR
            {
                const u32x4 qx = {hh == 0 ? (__builtin_bit_cast(unsigned, -m_run) >> 16) : 0u, 0u, 0u, 0u};
                f32x16 z16;
#pragma unroll
                for (int r = 0; r < 16; ++r) z16[r] = 0.f;
                s[0] = __builtin_amdgcn_mfma_f32_32x32x16_bf16(__builtin_bit_cast(bf16x8, onesA), __builtin_bit_cast(bf16x8, qx), z16, 0, 0, 0);
                s[1] = __builtin_amdgcn_mfma_f32_32x32x16_bf16(__builtin_bit_cast(bf16x8, onesA), __builtin_bit_cast(bf16x8, qx), z16, 0, 0, 0);
            }
            if constexpr (NK > 4) asm volatile("s_waitcnt lgkmcnt(8)" : "+v"(kf[0][0]), "+v"(kf[1][0]), "+v"(kf[0][1]), "+v"(kf[1][1]));
            else                  asm volatile("s_waitcnt lgkmcnt(4)" : "+v"(kf[0][0]), "+v"(kf[1][0]), "+v"(kf[0][1]), "+v"(kf[1][1]));
#pragma unroll
            for (int kk = 0; kk < 2; ++kk)
#pragma unroll
                for (int kb = 0; kb < 2; ++kb) s[kb] = __builtin_amdgcn_mfma_f32_32x32x16_bf16(__builtin_bit_cast(bf16x8, kf[kb][kk]), qf[kk], s[kb], 0, 0, 0);
            if constexpr (NK > 4) asm volatile("s_waitcnt lgkmcnt(4)" : "+v"(kf[0][2]), "+v"(kf[1][2]), "+v"(kf[0][3]), "+v"(kf[1][3]));
            else                  asm volatile("s_waitcnt lgkmcnt(0)" : "+v"(kf[0][2]), "+v"(kf[1][2]), "+v"(kf[0][3]), "+v"(kf[1][3]));
#pragma unroll
            for (int kk = 2; kk < 4; ++kk)
#pragma unroll
                for (int kb = 0; kb < 2; ++kb) s[kb] = __builtin_amdgcn_mfma_f32_32x32x16_bf16(__builtin_bit_cast(bf16x8, kf[kb][kk]), qf[kk], s[kb], 0, 0, 0);
            if constexpr (NK > 4) {
                asm volatile("s_waitcnt lgkmcnt(0)" : "+v"(kf[0][4]), "+v"(kf[1][4]), "+v"(kf[0][5]), "+v"(kf[1][5]));
#pragma unroll
                for (int kk = 4; kk < NK; ++kk)
#pragma unroll
                    for (int kb = 0; kb < 2; ++kb) s[kb] = __builtin_amdgcn_mfma_f32_32x32x16_bf16(__builtin_bit_cast(bf16x8, kf[kb][kk]), qf[kk], s[kb], 0, 0, 0);
            }
        }
        float mx = s[0][0];
#pragma unroll
        for (int r = 1; r < 16; ++r) mx = fmaxf(mx, s[0][r]);
#pragma unroll
        for (int r = 0; r < 16; ++r) mx = fmaxf(mx, s[1][r]);
        mx = fmaxf(mx, __shfl_xor(mx, 32));
        const bool first = it == 0;
        constexpr float FL_THR = 5.f;
        const bool grow = first || __builtin_amdgcn_ballot_w64(mx > FL_THR) != 0ull;
        if (grow) {
            const float dl = (first || mx > FL_THR) ? mx : 0.f;
            const float m_new = __builtin_bit_cast(float, pk_bf16(m_run + dl, 0.f) << 16);
            const float d = m_new - m_run, alpha = __builtin_amdgcn_exp2f(-d);
            m_run = m_new;
#pragma unroll
            for (int kb = 0; kb < 2; ++kb)
#pragma unroll
                for (int r = 0; r < 16; ++r) s[kb][r] -= d;
            l_run *= alpha;
#pragma unroll
            for (int dd = 0; dd < 4; ++dd)
#pragma unroll
                for (int r = 0; r < 16; ++r) o[dd][r] *= alpha;
        }
#pragma unroll
        for (int r = 0; r < 16; ++r) s[0][r] = __builtin_amdgcn_exp2f(s[0][r]);
        if (G == 2) __builtin_amdgcn_s_barrier();
        {
            const unsigned vb_ = (unsigned)(size_t)vs + (unsigned)((l31 * LDV + 4 * hh) * 2);
            const unsigned va0 = vb_, va1 = vb_ + 32 * LDV * 2, va2 = vb_ + 64 * LDV * 2, va3 = vb_ + 96 * LDV * 2;
            u32x4 fa0, fa1, fa2, fa3, fb0, fb1, fb2, fb3;
#define FL_VR(S_, g_) ds_rd2x64<(g_) * 4, (g_) * 4 + 2>(f##S_##0, va0); ds_rd2x64<(g_) * 4, (g_) * 4 + 2>(f##S_##1, va1); \
                      ds_rd2x64<(g_) * 4, (g_) * 4 + 2>(f##S_##2, va2); ds_rd2x64<(g_) * 4, (g_) * 4 + 2>(f##S_##3, va3);
#define FL_PV(S_, g_, W_) { asm volatile("s_waitcnt lgkmcnt(" #W_ ")" : "+v"(f##S_##0), "+v"(f##S_##1), "+v"(f##S_##2), "+v"(f##S_##3)); \
            constexpr int kb_ = (g_) >> 1, sp_ = (g_) & 1; \
            const u32x4 pbu = {pk_bf16(s[kb_][8 * sp_ + 0], s[kb_][8 * sp_ + 1]), pk_bf16(s[kb_][8 * sp_ + 2], s[kb_][8 * sp_ + 3]), \
                               pk_bf16(s[kb_][8 * sp_ + 4], s[kb_][8 * sp_ + 5]), pk_bf16(s[kb_][8 * sp_ + 6], s[kb_][8 * sp_ + 7])}; \
            const bf16x8 pbv = __builtin_bit_cast(bf16x8, pbu); \
            o[0] = __builtin_amdgcn_mfma_f32_32x32x16_bf16(__builtin_bit_cast(bf16x8, f##S_##0), pbv, o[0], 0, 0, 0); \
            o[1] = __builtin_amdgcn_mfma_f32_32x32x16_bf16(__builtin_bit_cast(bf16x8, f##S_##1), pbv, o[1], 0, 0, 0); \
            o[2] = __builtin_amdgcn_mfma_f32_32x32x16_bf16(__builtin_bit_cast(bf16x8, f##S_##2), pbv, o[2], 0, 0, 0); \
            o[3] = __builtin_amdgcn_mfma_f32_32x32x16_bf16(__builtin_bit_cast(bf16x8, f##S_##3), pbv, o[3], 0, 0, 0); \
            l_run += ((s[kb_][8 * sp_ + 0] + s[kb_][8 * sp_ + 1]) + (s[kb_][8 * sp_ + 2] + s[kb_][8 * sp_ + 3])) + ((s[kb_][8 * sp_ + 4] + s[kb_][8 * sp_ + 5]) + (s[kb_][8 * sp_ + 6] + s[kb_][8 * sp_ + 7])); }
            FL_VR(a, 0) FL_VR(b, 1)
            FL_PV(a, 0, 4)
            FL_VR(a, 2)
            FL_PV(b, 1, 4)
            FL_VR(b, 3)
#pragma unroll
            for (int r = 0; r < 16; ++r) s[1][r] = __builtin_amdgcn_exp2f(s[1][r]);
            FL_PV(a, 2, 4)
            FL_PV(b, 3, 0)
#undef FL_VR
#undef FL_PV
        }
        if (it + 1 < tpg) FL_SWRITE(b ^ 1)
        __syncthreads();
    }
#undef FL_TILE
    if (G == 2 && grp == 0) __builtin_amdgcn_s_barrier();
    l_run += __shfl_xor(l_run, 32);
    const int tid_ = TIDX, lane_ = tid_ & 63, wv_ = (tid_ >> 6) & 3, grp_ = tid_ >> 8, l31_ = lane_ & 31, hh_ = lane_ >> 5;
#define lane lane_
#define wv wv_
#define grp grp_
#define l31 l31_
#define hh hh_
    if (G == 2) {
        float* mb = (float*)lds;
        __syncthreads();
        if (grp == 1) {
            float* w = mb + wv * 66 * 64 + lane;
#pragma unroll
            for (int d = 0; d < 4; ++d)
#pragma unroll
                for (int r = 0; r < 16; ++r) w[(d * 16 + r) * 64] = o[d][r];
            w[64 * 64] = m_run; w[65 * 64] = l_run;
        }
        __syncthreads();
        if (grp == 0) {
            const float* w = mb + wv * 66 * 64 + lane;
            const float m1 = w[64 * 64], l1 = w[65 * 64];
            const float m = fmaxf(m_run, m1), a0 = __builtin_amdgcn_exp2f(m_run - m), a1 = __builtin_amdgcn_exp2f(m1 - m);
            l_run = l_run * a0 + l1 * a1;
#pragma unroll
            for (int d = 0; d < 4; ++d)
#pragma unroll
                for (int r = 0; r < 16; ++r) o[d][r] = o[d][r] * a0 + w[(d * 16 + r) * 64] * a1;
        }
    }
    if (grp == 0) {
        const float inv = 1.f / l_run;
        const size_t ro = (size_t)(q0 + wv * 32 + l31) * p.o_ld;
#pragma unroll
        for (int d = 0; d < 4; ++d)
#pragma unroll
            for (int g4 = 0; g4 < 4; ++g4) {
                const int co = d * 32 + g4 * 8 + 4 * hh;
                if (OBF) *(uint2*)(p.Ob + ro + co) = pk4(o[d][g4 * 4] * inv, o[d][g4 * 4 + 1] * inv, o[d][g4 * 4 + 2] * inv, o[d][g4 * 4 + 3] * inv);
                else *(float4*)(p.O + ro + co) = make_float4(o[d][g4 * 4] * inv, o[d][g4 * 4 + 1] * inv, o[d][g4 * 4 + 2] * inv, o[d][g4 * 4 + 3] * inv);
            }
    }
    __syncthreads();
#undef lane
#undef wv
#undef grp
#undef l31
#undef hh
}


struct TokInfo { int seq, pos, L, ci, t0, latent; };
__device__ __forceinline__ TokInfo tokinfo(int t) {
    TokInfo r;
    if (t < 4096) { r.seq = t >> 8; r.pos = t & 255; r.L = 256; r.ci = 0; r.t0 = t & ~255; r.latent = 0; }
    else { const int u = t - 4096, b = u >> 12; r.seq = 16 + b; r.pos = u & 4095; r.L = 4096; r.ci = 1 + b; r.t0 = 4096 + (b << 12); r.latent = 1; }
    return r;
}
constexpr int VLD = 4608 + 128;
struct Lay { int tbase, Tloc, seqbase, b0, nb; };
__device__ __forceinline__ size_t vt_off(const Lay& l, int seq, int h) {
    if (seq < 16) return ((size_t)(seq - l.seqbase) * 4 + h) * 128 * 256;
    const size_t ctxpart = l.seqbase < 16 ? (size_t)(16 - l.seqbase) * 4 * 128 * 256 : 0;
    return ctxpart + ((size_t)(seq - 16 - l.b0) * 4 + h) * 128 * VLD;
}
__device__ __forceinline__ const float* xrow(const float* xp, const float* xs, int t) { return t < 4096 ? xp + (size_t)t * DM : xs + (size_t)(t - 4096) * DM; }
__device__ __forceinline__ float bf_lo(unsigned u) { return __builtin_bit_cast(float, u << 16); }
__device__ __forceinline__ float bf_hi(unsigned u) { return __builtin_bit_cast(float, u & 0xffff0000u); }
__device__ __forceinline__ float bf1(bf16_t u) { return __builtin_bit_cast(float, (unsigned)u << 16); }
__device__ __forceinline__ bf16_t to_bf(float x) { return (bf16_t)(pk_bf16(x, 0.f) & 0xffffu); }
template <int NT>
__device__ __forceinline__ float group_sum256(float v, float* sh) {
    v = wave_sum(v);
    __syncthreads();
    if ((TIDX & 63) == 0) sh[TIDX >> 6] = v;
    __syncthreads();
    const int g = (TIDX >> 8) * 4;
    return sh[g] + sh[g + 1] + sh[g + 2] + sh[g + 3];
}

__device__ __forceinline__ void n_rope_tables(float* c64, float* s64, float* c32, float* s32) {
    for (int i = TIDX; i < 64 * 16; i += blockDim.x) {
        const int val = i >> 4, f = i & 15;
        const float ang = (float)val * powf(10000.f, -(float)f / 16.f);
        c64[i] = cosf(ang); s64[i] = sinf(ang);
    }
    for (int i = TIDX; i < 64 * 8; i += blockDim.x) {
        const int val = i >> 3, f = i & 7;
        const float ang = (float)val * powf(10000.f, -(float)f / 8.f);
        c32[i] = cosf(ang); s32[i] = sinf(ang);
    }
}

__device__ __forceinline__ int wsrc(int mode, int gh, int n, int N) {
    if (mode == 0) return n < N ? n : -1;
    if (mode == 1) { const int tile = n / (2 * gh), j = n % (2 * gh); return j < gh ? tile * gh + j : FF + tile * gh + (j - gh); }
    if (n < 256) return (n >> 6) * 192 + (n & 63);
    const int c = n - 256; return (c >> 7) * 192 + 64 + (c & 127);
}
template <int NT>
__device__ __forceinline__ void n_wconv(const float* __restrict__ W, int K, int N, bf16_t* __restrict__ Wt, int Npad, int mode, int gh, int vb0, float* lds) {
    const int grp = TIDX >> 8, tid = TIDX & 255;
    const int ntn = Npad / 64, ntiles = (K / 64) * ntn;
    const int vb = vb0 * (NT / 256) + grp;
    float (*tile)[65] = (float (*)[65])(lds + grp * 64 * 65);
    const bool act = vb < ntiles;
    const int k0 = act ? (vb / ntn) * 64 : 0, n0 = act ? (vb % ntn) * 64 : 0;
    __syncthreads();
    if (act) {
#pragma unroll
        for (int p = 0; p < 4; ++p) {
            const int r = p * 16 + (tid >> 4), c = (tid & 15) * 4;
            const int sc = wsrc(mode, gh, n0 + c, N);
            float4 v = make_float4(0.f, 0.f, 0.f, 0.f);
            if (sc >= 0) v = *(const float4*)(W + (size_t)(k0 + r) * N + sc);
            tile[r][c] = v.x; tile[r][c + 1] = v.y; tile[r][c + 2] = v.z; tile[r][c + 3] = v.w;
        }
    }
    __syncthreads();
    if (act) {
#pragma unroll
        for (int p = 0; p < 4; ++p) {
            const int n = p * 16 + (tid >> 4), k = (tid & 15) * 4;
            *(uint2*)(Wt + (size_t)(n0 + n) * K + k0 + k) = pk4(tile[k][n], tile[k + 1][n], tile[k + 2][n], tile[k + 3][n]);
        }
    }
}

template <int NT, int NI>
__device__ __forceinline__ void n_wconv_multi(const float* __restrict__ W, int K, int N, bf16_t* __restrict__ Wt, int Npad, int mode, int gh, int it0, float* lds, int ldo = 0) {
    if (ldo == 0) ldo = K;
    const int grp = TIDX >> 8, tid = TIDX & 255;
    const int ntn = Npad / 64, ntiles = (K / 64) * ntn;
    float4 v[NI][4];
    __syncthreads();
#pragma unroll
    for (int u = 0; u < NI; ++u) {
        const int vb = (it0 + u) * (NT / 256) + grp;
        const bool act = vb < ntiles;
        const int k0 = act ? (vb / ntn) * 64 : 0, n0 = act ? (vb % ntn) * 64 : 0;
#pragma unroll
        for (int p = 0; p < 4; ++p) {
            const int r = p * 16 + (tid >> 4), c = (tid & 15) * 4;
            const int sc = wsrc(mode, gh, n0 + c, N);
            v[u][p] = make_float4(0.f, 0.f, 0.f, 0.f);
            if (act && sc >= 0) v[u][p] = *(const float4*)(W + (size_t)(k0 + r) * N + sc);
        }
    }
#pragma unroll
    for (int u = 0; u < NI; ++u) {
        float (*tile)[65] = (float (*)[65])(lds + (u * (NT / 256) + grp) * 64 * 65);
#pragma unroll
        for (int p = 0; p < 4; ++p) {
            const int r = p * 16 + (tid >> 4), c = (tid & 15) * 4;
            tile[r][c] = v[u][p].x; tile[r][c + 1] = v[u][p].y; tile[r][c + 2] = v[u][p].z; tile[r][c + 3] = v[u][p].w;
        }
    }
    __syncthreads();
#pragma unroll
    for (int u = 0; u < NI; ++u) {
        const int vb = (it0 + u) * (NT / 256) + grp;
        if (vb < ntiles) {
            const int k0 = (vb / ntn) * 64, n0 = (vb % ntn) * 64;
            float (*tile)[65] = (float (*)[65])(lds + (u * (NT / 256) + grp) * 64 * 65);
#pragma unroll
            for (int p = 0; p < 4; ++p) {
                const int n = p * 16 + (tid >> 4), k = (tid & 15) * 4;
                *(uint2*)(Wt + (size_t)(n0 + n) * ldo + k0 + k) = pk4(tile[k][n], tile[k + 1][n], tile[k + 2][n], tile[k + 3][n]);
            }
        }
    }
}

template <int NT>
__device__ __forceinline__ void n_resnorm(const Lay lay, const float* xp, const float* xs, const float* __restrict__ src, const float* __restrict__ g,
                          const float* __restrict__ modl, int shoff, int scoff, bf16_t* __restrict__ out, int vb, float* lds) {
    const int lrow = vb * (NT / 256) + (TIDX >> 8), tid = TIDX & 255;
    const int t = lay.tbase + lrow;
    const TokInfo ti = tokinfo(t);
    const float* xr = src ? src + (size_t)lrow * DM : xrow(xp, xs, t);
    const float4 x = *(const float4*)(xr + tid * 4);
    const float ss = group_sum256<NT>(x.x * x.x + x.y * x.y + x.z * x.z + x.w * x.w, lds);
    const float rstd = rsqrtf(ss * (1.f / DM) + EPS);
    const float4 gg = *(const float4*)(g + tid * 4);
    const float* md = modl + (size_t)ti.ci * 6144;
    const float4 a = *(const float4*)(md + scoff + tid * 4), b = *(const float4*)(md + shoff + tid * 4);
    *(uint2*)(out + (size_t)lrow * DM + tid * 4) = pk4(x.x * rstd * gg.x * (1.f + a.x) + b.x, x.y * rstd * gg.y * (1.f + a.y) + b.y,
                                                       x.z * rstd * gg.z * (1.f + a.z) + b.z, x.w * rstd * gg.w * (1.f + a.w) + b.w);
}

template <int NT>
__device__ __forceinline__ void n_resnorm_w2(const Lay lay, const float* xp, const float* xs, const bf16_t* __restrict__ src, const float* __restrict__ g,
                          const float* __restrict__ modl, int shoff, int scoff, bf16_t* __restrict__ out, int vb) {
    const int lane = TIDX & 63, lrow0 = vb * (NT / 64) * 2 + (TIDX >> 6) * 2;
    float4 x[2][4];
#pragma unroll
    for (int k = 0; k < 2; ++k) {
        const int lrow = lrow0 + k;
        const float* xr = xrow(xp, xs, lay.tbase + lrow);
#pragma unroll
        for (int q = 0; q < 4; ++q) {
            if (src) { const uint2 u = *(const uint2*)(src + (size_t)lrow * DM + q * 256 + lane * 4); x[k][q] = make_float4(bf_lo(u.x), bf_hi(u.x), bf_lo(u.y), bf_hi(u.y)); }
            else x[k][q] = *(const float4*)(xr + q * 256 + lane * 4);
        }
    }
#pragma unroll
    for (int k = 0; k < 2; ++k) {
        const int lrow = lrow0 + k;
        const TokInfo ti = tokinfo(lay.tbase + lrow);
        float ss = 0.f;
#pragma unroll
        for (int q = 0; q < 4; ++q) ss += (x[k][q].x * x[k][q].x + x[k][q].y * x[k][q].y) + (x[k][q].z * x[k][q].z + x[k][q].w * x[k][q].w);
        ss = wave_sum(ss);
        const float rstd = rsqrtf(ss * (1.f / DM) + EPS);
        const float* md = modl + (size_t)ti.ci * 6144;
#pragma unroll
        for (int q = 0; q < 4; ++q) {
            const int c = q * 256 + lane * 4;
            const float4 gg = *(const float4*)(g + c), a = *(const float4*)(md + scoff + c), b = *(const float4*)(md + shoff + c);
            *(uint2*)(out + (size_t)lrow * DM + c) = pk4(x[k][q].x * rstd * gg.x * (1.f + a.x) + b.x, x[k][q].y * rstd * gg.y * (1.f + a.y) + b.y,
                                                         x[k][q].z * rstd * gg.z * (1.f + a.z) + b.z, x[k][q].w * rstd * gg.w * (1.f + a.w) + b.w);
        }
    }
}

struct ALoadBF {
    const bf16_t* A; int lda;
    __device__ __forceinline__ const bf16_t* ptr(int row, int k) const { return A + (size_t)row * lda + k; }
    __device__ __forceinline__ const char* ubase() const { return (const char*)A; }
    __device__ __forceinline__ unsigned boff(int row, int k) const { return (unsigned)(row * lda + k) * 2u; }
};
struct ALoadHalo {
    const bf16_t* A; int lda, base, row0, L; const bf16_t* zero;
    __device__ __forceinline__ const bf16_t* ptr(int r, int k) const {
        const int pos = row0 + r;
        if (pos < 0 || pos >= L) return zero;
        return A + (size_t)(base + pos) * lda + k;
    }
    __device__ __forceinline__ const char* ubase() const { return (const char*)zero; }
    __device__ __forceinline__ unsigned boff(int r, int k) const {
        const int pos = row0 + r;
        if (pos < 0 || pos >= L) return 0u;
        return (unsigned)((const char*)A - (const char*)zero) + (unsigned)((base + pos) * lda + k) * 2u;
    }
};
struct HaloTile { int seq, t0, L, row0, lo, hi; };
__device__ __forceinline__ HaloTile halo_tile(int g) {
    HaloTile h;
    if (g < 16) { h.seq = g; h.t0 = g * 256; h.L = 256; h.row0 = 0; h.lo = 0; h.hi = 256; }
    else { const int b = (g - 16) / 17, i = (g - 16) % 17; h.seq = 16 + b; h.t0 = 4096 + b * 4096; h.L = 4096; h.row0 = 254 * i - 1; h.lo = 1;
           const int last = 4096 - h.row0; h.hi = last < 255 ? last : 255; }
    return h;
}

template <int BM, int BN, int NT, class RowPtr>
__device__ __forceinline__ void store_transposed(const f32x4 (&acc)[4][4], int wr, int wc, int lane, char* lds, const RowPtr& rp) {
    constexpr int LDT = BM + 8;
    bf16_t* Lt = (bf16_t*)lds;
#pragma unroll
    for (int i = 0; i < 4; ++i)
#pragma unroll
        for (int j = 0; j < 4; ++j)
#pragma unroll
            for (int r = 0; r < 4; ++r)
                Lt[(wc * 64 + j * 16 + (lane >> 4) * 4 + r) * LDT + wr * 64 + i * 16 + (lane & 15)] = to_bf(acc[i][j][r]);
    __syncthreads();
    constexpr int CH = BN * (BM / 8) / NT;
#pragma unroll
    for (int k = 0; k < CH; ++k) {
        const int c = TIDX + k * NT, col = c / (BM / 8), kc = c % (BM / 8);
        *(uint4*)(rp(col) + kc * 8) = *(const uint4*)(Lt + col * LDT + kc * 8);
    }
    __syncthreads();
}

struct EpiIn0 {
    Lay lay; bf16_t *Qa, *Ka, *VtA, *tail; float *out_k, *out_v; const float *c64, *s64;
    template <int BM, int BN, int NT>
    __device__ __forceinline__ void run(f32x4 (&acc)[4][4], int m0, int n0, int wr, int wc, int lane, char* lds) const {
        const int nw = n0 + wc * 64, region = nw >> 9, cq = (lane >> 4) * 4;
        if (region <= 1) {
#pragma unroll
            for (int i = 0; i < 4; ++i) {
                const int lrow = m0 + wr * 64 + i * 16 + (lane & 15);
                const TokInfo ti = tokinfo(lay.tbase + lrow);
                if (ti.latent) {
#pragma unroll
                    for (int pg = 0; pg < 2; ++pg) {
                        const int val = pg ? (ti.pos & 63) : (ti.pos >> 6);
                        const float4 c4 = *(const float4*)(c64 + val * 16 + cq), s4 = *(const float4*)(s64 + val * 16 + cq);
                        const float cc[4] = {c4.x, c4.y, c4.z, c4.w}, sn[4] = {s4.x, s4.y, s4.z, s4.w};
#pragma unroll
                        for (int r = 0; r < 4; ++r) {
                            const float x1 = acc[i][2 * pg][r], x2 = acc[i][2 * pg + 1][r];
                            acc[i][2 * pg][r] = x1 * cc[r] - x2 * sn[r];
                            acc[i][2 * pg + 1][r] = x1 * sn[r] + x2 * cc[r];
                        }
                    }
                }
                bf16_t* dst = (region ? Ka : Qa) + (size_t)lrow * 512 + (nw & 511) + cq;
                const float qs = region ? 1.f : QSCALE_A;
#pragma unroll
                for (int j = 0; j < 4; ++j) *(uint2*)(dst + j * 16) = pk4(acc[i][j][0] * qs, acc[i][j][1] * qs, acc[i][j][2] * qs, acc[i][j][3] * qs);
                if (region == 1 && !ti.latent) {
                    float* ok = out_k + ((size_t)(ti.seq * 4 + ((nw - 512) >> 7)) * 256 + ti.pos) * 128 + ((nw - 512) & 127) + cq;
#pragma unroll
                    for (int j = 0; j < 4; ++j) *(float4*)(ok + j * 16) = make_float4(acc[i][j][0], acc[i][j][1], acc[i][j][2], acc[i][j][3]);
                }
            }
        } else if (region == 2) {
            const TokInfo t0 = tokinfo(lay.tbase + m0);
            if (!t0.latent) {
#pragma unroll
                for (int i = 0; i < 4; ++i) {
                    const int lrow = m0 + wr * 64 + i * 16 + (lane & 15);
                    const TokInfo ti = tokinfo(lay.tbase + lrow);
                    float* ov = out_v + ((size_t)(ti.seq * 4 + ((nw - 1024) >> 7)) * 256 + ti.pos) * 128 + ((nw - 1024) & 127) + cq;
#pragma unroll
                    for (int j = 0; j < 4; ++j) *(float4*)(ov + j * 16) = make_float4(acc[i][j][0], acc[i][j][1], acc[i][j][2], acc[i][j][3]);
                }
            }
            const int Lk = t0.latent ? VLD : 256, key0 = (t0.latent ? 512 : 0) + t0.pos;
            bf16_t* vb = VtA; const Lay l = lay; const int seq = t0.seq;
            store_transposed<BM, BN, NT>(acc, wr, wc, lane, lds, [=](int col) {
                const int c = n0 - 1024 + col;
                return vb + vt_off(l, seq, c >> 7) + (size_t)(c & 127) * Lk + key0;
            });
        } else {
#pragma unroll
            for (int i = 0; i < 4; ++i) {
                const int lrow = m0 + wr * 64 + i * 16 + (lane & 15);
                bf16_t* dst = tail + (size_t)lrow * 384 + (nw - 1536) + cq;
#pragma unroll
                for (int j = 0; j < 4; ++j) *(uint2*)(dst + j * 16) = pk4(acc[i][j][0], acc[i][j][1], acc[i][j][2], acc[i][j][3]);
            }
        }
    }
};

template <int NT>
__device__ __forceinline__ void n_l0_tail(const Lay lay, const bf16_t* __restrict__ tail, const float* __restrict__ q_norm, const float* __restrict__ kv_norm,
                          const float* __restrict__ cache_ckv, const float* __restrict__ cache_kpe, const float* c32, const float* s32,
                          bf16_t* __restrict__ qdn, bf16_t* __restrict__ ckvn, bf16_t* __restrict__ Kb, float* __restrict__ out_ckv, float* __restrict__ out_kpe,
                          int vb, float* lds) {
    const int lrow = vb * (NT / 256) + (TIDX >> 8), tid = TIDX & 255;
    if (lrow >= lay.Tloc) {
        const int cr = lrow - lay.Tloc, b = lay.b0 + (cr >> 9), p = cr & 511;
        if (tid < 128) ckvn[(size_t)lrow * 128 + tid] = to_bf(cache_ckv[((size_t)b * 512 + p) * 128 + tid]);
        else if (tid < 160) {
            const bf16_t v = to_bf(cache_kpe[((size_t)b * 512 + p) * 32 + (tid - 128)]);
#pragma unroll
            for (int h = 0; h < 4; ++h) Kb[(size_t)lrow * 384 + h * 96 + 64 + (tid - 128)] = v;
        }
        return;
    }
    const int t = lay.tbase + lrow;
    const TokInfo ti = tokinfo(t);
    const bf16_t* p = tail + (size_t)lrow * 384;
    {
        const float v = tid < 192 ? bf1(p[tid]) : 0.f;
        const float ss = group_sum256<NT>(v * v, lds);
        const float rstd = rsqrtf(ss * (1.f / 192.f) + EPS);
        if (tid < 192) qdn[(size_t)lrow * 192 + tid] = to_bf(v * rstd * q_norm[tid]);
    }
    {
        const float v = tid < 128 ? bf1(p[192 + tid]) : 0.f;
        const float ss = group_sum256<NT>(v * v, lds);
        const float rstd = rsqrtf(ss * (1.f / 128.f) + EPS);
        if (tid < 128) {
            const float val = v * rstd * kv_norm[tid];
            ckvn[(size_t)lrow * 128 + tid] = to_bf(val);
            if (!ti.latent) out_ckv[(size_t)t * 128 + tid] = val;
        }
    }
    if (tid < 32) {
        float val;
        if (ti.latent) {
            const int i = tid & 7, part = tid >> 3;
            const int vv = (part < 2) ? (ti.pos >> 6) : (ti.pos & 63);
            const float cs = c32[vv * 8 + i], sn = s32[vv * 8 + i];
            const int base = 320 + (part >> 1) * 16;
            const float x1 = bf1(p[base + i]), x2 = bf1(p[base + 8 + i]);
            val = (part & 1) ? (x1 * sn + x2 * cs) : (x1 * cs - x2 * sn);
        } else {
            val = bf1(p[320 + tid]);
            out_kpe[(size_t)t * 32 + tid] = val;
        }
        const bf16_t vb16 = to_bf(val);
#pragma unroll
        for (int h = 0; h < 4; ++h) Kb[(size_t)lrow * 384 + h * 96 + 64 + tid] = vb16;
    }
}

template <int NT>
__device__ __forceinline__ void n_l0_tail_w(const Lay lay, const bf16_t* __restrict__ tail, const float* __restrict__ q_norm, const float* __restrict__ kv_norm,
                          const float* __restrict__ cache_ckv, const float* __restrict__ cache_kpe, const float* c32, const float* s32,
                          bf16_t* __restrict__ qdn, bf16_t* __restrict__ ckvn, bf16_t* __restrict__ Kb, float* __restrict__ out_ckv, float* __restrict__ out_kpe, int vb) {
    const int lane = TIDX & 63, lrow = vb * (NT / 64) + (TIDX >> 6);
    if (lrow >= lay.Tloc) {
        const int cr = lrow - lay.Tloc, b = lay.b0 + (cr >> 9), p = cr & 511;
        const float2 c2 = *(const float2*)(cache_ckv + ((size_t)b * 512 + p) * 128 + lane * 2);
        *(unsigned*)(ckvn + (size_t)lrow * 128 + lane * 2) = pk_bf16(c2.x, c2.y);
        if (lane < 32) {
            const bf16_t v = to_bf(cache_kpe[((size_t)b * 512 + p) * 32 + lane]);
#pragma unroll
            for (int h = 0; h < 4; ++h) Kb[(size_t)lrow * 384 + h * 96 + 64 + lane] = v;
        }
        return;
    }
    const int t = lay.tbase + lrow;
    const TokInfo ti = tokinfo(t);
    const bf16_t* p = tail + (size_t)lrow * 384;
    {
        const float v0 = bf1(p[lane]), v1 = bf1(p[lane + 64]), v2 = bf1(p[lane + 128]);
        const float ss = wave_sum(v0 * v0 + v1 * v1 + v2 * v2);
        const float rstd = rsqrtf(ss * (1.f / 192.f) + EPS);
        bf16_t* q = qdn + (size_t)lrow * 192;
        q[lane] = to_bf(v0 * rstd * q_norm[lane]); q[lane + 64] = to_bf(v1 * rstd * q_norm[lane + 64]); q[lane + 128] = to_bf(v2 * rstd * q_norm[lane + 128]);
    }
    {
        const unsigned u = *(const unsigned*)(p + 192 + lane * 2);
        const float v0 = bf_lo(u), v1 = bf_hi(u);
        const float ss = wave_sum(v0 * v0 + v1 * v1);
        const float rstd = rsqrtf(ss * (1.f / 128.f) + EPS);
        const float2 kn = *(const float2*)(kv_norm + lane * 2);
        const float a = v0 * rstd * kn.x, b = v1 * rstd * kn.y;
        *(unsigned*)(ckvn + (size_t)lrow * 128 + lane * 2) = pk_bf16(a, b);
        if (!ti.latent) *(float2*)(out_ckv + (size_t)t * 128 + lane * 2) = make_float2(a, b);
    }
    if (lane < 32) {
        float val;
        if (ti.latent) {
            const int i = lane & 7, part = lane >> 3;
            const int vv = (part < 2) ? (ti.pos >> 6) : (ti.pos & 63);
            const float cs = c32[vv * 8 + i], sn = s32[vv * 8 + i];
            const int base = 320 + (part >> 1) * 16;
            const float x1 = bf1(p[base + i]), x2 = bf1(p[base + 8 + i]);
            val = (part & 1) ? (x1 * sn + x2 * cs) : (x1 * cs - x2 * sn);
        } else {
            val = bf1(p[320 + lane]);
            out_kpe[(size_t)t * 32 + lane] = val;
        }
        const bf16_t vb16 = to_bf(val);
#pragma unroll
        for (int h = 0; h < 4; ++h) Kb[(size_t)lrow * 384 + h * 96 + 64 + lane] = vb16;
    }
}

struct EpiQb {
    Lay lay; bf16_t* Qb; const float *c32, *s32;
    template <int BM, int BN, int NT>
    __device__ __forceinline__ void run(f32x4 (&acc)[4][4], int m0, int n0, int wr, int wc, int lane, char*) const {
        const int nw = n0 + wc * 64, cq = (lane >> 4) * 4;
#pragma unroll
        for (int i = 0; i < 4; ++i) {
            const int lrow = m0 + wr * 64 + i * 16 + (lane & 15);
            const TokInfo ti = tokinfo(lay.tbase + lrow);
#pragma unroll
            for (int j = 0; j < 4; ++j) {
                const int tix = ((nw >> 4) + j) % 6;
                if (tix >= 4) {
                    const int val = (tix == 4) ? (ti.pos >> 6) : (ti.pos & 63);
                    const int fo = ((lane >> 4) & 1) * 4;
                    const float4 c4 = *(const float4*)(c32 + val * 8 + fo), s4 = *(const float4*)(s32 + val * 8 + fo);
                    const float cc[4] = {c4.x, c4.y, c4.z, c4.w}, sn[4] = {s4.x, s4.y, s4.z, s4.w};
                    const bool isx2 = (lane >> 5) != 0;
#pragma unroll
                    for (int r = 0; r < 4; ++r) {
                        const float mine = acc[i][j][r], other = __shfl_xor(mine, 32);
                        const float rot = isx2 ? (other * sn[r] + mine * cc[r]) : (mine * cc[r] - other * sn[r]);
                        acc[i][j][r] = ti.latent ? rot : mine;
                    }
                }
                *(uint2*)(Qb + (size_t)lrow * 384 + nw + j * 16 + cq) = pk4(acc[i][j][0] * QSCALE_B, acc[i][j][1] * QSCALE_B, acc[i][j][2] * QSCALE_B, acc[i][j][3] * QSCALE_B);
            }
        }
    }
};
struct EpiKV {
    Lay lay; bf16_t *Kb, *VtB;
    template <int BM, int BN, int NT>
    __device__ __forceinline__ void run(f32x4 (&acc)[4][4], int m0, int n0, int wr, int wc, int lane, char* lds) const {
        const int nw = n0 + wc * 64, cq = (lane >> 4) * 4;
        if (n0 < 256) {
#pragma unroll
            for (int i = 0; i < 4; ++i) {
                const int lrow = m0 + wr * 64 + i * 16 + (lane & 15);
                bf16_t* dst = Kb + (size_t)lrow * 384 + (nw >> 6) * 96 + cq;
#pragma unroll
                for (int j = 0; j < 4; ++j) *(uint2*)(dst + j * 16) = pk4(acc[i][j][0], acc[i][j][1], acc[i][j][2], acc[i][j][3]);
            }
        } else {
            int seq, key0, Lk;
            if (m0 < lay.Tloc) { const TokInfo t0 = tokinfo(lay.tbase + m0); seq = t0.seq; Lk = t0.latent ? VLD : 256; key0 = (t0.latent ? 512 : 0) + t0.pos; }
            else { const int cr = m0 - lay.Tloc; seq = 16 + lay.b0 + (cr >> 9); Lk = VLD; key0 = cr & 511; }
            bf16_t* vb = VtB; const Lay l = lay;
            store_transposed<BM, BN, NT>(acc, wr, wc, lane, lds, [=](int col) {
                const int c = n0 - 256 + col;
                return vb + vt_off(l, seq, c >> 7) + (size_t)(c & 127) * Lk + key0;
            });
        }
    }
};

template <int NT>
__device__ __forceinline__ void n_combine0(const bf16_t* __restrict__ oa1, const bf16_t* __restrict__ oa2, const float* lq1, const float* lk1, const float* lq2, const float* lk2,
                           const float* __restrict__ subln, bf16_t* __restrict__ merged, int vb) {
    const int lrow = vb * (NT / 256) + (TIDX >> 8), tid = TIDX & 255, lane = tid & 63;
    const float la = wave_sum(lq1[lane] * lk1[lane]), lb = wave_sum(lq2[lane] * lk2[lane]);
    const float lam = expf(la) - expf(lb) + 0.2f;
    const unsigned u1 = *(const unsigned*)(oa1 + (size_t)lrow * 512 + tid * 2), u2 = *(const unsigned*)(oa2 + (size_t)lrow * 512 + tid * 2);
    const float x0 = bf_lo(u1) - lam * bf_lo(u2), x1 = bf_hi(u1) - lam * bf_hi(u2);
    const float ss = wave_sum(x0 * x0 + x1 * x1);
    const float rs = rsqrtf(ss * (1.f / 128.f) + EPS) * 0.8f;
    const int e = (tid * 2) & 127;
    *(unsigned*)(merged + (size_t)lrow * DM + tid * 2) = pk_bf16(x0 * rs * subln[e], x1 * rs * subln[e + 1]);
}

template <int NT, int R>
__device__ __forceinline__ void n_combine0_m(const bf16_t* __restrict__ oa1, const bf16_t* __restrict__ oa2, const float* lq1, const float* lk1, const float* lq2, const float* lk2,
                           const float* __restrict__ subln, bf16_t* __restrict__ merged, int vb) {
    const int lrow0 = vb * (NT / 256) * R + (TIDX >> 8), tid = TIDX & 255, lane = tid & 63;
    unsigned u1[R], u2[R];
#pragma unroll
    for (int k = 0; k < R; ++k) {
        const size_t lrow = (size_t)(lrow0 + k * (NT / 256));
        u1[k] = *(const unsigned*)(oa1 + lrow * 512 + tid * 2); u2[k] = *(const unsigned*)(oa2 + lrow * 512 + tid * 2);
    }
    const float la = wave_sum(lq1[lane] * lk1[lane]), lb = wave_sum(lq2[lane] * lk2[lane]);
    const float lam = expf(la) - expf(lb) + 0.2f;
    const int e = (tid * 2) & 127;
    const float s0 = subln[e], s1 = subln[e + 1];
#pragma unroll
    for (int k = 0; k < R; ++k) {
        const size_t lrow = (size_t)(lrow0 + k * (NT / 256));
        const float x0 = bf_lo(u1[k]) - lam * bf_lo(u2[k]), x1 = bf_hi(u1[k]) - lam * bf_hi(u2[k]);
        const float ss = wave_sum(x0 * x0 + x1 * x1);
        const float rs = rsqrtf(ss * (1.f / 128.f) + EPS) * 0.8f;
        *(unsigned*)(merged + lrow * DM + tid * 2) = pk_bf16(x0 * rs * s0, x1 * rs * s1);
    }
}

struct EpiResid {
    Lay lay; const float *xp, *xs; const bf16_t* src; bf16_t* h; const float* modl; int goff;
    template <int BM, int BN, int NT>
    __device__ __forceinline__ void run(f32x4 (&acc)[4][4], int m0, int n0, int wr, int wc, int lane, char* l) const { run<BM, BN, NT, 4>(acc, m0, n0, wr, wc, lane, l); }
    template <int BM, int BN, int NT, int NJ>
    __device__ __forceinline__ void run(f32x4 (&acc)[4][NJ], int m0, int n0, int wr, int wc, int lane, char*) const {
        const int nw = n0 + wc * (16 * NJ), cq = (lane >> 4) * 4;
#pragma unroll
        for (int i = 0; i < 4; ++i) {
            const int lrow = m0 + wr * 64 + i * 16 + (lane & 15), t = lay.tbase + lrow;
            const TokInfo ti = tokinfo(t);
            const float* xr = xrow(xp, xs, t);
            const float* gt = modl + (size_t)ti.ci * 6144 + goff;
#pragma unroll
            for (int j = 0; j < NJ; ++j) {
                const int col = nw + j * 16 + cq;
                float4 b4;
                if (src) { const uint2 u = *(const uint2*)(src + (size_t)lrow * DM + col); b4 = make_float4(bf_lo(u.x), bf_hi(u.x), bf_lo(u.y), bf_hi(u.y)); }
                else b4 = *(const float4*)(xr + col);
                const float4 g4 = *(const float4*)(gt + col);
                *(uint2*)(h + (size_t)lrow * DM + col) = pk4(b4.x + g4.x * acc[i][j][0], b4.y + g4.y * acc[i][j][1], b4.z + g4.z * acc[i][j][2], b4.w + g4.w * acc[i][j][3]);
            }
        }
    }
};

template <int MH = 128>
struct EpiResid256 {
    EpiResid e; int m0;
    template <int NT>
    __device__ __forceinline__ void run256(f32x4 (&acc)[2][2][MH / 32][2], int n0, int wr, int wc, int lane, char*) const {
        const int cq = (lane >> 4) * 4;
#pragma unroll
        for (int ai = 0; ai < 2; ++ai)
#pragma unroll
            for (int m = 0; m < MH / 32; ++m) {
                const int lrow = m0 + ai * MH + wr * (MH / 2) + m * 16 + (lane & 15), t = e.lay.tbase + lrow;
                const TokInfo ti = tokinfo(t);
                const float* xr = xrow(e.xp, e.xs, t);
                const float* gt = e.modl + (size_t)ti.ci * 6144 + e.goff;
#pragma unroll
                for (int bj = 0; bj < 2; ++bj)
#pragma unroll
                    for (int n = 0; n < 2; ++n) {
                        const int col = n0 + bj * 128 + wc * 32 + n * 16 + cq;
                        float4 b4;
                        if (e.src) { const uint2 u = *(const uint2*)(e.src + (size_t)lrow * DM + col); b4 = make_float4(bf_lo(u.x), bf_hi(u.x), bf_lo(u.y), bf_hi(u.y)); }
                        else b4 = *(const float4*)(xr + col);
                        const float4 g4 = *(const float4*)(gt + col);
                        *(uint2*)(e.h + (size_t)lrow * DM + col) = pk4(b4.x + g4.x * acc[ai][bj][m][n][0], b4.y + g4.y * acc[ai][bj][m][n][1],
                                                                       b4.z + g4.z * acc[ai][bj][m][n][2], b4.w + g4.w * acc[ai][bj][m][n][3]);
                    }
            }
    }
};

struct EpiFFNUp {
    Lay lay; HaloTile ht; const float* cw; const float* cb; bf16_t* act;
    template <int NT>
    __device__ __forceinline__ void conv(const float* U, int t128) const {
        constexpr int BM = 256, GH = 64, LDU = 132, NP = GH / 2, NG = NT / NP, RPG = BM / NG;
        const int tid = TIDX, fp = tid % NP, grp = tid / NP, fg = t128 * GH + 2 * fp;
        const float2 wg0 = *(const float2*)(cw + fg), wg1 = *(const float2*)(cw + FF2 + fg), wg2 = *(const float2*)(cw + 2 * FF2 + fg), bg = *(const float2*)(cb + fg);
        const float2 wv0 = *(const float2*)(cw + FF + fg), wv1 = *(const float2*)(cw + FF2 + FF + fg), wv2 = *(const float2*)(cw + 2 * FF2 + FF + fg), bv = *(const float2*)(cb + FF + fg);
        const int r0 = grp * RPG;
        const float* Ug = U + 2 * fp;
        const float2 z2 = make_float2(0.f, 0.f);
        float2 gp = r0 > 0 ? *(const float2*)(Ug + (r0 - 1) * LDU) : z2, vp = r0 > 0 ? *(const float2*)(Ug + (r0 - 1) * LDU + GH) : z2;
        float2 gc = *(const float2*)(Ug + r0 * LDU), vc = *(const float2*)(Ug + r0 * LDU + GH);
        bf16_t* ap = act + (size_t)(ht.t0 + ht.row0 + r0 - lay.tbase) * FF + fg;
#pragma unroll 2
        for (int r = r0; r < r0 + RPG; ++r) {
            const bool more = r + 1 < BM;
            const float2 gn = more ? *(const float2*)(Ug + (r + 1) * LDU) : z2, vn = more ? *(const float2*)(Ug + (r + 1) * LDU + GH) : z2;
            if (r >= ht.lo && r < ht.hi) {
                const float ga = wg0.x * gp.x + wg1.x * gc.x + wg2.x * gn.x + bg.x, gb = wg0.y * gp.y + wg1.y * gc.y + wg2.y * gn.y + bg.y;
                const float va = wv0.x * vp.x + wv1.x * vc.x + wv2.x * vn.x + bv.x, vb = wv0.y * vp.y + wv1.y * vc.y + wv2.y * vn.y + bv.y;
                *(unsigned*)ap = pk_bf16(ga * __builtin_amdgcn_rcpf(1.f + __expf(-ga)) * va, gb * __builtin_amdgcn_rcpf(1.f + __expf(-gb)) * vb);
            }
            ap += FF;
            gp = gc; gc = gn; vp = vc; vc = vn;
        }
    }
    template <int BM, int BN, int NT>
    __device__ __forceinline__ void run(f32x4 (&acc)[4][4], int m0, int n0, int wr, int wc, int lane, char* lds) const {
        static_assert(BM == 256 && BN == 128, "tile");
        constexpr int LDU = BN + 4;
        float* U = (float*)lds;
#pragma unroll
        for (int i = 0; i < 4; ++i)
#pragma unroll
            for (int j = 0; j < 4; ++j)
                *(f32x4*)(U + (wr * 64 + i * 16 + (lane & 15)) * LDU + wc * 64 + j * 16 + (lane >> 4) * 4) = acc[i][j];
        __syncthreads();
        conv<NT>(U, n0 / BN);
        __syncthreads();
    }
    template <int NT>
    __device__ __forceinline__ void run256(f32x4 (&acc)[2][2][4][2], int n0, int wr, int wc, int lane, char* lds) const {
        constexpr int LDU = 132;
        float* U = (float*)lds;
#pragma unroll
        for (int bj = 0; bj < 2; ++bj) {
#pragma unroll
            for (int ai = 0; ai < 2; ++ai)
#pragma unroll
                for (int m = 0; m < 4; ++m)
#pragma unroll
                    for (int n = 0; n < 2; ++n)
                        *(f32x4*)(U + (ai * 128 + wr * 64 + m * 16 + (lane & 15)) * LDU + wc * 32 + n * 16 + (lane >> 4) * 4) = acc[ai][bj][m][n];
            __syncthreads();
            conv<NT>(U, n0 / 128 + bj);
            __syncthreads();
        }
    }
};


template <int CTRL> __device__ __forceinline__ float dppf(float x) {
    return __builtin_bit_cast(float, __builtin_amdgcn_mov_dpp(__builtin_bit_cast(int, x), CTRL, 0xF, 0xF, true));
}
__device__ __forceinline__ float sfma(float a, float b, float c) { float d; asm("v_fma_f32 %0, %1, %2, %3" : "=v"(d) : "v"(a), "v"(b), "v"(c)); return d; }
__device__ __forceinline__ float smul(float a, float b) { float d; asm("v_mul_f32 %0, %1, %2" : "=v"(d) : "v"(a), "v"(b)); return d; }
__device__ __forceinline__ float sadd(float a, float b) { float d; asm("v_add_f32 %0, %1, %2" : "=v"(d) : "v"(a), "v"(b)); return d; }
__device__ __forceinline__ float red8(float x) { x += dppf<0xB1>(x); x += dppf<0x4E>(x); x += dppf<0x141>(x); return x; }
__device__ __forceinline__ float red16(float x) { x = red8(x); x += dppf<0x140>(x); return x; }
__device__ __forceinline__ float fsigmoid(float x) { return __builtin_amdgcn_rcpf(1.f + __expf(-x)); }
__device__ __forceinline__ float ftanh(float x) { return 1.f - 2.f * __builtin_amdgcn_rcpf(1.f + __expf(2.f * x)); }
__device__ __forceinline__ void unpack8(const uint4 u, float (&f)[8]) {
    f[0] = bf_lo(u.x); f[1] = bf_hi(u.x); f[2] = bf_lo(u.y); f[3] = bf_hi(u.y); f[4] = bf_lo(u.z); f[5] = bf_hi(u.z); f[6] = bf_lo(u.w); f[7] = bf_hi(u.w);
}

struct EpiIn1 {
    Lay lay; HaloTile ht; const float *mu, *conv_w, *conv_b; bf16_t *zcm, *zg, *xc; float* dtr;
    template <int NT>
    __device__ __forceinline__ void staged(const float* U, int nt) const {
        constexpr int BM = 256, BN = 128, LDU = BN + 4, NP = BN / 2, NG = NT / NP, RPG = BM / NG;
        const int n0 = nt * BN;
        const int tid = TIDX, fp = tid % NP, grp = tid / NP, r0 = grp * RPG;
        const bool mix = nt < 15;
        const int c = (mix ? n0 : n0 - 2432) + 2 * fp;
        const float2 z2 = make_float2(0.f, 0.f);
        const float2 k0 = mix ? z2 : *(const float2*)(conv_w + c), k1 = mix ? *(const float2*)(mu + c) : *(const float2*)(conv_w + 768 + c);
        const float2 k2 = mix ? z2 : *(const float2*)(conv_w + 2 * 768 + c), kb = mix ? z2 : *(const float2*)(conv_b + c);
        const float* Uc = U + 2 * fp;
        float2 xp = r0 > 0 ? *(const float2*)(Uc + (r0 - 1) * LDU) : z2, xv = *(const float2*)(Uc + r0 * LDU);
        const size_t lrow0 = (size_t)(ht.t0 + ht.row0 + r0 - lay.tbase);
        bf16_t* op = mix ? zcm + lrow0 * CC + c : xc + lrow0 * 768 + c;
        const int ostr = mix ? CC : 768;
#pragma unroll 2
        for (int r = r0; r < r0 + RPG; ++r) {
            const float2 xn = r + 1 < BM ? *(const float2*)(Uc + (r + 1) * LDU) : z2;
            if (r >= ht.lo && r < ht.hi) {
                float oa, ob;
                if (mix) { oa = xv.x + k1.x * (0.5f * (xp.x + xn.x) - xv.x); ob = xv.y + k1.y * (0.5f * (xp.y + xn.y) - xv.y); }
                else {
                    const float sa = k0.x * xp.x + k1.x * xv.x + k2.x * xn.x + kb.x, sb = k0.y * xp.y + k1.y * xv.y + k2.y * xn.y + kb.y;
                    oa = sa * __builtin_amdgcn_rcpf(1.f + __expf(-sa)); ob = sb * __builtin_amdgcn_rcpf(1.f + __expf(-sb));
                }
                *(unsigned*)op = pk_bf16(oa, ob);
            }
            op += ostr;
            xp = xv; xv = xn;
        }
    }
    template <int BM, int BN, int NT>
    __device__ __forceinline__ void run(f32x4 (&acc)[4][4], int m0, int n0, int wr, int wc, int lane, char* lds) const {
        static_assert(BN == 128 && BM == 256, "tile");
        const int nt = n0 / BN, cq = (lane >> 4) * 4;
        if (nt >= 15 && nt < 19) {
#pragma unroll
            for (int i = 0; i < 4; ++i) {
                const int r = wr * 64 + i * 16 + (lane & 15);
                if (r >= ht.lo && r < ht.hi) {
                    bf16_t* dst = zg + (size_t)(ht.t0 + ht.row0 + r - lay.tbase) * 512 + (n0 - 1920) + wc * 64 + cq;
#pragma unroll
                    for (int j = 0; j < 4; ++j) *(uint2*)(dst + j * 16) = pk4(acc[i][j][0], acc[i][j][1], acc[i][j][2], acc[i][j][3]);
                }
            }
            return;
        }
        if (nt == 25) {
            if (wc == 0 && lane < 32) {
#pragma unroll
                for (int i = 0; i < 4; ++i) {
                    const int r = wr * 64 + i * 16 + (lane & 15);
                    if (r >= ht.lo && r < ht.hi)
                        *(float4*)(dtr + (size_t)(ht.t0 + ht.row0 + r - lay.tbase) * 8 + cq) = make_float4(acc[i][0][0], acc[i][0][1], acc[i][0][2], acc[i][0][3]);
                }
            }
            return;
        }
        constexpr int LDU = BN + 4;
        float* U = (float*)lds;
#pragma unroll
        for (int i = 0; i < 4; ++i)
#pragma unroll
            for (int j = 0; j < 4; ++j)
                *(f32x4*)(U + (wr * 64 + i * 16 + (lane & 15)) * LDU + wc * 64 + j * 16 + cq) = acc[i][j];
        __syncthreads();
        staged<NT>(U, nt);
        __syncthreads();
    }
    template <int NT>
    __device__ __forceinline__ void run256(f32x4 (&acc)[2][2][4][2], int n0, int wr, int wc, int lane, char* lds) const {
        constexpr int LDU = 132;
        const int cq = (lane >> 4) * 4;
        float* U = (float*)lds;
#pragma unroll
        for (int bj = 0; bj < 2; ++bj) {
            const int nt = n0 / 128 + bj;
            if (nt >= 15 && nt < 19) {
#pragma unroll
                for (int ai = 0; ai < 2; ++ai)
#pragma unroll
                    for (int m = 0; m < 4; ++m) {
                        const int r = ai * 128 + wr * 64 + m * 16 + (lane & 15);
                        if (r >= ht.lo && r < ht.hi) {
                            bf16_t* dst = zg + (size_t)(ht.t0 + ht.row0 + r - lay.tbase) * 512 + (nt * 128 - 1920) + wc * 32 + cq;
#pragma unroll
                            for (int n = 0; n < 2; ++n) *(uint2*)(dst + n * 16) = pk4(acc[ai][bj][m][n][0], acc[ai][bj][m][n][1], acc[ai][bj][m][n][2], acc[ai][bj][m][n][3]);
                        }
                    }
            } else if (nt == 25) {
                if (wc == 0 && lane < 32) {
#pragma unroll
                    for (int ai = 0; ai < 2; ++ai)
#pragma unroll
                        for (int m = 0; m < 4; ++m) {
                            const int r = ai * 128 + wr * 64 + m * 16 + (lane & 15);
                            if (r >= ht.lo && r < ht.hi)
                                *(float4*)(dtr + (size_t)(ht.t0 + ht.row0 + r - lay.tbase) * 8 + cq) =
                                    make_float4(acc[ai][bj][m][0][0], acc[ai][bj][m][0][1], acc[ai][bj][m][0][2], acc[ai][bj][m][0][3]);
                        }
                }
            } else {
#pragma unroll
                for (int ai = 0; ai < 2; ++ai)
#pragma unroll
                    for (int m = 0; m < 4; ++m)
#pragma unroll
                        for (int n = 0; n < 2; ++n)
                            *(f32x4*)(U + (ai * 128 + wr * 64 + m * 16 + (lane & 15)) * LDU + wc * 32 + n * 16 + cq) = acc[ai][bj][m][n];
                __syncthreads();
                staged<NT>(U, nt);
                __syncthreads();
            }
        }
    }
};


template <int KS, bool TRANS>
__device__ __forceinline__ f32x4 mm_tile(const bf16_t* A, int lda, const bf16_t* Bt, int ldb, f32x4 acc, int lane) {
#pragma unroll
    for (int ks = 0; ks < KS; ++ks) {
        const bf16x8 a = *(const bf16x8*)(A + (lane & 15) * lda + ks * 32 + (lane >> 4) * 8);
        const bf16x8 b = *(const bf16x8*)(Bt + (lane & 15) * ldb + ks * 32 + (lane >> 4) * 8);
        acc = TRANS ? __builtin_amdgcn_mfma_f32_16x16x32_bf16(b, a, acc, 0, 0, 0) : __builtin_amdgcn_mfma_f32_16x16x32_bf16(a, b, acc, 0, 0, 0);
    }
    return acc;
}
typedef __attribute__((ext_vector_type(2))) unsigned u32x2;
__device__ __forceinline__ bf16x8 ld_row(const bf16_t* A, int lda, int lane) { return *(const bf16x8*)(A + (lane & 15) * lda + (lane >> 4) * 8); }
__device__ __forceinline__ bf16x8 ld_row16(const bf16_t* A, int lane) {
    bf16x8 a = *(const bf16x8*)(A + (lane & 15) * 24 + ((lane >> 4) & 1) * 8);
    if (lane >= 32) a = (bf16x8){0, 0, 0, 0, 0, 0, 0, 0};
    return a;
}
template <bool K16>
__device__ __forceinline__ bf16x8 ld_tr(const bf16_t* X, int ld, int lane) {
    const int g = K16 ? ((lane >> 4) & 1) : (lane >> 4), q = (lane & 15) >> 2, p = lane & 3;
    const unsigned a0 = (unsigned)(size_t)(X + (8 * g + q) * ld + 4 * p), a1 = a0 + 8u * (unsigned)ld;
    u32x2 r0, r1;
    asm volatile("ds_read_b64_tr_b16 %0, %2\n\tds_read_b64_tr_b16 %1, %3\n\ts_waitcnt lgkmcnt(0)" : "=&v"(r0), "=&v"(r1) : "v"(a0), "v"(a1) : "memory");
    u32x4 v = {r0.x, r0.y, r1.x, r1.y};
    if (K16 && lane >= 32) v = (u32x4){0u, 0u, 0u, 0u};
    return __builtin_bit_cast(bf16x8, v);
}
template <bool K16>
__device__ __forceinline__ void ld_tr2(const bf16_t* X0, const bf16_t* X1, int ld, int lane, bf16x8& o0, bf16x8& o1) {
    const int g = K16 ? ((lane >> 4) & 1) : (lane >> 4), q = (lane & 15) >> 2, p = lane & 3;
    const unsigned off = (unsigned)(((8 * g + q) * ld + 4 * p) * 2), st = 8u * (unsigned)ld;
    const unsigned a0 = (unsigned)(size_t)X0 + off, a1 = (unsigned)(size_t)X1 + off;
    u32x2 r0, r1, r2, r3;
    asm volatile("ds_read_b64_tr_b16 %0, %4\n\tds_read_b64_tr_b16 %1, %5\n\tds_read_b64_tr_b16 %2, %6\n\tds_read_b64_tr_b16 %3, %7\n\ts_waitcnt lgkmcnt(0)"
                 : "=&v"(r0), "=&v"(r1), "=&v"(r2), "=&v"(r3) : "v"(a0), "v"(a0 + st), "v"(a1), "v"(a1 + st) : "memory");
    u32x4 v0 = {r0.x, r0.y, r1.x, r1.y}, v1 = {r2.x, r2.y, r3.x, r3.y};
    if (K16 && lane >= 32) { v0 = (u32x4){0u, 0u, 0u, 0u}; v1 = v0; }
    o0 = __builtin_bit_cast(bf16x8, v0); o1 = __builtin_bit_cast(bf16x8, v1);
}
template <bool K16>
__device__ __forceinline__ void ld_tr4(const bf16_t* X0, const bf16_t* X1, const bf16_t* X2, const bf16_t* X3, int ld, int lane, bf16x8& o0, bf16x8& o1, bf16x8& o2, bf16x8& o3) {
    const int g = K16 ? ((lane >> 4) & 1) : (lane >> 4), q = (lane & 15) >> 2, p = lane & 3;
    const unsigned off = (unsigned)(((8 * g + q) * ld + 4 * p) * 2), st = 8u * (unsigned)ld;
    const unsigned a0 = (unsigned)(size_t)X0 + off, a1 = (unsigned)(size_t)X1 + off, a2 = (unsigned)(size_t)X2 + off, a3 = (unsigned)(size_t)X3 + off;
    u32x2 r0, r1, r2, r3, r4, r5, r6, r7;
    asm volatile("ds_read_b64_tr_b16 %0, %8\n\tds_read_b64_tr_b16 %1, %9\n\tds_read_b64_tr_b16 %2, %10\n\tds_read_b64_tr_b16 %3, %11\n\t"
                 "ds_read_b64_tr_b16 %4, %12\n\tds_read_b64_tr_b16 %5, %13\n\tds_read_b64_tr_b16 %6, %14\n\tds_read_b64_tr_b16 %7, %15\n\ts_waitcnt lgkmcnt(0)"
                 : "=&v"(r0), "=&v"(r1), "=&v"(r2), "=&v"(r3), "=&v"(r4), "=&v"(r5), "=&v"(r6), "=&v"(r7)
                 : "v"(a0), "v"(a0 + st), "v"(a1), "v"(a1 + st), "v"(a2), "v"(a2 + st), "v"(a3), "v"(a3 + st) : "memory");
    u32x4 v0 = {r0.x, r0.y, r1.x, r1.y}, v1 = {r2.x, r2.y, r3.x, r3.y}, v2 = {r4.x, r4.y, r5.x, r5.y}, v3 = {r6.x, r6.y, r7.x, r7.y};
    if (K16 && lane >= 32) { v0 = (u32x4){0u, 0u, 0u, 0u}; v1 = v0; v2 = v0; v3 = v0; }
    o0 = __builtin_bit_cast(bf16x8, v0); o1 = __builtin_bit_cast(bf16x8, v1); o2 = __builtin_bit_cast(bf16x8, v2); o3 = __builtin_bit_cast(bf16x8, v3);
}
template <bool TRANS>
__device__ __forceinline__ f32x4 mma(const bf16x8 a, const bf16x8 b, const f32x4 acc) {
    return TRANS ? __builtin_amdgcn_mfma_f32_16x16x32_bf16(b, a, acc, 0, 0, 0) : __builtin_amdgcn_mfma_f32_16x16x32_bf16(a, b, acc, 0, 0, 0);
}

template <int NT>
__device__ __forceinline__ void n_ssd2(const Lay lay, const bf16_t* __restrict__ xc, const float* __restrict__ dtr, const float* __restrict__ A_log, const float* __restrict__ dt_bias,
                                       const float* __restrict__ Dp, const float* __restrict__ H0f, const float* __restrict__ H0b, bf16_t* __restrict__ yd,
                                       float* __restrict__ Hf_out, float* __restrict__ Hb_out, int item, char* lds,
                                       const int c0, const int c1, const float* __restrict__ Hinit, float* __restrict__ Hend) {
    static_assert(NT == 512, "n_ssd2 needs 8 waves");
    const int tid = TIDX, lane = tid & 63, wv = tid >> 6;
    const int dir = item & 1, h = (item >> 1) & 7, seq = lay.seqbase + (item >> 4), g = h >> 2;
    const bool latent = seq >= 16;
    const int L = latent ? 4096 : 256, row0 = (latent ? 4096 + (seq - 16) * 4096 : seq * 256) - lay.tbase;
    bf16_t* Cs = (bf16_t*)lds; bf16_t* Bs = Cs + 4608; bf16_t* Cd = Bs + 4608; bf16_t* Sc = Cd + 4608; bf16_t* Xs = Sc + 4608; bf16_t* Xd = Xs + 4608;
    bf16_t* Sb0 = Xd + 4608; bf16_t* Sb1 = Sb0 + 4608;
    float* acum = (float*)(Sb1 + 4608); float* dts = acum + 64;
    const int pt = tid >> 3, part = tid & 7;
    const int tT = wv >> 1, q0 = (wv & 1) * 2;
    const float A = -__expf(A_log[dir * 8 + h]), Dv = Dp[dir * 8 + h], dtb = dt_bias[dir * 8 + h];
    f32x4 S[2];
    __syncthreads();
    {
        const float* H0 = dir ? H0b : H0f;
#pragma unroll
        for (int q = 0; q < 2; ++q)
#pragma unroll
            for (int r = 0; r < 4; ++r) {
                const int p = tT * 16 + (lane >> 4) * 4 + r, n = (q0 + q) * 16 + (lane & 15);
                const float v = Hinit ? Hinit[p * 64 + n] : (latent ? H0[((size_t)((seq - 16) * 8 + h) * 64 + p) * 64 + n] : 0.f);
                S[q][r] = v; Sb0[p * 72 + n] = to_bf(v);
            }
    }
    uint4 g_b, g_c, g_x; float g_dt = 0.f;
#define SSD2_LOAD(cidx) { const int s_ = (cidx) * 64 + pt; const int pos_ = dir ? (L - 1 - s_) : s_; \
        const bf16_t* xr_ = xc + (size_t)(row0 + pos_) * 768; \
        g_b = *(const uint4*)(xr_ + 512 + g * 64 + part * 8); g_c = *(const uint4*)(xr_ + 640 + g * 64 + part * 8); g_x = *(const uint4*)(xr_ + h * 64 + part * 8); \
        if (part == 0) g_dt = dtr[(size_t)(row0 + pos_) * 8 + h]; }
    SSD2_LOAD(c0)
    int cur = 0;
    for (int c = c0; c < c1; ++c) {
        bf16_t* Sbc = cur ? Sb1 : Sb0; bf16_t* Sbn = cur ? Sb0 : Sb1;
        float fc[8], fx[8];
        {
            unpack8(g_c, fc); unpack8(g_x, fx);
            *(uint4*)(Cs + pt * 72 + part * 8) = g_c;
            *(uint4*)(Bs + pt * 72 + part * 8) = g_b;
            *(uint4*)(Xs + pt * 72 + part * 8) = g_x;
            if (part == 0) {
                const float xx = g_dt + dtb;
                const float dt = fmaxf(xx, 0.f) + __logf(1.f + __expf(-fabsf(xx)));
                dts[pt] = dt; acum[pt] = dt * A;
            }
        }
        if (c + 1 < c1) SSD2_LOAD(c + 1)
        __syncthreads();
        if (wv == 0) {
            float v = acum[lane];
#pragma unroll
            for (int o = 1; o < 64; o <<= 1) { const float u = __shfl_up(v, o); if (lane >= o) v += u; }
            acum[lane] = v;
        }
        __syncthreads();
        {
            const float ac = acum[pt], et = __expf(ac), sc = dts[pt] * __expf(acum[63] - ac);
            *(uint4*)(Cd + pt * 72 + part * 8) = make_uint4(pk_bf16(fc[0] * et, fc[1] * et), pk_bf16(fc[2] * et, fc[3] * et), pk_bf16(fc[4] * et, fc[5] * et), pk_bf16(fc[6] * et, fc[7] * et));
            *(uint4*)(Xd + pt * 72 + part * 8) = make_uint4(pk_bf16(fx[0] * sc, fx[1] * sc), pk_bf16(fx[2] * sc, fx[3] * sc), pk_bf16(fx[4] * sc, fx[5] * sc), pk_bf16(fx[6] * sc, fx[7] * sc));
        }
        __syncthreads();
        {
#pragma unroll
            for (int q = 0; q < 2; ++q) {
                f32x4 acc = mm_tile<2, false>(Cs + tT * 16 * 72, 72, Bs + (q0 + q) * 16 * 72, 72, (f32x4){0.f, 0.f, 0.f, 0.f}, lane);
                const int j = (q0 + q) * 16 + (lane & 15);
                const float aj = acum[j], dj = dts[j];
#pragma unroll
                for (int r = 0; r < 4; ++r) {
                    const int t = tT * 16 + (lane >> 4) * 4 + r;
                    Sc[t * 72 + j] = to_bf(j <= t ? acc[r] * __expf(acum[t] - aj) * dj : 0.f);
                }
            }
        }
        __syncthreads();
        {
#pragma unroll
            for (int q = 0; q < 2; ++q) {
                f32x4 acc = (f32x4){0.f, 0.f, 0.f, 0.f};
                bf16x8 x0, x1;
                ld_tr2<false>(Xs + (q0 + q) * 16, Xs + 32 * 72 + (q0 + q) * 16, 72, lane, x0, x1);
                acc = mma<true>(ld_row(Sc + tT * 16 * 72, 72, lane), x0, acc);
                acc = mma<true>(ld_row(Sc + tT * 16 * 72 + 32, 72, lane), x1, acc);
                acc = mm_tile<2, true>(Cd + tT * 16 * 72, 72, Sbc + (q0 + q) * 16 * 72, 72, acc, lane);
                const int t = tT * 16 + (lane & 15), p = (q0 + q) * 16 + (lane >> 4) * 4;
                const int s = c * 64 + t, pos = dir ? (L - 1 - s) : s;
                const uint2 ux = *(const uint2*)(xc + (size_t)(row0 + pos) * 768 + h * 64 + p);
                *(uint2*)(yd + ((size_t)dir * lay.Tloc + row0 + pos) * 512 + h * 64 + p) =
                    pk4(acc[0] + Dv * bf_lo(ux.x), acc[1] + Dv * bf_hi(ux.x), acc[2] + Dv * bf_lo(ux.y), acc[3] + Dv * bf_hi(ux.y));
            }
            const float eC = __expf(acum[63]);
            bf16x8 xd0, xd1, bb00, bb01, bb10, bb11;
            ld_tr2<false>(Xd + tT * 16, Xd + 32 * 72 + tT * 16, 72, lane, xd0, xd1);
            ld_tr4<false>(Bs + q0 * 16, Bs + (q0 + 1) * 16, Bs + 32 * 72 + q0 * 16, Bs + 32 * 72 + (q0 + 1) * 16, 72, lane, bb00, bb01, bb10, bb11);
#pragma unroll
            for (int q = 0; q < 2; ++q) {
                S[q] = S[q] * eC;
                S[q] = mma<false>(xd0, q ? bb01 : bb00, S[q]);
                S[q] = mma<false>(xd1, q ? bb11 : bb10, S[q]);
#pragma unroll
                for (int r = 0; r < 4; ++r) Sbn[(tT * 16 + (lane >> 4) * 4 + r) * 72 + (q0 + q) * 16 + (lane & 15)] = to_bf(S[q][r]);
            }
        }
        __syncthreads();
        cur ^= 1;
    }
    float* Ho = dir ? Hb_out : Hf_out;
    if (!latent) {
#pragma unroll
        for (int q = 0; q < 2; ++q)
#pragma unroll
            for (int r = 0; r < 4; ++r) Ho[((size_t)(seq * 8 + h) * 64 + tT * 16 + (lane >> 4) * 4 + r) * 64 + (q0 + q) * 16 + (lane & 15)] = S[q][r];
    }
    if (Hend) {
#pragma unroll
        for (int q = 0; q < 2; ++q)
#pragma unroll
            for (int r = 0; r < 4; ++r) Hend[(tT * 16 + (lane >> 4) * 4 + r) * 64 + (q0 + q) * 16 + (lane & 15)] = S[q][r];
    }
#undef SSD2_LOAD
}

template <int NT>
__device__ __forceinline__ void n_wkv2(const Lay lay, const bf16_t* __restrict__ zcm, const bf16_t* __restrict__ w2t, const bf16_t* __restrict__ a2t,
                                       const float* __restrict__ w0, const float* __restrict__ a0, const float* __restrict__ k_k, const float* __restrict__ k_a,
                                       const float* __restrict__ S0f, const float* __restrict__ S0b, bf16_t* __restrict__ y,
                                       float* __restrict__ Sf_out, float* __restrict__ Sb_out, int item, char* lds) {
    static_assert(NT == 512, "n_wkv2 needs 8 waves");
    const int tid = TIDX, lane = tid & 63, wv = tid >> 6;
    const int dir = item & 1, h = (item >> 1) & 7, seq = lay.seqbase + (item >> 4);
    const bool latent = seq >= 16;
    const int L = latent ? 4096 : 256, row0 = (latent ? 4096 + (seq - 16) * 4096 : seq * 256) - lay.tbase;
    bf16_t* W2s = (bf16_t*)lds; bf16_t* A2s = W2s + 4608; bf16_t* Sb0 = A2s + 4608; bf16_t* Sb1 = Sb0 + 4608;
    bf16_t* KR = Sb1 + 4608; bf16_t* RR = KR + 2304;
    constexpr int LG = 68;
    float* AA = (float*)(RR + 2304); float* GG = AA + 32 * LG; float* rsv = GG + 32 * LG; float* gC = rsv + 32;
    bf16_t* X1 = (bf16_t*)(gC + 128); bf16_t* X2 = X1 + 2304;
    bf16_t* OPS = X2 + 2304;
    constexpr int OPS_SC = 7 * 1152;
    bf16_t* TMP = OPS + 2 * OPS_SC;
    constexpr int TMP_SC = 512 + 4 * 384 + 1152 + 1152;
    bf16_t* Us = TMP + 2 * TMP_SC;
    __syncthreads();
    {
        const int c = tid >> 3, part = tid & 7;
        *(uint4*)(W2s + c * 72 + part * 8) = *(const uint4*)(w2t + ((size_t)dir * 512 + h * 64 + c) * 64 + part * 8);
        *(uint4*)(A2s + c * 72 + part * 8) = *(const uint4*)(a2t + ((size_t)dir * 512 + h * 64 + c) * 64 + part * 8);
    }
    const int pt = tid >> 4, part = tid & 15, ch0 = part * 4;
    const int psc = pt >> 4, ptl = pt & 15;
    float kkc[4], kac[4];
#pragma unroll
    for (int i = 0; i < 4; ++i) { kkc[i] = k_k[h * 64 + ch0 + i]; kac[i] = k_a[h * 64 + ch0 + i]; }
    const int lm = wv >> 2, lrt = (wv >> 1) & 1, lct0 = (wv & 1) * 2;
    float lc0[2];
#pragma unroll
    for (int q = 0; q < 2; ++q) { const int ch = dir * 512 + h * 64 + (lct0 + q) * 16 + (lane & 15); lc0[q] = lm ? a0[ch] : w0[ch]; }
    const int vT = wv >> 1, kT0 = (wv & 1) * 2;
    f32x4 S[2];
    f32x4 accU = (f32x4){0.f, 0.f, 0.f, 0.f};
    {
        const float* S0 = dir ? S0b : S0f;
#pragma unroll
        for (int q = 0; q < 2; ++q)
#pragma unroll
            for (int r = 0; r < 4; ++r) {
                const int v = vT * 16 + (lane >> 4) * 4 + r, k = (kT0 + q) * 16 + (lane & 15);
                const float x = latent ? S0[((size_t)((seq - 16) * 8 + h) * 64 + v) * 64 + k] : 0.f;
                S[q][r] = x; Sb0[v * 72 + k] = to_bf(x);
            }
    }
    uint2 g_r, g_k, g_wd, g_ad, g_v;
#define WKV2_LOAD(cidx) { const int s_ = (cidx) * 32 + pt; const int pos_ = dir ? (L - 1 - s_) : s_; \
        const bf16_t* zr_ = zcm + (size_t)(row0 + pos_) * CC; \
        g_r = *(const uint2*)(zr_ + h * 64 + ch0); g_k = *(const uint2*)(zr_ + 512 + h * 64 + ch0); g_v = *(const uint2*)(zr_ + 1024 + h * 64 + ch0); \
        g_wd = *(const uint2*)(zr_ + 1536 + dir * 64 + ch0); g_ad = *(const uint2*)(zr_ + 1664 + dir * 64 + ch0); }
    WKV2_LOAD(0)
    const int nb = L / 32;
    int cur = 0;
    for (int c = 0; c < nb; ++c) {
        float fr[4], fk[4];
        {
            fr[0] = bf_lo(g_r.x); fr[1] = bf_hi(g_r.x); fr[2] = bf_lo(g_r.y); fr[3] = bf_hi(g_r.y);
            fk[0] = bf_lo(g_k.x); fk[1] = bf_hi(g_k.x); fk[2] = bf_lo(g_k.y); fk[3] = bf_hi(g_k.y);
            float ss = 0.f;
#pragma unroll
            for (int i = 0; i < 4; ++i) { const float q = fk[i] * kkc[i]; ss += q * q; }
            ss = red16(ss);
            if (part == 0) rsv[pt] = rsqrtf(ss + 1e-12f);
            *(uint2*)(X1 + pt * 72 + ch0) = pk4(ftanh(bf_lo(g_wd.x)), ftanh(bf_hi(g_wd.x)), ftanh(bf_lo(g_wd.y)), ftanh(bf_hi(g_wd.y)));
            *(uint2*)(X2 + pt * 72 + ch0) = g_ad;
            *(uint2*)(OPS + psc * OPS_SC + 6 * 1152 + ptl * 72 + ch0) = g_v;
        }
        if (c + 1 < nb) WKV2_LOAD(c + 1)
        __syncthreads();
        for (int rp2_ = 0; rp2_ < REP_W2; ++rp2_) {
        {
            const bf16_t* Xm = lm ? X2 : X1; const bf16_t* Wm = lm ? A2s : W2s;
#pragma unroll
            for (int q = 0; q < 2; ++q) {
                const f32x4 acc = mm_tile<2, false>(Xm + lrt * 16 * 72, 72, Wm + (lct0 + q) * 16 * 72, 72, (f32x4){0.f, 0.f, 0.f, 0.f}, lane);
#pragma unroll
                for (int r = 0; r < 4; ++r) {
                    const int o = (lrt * 16 + (lane >> 4) * 4 + r) * LG + (lct0 + q) * 16 + (lane & 15);
                    const float sg = fsigmoid(lc0[q] + acc[r]);
                    if (lm == 0) GG[o] = -0.606531f * sg; else AA[o] = sg;
                }
            }
        }
        __syncthreads();
        }
        if (tid < 128) {
            const int sc = tid >> 6, ch = tid & 63;
            float lw[16];
#pragma unroll
            for (int t = 0; t < 16; ++t) lw[t] = GG[(sc * 16 + t) * LG + ch];
#pragma unroll
            for (int t = 1; t < 16; ++t) lw[t] += lw[t - 1];
#pragma unroll
            for (int t = 0; t < 16; ++t) GG[(sc * 16 + t) * LG + ch] = lw[t];
        }
        __syncthreads();
        for (int rp4_ = 0; rp4_ < REP_W4; ++rp4_) {
        {
            const float rs = rsv[pt];
            bf16_t* ops = OPS + psc * OPS_SC;
            float va[4], vb[4], vk[4], vr[4], vbh[4], vkh[4];
#pragma unroll
            for (int i = 0; i < 4; ++i) {
                const int ch = ch0 + i;
                const float G = GG[pt * LG + ch], Gp = ptl ? GG[(pt - 1) * LG + ch] : 0.f, GC = GG[(psc * 16 + 15) * LG + ch];
                const float a = AA[pt * LG + ch], kk = fk[i] * kkc[i] * rs, ki = fk[i] * (1.f + (a - 1.f) * kac[i]);
                const float enG = __expf(-G), gc = __expf(GC);
                va[i] = -kk * __expf(Gp); vb[i] = kk * a * enG; vk[i] = ki * enG; vr[i] = fr[i] * __expf(G);
                vbh[i] = vb[i] * gc; vkh[i] = vk[i] * gc;
                if (ptl == 15) gC[psc * 64 + ch] = gc;
            }
            *(uint2*)(ops + 0 * 1152 + ptl * 72 + ch0) = pk4(va[0], va[1], va[2], va[3]);
            *(uint2*)(ops + 1 * 1152 + ptl * 72 + ch0) = pk4(vb[0], vb[1], vb[2], vb[3]);
            *(uint2*)(ops + 2 * 1152 + ptl * 72 + ch0) = pk4(vk[0], vk[1], vk[2], vk[3]);
            *(uint2*)(ops + 3 * 1152 + ptl * 72 + ch0) = pk4(vr[0], vr[1], vr[2], vr[3]);
            *(uint2*)(ops + 4 * 1152 + ptl * 72 + ch0) = pk4(vbh[0], vbh[1], vbh[2], vbh[3]);
            *(uint2*)(ops + 5 * 1152 + ptl * 72 + ch0) = pk4(vkh[0], vkh[1], vkh[2], vkh[3]);
        }
        __syncthreads();
        }
        for (int rp5_ = 0; rp5_ < REP_W567; ++rp5_) {
        {
            const int sc = wv >> 2, prod = wv & 3;
            const bf16_t* ops = OPS + sc * OPS_SC;
            bf16_t* tmp = TMP + sc * TMP_SC;
            const f32x4 acc = mm_tile<2, false>(ops + (prod < 2 ? 0 : 3) * 1152, 72, ops + ((prod & 1) ? 2 : 1) * 1152, 72, (f32x4){0.f, 0.f, 0.f, 0.f}, lane);
            const int j = lane & 15;
#pragma unroll
            for (int r = 0; r < 4; ++r) {
                const int t = (lane >> 4) * 4 + r;
                const float v = (prod < 2 ? (j < t) : (j <= t)) ? acc[r] : 0.f;
                if (prod == 0) ((float*)tmp)[t * 16 + j] = v;
                else tmp[512 + (prod - 1) * 384 + t * 24 + j] = to_bf(v);
            }
        }
        __syncthreads();
        {
            const int sc = wv >> 2, vt = wv & 3;
            const bf16_t* ops = OPS + sc * OPS_SC;
            bf16_t* tmp = TMP + sc * TMP_SC;
            const f32x4 acc = mma<false>(ld_row16(tmp + 512 + 0 * 384, lane), ld_tr<true>(ops + 6 * 1152 + vt * 16, 72, lane), (f32x4){0.f, 0.f, 0.f, 0.f});
#pragma unroll
            for (int r = 0; r < 4; ++r) tmp[512 + 4 * 384 + ((lane >> 4) * 4 + r) * 72 + vt * 16 + (lane & 15)] = to_bf(acc[r]);
            if (tid < 32) {
                const int isc = tid >> 4, j = tid & 15;
                const float* N = (const float*)(TMP + isc * TMP_SC);
                bf16_t* Mb = TMP + isc * TMP_SC + 512 + 3 * 384;
                float m[16];
#pragma unroll
                for (int t = 0; t < 16; ++t) {
                    float p0 = (t == j) ? 1.f : 0.f, p1 = 0.f, p2 = 0.f, p3 = 0.f;
#pragma unroll
                    for (int s = 0; s < t; ++s) {
                        const float nv = N[t * 16 + s];
                        if ((s & 3) == 0) p0 += nv * m[s]; else if ((s & 3) == 1) p1 += nv * m[s]; else if ((s & 3) == 2) p2 += nv * m[s]; else p3 += nv * m[s];
                    }
                    m[t] = (t >= j) ? (p0 + p1) + (p2 + p3) : 0.f;
                    Mb[t * 24 + j] = to_bf(m[t]);
                }
            }
        }
        __syncthreads();
        {
            const int sc = wv >> 2, tl = wv & 3;
            const bf16_t* ops = OPS + sc * OPS_SC;
            bf16_t* tmp = TMP + sc * TMP_SC;
            const bf16_t* Mb = tmp + 512 + 3 * 384;
            const bf16x8 mrow = ld_row16(Mb, lane);
            bf16x8 tA, tT1;
            ld_tr2<true>(ops + 0 * 1152 + tl * 16, tmp + 512 + 4 * 384 + tl * 16, 72, lane, tA, tT1);
            const f32x4 accW = mma<false>(mrow, tA, (f32x4){0.f, 0.f, 0.f, 0.f});
            bf16_t* Wt = tmp + 512 + 4 * 384 + 1152;
#pragma unroll
            for (int r = 0; r < 4; ++r) Wt[((lane >> 4) * 4 + r) * 72 + tl * 16 + (lane & 15)] = to_bf(accW[r]);
            accU = mma<false>(mrow, tT1, (f32x4){0.f, 0.f, 0.f, 0.f});
        }
        __syncthreads();
        }
#pragma unroll
        for (int sc = 0; sc < 2; ++sc) {
            bf16_t* Sbc = cur ? Sb1 : Sb0; bf16_t* Sbn = cur ? Sb0 : Sb1;
            const bf16_t* ops = OPS + sc * OPS_SC;
            const bf16_t* tmp = TMP + sc * TMP_SC;
            if ((wv >> 2) == sc) {
                const int vt = wv & 3;
                const f32x4 u = mm_tile<2, false>(tmp + 512 + 4 * 384 + 1152, 72, Sbc + vt * 16 * 72, 72, accU, lane);
#pragma unroll
                for (int r = 0; r < 4; ++r) Us[((lane >> 4) * 4 + r) * 72 + vt * 16 + (lane & 15)] = to_bf(u[r]);
            }
            __syncthreads();
            if (wv < 4) {
                const int vt = wv;
                f32x4 yv = mm_tile<2, true>(ops + 3 * 1152, 72, Sbc + vt * 16 * 72, 72, (f32x4){0.f, 0.f, 0.f, 0.f}, lane);
                bf16x8 tU, tV;
                ld_tr2<true>(Us + vt * 16, ops + 6 * 1152 + vt * 16, 72, lane, tU, tV);
                yv = mma<true>(ld_row16(tmp + 512 + 1 * 384, lane), tU, yv);
                yv = mma<true>(ld_row16(tmp + 512 + 2 * 384, lane), tV, yv);
                const int s = c * 32 + sc * 16 + (lane & 15), pos = dir ? (L - 1 - s) : s;
                *(uint2*)(y + ((size_t)dir * lay.Tloc + row0 + pos) * 512 + h * 64 + vt * 16 + (lane >> 4) * 4) = pk4(yv[0], yv[1], yv[2], yv[3]);
            }
            {
                bf16x8 aU, aV, b0, b1, k0_, k1_;
                ld_tr2<true>(Us + vT * 16, ops + 6 * 1152 + vT * 16, 72, lane, aU, aV);
                ld_tr4<true>(ops + 4 * 1152 + kT0 * 16, ops + 4 * 1152 + (kT0 + 1) * 16, ops + 5 * 1152 + kT0 * 16, ops + 5 * 1152 + (kT0 + 1) * 16, 72, lane, b0, b1, k0_, k1_);
#pragma unroll
                for (int q = 0; q < 2; ++q) {
                    const int kt = kT0 + q;
                    S[q] = S[q] * gC[sc * 64 + kt * 16 + (lane & 15)];
                    S[q] = mma<false>(aU, q ? b1 : b0, S[q]);
                    S[q] = mma<false>(aV, q ? k1_ : k0_, S[q]);
#pragma unroll
                    for (int r = 0; r < 4; ++r) Sbn[(vT * 16 + (lane >> 4) * 4 + r) * 72 + kt * 16 + (lane & 15)] = to_bf(S[q][r]);
                }
            }
            __syncthreads();
            cur ^= 1;
        }
    }
    float* So = dir ? Sb_out : Sf_out;
    if (!latent) {
#pragma unroll
        for (int q = 0; q < 2; ++q)
#pragma unroll
            for (int r = 0; r < 4; ++r) So[((size_t)(seq * 8 + h) * 64 + vT * 16 + (lane >> 4) * 4 + r) * 64 + (kT0 + q) * 16 + (lane & 15)] = S[q][r];
    }
#undef WKV2_LOAD
}

template <int NT>
__device__ __forceinline__ void n_wkv3(const Lay lay, const bf16_t* __restrict__ zcm, const bf16_t* __restrict__ w2t, const bf16_t* __restrict__ a2t,
                                       const float* __restrict__ w0, const float* __restrict__ a0, const float* __restrict__ k_k, const float* __restrict__ k_a,
                                       const float* __restrict__ S0f, const float* __restrict__ S0b, bf16_t* __restrict__ y,
                                       float* __restrict__ Sf_out, float* __restrict__ Sb_out, int item, char* lds,
                                       const int c0, const int c1, const float* __restrict__ Sinit, const int pq, float* __restrict__ Send) {
    static_assert(NT == 512, "n_wkv3 needs 8 waves");
    const int tid = TIDX, lane = tid & 63, wv = tid >> 6;
    const int dir = item & 1, h = (item >> 1) & 7, seq = lay.seqbase + (item >> 4);
    const bool latent = seq >= 16;
    const int L = latent ? 4096 : 256, row0 = (latent ? 4096 + (seq - 16) * 4096 : seq * 256) - lay.tbase;
    constexpr int OPS_SC = 7 * 1152;
    constexpr int TMP_SC = 512 + 4 * 384 + 1152 + 1152;
    constexpr int LG = 68;
    bf16_t* W2s = (bf16_t*)lds; bf16_t* A2s = W2s + 4608; bf16_t* Sb0 = A2s + 4608; bf16_t* Sb1 = Sb0 + 4608;
    float* rsv = (float*)(Sb1 + 4608); float* gC = rsv + 64;
    bf16_t* OPS = (bf16_t*)(gC + 256);
    bf16_t* TMP = OPS + 4 * OPS_SC;
    bf16_t* Us = TMP + 4 * TMP_SC;
    float* AA = (float*)TMP; float* GG = AA + 64 * LG;
    bf16_t* X1 = OPS; bf16_t* X2 = OPS + OPS_SC;
    static_assert(2 * 64 * LG * 4 <= 4 * TMP_SC * 2, "staging must fit in TMP");
    __syncthreads();
    {
        const int c = tid >> 3, part = tid & 7;
        *(uint4*)(W2s + c * 72 + part * 8) = *(const uint4*)(w2t + ((size_t)dir * 512 + h * 64 + c) * 64 + part * 8);
        *(uint4*)(A2s + c * 72 + part * 8) = *(const uint4*)(a2t + ((size_t)dir * 512 + h * 64 + c) * 64 + part * 8);
    }
    const int pt = tid >> 3, part = tid & 7, ch0 = part * 8;
    const int psc = pt >> 4, ptl = pt & 15;
    const int jsc = wv >> 2, jq = wv & 3;
    float lc0[2];
    lc0[0] = w0[dir * 512 + h * 64 + jq * 16 + (lane & 15)]; lc0[1] = a0[dir * 512 + h * 64 + jq * 16 + (lane & 15)];
    const int vT = wv >> 1, kT0 = (wv & 1) * 2;
    f32x4 S[2];
    f32x4 accU[2];
    {
        const float* S0 = dir ? S0b : S0f;
#pragma unroll
        for (int q = 0; q < 2; ++q)
#pragma unroll
            for (int r = 0; r < 4; ++r) {
                const int v = vT * 16 + (lane >> 4) * 4 + r, k = (kT0 + q) * 16 + (lane & 15);
                const float x = Sinit ? Sinit[v * 64 + k] : (latent ? S0[((size_t)((seq - 16) * 8 + h) * 64 + v) * 64 + k] : 0.f);
                S[q][r] = x; Sb0[v * 72 + k] = to_bf(x);
            }
    }
    uint4 g_r, g_k, g_wd, g_ad, g_v;
#define WKV3_LOAD(cidx) { const int s_ = (cidx) * 64 + pt; const int pos_ = dir ? (L - 1 - s_) : s_; \
        const bf16_t* zr_ = zcm + (size_t)(row0 + pos_) * CC; \
        g_r = *(const uint4*)(zr_ + h * 64 + ch0); g_k = *(const uint4*)(zr_ + 512 + h * 64 + ch0); g_v = *(const uint4*)(zr_ + 1024 + h * 64 + ch0); \
        g_wd = *(const uint4*)(zr_ + 1536 + dir * 64 + ch0); g_ad = *(const uint4*)(zr_ + 1664 + dir * 64 + ch0); \
        if (pq == 1) g_v = make_uint4(0u, 0u, 0u, 0u); }
    WKV3_LOAD(c0)
    int cur = 0;
    for (int c = c0; c < c1; ++c) {
        const int tid = TIDX, lane = tid & 63, wv = tid >> 6;
        const int pt = tid >> 3, part = tid & 7, ch0 = part * 8, psc = pt >> 4, ptl = pt & 15;
        const int jsc = wv >> 2, jq = wv & 3, vT = wv >> 1, kT0 = (wv & 1) * 2;
        {
            float fk[8], fw[8];
            unpack8(g_k, fk); unpack8(g_wd, fw);
            const float4 kk0 = *(const float4*)(k_k + h * 64 + ch0), kk1 = *(const float4*)(k_k + h * 64 + ch0 + 4);
            const float kkc[8] = {kk0.x, kk0.y, kk0.z, kk0.w, kk1.x, kk1.y, kk1.z, kk1.w};
            float ss = 0.f;
#pragma unroll
            for (int i = 0; i < 8; ++i) { const float q = fk[i] * kkc[i]; ss += q * q; }
            ss = red8(ss);
            if (part == 0) rsv[pt] = rsqrtf(ss + 1e-12f);
            *(uint4*)(X1 + pt * 72 + ch0) = make_uint4(pk_bf16(ftanh(fw[0]), ftanh(fw[1])), pk_bf16(ftanh(fw[2]), ftanh(fw[3])), pk_bf16(ftanh(fw[4]), ftanh(fw[5])), pk_bf16(ftanh(fw[6]), ftanh(fw[7])));
            *(uint4*)(X2 + pt * 72 + ch0) = g_ad;
            *(uint4*)(OPS + psc * OPS_SC + 6 * 1152 + ptl * 72 + ch0) = g_v;
        }
        __syncthreads();
        {
#pragma unroll
            for (int lm = 0; lm < 2; ++lm)
#pragma unroll
                for (int ri = 0; ri < 2; ++ri) {
                    const int rt = jsc + 2 * ri;
                    const f32x4 acc = mm_tile<2, false>((lm ? X2 : X1) + rt * 16 * 72, 72, (lm ? A2s : W2s) + jq * 16 * 72, 72, (f32x4){0.f, 0.f, 0.f, 0.f}, lane);
                    float sg[4];
#pragma unroll
                    for (int r = 0; r < 4; ++r) sg[r] = fsigmoid(lc0[lm] + acc[r]);
                    asm volatile("" ::: "memory");
#pragma unroll
                    for (int r = 0; r < 4; ++r) {
                        const int o = (rt * 16 + (lane >> 4) * 4 + r) * LG + jq * 16 + (lane & 15);
                        if (lm == 0) GG[o] = -0.606531f * sg[r]; else AA[o] = sg[r];
                    }
                }
        }
        __syncthreads();
        if (tid < 256) {
            const int sc = tid >> 6, ch = tid & 63;
            float lw[16];
#pragma unroll
            for (int t = 0; t < 16; ++t) lw[t] = GG[(sc * 16 + t) * LG + ch];
#pragma unroll
            for (int t = 1; t < 16; ++t) lw[t] += lw[t - 1];
#pragma unroll
            for (int t = 0; t < 16; ++t) GG[(sc * 16 + t) * LG + ch] = lw[t];
        }
        __syncthreads();
        {
            const float rs = rsv[pt];
            bf16_t* ops = OPS + psc * OPS_SC;
            float fr[8], fk[8];
            unpack8(g_r, fr); unpack8(g_k, fk);
#pragma unroll
            for (int hf = 0; hf < 2; ++hf) {
                float va[4], vb[4], vk[4], vr[4], vbh[4], vkh[4];
                const float4 kk4 = *(const float4*)(k_k + h * 64 + ch0 + hf * 4), ka4 = *(const float4*)(k_a + h * 64 + ch0 + hf * 4);
                const float kkc[4] = {kk4.x, kk4.y, kk4.z, kk4.w}, kac[4] = {ka4.x, ka4.y, ka4.z, ka4.w};
#pragma unroll
                for (int i = 0; i < 4; ++i) {
                    const int ii = hf * 4 + i, ch = ch0 + ii;
                    const float G = GG[pt * LG + ch], Gp = ptl ? GG[(pt - 1) * LG + ch] : 0.f, GC = GG[(psc * 16 + 15) * LG + ch];
                    const float a = AA[pt * LG + ch], kk = fk[ii] * kkc[i] * rs, ki = fk[ii] * (1.f + (a - 1.f) * kac[i]);
                    const float enG = __expf(-G), gc = __expf(GC);
                    va[i] = -kk * __expf(Gp); vb[i] = kk * a * enG; vk[i] = ki * enG; vr[i] = fr[ii] * __expf(G);
                    vbh[i] = vb[i] * gc; vkh[i] = vk[i] * gc;
                    if (ptl == 15) gC[psc * 64 + ch] = gc;
                }
                bf16_t* o4 = ops + ptl * 72 + ch0 + hf * 4;
                *(uint2*)(o4 + 0 * 1152) = pk4(va[0], va[1], va[2], va[3]);
                *(uint2*)(o4 + 1 * 1152) = pk4(vb[0], vb[1], vb[2], vb[3]);
                *(uint2*)(o4 + 2 * 1152) = pk4(vk[0], vk[1], vk[2], vk[3]);
                *(uint2*)(o4 + 3 * 1152) = pk4(vr[0], vr[1], vr[2], vr[3]);
                *(uint2*)(o4 + 4 * 1152) = pk4(vbh[0], vbh[1], vbh[2], vbh[3]);
                *(uint2*)(o4 + 5 * 1152) = pk4(vkh[0], vkh[1], vkh[2], vkh[3]);
            }
            if (c + 1 < c1) WKV3_LOAD(c + 1)
        }
        __syncthreads();
#pragma unroll
        for (int si = 0; si < 2; ++si) {
            const int sc = jsc + 2 * si, prod = jq;
            const bf16_t* ops = OPS + sc * OPS_SC;
            bf16_t* tmp = TMP + sc * TMP_SC;
            const f32x4 acc = mm_tile<2, false>(ops + (prod < 2 ? 0 : 3) * 1152, 72, ops + ((prod & 1) ? 2 : 1) * 1152, 72, (f32x4){0.f, 0.f, 0.f, 0.f}, lane);
            const int j = lane & 15;
#pragma unroll
            for (int r = 0; r < 4; ++r) {
                const int t = (lane >> 4) * 4 + r;
                const float v = (prod < 2 ? (j < t) : (j <= t)) ? acc[r] : 0.f;
                if (prod == 0) ((float*)tmp)[t * 16 + j] = v;
                else tmp[512 + (prod - 1) * 384 + t * 24 + j] = to_bf(v);
            }
        }
        __syncthreads();
        {
#pragma unroll
            for (int si = 0; si < 2; ++si) {
                const int sc = jsc + 2 * si, vt = jq;
                const bf16_t* ops = OPS + sc * OPS_SC;
                bf16_t* tmp = TMP + sc * TMP_SC;
                const f32x4 acc = mma<false>(ld_row16(tmp + 512 + 0 * 384, lane), ld_tr<true>(ops + 6 * 1152 + vt * 16, 72, lane), (f32x4){0.f, 0.f, 0.f, 0.f});
#pragma unroll
                for (int r = 0; r < 4; ++r) tmp[512 + 4 * 384 + ((lane >> 4) * 4 + r) * 72 + vt * 16 + (lane & 15)] = to_bf(acc[r]);
            }
            if (tid < 64) {
                const int isc = tid >> 4, j = tid & 15;
                const float* N = (const float*)(TMP + isc * TMP_SC);
                bf16_t* Mb = TMP + isc * TMP_SC + 512 + 3 * 384;
                float m[16];
#pragma unroll
                for (int t = 0; t < 16; ++t) {
                    float p0 = (t == j) ? 1.f : 0.f, p1 = 0.f, p2 = 0.f, p3 = 0.f;
#pragma unroll
                    for (int s = 0; s < t; ++s) {
                        const float nv = N[t * 16 + s];
                        if ((s & 3) == 0) p0 += nv * m[s]; else if ((s & 3) == 1) p1 += nv * m[s]; else if ((s & 3) == 2) p2 += nv * m[s]; else p3 += nv * m[s];
                    }
                    m[t] = (t >= j) ? (p0 + p1) + (p2 + p3) : 0.f;
                    Mb[t * 24 + j] = to_bf(m[t]);
                }
            }
        }
        __syncthreads();
#pragma unroll
        for (int si = 0; si < 2; ++si) {
            const int sc = jsc + 2 * si, tl = jq;
            const bf16_t* ops = OPS + sc * OPS_SC;
            bf16_t* tmp = TMP + sc * TMP_SC;
            const bf16x8 mrow = ld_row16(tmp + 512 + 3 * 384, lane);
            bf16x8 tA, tT1;
            ld_tr2<true>(ops + 0 * 1152 + tl * 16, tmp + 512 + 4 * 384 + tl * 16, 72, lane, tA, tT1);
            const f32x4 accW = mma<false>(mrow, tA, (f32x4){0.f, 0.f, 0.f, 0.f});
            bf16_t* Wt = tmp + 512 + 4 * 384 + 1152;
#pragma unroll
            for (int r = 0; r < 4; ++r) Wt[((lane >> 4) * 4 + r) * 72 + tl * 16 + (lane & 15)] = to_bf(accW[r]);
            accU[si] = mma<false>(mrow, tT1, (f32x4){0.f, 0.f, 0.f, 0.f});
        }
        __syncthreads();
#pragma unroll
        for (int sc = 0; sc < 4; ++sc) {
            bf16_t* Sbc = cur ? Sb1 : Sb0; bf16_t* Sbn = cur ? Sb0 : Sb1;
            const bf16_t* ops = OPS + sc * OPS_SC;
            const bf16_t* tmp = TMP + sc * TMP_SC;
            if (jsc == (sc & 1)) {
                const int vt = jq;
                const f32x4 u = mm_tile<2, false>(tmp + 512 + 4 * 384 + 1152, 72, Sbc + vt * 16 * 72, 72, accU[sc >> 1], lane);
#pragma unroll
                for (int r = 0; r < 4; ++r) Us[((lane >> 4) * 4 + r) * 72 + vt * 16 + (lane & 15)] = to_bf(u[r]);
            }
            __syncthreads();
            if (wv < 4 && pq == 0) {
                const int vt = wv;
                f32x4 yv = mm_tile<2, true>(ops + 3 * 1152, 72, Sbc + vt * 16 * 72, 72, (f32x4){0.f, 0.f, 0.f, 0.f}, lane);
                bf16x8 tU, tV;
                ld_tr2<true>(Us + vt * 16, ops + 6 * 1152 + vt * 16, 72, lane, tU, tV);
                yv = mma<true>(ld_row16(tmp + 512 + 1 * 384, lane), tU, yv);
                yv = mma<true>(ld_row16(tmp + 512 + 2 * 384, lane), tV, yv);
                const int s = c * 64 + sc * 16 + (lane & 15), pos = dir ? (L - 1 - s) : s;
                *(uint2*)(y + ((size_t)dir * lay.Tloc + row0 + pos) * 512 + h * 64 + vt * 16 + (lane >> 4) * 4) = pk4(yv[0], yv[1], yv[2], yv[3]);
            }
            {
                bf16x8 aU, aV, b0, b1, k0_, k1_;
                ld_tr2<true>(Us + vT * 16, ops + 6 * 1152 + vT * 16, 72, lane, aU, aV);
                ld_tr4<true>(ops + 4 * 1152 + kT0 * 16, ops + 4 * 1152 + (kT0 + 1) * 16, ops + 5 * 1152 + kT0 * 16, ops + 5 * 1152 + (kT0 + 1) * 16, 72, lane, b0, b1, k0_, k1_);
#pragma unroll
                for (int q = 0; q < 2; ++q) {
                    const int kt = kT0 + q;
                    S[q] = S[q] * gC[sc * 64 + kt * 16 + (lane & 15)];
                    S[q] = mma<false>(aU, q ? b1 : b0, S[q]);
                    S[q] = mma<false>(aV, q ? k1_ : k0_, S[q]);
#pragma unroll
                    for (int r = 0; r < 4; ++r) Sbn[(vT * 16 + (lane >> 4) * 4 + r) * 72 + kt * 16 + (lane & 15)] = to_bf(S[q][r]);
                }
            }
            __syncthreads();
            cur ^= 1;
        }
    }
    float* So = dir ? Sb_out : Sf_out;
    if (!latent) {
#pragma unroll
        for (int q = 0; q < 2; ++q)
#pragma unroll
            for (int r = 0; r < 4; ++r) So[((size_t)(seq * 8 + h) * 64 + vT * 16 + (lane >> 4) * 4 + r) * 64 + (kT0 + q) * 16 + (lane & 15)] = S[q][r];
    }
    if (Send) {
#pragma unroll
        for (int q = 0; q < 2; ++q)
#pragma unroll
            for (int r = 0; r < 4; ++r) Send[(vT * 16 + (lane >> 4) * 4 + r) * 64 + (kT0 + q) * 16 + (lane & 15)] = S[q][r];
    }
#undef WKV3_LOAD
}

template <int NT>
__device__ __forceinline__ void wkv_seg_init(const float* __restrict__ E0, const float* __restrict__ PQ, int nst, float* __restrict__ out, char* lds) {
    static_assert(NT == 512, "wkv_seg_init needs 512 threads");
    const int tid = TIDX, v = tid >> 3, kg = (tid & 7) * 8;
    float* Sl = (float*)lds;
    __syncthreads();
    {
        const float4 a = *(const float4*)(E0 + v * 64 + kg), b = *(const float4*)(E0 + v * 64 + kg + 4);
        float* d = Sl + v * 65 + kg;
        d[0] = a.x; d[1] = a.y; d[2] = a.z; d[3] = a.w; d[4] = b.x; d[5] = b.y; d[6] = b.z; d[7] = b.w;
    }
    __syncthreads();
    float* Pl = Sl + 64 * 65;
    for (int st = 0; st < nst; ++st) {
        const float* Pm = PQ + (size_t)st * 8192; const float* Qm = Pm + 4096;
        {
            const float4 p0 = *(const float4*)(Pm + tid * 8), p1 = *(const float4*)(Pm + tid * 8 + 4);
            *(float4*)(Pl + v * 68 + kg) = p0; *(float4*)(Pl + v * 68 + kg + 4) = p1;
        }
        float4 a0 = *(const float4*)(Qm + v * 64 + kg), a1 = *(const float4*)(Qm + v * 64 + kg + 4);
        __syncthreads();
#pragma unroll 8
        for (int j = 0; j < 64; ++j) {
            const float s = Sl[v * 65 + j];
            const float4 p0 = *(const float4*)(Pl + j * 68 + kg), p1 = *(const float4*)(Pl + j * 68 + kg + 4);
            a0.x += s * p0.x; a0.y += s * p0.y; a0.z += s * p0.z; a0.w += s * p0.w;
            a1.x += s * p1.x; a1.y += s * p1.y; a1.z += s * p1.z; a1.w += s * p1.w;
        }
        __syncthreads();
        float* d = Sl + v * 65 + kg;
        d[0] = a0.x; d[1] = a0.y; d[2] = a0.z; d[3] = a0.w; d[4] = a1.x; d[5] = a1.y; d[6] = a1.z; d[7] = a1.w;
        if (st + 1 == nst) { *(float4*)(out + v * 64 + kg) = a0; *(float4*)(out + v * 64 + kg + 4) = a1; }
        __syncthreads();
    }
}

template <int NT, int NI = 4>
__device__ __forceinline__ void n_combine1(const Lay lay, const bf16_t* __restrict__ zcm, const bf16_t* __restrict__ g2t, const bf16_t* __restrict__ y, const bf16_t* __restrict__ yd,
                                           const bf16_t* __restrict__ zg, const float* __restrict__ r_k, const float* __restrict__ ln_w, const float* __restrict__ ln_b,
                                           const float* __restrict__ gnorm, bf16_t* __restrict__ merged, int item, char* lds) {
    static_assert(NT == 512, "n_combine1 needs 8 waves");
    const int tid = TIDX, lane = tid & 63, wv = tid >> 6, cq = (lane >> 4) * 4;
    bf16_t* As = (bf16_t*)lds;
    float* red = (float*)(lds + 64 * 136 * 2);
    const int m0 = item * (16 * NI);
    __syncthreads();
    if ((tid >> 3) < 16 * NI) {
        const int t = tid >> 3, part = tid & 7;
        const bf16_t* src = zcm + (size_t)(m0 + t) * CC + 1792 + part * 16;
        float f0[8], f1[8];
        unpack8(*(const uint4*)src, f0); unpack8(*(const uint4*)(src + 8), f1);
        *(uint4*)(As + t * 136 + part * 16) = make_uint4(pk_bf16(fsigmoid(f0[0]), fsigmoid(f0[1])), pk_bf16(fsigmoid(f0[2]), fsigmoid(f0[3])),
                                                         pk_bf16(fsigmoid(f0[4]), fsigmoid(f0[5])), pk_bf16(fsigmoid(f0[6]), fsigmoid(f0[7])));
        *(uint4*)(As + t * 136 + part * 16 + 8) = make_uint4(pk_bf16(fsigmoid(f1[0]), fsigmoid(f1[1])), pk_bf16(fsigmoid(f1[2]), fsigmoid(f1[3])),
                                                             pk_bf16(fsigmoid(f1[4]), fsigmoid(f1[5])), pk_bf16(fsigmoid(f1[6]), fsigmoid(f1[7])));
    }
    __syncthreads();
    f32x4 acc[NI][4];
#pragma unroll
    for (int i = 0; i < NI; ++i)
#pragma unroll
        for (int j = 0; j < 4; ++j) acc[i][j] = (f32x4){0.f, 0.f, 0.f, 0.f};
#pragma unroll
    for (int ks = 0; ks < 4; ++ks) {
        bf16x8 a[NI], b[4];
#pragma unroll
        for (int i = 0; i < NI; ++i) a[i] = *(const bf16x8*)(As + (i * 16 + (lane & 15)) * 136 + ks * 32 + (lane >> 4) * 8);
#pragma unroll
        for (int j = 0; j < 4; ++j) b[j] = *(const bf16x8*)(g2t + (size_t)(wv * 64 + j * 16 + (lane & 15)) * 128 + ks * 32 + (lane >> 4) * 8);
#pragma unroll
        for (int i = 0; i < NI; ++i)
#pragma unroll
            for (int j = 0; j < 4; ++j) acc[i][j] = __builtin_amdgcn_mfma_f32_16x16x32_bf16(b[j], a[i], acc[i][j], 0, 0, 0);
    }
#pragma unroll
    for (int i = 0; i < NI; ++i) {
        const size_t lrow = (size_t)m0 + i * 16 + (lane & 15);
        float yy[4][4], rk = 0.f, sm = 0.f, zsq = 0.f;
        float vv[4][4];
#pragma unroll
        for (int j = 0; j < 4; ++j) {
            const int e = wv * 64 + j * 16 + cq;
            const uint2 ya = *(const uint2*)(y + lrow * 512 + e), yb = *(const uint2*)(y + ((size_t)lay.Tloc + lrow) * 512 + e);
            const uint2 ur = *(const uint2*)(zcm + lrow * CC + e), uk = *(const uint2*)(zcm + lrow * CC + 512 + e), uv = *(const uint2*)(zcm + lrow * CC + 1024 + e);
            const float4 rk4 = *(const float4*)(r_k + e);
            yy[j][0] = bf_lo(ya.x) + bf_lo(yb.x); yy[j][1] = bf_hi(ya.x) + bf_hi(yb.x); yy[j][2] = bf_lo(ya.y) + bf_lo(yb.y); yy[j][3] = bf_hi(ya.y) + bf_hi(yb.y);
            vv[j][0] = bf_lo(uv.x); vv[j][1] = bf_hi(uv.x); vv[j][2] = bf_lo(uv.y); vv[j][3] = bf_hi(uv.y);
            rk += bf_lo(ur.x) * bf_lo(uk.x) * rk4.x + bf_hi(ur.x) * bf_hi(uk.x) * rk4.y + bf_lo(ur.y) * bf_lo(uk.y) * rk4.z + bf_hi(ur.y) * bf_hi(uk.y) * rk4.w;
            sm += (yy[j][0] + yy[j][1]) + (yy[j][2] + yy[j][3]);
            const uint2 da = *(const uint2*)(yd + lrow * 512 + e), db = *(const uint2*)(yd + ((size_t)lay.Tloc + lrow) * 512 + e), uz = *(const uint2*)(zg + lrow * 512 + e);
            const float z0 = bf_lo(uz.x), z1 = bf_hi(uz.x), z2 = bf_lo(uz.y), z3 = bf_hi(uz.y);
            const float q0 = (bf_lo(da.x) + bf_lo(db.x)) * z0 * fsigmoid(z0), q1 = (bf_hi(da.x) + bf_hi(db.x)) * z1 * fsigmoid(z1);
            const float q2 = (bf_lo(da.y) + bf_lo(db.y)) * z2 * fsigmoid(z2), q3 = (bf_hi(da.y) + bf_hi(db.y)) * z3 * fsigmoid(z3);
            zsq += (q0 * q0 + q1 * q1) + (q2 * q2 + q3 * q3);
        }
        sm += __shfl_xor(sm, 16); sm += __shfl_xor(sm, 32);
        rk += __shfl_xor(rk, 16); rk += __shfl_xor(rk, 32);
        const float mean = sm * (1.f / 64.f);
        float var = 0.f, zs = 0.f;
#pragma unroll
        for (int j = 0; j < 4; ++j)
#pragma unroll
            for (int r = 0; r < 4; ++r) { const float d = yy[j][r] - mean; var += d * d; }
        zs = zsq;
        var += __shfl_xor(var, 16); var += __shfl_xor(var, 32);
        zs += __shfl_xor(zs, 16); zs += __shfl_xor(zs, 32);
        const float rstd = rsqrtf(var * (1.f / 64.f) + 64e-5f);
        if (lane < 16) red[wv * 64 + i * 16 + lane] = zs;
#pragma unroll
        for (int j = 0; j < 4; ++j) {
            const int e = wv * 64 + j * 16 + cq;
            const float4 lw4 = *(const float4*)(ln_w + e), lb4 = *(const float4*)(ln_b + e);
            const float o0 = ((yy[j][0] - mean) * rstd * lw4.x + lb4.x + rk * vv[j][0]) * acc[i][j][0];
            const float o1 = ((yy[j][1] - mean) * rstd * lw4.y + lb4.y + rk * vv[j][1]) * acc[i][j][1];
            const float o2 = ((yy[j][2] - mean) * rstd * lw4.z + lb4.z + rk * vv[j][2]) * acc[i][j][2];
            const float o3 = ((yy[j][3] - mean) * rstd * lw4.w + lb4.w + rk * vv[j][3]) * acc[i][j][3];
            *(uint2*)(merged + lrow * DM + e) = pk4(o0, o1, o2, o3);
        }
    }
    __syncthreads();
#pragma unroll
    for (int i = 0; i < NI; ++i) {
        const int tk = i * 16 + (lane & 15);
        float ss = 0.f;
#pragma unroll
        for (int w = 0; w < 8; ++w) ss += red[w * 64 + tk];
        const float rs = rsqrtf(ss * (1.f / 512.f) + EPS);
        const size_t lrow = (size_t)m0 + tk;
#pragma unroll
        for (int j = 0; j < 4; ++j) {
            const int e = wv * 64 + j * 16 + cq;
            const float4 gn = *(const float4*)(gnorm + e);
            const uint2 da = *(const uint2*)(yd + lrow * 512 + e), db = *(const uint2*)(yd + ((size_t)lay.Tloc + lrow) * 512 + e), uz = *(const uint2*)(zg + lrow * 512 + e);
            const float z0 = bf_lo(uz.x), z1 = bf_hi(uz.x), z2 = bf_lo(uz.y), z3 = bf_hi(uz.y);
            const float q0 = (bf_lo(da.x) + bf_lo(db.x)) * z0 * fsigmoid(z0), q1 = (bf_hi(da.x) + bf_hi(db.x)) * z1 * fsigmoid(z1);
            const float q2 = (bf_lo(da.y) + bf_lo(db.y)) * z2 * fsigmoid(z2), q3 = (bf_hi(da.y) + bf_hi(db.y)) * z3 * fsigmoid(z3);
            *(uint2*)(merged + lrow * DM + 512 + e) = pk4(q0 * rs * gn.x, q1 * rs * gn.y, q2 * rs * gn.z, q3 * rs * gn.w);
        }
    }
    __syncthreads();
}

template <int NT>
__device__ __forceinline__ void n_final(const Lay lay, const float* __restrict__ h, const float* __restrict__ g, float* __restrict__ out, int vb, float* lds) {
    const int lrow = vb * (NT / 256) + (TIDX >> 8), tid = TIDX & 255;
    const float4 x = *(const float4*)(h + (size_t)lrow * DM + tid * 4);
    const float ss = group_sum256<NT>(x.x * x.x + x.y * x.y + x.z * x.z + x.w * x.w, lds);
    const float rstd = rsqrtf(ss * (1.f / DM) + EPS);
    const float4 gg = *(const float4*)(g + tid * 4);
    *(float4*)(out + (size_t)(lay.tbase + lrow) * DM + tid * 4) = make_float4(x.x * rstd * gg.x, x.y * rstd * gg.y, x.z * rstd * gg.z, x.w * rstd * gg.w);
}

template <int NT>
__device__ __forceinline__ void n_final_w2(const Lay lay, const bf16_t* __restrict__ h, const float* __restrict__ g, float* __restrict__ out, int vb) {
    const int lane = TIDX & 63, lrow0 = vb * (NT / 64) * 2 + (TIDX >> 6) * 2;
    float4 x[2][4];
#pragma unroll
    for (int k = 0; k < 2; ++k)
#pragma unroll
        for (int q = 0; q < 4; ++q) { const uint2 u = *(const uint2*)(h + (size_t)(lrow0 + k) * DM + q * 256 + lane * 4); x[k][q] = make_float4(bf_lo(u.x), bf_hi(u.x), bf_lo(u.y), bf_hi(u.y)); }
#pragma unroll
    for (int k = 0; k < 2; ++k) {
        float ss = 0.f;
#pragma unroll
        for (int q = 0; q < 4; ++q) ss += (x[k][q].x * x[k][q].x + x[k][q].y * x[k][q].y) + (x[k][q].z * x[k][q].z + x[k][q].w * x[k][q].w);
        ss = wave_sum(ss);
        const float rstd = rsqrtf(ss * (1.f / DM) + EPS);
#pragma unroll
        for (int q = 0; q < 4; ++q) {
            const int c = q * 256 + lane * 4;
            const float4 gg = *(const float4*)(g + c);
            *(float4*)(out + (size_t)(lay.tbase + lrow0 + k) * DM + c) = make_float4(x[k][q].x * rstd * gg.x, x[k][q].y * rstd * gg.y, x[k][q].z * rstd * gg.z, x[k][q].w * rstd * gg.w);
        }
    }
}

template <int NT>
__device__ __forceinline__ void n_cache_k4(const Lay lay, const float* __restrict__ ck, bf16_t* __restrict__ Ka, int vb) {
    const int e4 = vb * NT + TIDX;
    const int bb = e4 >> 16, rem = e4 & 65535, p = rem >> 7, c = (rem & 127) * 4, h = c >> 7, j = c & 127;
    if (bb >= lay.nb) return;
    const int b = lay.b0 + bb;
    const float4 v = *(const float4*)(ck + (((size_t)b * 4 + h) * 512 + p) * 128 + j);
    *(uint2*)(Ka + ((size_t)lay.Tloc + bb * 512 + p) * 512 + c) = pk4(v.x, v.y, v.z, v.w);
}
template <int NT>
__device__ __forceinline__ void n_cache_kv(const Lay lay, const float* __restrict__ ck, const float* __restrict__ cv, bf16_t* __restrict__ Ka, bf16_t* __restrict__ VtA, int vb) {
    const int idx = vb * NT + TIDX;
    const int per = 4 * 512 * 128;
    const int bb = idx / (2 * per), r = idx % (2 * per);
    if (bb >= lay.nb) return;
    const int b = lay.b0 + bb;
    if (r < per) {
        const int p = r / 512, c = r % 512, h = c >> 7, j = c & 127;
        Ka[((size_t)lay.Tloc + bb * 512 + p) * 512 + c] = to_bf(ck[(((size_t)b * 4 + h) * 512 + p) * 128 + j]);
    } else {
        const int q = r - per, key = q % 512, dv = (q / 512) % 128, h = q / (512 * 128);
        VtA[vt_off(lay, 16 + b, h) + (size_t)dv * VLD + key] = to_bf(cv[(((size_t)b * 4 + h) * 512 + key) * 128 + dv]);
    }
}

struct Args { const void* p[24]; int i[16]; };
enum { PH_CACHE = 11, PH_GEMM_IN1, PH_SCAN, PH_COMBINE1, PH_FINAL, PH_WCONV = 0, PH_ROPE, PH_RESNORM, PH_GEMM_IN0, PH_TAIL, PH_GEMM_UQ, PH_GEMM_UKV, PH_FLASH, PH_COMBINE0, PH_GEMM_RES, PH_FFN_UP };
template <int NT, int BNB, int PH>
__device__ __forceinline__ void phase_body(const Args& a, int vb, float* lds) {
    const Lay lay{a.i[0], a.i[1], a.i[2], a.i[3], a.i[4]};
    if constexpr (PH == PH_GEMM_IN1) {
        const HaloTile ht = halo_tile(a.i[5] + vb / 26);
        gemm_tile<256, BNB, NT>(ALoadHalo{(const bf16_t*)a.p[0], DM, ht.t0 - lay.tbase, ht.row0, ht.L}, (const bf16_t*)a.p[1], DM, 0, (vb % 26) * BNB,
                                EpiIn1{lay, ht, (const float*)a.p[2], (const float*)a.p[3], (const float*)a.p[4], (bf16_t*)a.p[5], (bf16_t*)a.p[6], (bf16_t*)a.p[7], (float*)a.p[8]}, (char*)lds);
    } else if constexpr (PH == PH_COMBINE1) {
        n_combine1<NT>(lay, (const bf16_t*)a.p[0], (const bf16_t*)a.p[1], (const bf16_t*)a.p[2], (const bf16_t*)a.p[3], (const bf16_t*)a.p[4], (const float*)a.p[5], (const float*)a.p[6],
                       (const float*)a.p[7], (const float*)a.p[8], (bf16_t*)a.p[9], vb, (char*)lds);
    } else if constexpr (PH == PH_FINAL) {
        n_final<NT>(lay, (const float*)a.p[0], (const float*)a.p[1], (float*)a.p[2], vb, lds);
    } else if constexpr (PH == PH_CACHE) {
        n_cache_kv<NT>(lay, (const float*)a.p[0], (const float*)a.p[1], (bf16_t*)a.p[2], (bf16_t*)a.p[3], vb);
    } else if constexpr (PH == PH_WCONV) {
        n_wconv<NT>((const float*)a.p[0], a.i[5], a.i[6], (bf16_t*)a.p[1], a.i[7], a.i[8], a.i[9], vb, lds);
    } else if constexpr (PH == PH_ROPE) {
        n_rope_tables((float*)a.p[0], (float*)a.p[1], (float*)a.p[2], (float*)a.p[3]);
    } else if constexpr (PH == PH_RESNORM) {
        n_resnorm<NT>(lay, (const float*)a.p[0], (const float*)a.p[1], (const float*)a.p[2], (const float*)a.p[3], (const float*)a.p[4], a.i[5], a.i[6], (bf16_t*)a.p[5], vb, lds);
    } else if constexpr (PH == PH_GEMM_IN0) {
        gemm_tile<256, BNB, NT>(ALoadBF{(const bf16_t*)a.p[0], DM}, (const bf16_t*)a.p[1], DM, (vb / (1920 / BNB)) * 256, (vb % (1920 / BNB)) * BNB,
                                EpiIn0{lay, (bf16_t*)a.p[2], (bf16_t*)a.p[3], (bf16_t*)a.p[4], (bf16_t*)a.p[5], (float*)a.p[6], (float*)a.p[7], (const float*)a.p[8], (const float*)a.p[9]}, (char*)lds);
    } else if constexpr (PH == PH_TAIL) {
        n_l0_tail<NT>(lay, (const bf16_t*)a.p[0], (const float*)a.p[1], (const float*)a.p[2], (const float*)a.p[3], (const float*)a.p[4], (const float*)a.p[5], (const float*)a.p[6],
                      (bf16_t*)a.p[7], (bf16_t*)a.p[8], (bf16_t*)a.p[9], (float*)a.p[10], (float*)a.p[11], vb, lds);
    } else if constexpr (PH == PH_GEMM_UQ) {
        gemm_tile<256, BNB, NT>(ALoadBF{(const bf16_t*)a.p[0], 192}, (const bf16_t*)a.p[1], 192, (vb / (384 / BNB)) * 256, (vb % (384 / BNB)) * BNB,
                                EpiQb{lay, (bf16_t*)a.p[2], (const float*)a.p[3], (const float*)a.p[4]}, (char*)lds);
    } else if constexpr (PH == PH_GEMM_UKV) {
        gemm_tile<256, BNB, NT>(ALoadBF{(const bf16_t*)a.p[0], 128}, (const bf16_t*)a.p[1], 128, (vb / (768 / BNB)) * 256, (vb % (768 / BNB)) * BNB,
                                EpiKV{lay, (bf16_t*)a.p[2], (bf16_t*)a.p[3]}, (char*)lds);
    } else if constexpr (PH == PH_FLASH) {
        const bf16_t *Qa = (const bf16_t*)a.p[0], *Ka = (const bf16_t*)a.p[1], *VtA = (const bf16_t*)a.p[2], *Qb = (const bf16_t*)a.p[3], *Kb = (const bf16_t*)a.p[4], *VtB = (const bf16_t*)a.p[5];
        bf16_t *oa1h = (bf16_t*)a.p[6], *oa2h = (bf16_t*)a.p[7], *mrg16 = (bf16_t*)a.p[8];
        const int nqb = lay.Tloc / 128;
        const int mp = vb / (4 * nqb), hd = (vb / nqb) & 3, q0 = (vb % nqb) * 128;
        const TokInfo ti = tokinfo(lay.tbase + q0);
        const int tok0 = ti.t0 - lay.tbase, crow = lay.Tloc + (ti.latent ? (ti.seq - 16 - lay.b0) * 512 : 0);
        FlashP p;
        p.n0 = ti.latent ? 512 : 0; p.Lk = ti.L + p.n0; p.O = nullptr;
        if (mp < 2) {
            p.Q = Qa + hd * 128 + mp * 64; p.q_ld = 512;
            p.K0 = Ka + (size_t)crow * 512 + hd * 128 + mp * 64;
            p.K1 = Ka + (size_t)tok0 * 512 + hd * 128 + mp * 64; p.k_ld = 512;
            p.Vt = VtA + vt_off(lay, ti.seq, hd); p.vt_ld = ti.latent ? VLD : 256;
            p.Ob = (mp ? oa2h : oa1h) + hd * 128; p.o_ld = 512;
            p.c = 0.125f * 1.4426950408889634f;
            flash_item<64, NT, true>(p, q0, (char*)lds);
        } else {
            p.Q = Qb + hd * 96; p.q_ld = 384;
            p.K0 = Kb + (size_t)crow * 384 + hd * 96;
            p.K1 = Kb + (size_t)tok0 * 384 + hd * 96; p.k_ld = 384;
            p.Vt = VtB + vt_off(lay, ti.seq, hd); p.vt_ld = ti.latent ? VLD : 256;
            p.Ob = mrg16 + 512 + hd * 128; p.o_ld = DM;
            p.c = 0.10206207261596577f * 1.4426950408889634f;
            flash_item<96, NT, true>(p, q0, (char*)lds);
        }
    } else if constexpr (PH == PH_COMBINE0) {
        n_combine0<NT>((const bf16_t*)a.p[0], (const bf16_t*)a.p[1], (const float*)a.p[2], (const float*)a.p[3], (const float*)a.p[4], (const float*)a.p[5], (const float*)a.p[6], (bf16_t*)a.p[7], vb);
    } else if constexpr (PH == PH_GEMM_RES) {
        const EpiResid ep{lay, (const float*)a.p[2], (const float*)a.p[3], (const bf16_t*)a.p[4], (bf16_t*)a.p[5], (const float*)a.p[6], a.i[6]};
        const int m0 = (vb / (1024 / BNB)) * 256, n0 = (vb % (1024 / BNB)) * BNB;
        if (a.i[5] == DM) gemm_tile<256, BNB, NT>(ALoadBF{(const bf16_t*)a.p[0], DM}, (const bf16_t*)a.p[1], DM, m0, n0, ep, (char*)lds);
        else              gemm_tile<256, BNB, NT>(ALoadBF{(const bf16_t*)a.p[0], FF}, (const bf16_t*)a.p[1], FF, m0, n0, ep, (char*)lds);
    } else if constexpr (PH == PH_FFN_UP) {
        const HaloTile ht = halo_tile(a.i[5] + vb / (FF2 / BNB));
        gemm_tile<256, BNB, NT>(ALoadHalo{(const bf16_t*)a.p[0], DM, ht.t0 - lay.tbase, ht.row0, ht.L}, (const bf16_t*)a.p[1], DM, 0, (vb % (FF2 / BNB)) * BNB,
                                EpiFFNUp{lay, ht, (const float*)a.p[2], (const float*)a.p[3], (bf16_t*)a.p[4]}, (char*)lds);
    }
}

constexpr size_t al(size_t x) { return (x + 255) & ~(size_t)255; }
struct WS {
    static constexpr size_t BAR = 0;
    static constexpr size_t ZERO = al(BAR + 16384);
    static constexpr size_t MOD = al(ZERO + 4096);
    static constexpr size_t ROPE = al(MOD + 2 * 3 * 6144 * 4);
    static constexpr size_t H = al(ROPE + 3072 * 4);
    static constexpr size_t WT_IN0 = al(H + (size_t)TT * DM * 4);
    static constexpr size_t WT_OUT0 = al(WT_IN0 + (size_t)1920 * 1024 * 2);
    static constexpr size_t WT_OUT1 = al(WT_OUT0 + (size_t)1024 * 1024 * 2);
    static constexpr size_t WT_UP0 = al(WT_OUT1 + (size_t)1024 * 1024 * 2);
    static constexpr size_t WT_UP1 = al(WT_UP0 + (size_t)FF2 * 1024 * 2);
    static constexpr size_t WT_DN0 = al(WT_UP1 + (size_t)FF2 * 1024 * 2);
    static constexpr size_t WT_DN1 = al(WT_DN0 + (size_t)1024 * FF * 2);
    static constexpr size_t WT_UQ = al(WT_DN1 + (size_t)1024 * FF * 2);
    static constexpr size_t WT_UKV = al(WT_UQ + (size_t)384 * 192 * 2);
    static constexpr size_t WT_IN1 = al(WT_UKV + (size_t)768 * 128 * 2);
    static constexpr size_t W2T = al(WT_IN1 + (size_t)3328 * 1024 * 2);
    static constexpr size_t A2T = al(W2T + (size_t)2 * 512 * 64 * 2);
    static constexpr size_t G2T = al(A2T + (size_t)2 * 512 * 64 * 2);
    static constexpr size_t HN = al(G2T + (size_t)512 * 128 * 2);
    static constexpr size_t BIG = al(HN + (size_t)TT * DM * 2);
    static constexpr size_t TAIL = BIG;
    static constexpr size_t QA = al(TAIL + (size_t)TT * 384 * 2);
    static constexpr size_t KA = al(QA + (size_t)TT * 512 * 2);
    static constexpr size_t VTA = al(KA + (size_t)(TT + 1024) * 512 * 2);
    static constexpr size_t VT_ELEMS = (size_t)16 * 4 * 128 * 256 + (size_t)2 * 4 * 128 * VLD;
    static constexpr size_t QDN = al(VTA + VT_ELEMS * 2);
    static constexpr size_t CKVN = al(QDN + (size_t)TT * 192 * 2);
    static constexpr size_t QB = al(CKVN + (size_t)(TT + 1024) * 128 * 2);
    static constexpr size_t KB = al(QB + (size_t)TT * 384 * 2);
    static constexpr size_t VTB = al(KB + (size_t)(TT + 1024) * 384 * 2);
    static constexpr size_t OA1 = al(VTB + VT_ELEMS * 2);
    static constexpr size_t OA2 = al(OA1 + (size_t)TT * 512 * 2);
    static constexpr size_t END0 = al(OA2 + (size_t)TT * 512 * 2);
    static constexpr size_t ZCM = BIG;
    static constexpr size_t ZG = al(ZCM + (size_t)TT * CC * 2);
    static constexpr size_t XC = al(ZG + (size_t)TT * 512 * 2);
    static constexpr size_t DTR = al(XC + (size_t)TT * 768 * 2);
    static constexpr size_t Y16 = al(DTR + (size_t)TT * 8 * 4);
    static constexpr size_t YD16 = al(Y16 + (size_t)2 * TT * 512 * 2);
    static constexpr size_t SEG_IZ = al(YD16 + (size_t)2 * TT * 512 * 2);
    static constexpr size_t SEG_E0 = al(SEG_IZ + 2 * 16384);
    static constexpr size_t SEG_PQ = al(SEG_E0 + 32 * 16384);
    static constexpr size_t SEG_SI = al(SEG_PQ + 192 * 16384);
    static constexpr size_t SEG_HS = al(SEG_SI + 128 * 16384);
    static constexpr size_t END1 = al(SEG_HS + 32 * 16384);
    static constexpr size_t ACT = BIG;
    static constexpr size_t END2 = al(ACT + (size_t)TT * FF * 2);
    static constexpr size_t TOTAL = END0 > END1 ? (END0 > END2 ? END0 : END2) : (END1 > END2 ? END1 : END2);
};
static_assert(WS::TOTAL <= (size_t)256 * 1024 * 1024, "workspace map exceeds the guaranteed 256 MiB");


__device__ __forceinline__ int xcd_remap(int vb, int n) {
    const int q = n >> 3, r = n & 7, x = vb & 7, o = vb >> 3;
    return (x < r ? x * (q + 1) : r * (q + 1) + (x - r) * q) + o;
}

struct MP { const float* in[59]; float* out; char* ws; };


__device__ __forceinline__ char* launder_c(char* p) { size_t z = 0; asm volatile("" : "+s"(z)); return p + z; }
__device__ __forceinline__ float* launder_f(float* p) { size_t z = 0; asm volatile("" : "+s"(z)); return p + z; }
__device__ __forceinline__ int bid_opaque() { int b = blockIdx.x; asm volatile("" : "+s"(b)); return b; }
typedef const __attribute__((address_space(1))) float* gcfptr;
struct InTab {
    const char* base;
    __device__ __forceinline__ const float* operator[](int k) const { return (const float*)(gcfptr)(((const float* const*)base)[k]); }
};
__device__ __forceinline__ InTab in_tab() { size_t z = 0; asm volatile("" : "+s"(z)); return InTab{(const char*)__builtin_amdgcn_kernarg_segment_ptr() + z}; }
#define PH_BEGIN(NVB) for (int vb = bid_opaque(); vb < (NVB); vb += gridDim.x) { char* ws = launder_c(ws0); float* out = launder_f(out0); const InTab in = in_tab(); (void)ws; (void)out; (void)in;
#define PH_END } xcd_barrier(xb);
#define PH_NEXT(NVB) } for (int vb = bid_opaque(); vb < (NVB); vb += gridDim.x) { char* ws = launder_c(ws0); float* out = launder_f(out0); const InTab in = in_tab(); (void)ws; (void)out; (void)in;

#define mod ((float*)(ws + WS::MOD))
#define h ((bf16_t*)(ws + WS::H))
#define wt_in0 ((bf16_t*)(ws + WS::WT_IN0))
#define wt_uq ((bf16_t*)(ws + WS::WT_UQ))
#define wt_ukv ((bf16_t*)(ws + WS::WT_UKV))
#define wt_in1 ((bf16_t*)(ws + WS::WT_IN1))
#define w2t ((bf16_t*)(ws + WS::W2T))
#define a2t ((bf16_t*)(ws + WS::A2T))
#define g2t ((bf16_t*)(ws + WS::G2T))
#define hn16 ((bf16_t*)(ws + WS::HN))
#define act16 ((bf16_t*)(ws + WS::ACT))
#define tail16 ((bf16_t*)(ws + WS::TAIL))
#define Qa ((bf16_t*)(ws + WS::QA))
#define Ka ((bf16_t*)(ws + WS::KA))
#define VtA ((bf16_t*)(ws + WS::VTA))
#define qdn16 ((bf16_t*)(ws + WS::QDN))
#define ckvn16 ((bf16_t*)(ws + WS::CKVN))
#define Qb ((bf16_t*)(ws + WS::QB))
#define Kb ((bf16_t*)(ws + WS::KB))
#define VtB ((bf16_t*)(ws + WS::VTB))
#define oa1h ((bf16_t*)(ws + WS::OA1))
#define oa2h ((bf16_t*)(ws + WS::OA2))
#define zcm16 ((bf16_t*)(ws + WS::ZCM))
#define zg16 ((bf16_t*)(ws + WS::ZG))
#define xc16 ((bf16_t*)(ws + WS::XC))
#define dtr ((float*)(ws + WS::DTR))
#define y16 ((bf16_t*)(ws + WS::Y16))
#define yd16 ((bf16_t*)(ws + WS::YD16))
#define c64 ((float*)(ws + WS::ROPE))
#define s64 ((float*)(ws + WS::ROPE) + 1024)
#define c32 ((float*)(ws + WS::ROPE) + 2048)
#define s32 ((float*)(ws + WS::ROPE) + 2560)
#define mrg16 ((bf16_t*)(ws + WS::HN))
#define o_k (out + (size_t)TT * DM)
#define o_v (o_k + 16 * 4 * 256 * 128)
#define o_ckv (o_v + 16 * 4 * 256 * 128)
#define o_kpe (o_ckv + 16 * 256 * 128)
#define o_wf (o_kpe + 16 * 256 * 32)
#define o_wb (o_wf + 16 * 8 * 64 * 64)
#define o_sf (o_wb + 16 * 8 * 64 * 64)
#define o_sb (o_sf + 16 * 8 * 64 * 64)
__global__ void __launch_bounds__(512) mega(MP P) {
    constexpr int NT = 512, BNB = 128, TPB = 2;
    __shared__ __attribute__((aligned(16))) float lds[LDS_BYTES / 4];
    volatile LAS unsigned* st = (volatile LAS unsigned*)(lds + LDS_BYTES / 4 - 4);
    if (TIDX == 0) { st[0] = 0u; st[1] = 0u; st[2] = 0u; st[3] = 0u; }
    __syncthreads();
    XcdBarrier xb = xcd_barrier_post((unsigned*)P.ws, st);
    const InTab in = in_tab();
    char* const ws0 = P.ws;
    float* const out0 = P.out;
    char* ws = ws0;
    float* out = out0;
    const Lay lay{0, TT, 0, 0, 2};
    constexpr int NCR = 1024, MT = TT / 256, MTC = (TT + NCR) / 256, NHT = 50;

    for (int rp0_ = 0; rp0_ < REP_P0; ++rp0_) {
    constexpr int P_IN0 = 16 * 30 / TPB / 2, P_UP0 = 16 * 88 / TPB / 2, P_DN0 = 44 * 16 / TPB / 2, P_OUT0 = 16 * 16 / TPB / 2, P_UQ = 5, P_UKV = 6, P_W2 = 4, P_A2 = 4, P_G2 = 4, P_CV = 32;
    constexpr int Q1 = P_IN0, Q2 = Q1 + P_UP0, Q3 = Q2 + P_DN0, Q4 = Q3 + P_OUT0, Q5 = Q4 + P_UQ, Q6 = Q5 + P_UKV, Q7 = Q6 + P_W2, Q8 = Q7 + P_A2, Q9 = Q8 + P_G2, Q10 = Q9 + P_CV;
    constexpr int QA = Q10 + 2 * 96, QK = QA + 2 * 512 * 128 / NT, QT = QK + 1;
    PH_BEGIN(QT)
        if (vb < Q10) {
            const float* W; bf16_t* Wt; int K_, N_, Np_, mode_ = 0, gh_ = 0, it_, ldo_ = 0;
            if (vb < Q1)      { W = in[20]; Wt = wt_in0; K_ = 1024; N_ = N0; Np_ = 1920; it_ = vb * 2; }
            else if (vb < Q2) { W = in[16]; Wt = (bf16_t*)(ws + WS::WT_UP0); K_ = 1024; N_ = FF2; Np_ = FF2; mode_ = 1; gh_ = BNB / 2; it_ = (vb - Q1) * 2; }
            else if (vb < Q3) { W = in[19]; Wt = (bf16_t*)(ws + WS::WT_DN0); K_ = FF; N_ = 1024; Np_ = 1024; it_ = (vb - Q2) * 2; }
            else if (vb < Q4) { W = in[30]; Wt = (bf16_t*)(ws + WS::WT_OUT0); K_ = 1024; N_ = 1024; Np_ = 1024; it_ = (vb - Q3) * 2; }
            else if (vb < Q5) { W = in[27]; Wt = wt_uq; K_ = 192; N_ = 384; Np_ = 384; it_ = (vb - Q4) * 2; }
            else if (vb < Q6) { W = in[29]; Wt = wt_ukv; K_ = 128; N_ = 768; Np_ = 768; mode_ = 2; it_ = (vb - Q5) * 2; }
            else if (vb < Q7) { const int j = vb - Q6; W = in[42] + (size_t)(j >> 1) * 64 * 512; Wt = w2t + (size_t)(j >> 1) * 512 * 64; K_ = 64; N_ = 512; Np_ = 512; it_ = (j & 1) * 2; }
            else if (vb < Q8) { const int j = vb - Q7; W = in[44] + (size_t)(j >> 1) * 64 * 512; Wt = a2t + (size_t)(j >> 1) * 512 * 64; K_ = 64; N_ = 512; Np_ = 512; it_ = (j & 1) * 2; }
            else if (vb < Q9) { W = in[45]; Wt = g2t; K_ = 128; N_ = 512; Np_ = 512; it_ = (vb - Q8) * 2; }
            else {
                const int j = vb - Q9; W = in[3] + (size_t)(j >> 2) * 512 * 128; Wt = VtA + vt_off(lay, 16 + (j >> 4), (j >> 2) & 3); K_ = 512; N_ = 128; Np_ = 128; it_ = (j & 3) * 2; ldo_ = VLD;
            }
            n_wconv_multi<NT, 2>(W, K_, N_, Wt, Np_, mode_, gh_, it_, lds, ldo_);
        } else if (vb < QA) n_ada<NT>(in[10], in[11], in[12], in[13], in[31], in[32], mod, vb - Q10, lds);
        else if (vb < QK) n_cache_k4<NT>(lay, in[2], Ka, vb - QA);
        else n_rope_tables(c64, s64, c32, s32);
    PH_END

    }
    constexpr int CV_IN1 = 16 * 52 / TPB, CV_OUT = 16 * 16 / TPB, CV_UP = 16 * 88 / TPB, CV_DN = 44 * 16 / TPB;
    static_assert(CV_IN1 % 2 == 0 && CV_OUT % 2 == 0 && CV_UP % 2 == 0 && CV_DN % 2 == 0, "item pairs must not straddle two weights");
#define CONV_PAIR(c_) { const int cc_ = (c_); \
        const float* W; bf16_t* Wt; int K_, N_, Np_, mode_, gh_, it_; \
        if (cc_ < CV_IN1) { W = in[39]; Wt = wt_in1; K_ = 1024; N_ = N1; Np_ = 3328; mode_ = 0; gh_ = 0; it_ = cc_; } \
        else if (cc_ < CV_IN1 + CV_OUT) { W = in[57]; Wt = (bf16_t*)(ws + WS::WT_OUT1); K_ = 1024; N_ = 1024; Np_ = 1024; mode_ = 0; gh_ = 0; it_ = cc_ - CV_IN1; } \
        else if (cc_ < CV_IN1 + CV_OUT + CV_UP) { W = in[35]; Wt = (bf16_t*)(ws + WS::WT_UP1); K_ = 1024; N_ = FF2; Np_ = FF2; mode_ = 1; gh_ = BNB / 2; it_ = cc_ - CV_IN1 - CV_OUT; } \
        else { W = in[38]; Wt = (bf16_t*)(ws + WS::WT_DN1); K_ = FF; N_ = 1024; Np_ = 1024; mode_ = 0; gh_ = 0; it_ = cc_ - CV_IN1 - CV_OUT - CV_UP; } \
        n_wconv_multi<NT, 2>(W, K_, N_, Wt, Np_, mode_, gh_, it_, lds); }
    for (int l = 0; l < 2; ++l) {
        const float* modl = mod + (size_t)l * 3 * 6144;
        const int cb = l ? 31 : 12;
#define wt_out ((const bf16_t*)(ws + (l ? WS::WT_OUT1 : WS::WT_OUT0)))
#define wt_up ((const bf16_t*)(ws + (l ? WS::WT_UP1 : WS::WT_UP0)))
#define wt_dn ((const bf16_t*)(ws + (l ? WS::WT_DN1 : WS::WT_DN0)))
        PH_BEGIN(TT / 16)
            n_resnorm_w2<NT>(lay, in[0], in[1], l ? h : nullptr, in[cb + 2], modl, 0, 1024, hn16, vb);
        PH_END
        if (l == 0) {
            PH_BEGIN(MT * (1920 / BNB))
                const int tb = xcd_remap(vb, MT * (1920 / BNB));
                gemm_tile<256, BNB, NT>(ALoadBF{hn16, DM}, wt_in0, DM, (tb / (1920 / BNB)) * 256, (tb % (1920 / BNB)) * BNB,
                                        EpiIn0{lay, Qa, Ka, VtA, tail16, o_k, o_v, c64, s64}, (char*)lds);
            PH_END
            PH_BEGIN((TT + NCR) / 8)
                n_l0_tail_w<NT>(lay, tail16, in[26], in[28], in[4], in[5], c32, s32, qdn16, ckvn16, Kb, o_ckv, o_kpe, vb);
            PH_END
            constexpr int UQT = MT * (384 / BNB), UKT = MTC * (768 / BNB);
            PH_BEGIN(UQT + UKT)
                if (vb < UKT) gemm_tile<256, BNB, NT>(ALoadBF{ckvn16, 128}, wt_ukv, 128, (vb / (768 / BNB)) * 256, (vb % (768 / BNB)) * BNB, EpiKV{lay, Kb, VtB}, (char*)lds);
                else { const int u = vb - UKT; gemm_tile<256, BNB, NT>(ALoadBF{qdn16, 192}, wt_uq, 192, (u / (384 / BNB)) * 256, (u % (384 / BNB)) * BNB, EpiQb{lay, Qb, c32, s32}, (char*)lds); }
            PH_END
            for (int rep_ = 0; rep_ < REP_FLASH; ++rep_) {
            for (int vb = bid_opaque(); vb < 1152; vb += gridDim.x) { char* ws = launder_c(ws0); float* out = launder_f(out0); const InTab in = in_tab(); (void)ws; (void)out; (void)in;
                int mp, hd, q0;
                if (vb < 768) {
                    const int r = vb >> 8, b = vb & 255, x = b & 7, j = b >> 3;
                    int batch;
                    if (r == 0) { mp = 2; hd = x & 3; batch = x >> 2; }
                    else { const int a = 2 * x + (r - 1); batch = a >> 3; hd = (a >> 1) & 3; mp = a & 1; }
                    q0 = 4096 + batch * 4096 + j * 128;
                } else { const int j = vb - 768; mp = j >> 7; hd = (j >> 5) & 3; q0 = (j & 31) * 128; }
                const TokInfo ti = tokinfo(q0);
                const int crow = TT + (ti.latent ? (ti.seq - 16) * 512 : 0);
                FlashP p;
                p.n0 = ti.latent ? 512 : 0; p.Lk = ti.L + p.n0; p.O = nullptr;
                if (mp < 2) {
                    p.Q = Qa + hd * 128 + mp * 64; p.q_ld = 512;
                    p.K0 = Ka + (size_t)crow * 512 + hd * 128 + mp * 64;
                    p.K1 = Ka + (size_t)ti.t0 * 512 + hd * 128 + mp * 64; p.k_ld = 512;
                    p.Vt = VtA + vt_off(lay, ti.seq, hd); p.vt_ld = ti.latent ? VLD : 256;
                    p.Ob = (mp ? oa2h : oa1h) + hd * 128; p.o_ld = 512;
                    p.c = 0.125f * 1.4426950408889634f;
                    flash_item<64, NT, true>(p, q0, (char*)lds);
                } else {
                    p.Q = Qb + hd * 96; p.q_ld = 384;
                    p.K0 = Kb + (size_t)crow * 384 + hd * 96;
                    p.K1 = Kb + (size_t)ti.t0 * 384 + hd * 96; p.k_ld = 384;
                    p.Vt = VtB + vt_off(lay, ti.seq, hd); p.vt_ld = ti.latent ? VLD : 256;
                    p.Ob = mrg16 + 512 + hd * 128; p.o_ld = DM;
                    p.c = 0.10206207261596577f * 1.4426950408889634f;
                    flash_item<96, NT, true>(p, q0, (char*)lds);
                }
            PH_END
            }
            PH_BEGIN(TT / TPB / 4)
                n_combine0_m<NT, 4>(oa1h, oa2h, in[21], in[22], in[23], in[24], in[25], mrg16, vb);
            PH_END
        } else {
            {
                float* segf = (float*)(ws + WS::SEG_IZ);
                for (int i = blockIdx.x * NT + TIDX; i < 8192; i += gridDim.x * NT) segf[i] = (i < 4096 && (i >> 6) == (i & 63)) ? 1.f : 0.f;
            }
            constexpr int IN1T = NHT * 13, IN1L = IN1T - 512, IN1F = 256 - IN1L, CVP = (CV_OUT + CV_UP + CV_DN) / 2;
            PH_BEGIN(256 * (2 + (CVP + IN1F - 1) / IN1F))
                const int slot = vb & 255, rnd = vb >> 8;
                if (vb < IN1T) {
                    const int tb = xcd_remap(vb, IN1T);
                    const HaloTile ht = halo_tile(tb / 13);
                    gemm256_tile<NT>(ALoadHalo{hn16, DM, ht.t0, ht.row0, ht.L, (const bf16_t*)(ws + WS::ZERO)}, wt_in1, DM, (tb % 13) * 256,
                                     EpiIn1{lay, ht, in[40], in[51], in[52], zcm16, zg16, xc16, dtr}, (char*)lds);
                } else if (slot >= IN1L) {
                    const int p = (slot - IN1L) + IN1F * (rnd - 2);
                    if (p < CVP) CONV_PAIR(CV_IN1 + 2 * p)
                }
            PH_END
            for (int rep_ = 0; rep_ < REP_SCAN; ++rep_)
            for (int pass = 0; pass < 2; ++pass) {
            for (int vb = bid_opaque();; vb += gridDim.x) { char* ws = launder_c(ws0); float* out = launder_f(out0); const InTab in = in_tab(); (void)ws; (void)out; (void)in;
                if (pass == 1) {
                    __syncthreads();
                    if (TIDX == 0) st[3] = xb_add((unsigned*)ws0, 1u);
                    __syncthreads();
                    vb = __builtin_amdgcn_readfirstlane((int)st[3]);
                }
                if (vb >= (pass == 0 ? 256 : 672)) break;
                const int slot = vb & 255, rnd = vb >> 8;
                int kind = 0, item = 0, c0 = 0, c1 = 0, pq = 0, nst = 0;
                const float* sinit = nullptr; float* send = nullptr; const float* pqsrc = nullptr; const float* e0src = nullptr; float* siout = nullptr;
                float* segf = (float*)(ws + WS::SEG_IZ);
                float* e0b = (float*)(ws + WS::SEG_E0); float* pqb = (float*)(ws + WS::SEG_PQ); float* sib = (float*)(ws + WS::SEG_SI); float* hsb = (float*)(ws + WS::SEG_HS);
                constexpr int SSD_CUT = 31;
                if (pass == 0) {
                    if (slot < 32) { kind = 1; item = ((16 + (slot >> 4)) << 4) | (slot & 15); c0 = 0; c1 = 12; send = e0b + (size_t)slot * 4096; }
                    else if (slot < 224) {
                        const int j = slot - 32, chain = j / 6, rem = j - chain * 6, seg = 1 + (rem >> 1); pq = 1 + (rem & 1);
                        kind = 1; item = ((16 + (chain >> 4)) << 4) | (chain & 15); c0 = 12 + 13 * (seg - 1); c1 = c0 + 13;
                        sinit = segf + (pq == 1 ? 0 : 4096); send = pqb + ((size_t)(chain * 3 + seg - 1) * 2 + (pq - 1)) * 4096;
                    } else { const int chain = slot - 224; kind = 2; item = ((16 + (chain >> 4)) << 4) | (chain & 15); c0 = 0; c1 = SSD_CUT; send = hsb + (size_t)chain * 4096; }
                } else {
                    if (vb < 128) {
                        const int chain = vb & 31, seg = 4 - (vb >> 5);
                        kind = 1; item = ((16 + (chain >> 4)) << 4) | (chain & 15); c0 = 12 + 13 * (seg - 1); c1 = c0 + 13;
                        e0src = e0b + (size_t)chain * 4096; pqsrc = pqb + (size_t)chain * 6 * 4096; nst = seg - 1; siout = sib + (size_t)vb * 4096;
                        sinit = nst ? siout : e0src;
                    } else if (vb < 160) { const int chain = vb - 128; kind = 2; item = ((16 + (chain >> 4)) << 4) | (chain & 15); c0 = SSD_CUT; c1 = 64; sinit = hsb + (size_t)chain * 4096; }
                    else if (vb < 416) { kind = 1; item = vb - 160; c0 = 0; c1 = 4; }
                    else { kind = 2; item = vb - 416; c0 = 0; c1 = 4; }
                }
                if (kind == 1) {
                    if (nst) wkv_seg_init<NT>(e0src, pqsrc, nst, siout, (char*)lds);
                    n_wkv3<NT>(lay, zcm16, w2t, a2t, in[41], in[43], in[46], in[47], in[6], in[7], y16, o_wf, o_wb, item, (char*)lds, c0, c1, sinit, pq, send);
                } else if (kind == 2) {
                    n_ssd2<NT>(lay, xc16, dtr, in[53], in[54], in[55], in[8], in[9], yd16, o_sf, o_sb, item, (char*)lds, c0, c1, sinit, send);
                }
            PH_END
            }
            PH_BEGIN(TT / 48)
                n_combine1<NT, 3>(lay, zcm16, g2t, y16, yd16, zg16, in[48], in[49], in[50], in[56], mrg16, vb, (char*)lds);
            PH_END
        }
        PH_BEGIN((TT / 128) * 8)
            const int tb = xcd_remap(vb, (TT / 128) * 8);
            gemm_tile<128, 128, NT, ALoadBF, EpiResid, 4>(ALoadBF{mrg16, DM}, wt_out, DM, (tb >> 3) * 128, (tb & 7) * 128,
                                    EpiResid{lay, in[0], in[1], l ? h : nullptr, h, modl, 2048}, (char*)lds);
        PH_END
        PH_BEGIN(TT / 16)
            n_resnorm_w2<NT>(lay, in[0], in[1], h, in[cb + 3], modl, 3072, 4096, hn16, vb);
        PH_END
        for (int rep_ = 0; rep_ < REP_UP; ++rep_) {
        constexpr int UPT = NHT * (FF2 / 256), UPF = (UPT / 256) * 256;
        PH_BEGIN(l == 0 ? 256 * 6 : UPF + 2 * (UPT - UPF))
            const int slot = vb & 255, rnd = vb >> 8;
            if (vb < UPF) {
                const int tb = xcd_remap(vb, UPF);
                const HaloTile ht = halo_tile(tb / (FF2 / 256));
                gemm256_tile<NT>(ALoadHalo{hn16, DM, ht.t0, ht.row0, ht.L, (const bf16_t*)(ws + WS::ZERO)}, wt_up, DM, (tb % (FF2 / 256)) * 256,
                                 EpiFFNUp{lay, ht, in[cb + 5], in[cb + 6], act16}, (char*)lds);
            } else if (rnd == 4 && slot < 2 * (UPT - UPF)) {
                const int v2 = slot, tb = UPF + (v2 >> 1);
                const HaloTile ht = halo_tile(tb / (FF2 / 256));
                gemm_tile<256, BNB, NT>(ALoadHalo{hn16, DM, ht.t0, ht.row0, ht.L, (const bf16_t*)(ws + WS::ZERO)}, wt_up, DM, 0, ((tb % (FF2 / 256)) * 2 + (v2 & 1)) * BNB,
                                        EpiFFNUp{lay, ht, in[cb + 5], in[cb + 6], act16}, (char*)lds);
            } else if (slot >= 2 * (UPT - UPF)) {
                const int p = (slot - 2 * (UPT - UPF)) + (256 - 2 * (UPT - UPF)) * (rnd - 4);
                if (p < CV_IN1 / 2) CONV_PAIR(2 * p)
            }
        PH_END
        }
        PH_BEGIN(256)
            const int tb = xcd_remap(vb, 256);
            gemm256_tile<NT, ALoadBF, EpiResid256<96>, 96>(ALoadBF{act16 + (size_t)(tb >> 2) * 192 * FF, FF}, wt_dn, FF, (tb & 3) * 256,
                             EpiResid256<96>{EpiResid{lay, in[0], in[1], h, h, modl, 5120}, (tb >> 2) * 192}, (char*)lds);
        PH_END
    }
    PH_BEGIN(TT / 16)
        n_final_w2<NT>(lay, h, in[58], out, vb);
    }
}
#undef mod
#undef h
#undef wt_in0
#undef wt_uq
#undef wt_ukv
#undef wt_in1
#undef w2t
#undef a2t
#undef g2t
#undef hn16
#undef act16
#undef tail16
#undef Qa
#undef Ka
#undef VtA
#undef qdn16
#undef ckvn16
#undef Qb
#undef Kb
#undef VtB
#undef oa1h
#undef oa2h
#undef zcm16
#undef zg16
#undef xc16
#undef dtr
#undef y16
#undef yd16
#undef c64
#undef s64
#undef c32
#undef s32
#undef mrg16
#undef o_k
#undef o_v
#undef o_ckv
#undef o_kpe
#undef o_wf
#undef o_wb
#undef o_sf
#undef o_sb
#undef wt_out
#undef wt_up
#undef wt_dn
}

extern "C" void kernel_launch(void* const* d_in, const int* in_sizes, int n_in, void* d_out, int out_size, void* d_ws, size_t ws_size,
                              hipStream_t stream) {
    if (n_in != 59 || ws_size < WS::TOTAL) return;
    static int grid = 0;
    if (grid == 0) {
        int dev = 0, cus = 0, per_cu = 0;
        (void)hipGetDevice(&dev);
        (void)hipDeviceGetAttribute(&cus, hipDeviceAttributeMultiprocessorCount, dev);
        (void)hipOccupancyMaxActiveBlocksPerMultiprocessor(&per_cu, (const void*)mega, 512, 0);
        grid = (per_cu >= 1) ? cus : 0;
        if (grid <= 0) grid = -1;
    }
    if (grid < 0) return;
    MP P{};
    for (int i = 0; i < 59; ++i) P.in[i] = (const float*)d_in[i];
    P.out = (float*)d_out;
    P.ws = (char*)d_ws;
    (void)hipMemsetAsync(d_ws, 0, WS::ZERO + 4096, stream);
    hipLaunchKernelGGL(mega, dim3(grid), dim3(512), 0, stream, P);
}
```

```cpp
#include <hip/hip_runtime.h>
#include <math.h>

namespace {
constexpr int DM = 1024, FF = 2816, FF2 = 5632;
constexpr int N0 = 1888, N1 = 3208, CC = 1920;
constexpr int TT = 12288;
constexpr float EPS = 1e-6f;
constexpr int LDS_BYTES = 151040;
#ifndef REP_UP
#define REP_UP 1
#endif
#ifndef REP_FLASH
#define REP_FLASH 1
#endif
#ifndef REP_W567
#define REP_W567 1
#endif
#ifndef REP_W2
#define REP_W2 1
#endif
#ifndef REP_W4
#define REP_W4 1
#endif
#ifndef REP_P0
#define REP_P0 1
#endif
#ifndef REP_SCAN
#define REP_SCAN 1
#endif

__device__ __forceinline__ int tid_opaque() { int t = threadIdx.x; asm volatile("" : "+v"(t)); return t; }
#define TIDX tid_opaque()

#define XB_TMO      128
#define XB_XCNT(j)  (256  + 64 * (j))
#define XB_XSUB(j)  (1280 + 64 * (j))
#define XB_XGEN(j)  (2304 + 64 * (j))
#define XB_TOP      3328
#define XB_TOPGEN   3392
#define XCD_BAR_WORDS 3456
#define XB_SPIN_CAP (1u << 22)
#define LAS __attribute__((address_space(3)))
__device__ __forceinline__ unsigned xb_ld(unsigned* p)              { return __hip_atomic_load(p, __ATOMIC_RELAXED, __HIP_MEMORY_SCOPE_AGENT); }
__device__ __forceinline__ unsigned xb_add(unsigned* p, unsigned v) { return __hip_atomic_fetch_add(p, v, __ATOMIC_RELAXED, __HIP_MEMORY_SCOPE_AGENT); }
__device__ __forceinline__ unsigned xb_xcc_id() { return (unsigned)__builtin_amdgcn_s_getreg((3 << 11) | 20) & 0xFu; }
#define XB_SPIN(cond, bar) do { unsigned _sp = 0; while (cond) { __builtin_amdgcn_s_sleep(1); \
    if ((++_sp & 255u) == 0u) { if (xb_ld(&(bar)[XB_TMO])) break; if (_sp > XB_SPIN_CAP) { atomicAdd(&(bar)[XB_TMO], 1u); break; } } } } while (0)
struct XcdBarrier { unsigned* bar; unsigned x; volatile LAS unsigned* st; };
__device__ __forceinline__ XcdBarrier xcd_barrier_post(unsigned* bar, volatile LAS unsigned* st) {
    XcdBarrier b; b.bar = bar; b.x = xb_xcc_id(); b.st = st;
    if (TIDX == 0) st[2] = xb_add(&bar[XB_XCNT(b.x)], 1u);
    return b;
}
__device__ __forceinline__ void xcd_barrier_complete(unsigned* bar, unsigned x, unsigned& nloc, unsigned& nx) {
    asm volatile("" : "+s"(x));
    const unsigned G = gridDim.x * gridDim.y * gridDim.z;
    unsigned sum, cnt, mine, sp = 0u;
    for (;;) {
        sum = 0u; cnt = 0u; mine = 0u;
#pragma unroll
        for (unsigned j = 0; j < 16; ++j) { const unsigned c = xb_ld(&bar[XB_XCNT(j)]); sum += c; cnt += (c > 0u) ? 1u : 0u; mine = (j == x) ? c : mine; }
        if (sum == G) break;
        __builtin_amdgcn_s_sleep(1);
        if ((++sp & 255u) == 0u) { if (xb_ld(&bar[XB_TMO])) break; if (sp > XB_SPIN_CAP) { atomicAdd(&bar[XB_TMO], 1u); break; } }
    }
    nloc = mine > 0u ? mine : 1u; nx = cnt > 0u ? cnt : 1u;
}
__device__ __forceinline__ int xcd_hw_index(const XcdBarrier& b) {
    if (TIDX == 0) {
        bool ok = gridDim.x == 256u;
#pragma unroll
        for (unsigned j = 0; j < 16; ++j) { const unsigned c = xb_ld(&b.bar[XB_XCNT(j)]); ok = ok && (j < 8u ? c == 32u : c == 0u); }
        const unsigned rank = b.st[2];
        b.st[3] = (ok && rank < 32u && b.x < 8u) ? rank * 8u + b.x : 0xFFFFFFFFu;
    }
    __syncthreads();
    const int r = (int)b.st[3];
    __syncthreads();
    return r;
}
__device__ __forceinline__ void xcd_barrier(const XcdBarrier& b) {
    asm volatile("s_waitcnt vmcnt(0)" ::: "memory");
    __syncthreads();
    if (TIDX == 0) {
        unsigned* bar = b.bar;
        __builtin_amdgcn_s_waitcnt(0);
        unsigned nloc = b.st[0], nx = b.st[1];
        if (nloc == 0u) { xcd_barrier_complete(bar, b.x, nloc, nx); b.st[0] = nloc; b.st[1] = nx; }
        const unsigned old = xb_add(&bar[XB_XSUB(b.x)], 1u);
        const unsigned gen = old / nloc;
        if (old + 1u == (gen + 1u) * nloc) {
            __builtin_amdgcn_fence(__ATOMIC_RELEASE, "agent");
            asm volatile("s_waitcnt vmcnt(0)" ::: "memory");
            const unsigned og = xb_add(&bar[XB_TOP], 1u);
            const unsigned tg = og / nx;
            if (og + 1u == (tg + 1u) * nx) xb_add(&bar[XB_TOPGEN], 1u);
            else XB_SPIN(xb_ld(&bar[XB_TOPGEN]) == tg, bar);
            __builtin_amdgcn_fence(__ATOMIC_ACQUIRE, "agent");
            xb_add(&bar[XB_XGEN(b.x)], 1u);
            asm volatile("s_waitcnt vmcnt(0)" ::: "memory");
        } else {
            XB_SPIN(xb_ld(&bar[XB_XGEN(b.x)]) == gen, bar);
            __builtin_amdgcn_fence(__ATOMIC_ACQUIRE, "agent");
            asm volatile("s_waitcnt vmcnt(0)" ::: "memory");
        }
    }
    __syncthreads();
}

__device__ __forceinline__ float silu_f(float x) { return x / (1.f + expf(-x)); }
__device__ __forceinline__ float sigmoid_f(float x) { return 1.f / (1.f + expf(-x)); }
template <int CTRL> __device__ __forceinline__ float dpp_mov(float x) {
    return __builtin_bit_cast(float, __builtin_amdgcn_mov_dpp(__builtin_bit_cast(int, x), CTRL, 0xF, 0xF, true));
}
__device__ __forceinline__ float wave_sum(float v) {
    v += dpp_mov<0xB1>(v);
    v += dpp_mov<0x4E>(v);
    v += dpp_mov<0x141>(v);
    v += dpp_mov<0x140>(v);
    v += __builtin_bit_cast(float, __builtin_amdgcn_update_dpp(0, __builtin_bit_cast(int, v), 0x142, 0xA, 0xF, false));
    v += __builtin_bit_cast(float, __builtin_amdgcn_update_dpp(0, __builtin_bit_cast(int, v), 0x143, 0xC, 0xF, false));
    return __builtin_bit_cast(float, __builtin_amdgcn_readlane(__builtin_bit_cast(int, v), 63));
}
__device__ __forceinline__ float block_sum256(float v, float* sh) {
    v = wave_sum(v);
    __syncthreads();
    if ((TIDX & 63) == 0) sh[TIDX >> 6] = v;
    __syncthreads();
    return sh[0] + sh[1] + sh[2] + sh[3];
}

template <int NT>
__device__ __forceinline__ void n_ada(const float* __restrict__ c, const float* __restrict__ c_ctx, const float* __restrict__ W0, const float* __restrict__ b0,
                                      const float* __restrict__ W1, const float* __restrict__ b1, float* __restrict__ mod, int vb, float* lds) {
    const int tid = TIDX, col = tid & 63, kp = tid >> 6;
    const int l = vb / 96, j = (vb % 96) * 64 + col;
    const float* W = (l ? W1 : W0) + j;
    float* sc = lds + 2048;
    __syncthreads();
    for (int i = tid; i < 3072; i += NT) sc[i] = silu_f(i < 1024 ? c_ctx[i] : c[i - 1024]);
    __syncthreads();
    float s0 = 0.f, s1 = 0.f, s2 = 0.f;
#pragma unroll 8
    for (int k = kp * 128; k < kp * 128 + 128; ++k) {
        const float w = W[(size_t)k * 6144];
        s0 += sc[k] * w; s1 += sc[1024 + k] * w; s2 += sc[2048 + k] * w;
    }
    __syncthreads();
    lds[(kp * 3 + 0) * 64 + col] = s0; lds[(kp * 3 + 1) * 64 + col] = s1; lds[(kp * 3 + 2) * 64 + col] = s2;
    __syncthreads();
    if (tid < 192) {
        const int ci = tid >> 6;
        float s = 0.f;
#pragma unroll
        for (int q = 0; q < 8; ++q) s += lds[(q * 3 + ci) * 64 + col];
        mod[(size_t)(l * 3 + ci) * 6144 + j] = s + (l ? b1 : b0)[j];
    }
}

typedef __attribute__((ext_vector_type(8))) short bf16x8;
typedef __attribute__((ext_vector_type(4))) float f32x4;
typedef __attribute__((ext_vector_type(2))) __bf16 bf16x2_t;
typedef __attribute__((ext_vector_type(2))) float f32x2_t;
typedef unsigned short bf16_t;
typedef __attribute__((ext_vector_type(4))) unsigned u32x4;
__device__ __forceinline__ unsigned pk_bf16(float a, float b) {
    bf16x2_t v = __builtin_convertvector((f32x2_t){a, b}, bf16x2_t);
    return __builtin_bit_cast(unsigned, v);
}
__device__ __forceinline__ int gt_lds_byte(int r, int c) {
    const int st = (r >> 4) * 2 + (c >> 5), ob = (r & 15) * 64 + (c & 31) * 2;
    return st * 1024 + (ob ^ (((ob >> 9) & 1) << 5));
}
template <int BM, int BN, int NT, class AL, class EP, int WN = BN / 64>
__device__ __forceinline__ void gemm_tile(const AL& al, const bf16_t* __restrict__ Wt, int K, int m0, int n0, const EP& ep, char* lds) {
    constexpr int NW = NT / 64, NJ = BN / WN / 16;
    constexpr int A_L = BM / 8 / NW, B_L = BN / 8 / NW;
    static_assert((BM / 64) * WN * 64 == NT && (NJ == 4 || NJ == 2), "wave layout");
    char* As = lds;
    char* Bs = lds + 3 * BM * 128;
    const int tid = TIDX, lane = tid & 63, wv = tid >> 6, wr = wv / WN, wc = wv % WN;
    f32x4 acc[4][NJ];
#pragma unroll
    for (int i = 0; i < 4; ++i)
#pragma unroll
        for (int j = 0; j < NJ; ++j) acc[i][j] = (f32x4){0.f, 0.f, 0.f, 0.f};
    const int sb = lane * 16, swz = sb ^ (((sb >> 9) & 1) << 5), lr = swz >> 6, lc = (swz & 63) >> 1;
    const bf16_t* ap[A_L];
    const bf16_t* bp[B_L];
#pragma unroll
    for (int i = 0; i < A_L; ++i) { const int st = wv + NW * i; ap[i] = al.ptr(m0 + (st >> 1) * 16 + lr, (st & 1) * 32 + lc); }
#pragma unroll
    for (int i = 0; i < B_L; ++i) { const int st = wv + NW * i; bp[i] = Wt + (size_t)(n0 + (st >> 1) * 16 + lr) * K + (st & 1) * 32 + lc; }
#define GT_STAGE(buf_, k0_) { \
        _Pragma("unroll") for (int i_ = 0; i_ < A_L; ++i_) \
            __builtin_amdgcn_global_load_lds((const unsigned*)(ap[i_] + (k0_)), (__attribute__((address_space(3))) unsigned*)(As + (buf_) * BM * 128 + (wv + NW * i_) * 1024), 16, 0, 0); \
        _Pragma("unroll") for (int i_ = 0; i_ < B_L; ++i_) \
            __builtin_amdgcn_global_load_lds((const unsigned*)(bp[i_] + (k0_)), (__attribute__((address_space(3))) unsigned*)(Bs + (buf_) * BN * 128 + (wv + NW * i_) * 1024), 16, 0, 0); }
    __syncthreads();
    const int nk = K / 64;
    GT_STAGE(0, 0)
    if (nk > 1) GT_STAGE(1, 64)
    const int fr = lane & 15, fq = lane >> 4;
    for (int kt = 0; kt < nk; ++kt) {
        if (kt + 1 < nk) asm volatile("s_waitcnt vmcnt(%0)" :: "n"(A_L + B_L) : "memory");
        else             asm volatile("s_waitcnt vmcnt(0)" ::: "memory");
        asm volatile("s_waitcnt lgkmcnt(0)" ::: "memory");
        __builtin_amdgcn_s_barrier();
        asm volatile("" ::: "memory");
        const int cb = kt % 3;
        if (kt + 2 < nk) { const int nb_ = (kt + 2) % 3; GT_STAGE(nb_, (kt + 2) * 64) }
        const char* Ab = As + cb * BM * 128;
        const char* Bb = Bs + cb * BN * 128;
        {
            u32x4 x0, x1, x2, x3, x4, x5, x6, x7, y0, y1, y2, y3, y4, y5, y6, y7;
            const unsigned aa0 = (unsigned)(size_t)(Ab + gt_lds_byte(wr * 64 + 0 + fr, fq * 8)), aa1 = (unsigned)(size_t)(Ab + gt_lds_byte(wr * 64 + 16 + fr, fq * 8));
            const unsigned aa2 = (unsigned)(size_t)(Ab + gt_lds_byte(wr * 64 + 32 + fr, fq * 8)), aa3 = (unsigned)(size_t)(Ab + gt_lds_byte(wr * 64 + 48 + fr, fq * 8));
            const unsigned ab0 = (unsigned)(size_t)(Bb + gt_lds_byte(wc * (16 * NJ) + 0 + fr, fq * 8)), ab1 = (unsigned)(size_t)(Bb + gt_lds_byte(wc * (16 * NJ) + 16 + fr, fq * 8));
            if constexpr (NJ == 4) {
                const unsigned ab2 = (unsigned)(size_t)(Bb + gt_lds_byte(wc * (16 * NJ) + 32 + fr, fq * 8)), ab3 = (unsigned)(size_t)(Bb + gt_lds_byte(wc * (16 * NJ) + 48 + fr, fq * 8));
                asm volatile("ds_read_b128 %0, %16\n\tds_read_b128 %1, %17\n\tds_read_b128 %2, %18\n\tds_read_b128 %3, %19\n\t"
                             "ds_read_b128 %4, %20\n\tds_read_b128 %5, %21\n\tds_read_b128 %6, %22\n\tds_read_b128 %7, %23\n\t"
                             "ds_read_b128 %8, %16 offset:1024\n\tds_read_b128 %9, %17 offset:1024\n\tds_read_b128 %10, %18 offset:1024\n\tds_read_b128 %11, %19 offset:1024\n\t"
                             "ds_read_b128 %12, %20 offset:1024\n\tds_read_b128 %13, %21 offset:1024\n\tds_read_b128 %14, %22 offset:1024\n\tds_read_b128 %15, %23 offset:1024\n\t"
                             "s_waitcnt lgkmcnt(8)"
                             : "=&v"(x0), "=&v"(x1), "=&v"(x2), "=&v"(x3), "=&v"(x4), "=&v"(x5), "=&v"(x6), "=&v"(x7),
                               "=&v"(y0), "=&v"(y1), "=&v"(y2), "=&v"(y3), "=&v"(y4), "=&v"(y5), "=&v"(y6), "=&v"(y7)
                             : "v"(aa0), "v"(aa1), "v"(aa2), "v"(aa3), "v"(ab0), "v"(ab1), "v"(ab2), "v"(ab3) : "memory");
            } else {
                asm volatile("ds_read_b128 %0, %12\n\tds_read_b128 %1, %13\n\tds_read_b128 %2, %14\n\tds_read_b128 %3, %15\n\t"
                             "ds_read_b128 %4, %16\n\tds_read_b128 %5, %17\n\t"
                             "ds_read_b128 %6, %12 offset:1024\n\tds_read_b128 %7, %13 offset:1024\n\tds_read_b128 %8, %14 offset:1024\n\tds_read_b128 %9, %15 offset:1024\n\t"
                             "ds_read_b128 %10, %16 offset:1024\n\tds_read_b128 %11, %17 offset:1024\n\t"
                             "s_waitcnt lgkmcnt(6)"
                             : "=&v"(x0), "=&v"(x1), "=&v"(x2), "=&v"(x3), "=&v"(x4), "=&v"(x5),
                               "=&v"(y0), "=&v"(y1), "=&v"(y2), "=&v"(y3), "=&v"(y4), "=&v"(y5)
                             : "v"(aa0), "v"(aa1), "v"(aa2), "v"(aa3), "v"(ab0), "v"(ab1) : "memory");
            }
            const bf16x8 a0[4] = {__builtin_bit_cast(bf16x8, x0), __builtin_bit_cast(bf16x8, x1), __builtin_bit_cast(bf16x8, x2), __builtin_bit_cast(bf16x8, x3)};
#pragma unroll
            for (int i = 0; i < 4; ++i) {
                acc[i][0] = __builtin_amdgcn_mfma_f32_16x16x32_bf16(__builtin_bit_cast(bf16x8, x4), a0[i], acc[i][0], 0, 0, 0);
                acc[i][1] = __builtin_amdgcn_mfma_f32_16x16x32_bf16(__builtin_bit_cast(bf16x8, x5), a0[i], acc[i][1], 0, 0, 0);
                if constexpr (NJ == 4) {
                    acc[i][2] = __builtin_amdgcn_mfma_f32_16x16x32_bf16(__builtin_bit_cast(bf16x8, x6), a0[i], acc[i][2], 0, 0, 0);
                    acc[i][3] = __builtin_amdgcn_mfma_f32_16x16x32_bf16(__builtin_bit_cast(bf16x8, x7), a0[i], acc[i][3], 0, 0, 0);
                }
            }
            if constexpr (NJ == 4)
                asm volatile("s_waitcnt lgkmcnt(0)" : "+v"(y0), "+v"(y1), "+v"(y2), "+v"(y3), "+v"(y4), "+v"(y5), "+v"(y6), "+v"(y7), "+v"(acc[3][3]) :: "memory");
            else
                asm volatile("s_waitcnt lgkmcnt(0)" : "+v"(y0), "+v"(y1), "+v"(y2), "+v"(y3), "+v"(y4), "+v"(y5), "+v"(acc[3][1]) :: "memory");
            const bf16x8 a1[4] = {__builtin_bit_cast(bf16x8, y0), __builtin_bit_cast(bf16x8, y1), __builtin_bit_cast(bf16x8, y2), __builtin_bit_cast(bf16x8, y3)};
#pragma unroll
            for (int i = 0; i < 4; ++i) {
                acc[i][0] = __builtin_amdgcn_mfma_f32_16x16x32_bf16(__builtin_bit_cast(bf16x8, y4), a1[i], acc[i][0], 0, 0, 0);
                acc[i][1] = __builtin_amdgcn_mfma_f32_16x16x32_bf16(__builtin_bit_cast(bf16x8, y5), a1[i], acc[i][1], 0, 0, 0);
                if constexpr (NJ == 4) {
                    acc[i][2] = __builtin_amdgcn_mfma_f32_16x16x32_bf16(__builtin_bit_cast(bf16x8, y6), a1[i], acc[i][2], 0, 0, 0);
                    acc[i][3] = __builtin_amdgcn_mfma_f32_16x16x32_bf16(__builtin_bit_cast(bf16x8, y7), a1[i], acc[i][3], 0, 0, 0);
                }
            }
        }
    }
    __syncthreads();
#undef GT_STAGE
    if constexpr (NJ == 4) ep.template run<BM, BN, NT>(acc, m0, n0, wr, wc, lane, lds);
    else ep.template run<BM, BN, NT, NJ>(acc, m0, n0, wr, wc, lane, lds);
}

template <int NT, class AL, class EP, int MH = 128>
__device__ __forceinline__ void gemm256_tile(const AL& al, const bf16_t* __restrict__ Wt, const int K, const int n0, const EP& ep, char* lds) {
    static_assert(NT == 512 && (MH == 128 || MH == 96), "gemm256_tile needs 8 waves; A halves of 128 or 96 rows");
    constexpr int NM = MH / 32;
    constexpr int HB = 128 * 64 * 2;
    const int tid = TIDX, lane = tid & 63, wid = tid >> 6, wr = wid >> 2, wc = wid & 3, fr = lane & 15, fq = lane >> 4;
    const int sb = lane * 16, swz = sb ^ (((sb >> 9) & 1) << 5);
    const int R0 = (wid >> 1) * 16 + (swz >> 6), C0 = (wid & 1) * 32 + ((swz & 63) >> 1);
    const unsigned ao00 = al.boff(R0, C0), ao10 = al.boff(R0 + MH, C0);
    const unsigned ao01 = (R0 + 64 < MH) ? al.boff(R0 + 64, C0) : ao00, ao11 = (R0 + 64 < MH) ? al.boff(R0 + MH + 64, C0) : ao10;
    const unsigned bo = (unsigned)(R0 * K + C0) * 2u;
    const char* const abase = al.ubase();
    const char* const bbase = (const char*)(Wt + (size_t)n0 * K);
    const size_t bK64 = (size_t)64 * K * 2;
    const unsigned stg = (unsigned)(size_t)lds + (unsigned)__builtin_amdgcn_readfirstlane(wid) * 1024u;
    f32x4 acc[2][2][NM][2];
#pragma unroll
    for (int a = 0; a < 2; ++a)
#pragma unroll
        for (int b = 0; b < 2; ++b)
#pragma unroll
            for (int m = 0; m < NM; ++m)
#pragma unroll
                for (int n = 0; n < 2; ++n) acc[a][b][m][n] = (f32x4){0.f, 0.f, 0.f, 0.f};
    bf16x8 At[NM][2], B0[2][2], B1[2][2];
#define G8_SA(b_, h_) (((b_) * 2 + (h_)) * HB)
#define G8_SB(b_, h_) ((4 + (b_) * 2 + (h_)) * HB)
#define G8_GLDS(vo_, sb_, m0_) asm volatile("s_mov_b32 m0, %2\n\tglobal_load_lds_dwordx4 %0, %1" :: "v"(vo_), "s"(sb_), "s"(m0_) : "memory", "m0")
#define G8_STAGE_A(b_, h_, kt_) { const char* kb_ = abase + (size_t)(kt_) * 128; \
        G8_GLDS(((h_) ? ao10 : ao00), kb_, stg + G8_SA(b_, h_)); G8_GLDS(((h_) ? ao11 : ao01), kb_, stg + G8_SA(b_, h_) + 8192); }
#define G8_STAGE_B(b_, h_, kt_) { const char* kb_ = bbase + (size_t)((h_) * 2) * bK64 + (size_t)(kt_) * 128; const char* kb2_ = kb_ + bK64; \
        G8_GLDS(bo, kb_, stg + G8_SB(b_, h_)); G8_GLDS(bo, kb2_, stg + G8_SB(b_, h_) + 8192); }
#define G8_LDA(b_, h_) { _Pragma("unroll") for (int m = 0; m < NM; ++m) _Pragma("unroll") for (int k = 0; k < 2; ++k) \
        At[m][k] = *(const bf16x8*)(lds + G8_SA(b_, h_) + gt_lds_byte(wr * (MH / 2) + m * 16 + fr, k * 32 + fq * 8)); }
#define G8_LDB(dst_, b_, h_) { _Pragma("unroll") for (int n = 0; n < 2; ++n) _Pragma("unroll") for (int k = 0; k < 2; ++k) \
        dst_[n][k] = *(const bf16x8*)(lds + G8_SB(b_, h_) + gt_lds_byte(wc * 32 + n * 16 + fr, k * 32 + fq * 8)); }
#define G8_MMA(ai_, bj_, Bx_) { __builtin_amdgcn_s_setprio(1); \
        _Pragma("unroll") for (int m = 0; m < NM; ++m) _Pragma("unroll") for (int n = 0; n < 2; ++n) _Pragma("unroll") for (int k = 0; k < 2; ++k) \
            acc[ai_][bj_][m][n] = __builtin_amdgcn_mfma_f32_16x16x32_bf16(Bx_[n][k], At[m][k], acc[ai_][bj_][m][n], 0, 0, 0); \
        __builtin_amdgcn_s_setprio(0); }
#define G8_WAIT_V(n_) asm volatile("s_waitcnt vmcnt(" #n_ ")" ::: "memory")
#define G8_WAIT_L(n_) asm volatile("s_waitcnt lgkmcnt(" #n_ ")" ::: "memory")
#define G8_WAIT_LA { if constexpr (NM == 4) { G8_WAIT_L(8); } else { G8_WAIT_L(6); } }
#define G8_BAR __builtin_amdgcn_s_barrier()
#define G8_SCHED __builtin_amdgcn_sched_barrier(0)
    const int nt = K / 64;
    __syncthreads();
    G8_STAGE_B(0, 0, 0) G8_STAGE_A(0, 0, 0) G8_STAGE_B(0, 1, 0) G8_STAGE_A(0, 1, 0)
    if (wr == 1) G8_BAR;
    G8_WAIT_V(4); G8_BAR;
    G8_STAGE_B(1, 0, 1) G8_STAGE_A(1, 0, 1) G8_STAGE_B(1, 1, 1)
    G8_WAIT_V(6); G8_BAR;
    for (int t = 0; t < nt; t += 2) {
        const bool more = t + 2 < nt;
        G8_LDB(B0, 0, 0) G8_SCHED; G8_LDA(0, 0) G8_STAGE_A(1, 1, t + 1)
        G8_WAIT_LA G8_BAR; G8_WAIT_L(0); G8_MMA(0, 0, B0) G8_BAR; G8_SCHED;
        G8_LDB(B1, 0, 1) if (more) G8_STAGE_B(0, 0, t + 2)
        G8_BAR; G8_WAIT_L(0); G8_MMA(0, 1, B1) G8_BAR;
        G8_LDA(0, 1) if (more) G8_STAGE_A(0, 0, t + 2)
        G8_BAR; G8_WAIT_L(0); G8_MMA(1, 0, B0) G8_BAR; G8_SCHED;
        if (more) { G8_STAGE_B(0, 1, t + 2) G8_WAIT_V(6); } else { G8_WAIT_V(0); }
        G8_BAR; G8_MMA(1, 1, B1) G8_BAR;
        G8_LDB(B0, 1, 0) G8_SCHED; G8_LDA(1, 0) if (more) G8_STAGE_A(0, 1, t + 2)
        G8_WAIT_LA G8_BAR; G8_WAIT_L(0); G8_MMA(0, 0, B0) G8_BAR; G8_SCHED;
        G8_LDB(B1, 1, 1) if (more) G8_STAGE_B(1, 0, t + 3)
        G8_BAR; G8_WAIT_L(0); G8_MMA(0, 1, B1) G8_BAR;
        G8_LDA(1, 1) if (more) G8_STAGE_A(1, 0, t + 3)
        G8_BAR; G8_WAIT_L(0); G8_MMA(1, 0, B0) G8_BAR; G8_SCHED;
        if (more) { G8_STAGE_B(1, 1, t + 3) G8_WAIT_V(6); }
        G8_BAR; G8_MMA(1, 1, B1) G8_BAR;
    }
    if (wr == 0) G8_BAR;
    __syncthreads();
#undef G8_SA
#undef G8_SB
#undef G8_GLDS
#undef G8_STAGE_A
#undef G8_STAGE_B
#undef G8_LDA
#undef G8_LDB
#undef G8_MMA
#undef G8_WAIT_V
#undef G8_WAIT_L
#undef G8_WAIT_LA
#undef G8_BAR
#undef G8_SCHED
    {
        const int t2 = TIDX;
        ep.template run256<NT>(acc, n0, t2 >> 8, (t2 >> 6) & 3, t2 & 63, lds);
    }
}

typedef __attribute__((ext_vector_type(16))) float f32x16;
__device__ __forceinline__ uint2 pk4(float a, float b, float c, float d) { return make_uint2(pk_bf16(a, b), pk_bf16(c, d)); }
constexpr float QSCALE_A = 0.125f * 1.4426950408889634f, QSCALE_B = 0.10206207261596577f * 1.4426950408889634f;
struct FlashP {
    const bf16_t* Q; int q_ld;
    const bf16_t* K0; const bf16_t* K1; int k_ld;
    const bf16_t* Vt; int vt_ld;
    int n0, Lk;
    float* O; bf16_t* Ob; int o_ld;
    float c;
};
template <int OFF> __device__ __forceinline__ void ds_rd128(u32x4& d, unsigned addr) { asm volatile("ds_read_b128 %0, %1 offset:%2" : "=&v"(d) : "v"(addr), "n"(OFF)); }
template <int O0, int O1> __device__ __forceinline__ void ds_rd2x64(u32x4& d, unsigned addr) { asm volatile("ds_read2_b64 %0, %1 offset0:%2 offset1:%3" : "=&v"(d) : "v"(addr), "n"(O0), "n"(O1)); }
template <int DQ, int NT, bool OBF>
__device__ __forceinline__ void flash_item(const FlashP& p, int q0, char* lds) {
    constexpr int G = NT / 256;
    constexpr int LDQ = DQ + 8, LDV = 68;
    constexpr int KCH = 64 * (DQ / 8) / 256;
    constexpr int KT_BYTES = 64 * LDQ * 2, VT_BYTES = 128 * LDV * 2, BUF_BYTES = KT_BYTES + VT_BYTES;
    const int tid = TIDX, lane = tid & 63, wv = (tid >> 6) & 3, grp = tid >> 8, gt = tid & 255;
    const int l31 = lane & 31, hh = lane >> 5;
    char* gl = lds + grp * 2 * BUF_BYTES;
    bf16x8 qf[DQ / 16];
    {
        const bf16_t* qr = p.Q + (size_t)(q0 + wv * 32 + l31) * p.q_ld + hh * 8;
#pragma unroll
        for (int ks = 0; ks < DQ / 16; ++ks) qf[ks] = *(const bf16x8*)(qr + ks * 16);
    }
    f32x16 o[4];
#pragma unroll
    for (int d = 0; d < 4; ++d)
#pragma unroll
        for (int r = 0; r < 16; ++r) o[d][r] = 0.f;
    float m_run = 0.f, l_run = 0.f;
    const u32x4 onesA = {hh == 0 ? 0x3F80u : 0u, 0u, 0u, 0u};
    const int ntile = p.Lk / 64, tpg = ntile / G, t_beg = grp * tpg, t_end = t_beg + tpg;
    uint4 rk0, rk1, rk2 = make_uint4(0u, 0u, 0u, 0u), rv0, rv1, rv2, rv3;
#define FL_KOFF(i) (unsigned)((((gt + (i) * 256) / (DQ / 8)) * p.k_ld + ((gt + (i) * 256) % (DQ / 8)) * 8) * 2)
    const unsigned ko0 = FL_KOFF(0), ko1 = FL_KOFF(1), ko2 = KCH > 2 ? FL_KOFF(2) : 0u;
    const unsigned vo0 = (unsigned)(((gt >> 3) * p.vt_ld + (gt & 7) * 8) * 2);
    const size_t vstep = (size_t)32 * p.vt_ld * 2;
#define FL_GLOAD(t) { const int j0_ = (t) * 64; \
        const char* kb_ = (const char*)((j0_ < p.n0) ? p.K0 + (size_t)j0_ * p.k_ld : p.K1 + (size_t)(j0_ - p.n0) * p.k_ld); \
        const char* vb0_ = (const char*)(p.Vt + j0_); \
        rk0 = *(const uint4*)(kb_ + (size_t)ko0); rk1 = *(const uint4*)(kb_ + (size_t)ko1); if (KCH > 2) rk2 = *(const uint4*)(kb_ + (size_t)ko2); \
        rv0 = *(const uint4*)(vb0_ + (size_t)vo0); rv1 = *(const uint4*)(vb0_ + vstep + (size_t)vo0); \
        rv2 = *(const uint4*)(vb0_ + 2 * vstep + (size_t)vo0); rv3 = *(const uint4*)(vb0_ + 3 * vstep + (size_t)vo0); }
#define FL_KST(i, R) { const int c_ = gt + (i) * 256; const int row_ = c_ / (DQ / 8), ch_ = c_ % (DQ / 8); *(uint4*)(ks_ + row_ * LDQ + ch_ * 8) = R; }
#define FL_VST(i, R) { const int c_ = gt + (i) * 256; const int row_ = c_ >> 3, ch_ = c_ & 7; bf16_t* d_ = vs_ + row_ * LDV + ch_ * 8; \
        *(uint2*)d_ = make_uint2(R.x, R.y); *(uint2*)(d_ + 4) = make_uint2(R.z, R.w); }
#define FL_SWRITE(b) { bf16_t* ks_ = (bf16_t*)(gl + (b) * BUF_BYTES); bf16_t* vs_ = (bf16_t*)(gl + (b) * BUF_BYTES + KT_BYTES); \
        FL_KST(0, rk0) FL_KST(1, rk1) if (KCH > 2) FL_KST(2, rk2) \
        FL_VST(0, rv0) FL_VST(1, rv1) FL_VST(2, rv2) FL_VST(3, rv3) }
    const int rot = (((q0 >> 7) & 31) * tpg) >> 5;
#define FL_TILE(i_) (t_beg + ((i_) + rot < tpg ? (i_) + rot : (i_) + rot - tpg))
    __syncthreads();
    FL_GLOAD(FL_TILE(0)) FL_SWRITE(0)
    __syncthreads();
    if (G == 2 && grp == 1) __builtin_amdgcn_s_barrier();
    for (int it = 0; it < tpg; ++it) {
        const int b = it & 1;
        if (it + 1 < tpg) FL_GLOAD(FL_TILE(it + 1))
        const bf16_t* ks = (const bf16_t*)(gl + b * BUF_BYTES);
        const bf16_t* vs = (const bf16_t*)(gl + b * BUF_BYTES + KT_BYTES);
        f32x16 s[2];
        {
            constexpr int NK = DQ / 16;
            const unsigned kaddr = (unsigned)(size_t)ks + (unsigned)((l31 * LDQ + hh * 8) * 2);
            u32x4 kf[2][NK];
#define FL_KR(kb_, kk_) ds_rd128<((kb_) * 32 * LDQ + (kk_) * 16) * 2>(kf[kb_][kk_], kaddr);
            FL_KR(0, 0) FL_KR(1, 0) FL_KR(0, 1) FL_KR(1, 1) FL_KR(0, 2) FL_KR(1, 2) FL_KR(0, 3) FL_KR(1, 3)
            if constexpr (NK > 4) { FL_KR(0, 4) FL_KR(1, 4) FL_KR(0, 5) FL_KR(1, 5) }
#undef FL_KR
            {
                const u32x4 qx = {hh == 0 ? (__builtin_bit_cast(unsigned, -m_run) >> 16) : 0u, 0u, 0u, 0u};
                f32x16 z16;
#pragma unroll
                for (int r = 0; r < 16; ++r) z16[r] = 0.f;
                s[0] = __builtin_amdgcn_mfma_f32_32x32x16_bf16(__builtin_bit_cast(bf16x8, onesA), __builtin_bit_cast(bf16x8, qx), z16, 0, 0, 0);
                s[1] = __builtin_amdgcn_mfma_f32_32x32x16_bf16(__builtin_bit_cast(bf16x8, onesA), __builtin_bit_cast(bf16x8, qx), z16, 0, 0, 0);
            }
            if constexpr (NK > 4) asm volatile("s_waitcnt lgkmcnt(8)" : "+v"(kf[0][0]), "+v"(kf[1][0]), "+v"(kf[0][1]), "+v"(kf[1][1]));
            else                  asm volatile("s_waitcnt lgkmcnt(4)" : "+v"(kf[0][0]), "+v"(kf[1][0]), "+v"(kf[0][1]), "+v"(kf[1][1]));
#pragma unroll
            for (int kk = 0; kk < 2; ++kk)
#pragma unroll
                for (int kb = 0; kb < 2; ++kb) s[kb] = __builtin_amdgcn_mfma_f32_32x32x16_bf16(__builtin_bit_cast(bf16x8, kf[kb][kk]), qf[kk], s[kb], 0, 0, 0);
            if constexpr (NK > 4) asm volatile("s_waitcnt lgkmcnt(4)" : "+v"(kf[0][2]), "+v"(kf[1][2]), "+v"(kf[0][3]), "+v"(kf[1][3]));
            else                  asm volatile("s_waitcnt lgkmcnt(0)" : "+v"(kf[0][2]), "+v"(kf[1][2]), "+v"(kf[0][3]), "+v"(kf[1][3]));
#pragma unroll
            for (int kk = 2; kk < 4; ++kk)
#pragma unroll
                for (int kb = 0; kb < 2; ++kb) s[kb] = __builtin_amdgcn_mfma_f32_32x32x16_bf16(__builtin_bit_cast(bf16x8, kf[kb][kk]), qf[kk], s[kb], 0, 0, 0);
            if constexpr (NK > 4) {
                asm volatile("s_waitcnt lgkmcnt(0)" : "+v"(kf[0][4]), "+v"(kf[1][4]), "+v"(kf[0][5]), "+v"(kf[1][5]));
#pragma unroll
                for (int kk = 4; kk < NK; ++kk)
#pragma unroll
                    for (int kb = 0; kb < 2; ++kb) s[kb] = __builtin_amdgcn_mfma_f32_32x32x16_bf16(__builtin_bit_cast(bf16x8, kf[kb][kk]), qf[kk], s[kb], 0, 0, 0);
            }
        }
        float mx = s[0][0];
#pragma unroll
        for (int r = 1; r < 16; ++r) mx = fmaxf(mx, s[0][r]);
#pragma unroll
        for (int r = 0; r < 16; ++r) mx = fmaxf(mx, s[1][r]);
        mx = fmaxf(mx, __shfl_xor(mx, 32));
        const bool first = it == 0;
        constexpr float FL_THR = 5.f;
        const bool grow = first || __builtin_amdgcn_ballot_w64(mx > FL_THR) != 0ull;
        if (grow) {
            const float dl = (first || mx > FL_THR) ? mx : 0.f;
            const float m_new = __builtin_bit_cast(float, pk_bf16(m_run + dl, 0.f) << 16);
            const float d = m_new - m_run, alpha = __builtin_amdgcn_exp2f(-d);
            m_run = m_new;
#pragma unroll
            for (int kb = 0; kb < 2; ++kb)
#pragma unroll
                for (int r = 0; r < 16; ++r) s[kb][r] -= d;
            l_run *= alpha;
#pragma unroll
            for (int dd = 0; dd < 4; ++dd)
#pragma unroll
                for (int r = 0; r < 16; ++r) o[dd][r] *= alpha;
        }
#pragma unroll
        for (int r = 0; r < 16; ++r) s[0][r] = __builtin_amdgcn_exp2f(s[0][r]);
        if (G == 2) __builtin_amdgcn_s_barrier();
        {
            const unsigned vb_ = (unsigned)(size_t)vs + (unsigned)((l31 * LDV + 4 * hh) * 2);
            const unsigned va0 = vb_, va1 = vb_ + 32 * LDV * 2, va2 = vb_ + 64 * LDV * 2, va3 = vb_ + 96 * LDV * 2;
            u32x4 fa0, fa1, fa2, fa3, fb0, fb1, fb2, fb3;
#define FL_VR(S_, g_) ds_rd2x64<(g_) * 4, (g_) * 4 + 2>(f##S_##0, va0); ds_rd2x64<(g_) * 4, (g_) * 4 + 2>(f##S_##1, va1); \
                      ds_rd2x64<(g_) * 4, (g_) * 4 + 2>(f##S_##2, va2); ds_rd2x64<(g_) * 4, (g_) * 4 + 2>(f##S_##3, va3);
#define FL_PV(S_, g_, W_) { asm volatile("s_waitcnt lgkmcnt(" #W_ ")" : "+v"(f##S_##0), "+v"(f##S_##1), "+v"(f##S_##2), "+v"(f##S_##3)); \
            constexpr int kb_ = (g_) >> 1, sp_ = (g_) & 1; \
            const u32x4 pbu = {pk_bf16(s[kb_][8 * sp_ + 0], s[kb_][8 * sp_ + 1]), pk_bf16(s[kb_][8 * sp_ + 2], s[kb_][8 * sp_ + 3]), \
                               pk_bf16(s[kb_][8 * sp_ + 4], s[kb_][8 * sp_ + 5]), pk_bf16(s[kb_][8 * sp_ + 6], s[kb_][8 * sp_ + 7])}; \
            const bf16x8 pbv = __builtin_bit_cast(bf16x8, pbu); \
            o[0] = __builtin_amdgcn_mfma_f32_32x32x16_bf16(__builtin_bit_cast(bf16x8, f##S_##0), pbv, o[0], 0, 0, 0); \
            o[1] = __builtin_amdgcn_mfma_f32_32x32x16_bf16(__builtin_bit_cast(bf16x8, f##S_##1), pbv, o[1], 0, 0, 0); \
            o[2] = __builtin_amdgcn_mfma_f32_32x32x16_bf16(__builtin_bit_cast(bf16x8, f##S_##2), pbv, o[2], 0, 0, 0); \
            o[3] = __builtin_amdgcn_mfma_f32_32x32x16_bf16(__builtin_bit_cast(bf16x8, f##S_##3), pbv, o[3], 0, 0, 0); \
            l_run += ((s[kb_][8 * sp_ + 0] + s[kb_][8 * sp_ + 1]) + (s[kb_][8 * sp_ + 2] + s[kb_][8 * sp_ + 3])) + ((s[kb_][8 * sp_ + 4] + s[kb_][8 * sp_ + 5]) + (s[kb_][8 * sp_ + 6] + s[kb_][8 * sp_ + 7])); }
            FL_VR(a, 0) FL_VR(b, 1)
            FL_PV(a, 0, 4)
            FL_VR(a, 2)
            FL_PV(b, 1, 4)
            FL_VR(b, 3)
#pragma unroll
            for (int r = 0; r < 16; ++r) s[1][r] = __builtin_amdgcn_exp2f(s[1][r]);
            FL_PV(a, 2, 4)
            FL_PV(b, 3, 0)
#undef FL_VR
#undef FL_PV
        }
        if (it + 1 < tpg) FL_SWRITE(b ^ 1)
        __syncthreads();
    }
#undef FL_TILE
    if (G == 2 && grp == 0) __builtin_amdgcn_s_barrier();
    l_run += __shfl_xor(l_run, 32);
    const int tid_ = TIDX, lane_ = tid_ & 63, wv_ = (tid_ >> 6) & 3, grp_ = tid_ >> 8, l31_ = lane_ & 31, hh_ = lane_ >> 5;
#define lane lane_
#define wv wv_
#define grp grp_
#define l31 l31_
#define hh hh_
    if (G == 2) {
        float* mb = (float*)lds;
        __syncthreads();
        if (grp == 1) {
            float* w = mb + wv * 66 * 64 + lane;
#pragma unroll
            for (int d = 0; d < 4; ++d)
#pragma unroll
                for (int r = 0; r < 16; ++r) w[(d * 16 + r) * 64] = o[d][r];
            w[64 * 64] = m_run; w[65 * 64] = l_run;
        }
        __syncthreads();
        if (grp == 0) {
            const float* w = mb + wv * 66 * 64 + lane;
            const float m1 = w[64 * 64], l1 = w[65 * 64];
            const float m = fmaxf(m_run, m1), a0 = __builtin_amdgcn_exp2f(m_run - m), a1 = __builtin_amdgcn_exp2f(m1 - m);
            l_run = l_run * a0 + l1 * a1;
#pragma unroll
            for (int d = 0; d < 4; ++d)
#pragma unroll
                for (int r = 0; r < 16; ++r) o[d][r] = o[d][r] * a0 + w[(d * 16 + r) * 64] * a1;
        }
    }
    if (grp == 0) {
        const float inv = 1.f / l_run;
        const size_t ro = (size_t)(q0 + wv * 32 + l31) * p.o_ld;
#pragma unroll
        for (int d = 0; d < 4; ++d)
#pragma unroll
            for (int g4 = 0; g4 < 4; ++g4) {
                const int co = d * 32 + g4 * 8 + 4 * hh;
                if (OBF) *(uint2*)(p.Ob + ro + co) = pk4(o[d][g4 * 4] * inv, o[d][g4 * 4 + 1] * inv, o[d][g4 * 4 + 2] * inv, o[d][g4 * 4 + 3] * inv);
                else *(float4*)(p.O + ro + co) = make_float4(o[d][g4 * 4] * inv, o[d][g4 * 4 + 1] * inv, o[d][g4 * 4 + 2] * inv, o[d][g4 * 4 + 3] * inv);
            }
    }
    __syncthreads();
#undef lane
#undef wv
#undef grp
#undef l31
#undef hh
}


struct TokInfo { int seq, pos, L, ci, t0, latent; };
__device__ __forceinline__ TokInfo tokinfo(int t) {
    TokInfo r;
    if (t < 4096) { r.seq = t >> 8; r.pos = t & 255; r.L = 256; r.ci = 0; r.t0 = t & ~255; r.latent = 0; }
    else { const int u = t - 4096, b = u >> 12; r.seq = 16 + b; r.pos = u & 4095; r.L = 4096; r.ci = 1 + b; r.t0 = 4096 + (b << 12); r.latent = 1; }
    return r;
}
constexpr int VLD = 4608 + 128;
struct Lay { int tbase, Tloc, seqbase, b0, nb; };
__device__ __forceinline__ size_t vt_off(const Lay& l, int seq, int h) {
    if (seq < 16) return ((size_t)(seq - l.seqbase) * 4 + h) * 128 * 256;
    const size_t ctxpart = l.seqbase < 16 ? (size_t)(16 - l.seqbase) * 4 * 128 * 256 : 0;
    return ctxpart + ((size_t)(seq - 16 - l.b0) * 4 + h) * 128 * VLD;
}
__device__ __forceinline__ const float* xrow(const float* xp, const float* xs, int t) { return t < 4096 ? xp + (size_t)t * DM : xs + (size_t)(t - 4096) * DM; }
__device__ __forceinline__ float bf_lo(unsigned u) { return __builtin_bit_cast(float, u << 16); }
__device__ __forceinline__ float bf_hi(unsigned u) { return __builtin_bit_cast(float, u & 0xffff0000u); }
__device__ __forceinline__ float bf1(bf16_t u) { return __builtin_bit_cast(float, (unsigned)u << 16); }
__device__ __forceinline__ bf16_t to_bf(float x) { return (bf16_t)(pk_bf16(x, 0.f) & 0xffffu); }
template <int NT>
__device__ __forceinline__ float group_sum256(float v, float* sh) {
    v = wave_sum(v);
    __syncthreads();
    if ((TIDX & 63) == 0) sh[TIDX >> 6] = v;
    __syncthreads();
    const int g = (TIDX >> 8) * 4;
    return sh[g] + sh[g + 1] + sh[g + 2] + sh[g + 3];
}

__device__ __forceinline__ void n_rope_tables(float* c64, float* s64, float* c32, float* s32) {
    for (int i = TIDX; i < 64 * 16; i += blockDim.x) {
        const int val = i >> 4, f = i & 15;
        const float ang = (float)val * powf(10000.f, -(float)f / 16.f);
        c64[i] = cosf(ang); s64[i] = sinf(ang);
    }
    for (int i = TIDX; i < 64 * 8; i += blockDim.x) {
        const int val = i >> 3, f = i & 7;
        const float ang = (float)val * powf(10000.f, -(float)f / 8.f);
        c32[i] = cosf(ang); s32[i] = sinf(ang);
    }
}

__device__ __forceinline__ int wsrc(int mode, int gh, int n, int N) {
    if (mode == 0) return n < N ? n : -1;
    if (mode == 1) { const int tile = n / (2 * gh), j = n % (2 * gh); return j < gh ? tile * gh + j : FF + tile * gh + (j - gh); }
    if (n < 256) return (n >> 6) * 192 + (n & 63);
    const int c = n - 256; return (c >> 7) * 192 + 64 + (c & 127);
}
template <int NT>
__device__ __forceinline__ void n_wconv(const float* __restrict__ W, int K, int N, bf16_t* __restrict__ Wt, int Npad, int mode, int gh, int vb0, float* lds) {
    const int grp = TIDX >> 8, tid = TIDX & 255;
    const int ntn = Npad / 64, ntiles = (K / 64) * ntn;
    const int vb = vb0 * (NT / 256) + grp;
    float (*tile)[65] = (float (*)[65])(lds + grp * 64 * 65);
    const bool act = vb < ntiles;
    const int k0 = act ? (vb / ntn) * 64 : 0, n0 = act ? (vb % ntn) * 64 : 0;
    __syncthreads();
    if (act) {
#pragma unroll
        for (int p = 0; p < 4; ++p) {
            const int r = p * 16 + (tid >> 4), c = (tid & 15) * 4;
            const int sc = wsrc(mode, gh, n0 + c, N);
            float4 v = make_float4(0.f, 0.f, 0.f, 0.f);
            if (sc >= 0) v = *(const float4*)(W + (size_t)(k0 + r) * N + sc);
            tile[r][c] = v.x; tile[r][c + 1] = v.y; tile[r][c + 2] = v.z; tile[r][c + 3] = v.w;
        }
    }
    __syncthreads();
    if (act) {
#pragma unroll
        for (int p = 0; p < 4; ++p) {
            const int n = p * 16 + (tid >> 4), k = (tid & 15) * 4;
            *(uint2*)(Wt + (size_t)(n0 + n) * K + k0 + k) = pk4(tile[k][n], tile[k + 1][n], tile[k + 2][n], tile[k + 3][n]);
        }
    }
}

template <int NT, int NI>
__device__ __forceinline__ void n_wconv_multi(const float* __restrict__ W, int K, int N, bf16_t* __restrict__ Wt, int Npad, int mode, int gh, int it0, float* lds, int ldo = 0) {
    if (ldo == 0) ldo = K;
    const int grp = TIDX >> 8, tid = TIDX & 255;
    const int ntn = Npad / 64, ntiles = (K / 64) * ntn;
    float4 v[NI][4];
    __syncthreads();
#pragma unroll
    for (int u = 0; u < NI; ++u) {
        const int vb = (it0 + u) * (NT / 256) + grp;
        const bool act = vb < ntiles;
        const int k0 = act ? (vb / ntn) * 64 : 0, n0 = act ? (vb % ntn) * 64 : 0;
#pragma unroll
        for (int p = 0; p < 4; ++p) {
            const int r = p * 16 + (tid >> 4), c = (tid & 15) * 4;
            const int sc = wsrc(mode, gh, n0 + c, N);
            v[u][p] = make_float4(0.f, 0.f, 0.f, 0.f);
            if (act && sc >= 0) v[u][p] = *(const float4*)(W + (size_t)(k0 + r) * N + sc);
        }
    }
#pragma unroll
    for (int u = 0; u < NI; ++u) {
        float (*tile)[65] = (float (*)[65])(lds + (u * (NT / 256) + grp) * 64 * 65);
#pragma unroll
        for (int p = 0; p < 4; ++p) {
            const int r = p * 16 + (tid >> 4), c = (tid & 15) * 4;
            tile[r][c] = v[u][p].x; tile[r][c + 1] = v[u][p].y; tile[r][c + 2] = v[u][p].z; tile[r][c + 3] = v[u][p].w;
        }
    }
    __syncthreads();
#pragma unroll
    for (int u = 0; u < NI; ++u) {
        const int vb = (it0 + u) * (NT / 256) + grp;
        if (vb < ntiles) {
            const int k0 = (vb / ntn) * 64, n0 = (vb % ntn) * 64;
            float (*tile)[65] = (float (*)[65])(lds + (u * (NT / 256) + grp) * 64 * 65);
#pragma unroll
            for (int p = 0; p < 4; ++p) {
                const int n = p * 16 + (tid >> 4), k = (tid & 15) * 4;
                *(uint2*)(Wt + (size_t)(n0 + n) * ldo + k0 + k) = pk4(tile[k][n], tile[k + 1][n], tile[k + 2][n], tile[k + 3][n]);
            }
        }
    }
}

template <int NT>
__device__ __forceinline__ void n_resnorm(const Lay lay, const float* xp, const float* xs, const float* __restrict__ src, const float* __restrict__ g,
                          const float* __restrict__ modl, int shoff, int scoff, bf16_t* __restrict__ out, int vb, float* lds) {
    const int lrow = vb * (NT / 256) + (TIDX >> 8), tid = TIDX & 255;
    const int t = lay.tbase + lrow;
    const TokInfo ti = tokinfo(t);
    const float* xr = src ? src + (size_t)lrow * DM : xrow(xp, xs, t);
    const float4 x = *(const float4*)(xr + tid * 4);
    const float ss = group_sum256<NT>(x.x * x.x + x.y * x.y + x.z * x.z + x.w * x.w, lds);
    const float rstd = rsqrtf(ss * (1.f / DM) + EPS);
    const float4 gg = *(const float4*)(g + tid * 4);
    const float* md = modl + (size_t)ti.ci * 6144;
    const float4 a = *(const float4*)(md + scoff + tid * 4), b = *(const float4*)(md + shoff + tid * 4);
    *(uint2*)(out + (size_t)lrow * DM + tid * 4) = pk4(x.x * rstd * gg.x * (1.f + a.x) + b.x, x.y * rstd * gg.y * (1.f + a.y) + b.y,
                                                       x.z * rstd * gg.z * (1.f + a.z) + b.z, x.w * rstd * gg.w * (1.f + a.w) + b.w);
}

template <int NT>
__device__ __forceinline__ void n_resnorm_w2(const Lay lay, const float* xp, const float* xs, const bf16_t* __restrict__ src, const float* __restrict__ g,
                          const float* __restrict__ modl, int shoff, int scoff, bf16_t* __restrict__ out, int vb) {
    const int lane = TIDX & 63, lrow0 = vb * (NT / 64) * 2 + (TIDX >> 6) * 2;
    float4 x[2][4];
#pragma unroll
    for (int k = 0; k < 2; ++k) {
        const int lrow = lrow0 + k;
        const float* xr = xrow(xp, xs, lay.tbase + lrow);
#pragma unroll
        for (int q = 0; q < 4; ++q) {
            if (src) { const uint2 u = *(const uint2*)(src + (size_t)lrow * DM + q * 256 + lane * 4); x[k][q] = make_float4(bf_lo(u.x), bf_hi(u.x), bf_lo(u.y), bf_hi(u.y)); }
            else x[k][q] = *(const float4*)(xr + q * 256 + lane * 4);
        }
    }
#pragma unroll
    for (int k = 0; k < 2; ++k) {
        const int lrow = lrow0 + k;
        const TokInfo ti = tokinfo(lay.tbase + lrow);
        float ss = 0.f;
#pragma unroll
        for (int q = 0; q < 4; ++q) ss += (x[k][q].x * x[k][q].x + x[k][q].y * x[k][q].y) + (x[k][q].z * x[k][q].z + x[k][q].w * x[k][q].w);
        ss = wave_sum(ss);
        const float rstd = rsqrtf(ss * (1.f / DM) + EPS);
        const float* md = modl + (size_t)ti.ci * 6144;
#pragma unroll
        for (int q = 0; q < 4; ++q) {
            const int c = q * 256 + lane * 4;
            const float4 gg = *(const float4*)(g + c), a = *(const float4*)(md + scoff + c), b = *(const float4*)(md + shoff + c);
            *(uint2*)(out + (size_t)lrow * DM + c) = pk4(x[k][q].x * rstd * gg.x * (1.f + a.x) + b.x, x[k][q].y * rstd * gg.y * (1.f + a.y) + b.y,
                                                         x[k][q].z * rstd * gg.z * (1.f + a.z) + b.z, x[k][q].w * rstd * gg.w * (1.f + a.w) + b.w);
        }
    }
}

struct ALoadBF {
    const bf16_t* A; int lda;
    __device__ __forceinline__ const bf16_t* ptr(int row, int k) const { return A + (size_t)row * lda + k; }
    __device__ __forceinline__ const char* ubase() const { return (const char*)A; }
    __device__ __forceinline__ unsigned boff(int row, int k) const { return (unsigned)(row * lda + k) * 2u; }
};
struct ALoadHalo {
    const bf16_t* A; int lda, base, row0, L; const bf16_t* zero;
    __device__ __forceinline__ const bf16_t* ptr(int r, int k) const {
        const int pos = row0 + r;
        if (pos < 0 || pos >= L) return zero;
        return A + (size_t)(base + pos) * lda + k;
    }
    __device__ __forceinline__ const char* ubase() const { return (const char*)zero; }
    __device__ __forceinline__ unsigned boff(int r, int k) const {
        const int pos = row0 + r;
        if (pos < 0 || pos >= L) return 0u;
        return (unsigned)((const char*)A - (const char*)zero) + (unsigned)((base + pos) * lda + k) * 2u;
    }
};
struct HaloTile { int seq, t0, L, row0, lo, hi; };
__device__ __forceinline__ HaloTile halo_tile(int g) {
    HaloTile h;
    if (g < 16) { h.seq = g; h.t0 = g * 256; h.L = 256; h.row0 = 0; h.lo = 0; h.hi = 256; }
    else { const int b = (g - 16) / 17, i = (g - 16) % 17; h.seq = 16 + b; h.t0 = 4096 + b * 4096; h.L = 4096; h.row0 = 254 * i - 1; h.lo = 1;
           const int last = 4096 - h.row0; h.hi = last < 255 ? last : 255; }
    return h;
}

template <int BM, int BN, int NT, class RowPtr>
__device__ __forceinline__ void store_transposed(const f32x4 (&acc)[4][4], int wr, int wc, int lane, char* lds, const RowPtr& rp) {
    constexpr int LDT = BM + 8;
    bf16_t* Lt = (bf16_t*)lds;
#pragma unroll
    for (int i = 0; i < 4; ++i)
#pragma unroll
        for (int j = 0; j < 4; ++j)
#pragma unroll
            for (int r = 0; r < 4; ++r)
                Lt[(wc * 64 + j * 16 + (lane >> 4) * 4 + r) * LDT + wr * 64 + i * 16 + (lane & 15)] = to_bf(acc[i][j][r]);
    __syncthreads();
    constexpr int CH = BN * (BM / 8) / NT;
#pragma unroll
    for (int k = 0; k < CH; ++k) {
        const int c = TIDX + k * NT, col = c / (BM / 8), kc = c % (BM / 8);
        *(uint4*)(rp(col) + kc * 8) = *(const uint4*)(Lt + col * LDT + kc * 8);
    }
    __syncthreads();
}

struct EpiIn0 {
    Lay lay; bf16_t *Qa, *Ka, *VtA, *tail; float *out_k, *out_v; const float *c64, *s64;
    template <int BM, int BN, int NT>
    __device__ __forceinline__ void run(f32x4 (&acc)[4][4], int m0, int n0, int wr, int wc, int lane, char* lds) const {
        const int nw = n0 + wc * 64, region = nw >> 9, cq = (lane >> 4) * 4;
        if (region <= 1) {
#pragma unroll
            for (int i = 0; i < 4; ++i) {
                const int lrow = m0 + wr * 64 + i * 16 + (lane & 15);
                const TokInfo ti = tokinfo(lay.tbase + lrow);
                if (ti.latent) {
#pragma unroll
                    for (int pg = 0; pg < 2; ++pg) {
                        const int val = pg ? (ti.pos & 63) : (ti.pos >> 6);
                        const float4 c4 = *(const float4*)(c64 + val * 16 + cq), s4 = *(const float4*)(s64 + val * 16 + cq);
                        const float cc[4] = {c4.x, c4.y, c4.z, c4.w}, sn[4] = {s4.x, s4.y, s4.z, s4.w};
#pragma unroll
                        for (int r = 0; r < 4; ++r) {
                            const float x1 = acc[i][2 * pg][r], x2 = acc[i][2 * pg + 1][r];
                            acc[i][2 * pg][r] = x1 * cc[r] - x2 * sn[r];
                            acc[i][2 * pg + 1][r] = x1 * sn[r] + x2 * cc[r];
                        }
                    }
                }
                bf16_t* dst = (region ? Ka : Qa) + (size_t)lrow * 512 + (nw & 511) + cq;
                const float qs = region ? 1.f : QSCALE_A;
#pragma unroll
                for (int j = 0; j < 4; ++j) *(uint2*)(dst + j * 16) = pk4(acc[i][j][0] * qs, acc[i][j][1] * qs, acc[i][j][2] * qs, acc[i][j][3] * qs);
                if (region == 1 && !ti.latent) {
                    float* ok = out_k + ((size_t)(ti.seq * 4 + ((nw - 512) >> 7)) * 256 + ti.pos) * 128 + ((nw - 512) & 127) + cq;
#pragma unroll
                    for (int j = 0; j < 4; ++j) *(float4*)(ok + j * 16) = make_float4(acc[i][j][0], acc[i][j][1], acc[i][j][2], acc[i][j][3]);
                }
            }
        } else if (region == 2) {
            const TokInfo t0 = tokinfo(lay.tbase + m0);
            if (!t0.latent) {
#pragma unroll
                for (int i = 0; i < 4; ++i) {
                    const int lrow = m0 + wr * 64 + i * 16 + (lane & 15);
                    const TokInfo ti = tokinfo(lay.tbase + lrow);
                    float* ov = out_v + ((size_t)(ti.seq * 4 + ((nw - 1024) >> 7)) * 256 + ti.pos) * 128 + ((nw - 1024) & 127) + cq;
#pragma unroll
                    for (int j = 0; j < 4; ++j) *(float4*)(ov + j * 16) = make_float4(acc[i][j][0], acc[i][j][1], acc[i][j][2], acc[i][j][3]);
                }
            }
            const int Lk = t0.latent ? VLD : 256, key0 = (t0.latent ? 512 : 0) + t0.pos;
            bf16_t* vb = VtA; const Lay l = lay; const int seq = t0.seq;
            store_transposed<BM, BN, NT>(acc, wr, wc, lane, lds, [=](int col) {
                const int c = n0 - 1024 + col;
                return vb + vt_off(l, seq, c >> 7) + (size_t)(c & 127) * Lk + key0;
            });
        } else {
#pragma unroll
            for (int i = 0; i < 4; ++i) {
                const int lrow = m0 + wr * 64 + i * 16 + (lane & 15);
                bf16_t* dst = tail + (size_t)lrow * 384 + (nw - 1536) + cq;
#pragma unroll
                for (int j = 0; j < 4; ++j) *(uint2*)(dst + j * 16) = pk4(acc[i][j][0], acc[i][j][1], acc[i][j][2], acc[i][j][3]);
            }
        }
    }
};

template <int NT>
__device__ __forceinline__ void n_l0_tail(const Lay lay, const bf16_t* __restrict__ tail, const float* __restrict__ q_norm, const float* __restrict__ kv_norm,
                          const float* __restrict__ cache_ckv, const float* __restrict__ cache_kpe, const float* c32, const float* s32,
                          bf16_t* __restrict__ qdn, bf16_t* __restrict__ ckvn, bf16_t* __restrict__ Kb, float* __restrict__ out_ckv, float* __restrict__ out_kpe,
                          int vb, float* lds) {
    const int lrow = vb * (NT / 256) + (TIDX >> 8), tid = TIDX & 255;
    if (lrow >= lay.Tloc) {
        const int cr = lrow - lay.Tloc, b = lay.b0 + (cr >> 9), p = cr & 511;
        if (tid < 128) ckvn[(size_t)lrow * 128 + tid] = to_bf(cache_ckv[((size_t)b * 512 + p) * 128 + tid]);
        else if (tid < 160) {
            const bf16_t v = to_bf(cache_kpe[((size_t)b * 512 + p) * 32 + (tid - 128)]);
#pragma unroll
            for (int h = 0; h < 4; ++h) Kb[(size_t)lrow * 384 + h * 96 + 64 + (tid - 128)] = v;
        }
        return;
    }
    const int t = lay.tbase + lrow;
    const TokInfo ti = tokinfo(t);
    const bf16_t* p = tail + (size_t)lrow * 384;
    {
        const float v = tid < 192 ? bf1(p[tid]) : 0.f;
        const float ss = group_sum256<NT>(v * v, lds);
        const float rstd = rsqrtf(ss * (1.f / 192.f) + EPS);
        if (tid < 192) qdn[(size_t)lrow * 192 + tid] = to_bf(v * rstd * q_norm[tid]);
    }
    {
        const float v = tid < 128 ? bf1(p[192 + tid]) : 0.f;
        const float ss = group_sum256<NT>(v * v, lds);
        const float rstd = rsqrtf(ss * (1.f / 128.f) + EPS);
        if (tid < 128) {
            const float val = v * rstd * kv_norm[tid];
            ckvn[(size_t)lrow * 128 + tid] = to_bf(val);
            if (!ti.latent) out_ckv[(size_t)t * 128 + tid] = val;
        }
    }
    if (tid < 32) {
        float val;
        if (ti.latent) {
            const int i = tid & 7, part = tid >> 3;
            const int vv = (part < 2) ? (ti.pos >> 6) : (ti.pos & 63);
            const float cs = c32[vv * 8 + i], sn = s32[vv * 8 + i];
            const int base = 320 + (part >> 1) * 16;
            const float x1 = bf1(p[base + i]), x2 = bf1(p[base + 8 + i]);
            val = (part & 1) ? (x1 * sn + x2 * cs) : (x1 * cs - x2 * sn);
        } else {
            val = bf1(p[320 + tid]);
            out_kpe[(size_t)t * 32 + tid] = val;
        }
        const bf16_t vb16 = to_bf(val);
#pragma unroll
        for (int h = 0; h < 4; ++h) Kb[(size_t)lrow * 384 + h * 96 + 64 + tid] = vb16;
    }
}

template <int NT>
__device__ __forceinline__ void n_l0_tail_w(const Lay lay, const bf16_t* __restrict__ tail, const float* __restrict__ q_norm, const float* __restrict__ kv_norm,
                          const float* __restrict__ cache_ckv, const float* __restrict__ cache_kpe, const float* c32, const float* s32,
                          bf16_t* __restrict__ qdn, bf16_t* __restrict__ ckvn, bf16_t* __restrict__ Kb, float* __restrict__ out_ckv, float* __restrict__ out_kpe, int vb) {
    const int lane = TIDX & 63, lrow = vb * (NT / 64) + (TIDX >> 6);
    if (lrow >= lay.Tloc) {
        const int cr = lrow - lay.Tloc, b = lay.b0 + (cr >> 9), p = cr & 511;
        const float2 c2 = *(const float2*)(cache_ckv + ((size_t)b * 512 + p) * 128 + lane * 2);
        *(unsigned*)(ckvn + (size_t)lrow * 128 + lane * 2) = pk_bf16(c2.x, c2.y);
        if (lane < 32) {
            const bf16_t v = to_bf(cache_kpe[((size_t)b * 512 + p) * 32 + lane]);
#pragma unroll
            for (int h = 0; h < 4; ++h) Kb[(size_t)lrow * 384 + h * 96 + 64 + lane] = v;
        }
        return;
    }
    const int t = lay.tbase + lrow;
    const TokInfo ti = tokinfo(t);
    const bf16_t* p = tail + (size_t)lrow * 384;
    {
        const float v0 = bf1(p[lane]), v1 = bf1(p[lane + 64]), v2 = bf1(p[lane + 128]);
        const float ss = wave_sum(v0 * v0 + v1 * v1 + v2 * v2);
        const float rstd = rsqrtf(ss * (1.f / 192.f) + EPS);
        bf16_t* q = qdn + (size_t)lrow * 192;
        q[lane] = to_bf(v0 * rstd * q_norm[lane]); q[lane + 64] = to_bf(v1 * rstd * q_norm[lane + 64]); q[lane + 128] = to_bf(v2 * rstd * q_norm[lane + 128]);
    }
    {
        const unsigned u = *(const unsigned*)(p + 192 + lane * 2);
        const float v0 = bf_lo(u), v1 = bf_hi(u);
        const float ss = wave_sum(v0 * v0 + v1 * v1);
        const float rstd = rsqrtf(ss * (1.f / 128.f) + EPS);
        const float2 kn = *(const float2*)(kv_norm + lane * 2);
        const float a = v0 * rstd * kn.x, b = v1 * rstd * kn.y;
        *(unsigned*)(ckvn + (size_t)lrow * 128 + lane * 2) = pk_bf16(a, b);
        if (!ti.latent) *(float2*)(out_ckv + (size_t)t * 128 + lane * 2) = make_float2(a, b);
    }
    if (lane < 32) {
        float val;
        if (ti.latent) {
            const int i = lane & 7, part = lane >> 3;
            const int vv = (part < 2) ? (ti.pos >> 6) : (ti.pos & 63);
            const float cs = c32[vv * 8 + i], sn = s32[vv * 8 + i];
            const int base = 320 + (part >> 1) * 16;
            const float x1 = bf1(p[base + i]), x2 = bf1(p[base + 8 + i]);
            val = (part & 1) ? (x1 * sn + x2 * cs) : (x1 * cs - x2 * sn);
        } else {
            val = bf1(p[320 + lane]);
            out_kpe[(size_t)t * 32 + lane] = val;
        }
        const bf16_t vb16 = to_bf(val);
#pragma unroll
        for (int h = 0; h < 4; ++h) Kb[(size_t)lrow * 384 + h * 96 + 64 + lane] = vb16;
    }
}

struct EpiQb {
    Lay lay; bf16_t* Qb; const float *c32, *s32;
    template <int BM, int BN, int NT>
    __device__ __forceinline__ void run(f32x4 (&acc)[4][4], int m0, int n0, int wr, int wc, int lane, char*) const {
        const int nw = n0 + wc * 64, cq = (lane >> 4) * 4;
#pragma unroll
        for (int i = 0; i < 4; ++i) {
            const int lrow = m0 + wr * 64 + i * 16 + (lane & 15);
            const TokInfo ti = tokinfo(lay.tbase + lrow);
#pragma unroll
            for (int j = 0; j < 4; ++j) {
                const int tix = ((nw >> 4) + j) % 6;
                if (tix >= 4) {
                    const int val = (tix == 4) ? (ti.pos >> 6) : (ti.pos & 63);
                    const int fo = ((lane >> 4) & 1) * 4;
                    const float4 c4 = *(const float4*)(c32 + val * 8 + fo), s4 = *(const float4*)(s32 + val * 8 + fo);
                    const float cc[4] = {c4.x, c4.y, c4.z, c4.w}, sn[4] = {s4.x, s4.y, s4.z, s4.w};
                    const bool isx2 = (lane >> 5) != 0;
#pragma unroll
                    for (int r = 0; r < 4; ++r) {
                        const float mine = acc[i][j][r], other = __shfl_xor(mine, 32);
                        const float rot = isx2 ? (other * sn[r] + mine * cc[r]) : (mine * cc[r] - other * sn[r]);
                        acc[i][j][r] = ti.latent ? rot : mine;
                    }
                }
                *(uint2*)(Qb + (size_t)lrow * 384 + nw + j * 16 + cq) = pk4(acc[i][j][0] * QSCALE_B, acc[i][j][1] * QSCALE_B, acc[i][j][2] * QSCALE_B, acc[i][j][3] * QSCALE_B);
            }
        }
    }
};
struct EpiKV {
    Lay lay; bf16_t *Kb, *VtB;
    template <int BM, int BN, int NT>
    __device__ __forceinline__ void run(f32x4 (&acc)[4][4], int m0, int n0, int wr, int wc, int lane, char* lds) const {
        const int nw = n0 + wc * 64, cq = (lane >> 4) * 4;
        if (n0 < 256) {
#pragma unroll
            for (int i = 0; i < 4; ++i) {
                const int lrow = m0 + wr * 64 + i * 16 + (lane & 15);
                bf16_t* dst = Kb + (size_t)lrow * 384 + (nw >> 6) * 96 + cq;
#pragma unroll
                for (int j = 0; j < 4; ++j) *(uint2*)(dst + j * 16) = pk4(acc[i][j][0], acc[i][j][1], acc[i][j][2], acc[i][j][3]);
            }
        } else {
            int seq, key0, Lk;
            if (m0 < lay.Tloc) { const TokInfo t0 = tokinfo(lay.tbase + m0); seq = t0.seq; Lk = t0.latent ? VLD : 256; key0 = (t0.latent ? 512 : 0) + t0.pos; }
            else { const int cr = m0 - lay.Tloc; seq = 16 + lay.b0 + (cr >> 9); Lk = VLD; key0 = cr & 511; }
            bf16_t* vb = VtB; const Lay l = lay;
            store_transposed<BM, BN, NT>(acc, wr, wc, lane, lds, [=](int col) {
                const int c = n0 - 256 + col;
                return vb + vt_off(l, seq, c >> 7) + (size_t)(c & 127) * Lk + key0;
            });
        }
    }
};

template <int NT>
__device__ __forceinline__ void n_combine0(const bf16_t* __restrict__ oa1, const bf16_t* __restrict__ oa2, const float* lq1, const float* lk1, const float* lq2, const float* lk2,
                           const float* __restrict__ subln, bf16_t* __restrict__ merged, int vb) {
    const int lrow = vb * (NT / 256) + (TIDX >> 8), tid = TIDX & 255, lane = tid & 63;
    const float la = wave_sum(lq1[lane] * lk1[lane]), lb = wave_sum(lq2[lane] * lk2[lane]);
    const float lam = expf(la) - expf(lb) + 0.2f;
    const unsigned u1 = *(const unsigned*)(oa1 + (size_t)lrow * 512 + tid * 2), u2 = *(const unsigned*)(oa2 + (size_t)lrow * 512 + tid * 2);
    const float x0 = bf_lo(u1) - lam * bf_lo(u2), x1 = bf_hi(u1) - lam * bf_hi(u2);
    const float ss = wave_sum(x0 * x0 + x1 * x1);
    const float rs = rsqrtf(ss * (1.f / 128.f) + EPS) * 0.8f;
    const int e = (tid * 2) & 127;
    *(unsigned*)(merged + (size_t)lrow * DM + tid * 2) = pk_bf16(x0 * rs * subln[e], x1 * rs * subln[e + 1]);
}

template <int NT, int R>
__device__ __forceinline__ void n_combine0_m(const bf16_t* __restrict__ oa1, const bf16_t* __restrict__ oa2, const float* lq1, const float* lk1, const float* lq2, const float* lk2,
                           const float* __restrict__ subln, bf16_t* __restrict__ merged, int vb) {
    const int lrow0 = vb * (NT / 256) * R + (TIDX >> 8), tid = TIDX & 255, lane = tid & 63;
    unsigned u1[R], u2[R];
#pragma unroll
    for (int k = 0; k < R; ++k) {
        const size_t lrow = (size_t)(lrow0 + k * (NT / 256));
        u1[k] = *(const unsigned*)(oa1 + lrow * 512 + tid * 2); u2[k] = *(const unsigned*)(oa2 + lrow * 512 + tid * 2);
    }
    const float la = wave_sum(lq1[lane] * lk1[lane]), lb = wave_sum(lq2[lane] * lk2[lane]);
    const float lam = expf(la) - expf(lb) + 0.2f;
    const int e = (tid * 2) & 127;
    const float s0 = subln[e], s1 = subln[e + 1];
#pragma unroll
    for (int k = 0; k < R; ++k) {
        const size_t lrow = (size_t)(lrow0 + k * (NT / 256));
        const float x0 = bf_lo(u1[k]) - lam * bf_lo(u2[k]), x1 = bf_hi(u1[k]) - lam * bf_hi(u2[k]);
        const float ss = wave_sum(x0 * x0 + x1 * x1);
        const float rs = rsqrtf(ss * (1.f / 128.f) + EPS) * 0.8f;
        *(unsigned*)(merged + lrow * DM + tid * 2) = pk_bf16(x0 * rs * s0, x1 * rs * s1);
    }
}

struct EpiResid {
    Lay lay; const float *xp, *xs; const bf16_t* src; bf16_t* h; const float* modl; int goff;
    template <int BM, int BN, int NT>
    __device__ __forceinline__ void run(f32x4 (&acc)[4][4], int m0, int n0, int wr, int wc, int lane, char* l) const { run<BM, BN, NT, 4>(acc, m0, n0, wr, wc, lane, l); }
    template <int BM, int BN, int NT, int NJ>
    __device__ __forceinline__ void run(f32x4 (&acc)[4][NJ], int m0, int n0, int wr, int wc, int lane, char*) const {
        const int nw = n0 + wc * (16 * NJ), cq = (lane >> 4) * 4;
#pragma unroll
        for (int i = 0; i < 4; ++i) {
            const int lrow = m0 + wr * 64 + i * 16 + (lane & 15), t = lay.tbase + lrow;
            const TokInfo ti = tokinfo(t);
            const float* xr = xrow(xp, xs, t);
            const float* gt = modl + (size_t)ti.ci * 6144 + goff;
#pragma unroll
            for (int j = 0; j < NJ; ++j) {
                const int col = nw + j * 16 + cq;
                float4 b4;
                if (src) { const uint2 u = *(const uint2*)(src + (size_t)lrow * DM + col); b4 = make_float4(bf_lo(u.x), bf_hi(u.x), bf_lo(u.y), bf_hi(u.y)); }
                else b4 = *(const float4*)(xr + col);
                const float4 g4 = *(const float4*)(gt + col);
                *(uint2*)(h + (size_t)lrow * DM + col) = pk4(b4.x + g4.x * acc[i][j][0], b4.y + g4.y * acc[i][j][1], b4.z + g4.z * acc[i][j][2], b4.w + g4.w * acc[i][j][3]);
            }
        }
    }
};

template <int MH = 128>
struct EpiResid256 {
    EpiResid e; int m0;
    template <int NT>
    __device__ __forceinline__ void run256(f32x4 (&acc)[2][2][MH / 32][2], int n0, int wr, int wc, int lane, char*) const {
        const int cq = (lane >> 4) * 4;
#pragma unroll
        for (int ai = 0; ai < 2; ++ai)
#pragma unroll
            for (int m = 0; m < MH / 32; ++m) {
                const int lrow = m0 + ai * MH + wr * (MH / 2) + m * 16 + (lane & 15), t = e.lay.tbase + lrow;
                const TokInfo ti = tokinfo(t);
                const float* xr = xrow(e.xp, e.xs, t);
                const float* gt = e.modl + (size_t)ti.ci * 6144 + e.goff;
#pragma unroll
                for (int bj = 0; bj < 2; ++bj)
#pragma unroll
                    for (int n = 0; n < 2; ++n) {
                        const int col = n0 + bj * 128 + wc * 32 + n * 16 + cq;
                        float4 b4;
                        if (e.src) { const uint2 u = *(const uint2*)(e.src + (size_t)lrow * DM + col); b4 = make_float4(bf_lo(u.x), bf_hi(u.x), bf_lo(u.y), bf_hi(u.y)); }
                        else b4 = *(const float4*)(xr + col);
                        const float4 g4 = *(const float4*)(gt + col);
                        *(uint2*)(e.h + (size_t)lrow * DM + col) = pk4(b4.x + g4.x * acc[ai][bj][m][n][0], b4.y + g4.y * acc[ai][bj][m][n][1],
                                                                       b4.z + g4.z * acc[ai][bj][m][n][2], b4.w + g4.w * acc[ai][bj][m][n][3]);
                    }
            }
    }
};

struct EpiFFNUp {
    Lay lay; HaloTile ht; const float* cw; const float* cb; bf16_t* act;
    struct CW { float2 wg0, wg1, wg2, bg, wv0, wv1, wv2, bv; };
    template <int NT>
    __device__ __forceinline__ CW conv_w(int t128) const {
        constexpr int GH = 64, NP = GH / 2;
        const int fg = t128 * GH + 2 * (TIDX % NP);
        CW w;
        w.wg0 = *(const float2*)(cw + fg); w.wg1 = *(const float2*)(cw + FF2 + fg); w.wg2 = *(const float2*)(cw + 2 * FF2 + fg); w.bg = *(const float2*)(cb + fg);
        w.wv0 = *(const float2*)(cw + FF + fg); w.wv1 = *(const float2*)(cw + FF2 + FF + fg); w.wv2 = *(const float2*)(cw + 2 * FF2 + FF + fg); w.bv = *(const float2*)(cb + FF + fg);
        return w;
    }
    template <int NT>
    __device__ __forceinline__ void conv(const float* U, int t128, const CW& w) const {
        constexpr int BM = 256, GH = 64, LDU = 132, NP = GH / 2, NG = NT / NP, RPG = BM / NG;
        const int tid = TIDX, fp = tid % NP, grp = tid / NP, fg = t128 * GH + 2 * fp;
        const float2 wg0 = w.wg0, wg1 = w.wg1, wg2 = w.wg2, bg = w.bg, wv0 = w.wv0, wv1 = w.wv1, wv2 = w.wv2, bv = w.bv;
        const int r0 = grp * RPG;
        const float* Ug = U + 2 * fp;
        const float2 z2 = make_float2(0.f, 0.f);
        float2 gq[RPG + 2], vq[RPG + 2];
        {
            const int rm = r0 > 0 ? r0 - 1 : 0, rp = r0 + RPG < BM ? r0 + RPG : BM - 1;
            gq[0] = *(const float2*)(Ug + rm * LDU); vq[0] = *(const float2*)(Ug + rm * LDU + GH);
#pragma unroll
            for (int k = 0; k < RPG; ++k) { gq[k + 1] = *(const float2*)(Ug + (r0 + k) * LDU); vq[k + 1] = *(const float2*)(Ug + (r0 + k) * LDU + GH); }
            gq[RPG + 1] = *(const float2*)(Ug + rp * LDU); vq[RPG + 1] = *(const float2*)(Ug + rp * LDU + GH);
            if (r0 == 0) { gq[0] = z2; vq[0] = z2; }
            if (r0 + RPG == BM) { gq[RPG + 1] = z2; vq[RPG + 1] = z2; }
        }
        bf16_t* ap = act + (size_t)(ht.t0 + ht.row0 + r0 - lay.tbase) * FF + fg;
#pragma unroll
        for (int k = 0; k < RPG; ++k) {
            const int r = r0 + k;
            if (r >= ht.lo && r < ht.hi) {
                const float2 gp = gq[k], gc = gq[k + 1], gn = gq[k + 2], vp = vq[k], vc = vq[k + 1], vn = vq[k + 2];
                const float ga = wg0.x * gp.x + wg1.x * gc.x + wg2.x * gn.x + bg.x, gb = wg0.y * gp.y + wg1.y * gc.y + wg2.y * gn.y + bg.y;
                const float va = wv0.x * vp.x + wv1.x * vc.x + wv2.x * vn.x + bv.x, vb = wv0.y * vp.y + wv1.y * vc.y + wv2.y * vn.y + bv.y;
                *(unsigned*)(ap + (size_t)k * FF) = pk_bf16(ga * __builtin_amdgcn_rcpf(1.f + __expf(-ga)) * va, gb * __builtin_amdgcn_rcpf(1.f + __expf(-gb)) * vb);
            }
        }
    }
    template <int BM, int BN, int NT>
    __device__ __forceinline__ void run(f32x4 (&acc)[4][4], int m0, int n0, int wr, int wc, int lane, char* lds) const {
        static_assert(BM == 256 && BN == 128, "tile");
        constexpr int LDU = BN + 4;
        float* U = (float*)lds;
        const CW w = conv_w<NT>(n0 / BN);
#pragma unroll
        for (int i = 0; i < 4; ++i)
#pragma unroll
            for (int j = 0; j < 4; ++j)
                *(f32x4*)(U + (wr * 64 + i * 16 + (lane & 15)) * LDU + wc * 64 + j * 16 + (lane >> 4) * 4) = acc[i][j];
        __syncthreads();
        conv<NT>(U, n0 / BN, w);
        __syncthreads();
    }
    template <int NT>
    __device__ __forceinline__ void run256(f32x4 (&acc)[2][2][4][2], int n0, int wr, int wc, int lane, char* lds) const {
        constexpr int LDU = 132;
        float* U = (float*)lds;
        const CW w0 = conv_w<NT>(n0 / 128), w1 = conv_w<NT>(n0 / 128 + 1);
#pragma unroll
        for (int bj = 0; bj < 2; ++bj) {
#pragma unroll
            for (int ai = 0; ai < 2; ++ai)
#pragma unroll
                for (int m = 0; m < 4; ++m)
#pragma unroll
                    for (int n = 0; n < 2; ++n)
                        *(f32x4*)(U + (ai * 128 + wr * 64 + m * 16 + (lane & 15)) * LDU + wc * 32 + n * 16 + (lane >> 4) * 4) = acc[ai][bj][m][n];
            __syncthreads();
            conv<NT>(U, n0 / 128 + bj, bj == 0 ? w0 : w1);
            __syncthreads();
        }
    }
};


template <int CTRL> __device__ __forceinline__ float dppf(float x) {
    return __builtin_bit_cast(float, __builtin_amdgcn_mov_dpp(__builtin_bit_cast(int, x), CTRL, 0xF, 0xF, true));
}
__device__ __forceinline__ float sfma(float a, float b, float c) { float d; asm("v_fma_f32 %0, %1, %2, %3" : "=v"(d) : "v"(a), "v"(b), "v"(c)); return d; }
__device__ __forceinline__ float smul(float a, float b) { float d; asm("v_mul_f32 %0, %1, %2" : "=v"(d) : "v"(a), "v"(b)); return d; }
__device__ __forceinline__ float sadd(float a, float b) { float d; asm("v_add_f32 %0, %1, %2" : "=v"(d) : "v"(a), "v"(b)); return d; }
__device__ __forceinline__ float red8(float x) { x += dppf<0xB1>(x); x += dppf<0x4E>(x); x += dppf<0x141>(x); return x; }
__device__ __forceinline__ float red16(float x) { x = red8(x); x += dppf<0x140>(x); return x; }
__device__ __forceinline__ float fsigmoid(float x) { return __builtin_amdgcn_rcpf(1.f + __expf(-x)); }
__device__ __forceinline__ float ftanh(float x) { return 1.f - 2.f * __builtin_amdgcn_rcpf(1.f + __expf(2.f * x)); }
__device__ __forceinline__ void unpack8(const uint4 u, float (&f)[8]) {
    f[0] = bf_lo(u.x); f[1] = bf_hi(u.x); f[2] = bf_lo(u.y); f[3] = bf_hi(u.y); f[4] = bf_lo(u.z); f[5] = bf_hi(u.z); f[6] = bf_lo(u.w); f[7] = bf_hi(u.w);
}

struct EpiIn1 {
    Lay lay; HaloTile ht; const float *mu, *conv_w, *conv_b; bf16_t *zcm, *zg, *xc; float* dtr;
    struct SW { float2 k0, k1, k2, kb; };
    template <int NT>
    __device__ __forceinline__ SW staged_w(int nt) const {
        constexpr int BN = 128, NP = BN / 2;
        const bool mix = nt < 15;
        const int c = (mix ? nt * BN : nt * BN - 2432) + 2 * (TIDX % NP);
        const float2 z2 = make_float2(0.f, 0.f);
        SW w;
        w.k0 = mix ? z2 : *(const float2*)(conv_w + c); w.k1 = mix ? *(const float2*)(mu + c) : *(const float2*)(conv_w + 768 + c);
        w.k2 = mix ? z2 : *(const float2*)(conv_w + 2 * 768 + c); w.kb = mix ? z2 : *(const float2*)(conv_b + c);
        return w;
    }
    template <int NT>
    __device__ __forceinline__ void staged(const float* U, int nt, const SW& w) const {
        constexpr int BM = 256, BN = 128, LDU = BN + 4, NP = BN / 2, NG = NT / NP, RPG = BM / NG;
        const int n0 = nt * BN;
        const int tid = TIDX, fp = tid % NP, grp = tid / NP, r0 = grp * RPG;
        const bool mix = nt < 15;
        const int c = (mix ? n0 : n0 - 2432) + 2 * fp;
        const float2 z2 = make_float2(0.f, 0.f);
        const float2 k0 = w.k0, k1 = w.k1, k2 = w.k2, kb = w.kb;
        const float* Uc = U + 2 * fp;
        float2 xq[RPG + 2];
        {
            const int rm = r0 > 0 ? r0 - 1 : 0, rp = r0 + RPG < BM ? r0 + RPG : BM - 1;
            xq[0] = *(const float2*)(Uc + rm * LDU);
#pragma unroll
            for (int k = 0; k < RPG; ++k) xq[k + 1] = *(const float2*)(Uc + (r0 + k) * LDU);
            xq[RPG + 1] = *(const float2*)(Uc + rp * LDU);
            if (r0 == 0) xq[0] = z2;
            if (r0 + RPG == BM) xq[RPG + 1] = z2;
        }
        const size_t lrow0 = (size_t)(ht.t0 + ht.row0 + r0 - lay.tbase);
        const int ostr = mix ? CC : 768;
        bf16_t* op = zcm + ((mix ? (ptrdiff_t)0 : xc - zcm) + (ptrdiff_t)lrow0 * ostr + c);
#pragma unroll
        for (int k = 0; k < RPG; ++k) {
            const int r = r0 + k;
            if (r >= ht.lo && r < ht.hi) {
                const float2 xp = xq[k], xv = xq[k + 1], xn = xq[k + 2];
                float oa, ob;
                if (mix) { oa = xv.x + k1.x * (0.5f * (xp.x + xn.x) - xv.x); ob = xv.y + k1.y * (0.5f * (xp.y + xn.y) - xv.y); }
                else {
                    const float sa = k0.x * xp.x + k1.x * xv.x + k2.x * xn.x + kb.x, sb = k0.y * xp.y + k1.y * xv.y + k2.y * xn.y + kb.y;
                    oa = sa * __builtin_amdgcn_rcpf(1.f + __expf(-sa)); ob = sb * __builtin_amdgcn_rcpf(1.f + __expf(-sb));
                }
                *(unsigned*)(op + (size_t)k * ostr) = pk_bf16(oa, ob);
            }
        }
    }
    template <int BM, int BN, int NT>
    __device__ __forceinline__ void run(f32x4 (&acc)[4][4], int m0, int n0, int wr, int wc, int lane, char* lds) const {
        static_assert(BN == 128 && BM == 256, "tile");
        const int nt = n0 / BN, cq = (lane >> 4) * 4;
        if (nt >= 15 && nt < 19) {
#pragma unroll
            for (int i = 0; i < 4; ++i) {
                const int r = wr * 64 + i * 16 + (lane & 15);
                if (r >= ht.lo && r < ht.hi) {
                    bf16_t* dst = zg + (size_t)(ht.t0 + ht.row0 + r - lay.tbase) * 512 + (n0 - 1920) + wc * 64 + cq;
#pragma unroll
                    for (int j = 0; j < 4; ++j) *(uint2*)(dst + j * 16) = pk4(acc[i][j][0], acc[i][j][1], acc[i][j][2], acc[i][j][3]);
                }
            }
            return;
        }
        if (nt == 25) {
            if (wc == 0 && lane < 32) {
#pragma unroll
                for (int i = 0; i < 4; ++i) {
                    const int r = wr * 64 + i * 16 + (lane & 15);
                    if (r >= ht.lo && r < ht.hi)
                        *(float4*)(dtr + (size_t)(ht.t0 + ht.row0 + r - lay.tbase) * 8 + cq) = make_float4(acc[i][0][0], acc[i][0][1], acc[i][0][2], acc[i][0][3]);
                }
            }
            return;
        }
        constexpr int LDU = BN + 4;
        float* U = (float*)lds;
        const SW w = staged_w<NT>(nt);
#pragma unroll
        for (int i = 0; i < 4; ++i)
#pragma unroll
            for (int j = 0; j < 4; ++j)
                *(f32x4*)(U + (wr * 64 + i * 16 + (lane & 15)) * LDU + wc * 64 + j * 16 + cq) = acc[i][j];
        __syncthreads();
        staged<NT>(U, nt, w);
        __syncthreads();
    }
    template <int NT>
    __device__ __forceinline__ void run256(f32x4 (&acc)[2][2][4][2], int n0, int wr, int wc, int lane, char* lds) const {
        constexpr int LDU = 132;
        const int cq = (lane >> 4) * 4;
        float* U = (float*)lds;
#pragma unroll
        for (int bj = 0; bj < 2; ++bj) {
            const int nt = n0 / 128 + bj;
            if (nt >= 15 && nt < 19) {
#pragma unroll
                for (int ai = 0; ai < 2; ++ai)
#pragma unroll
                    for (int m = 0; m < 4; ++m) {
                        const int r = ai * 128 + wr * 64 + m * 16 + (lane & 15);
                        if (r >= ht.lo && r < ht.hi) {
                            bf16_t* dst = zg + (size_t)(ht.t0 + ht.row0 + r - lay.tbase) * 512 + (nt * 128 - 1920) + wc * 32 + cq;
#pragma unroll
                            for (int n = 0; n < 2; ++n) *(uint2*)(dst + n * 16) = pk4(acc[ai][bj][m][n][0], acc[ai][bj][m][n][1], acc[ai][bj][m][n][2], acc[ai][bj][m][n][3]);
                        }
                    }
            } else if (nt == 25) {
                if (wc == 0 && lane < 32) {
#pragma unroll
                    for (int ai = 0; ai < 2; ++ai)
#pragma unroll
                        for (int m = 0; m < 4; ++m) {
                            const int r = ai * 128 + wr * 64 + m * 16 + (lane & 15);
                            if (r >= ht.lo && r < ht.hi)
                                *(float4*)(dtr + (size_t)(ht.t0 + ht.row0 + r - lay.tbase) * 8 + cq) =
                                    make_float4(acc[ai][bj][m][0][0], acc[ai][bj][m][0][1], acc[ai][bj][m][0][2], acc[ai][bj][m][0][3]);
                        }
                }
            } else {
                const SW w = staged_w<NT>(nt);
#pragma unroll
                for (int ai = 0; ai < 2; ++ai)
#pragma unroll
                    for (int m = 0; m < 4; ++m)
#pragma unroll
                        for (int n = 0; n < 2; ++n)
                            *(f32x4*)(U + (ai * 128 + wr * 64 + m * 16 + (lane & 15)) * LDU + wc * 32 + n * 16 + cq) = acc[ai][bj][m][n];
                __syncthreads();
                staged<NT>(U, nt, w);
                __syncthreads();
            }
        }
    }
};


template <int KS, bool TRANS>
__device__ __forceinline__ f32x4 mm_tile(const bf16_t* A, int lda, const bf16_t* Bt, int ldb, f32x4 acc, int lane) {
#pragma unroll
    for (int ks = 0; ks < KS; ++ks) {
        const bf16x8 a = *(const bf16x8*)(A + (lane & 15) * lda + ks * 32 + (lane >> 4) * 8);
        const bf16x8 b = *(const bf16x8*)(Bt + (lane & 15) * ldb + ks * 32 + (lane >> 4) * 8);
        acc = TRANS ? __builtin_amdgcn_mfma_f32_16x16x32_bf16(b, a, acc, 0, 0, 0) : __builtin_amdgcn_mfma_f32_16x16x32_bf16(a, b, acc, 0, 0, 0);
    }
    return acc;
}
typedef __attribute__((ext_vector_type(2))) unsigned u32x2;
__device__ __forceinline__ bf16x8 ld_row(const bf16_t* A, int lda, int lane) { return *(const bf16x8*)(A + (lane & 15) * lda + (lane >> 4) * 8); }
__device__ __forceinline__ bf16x8 ld_row16(const bf16_t* A, int lane) {
    bf16x8 a = *(const bf16x8*)(A + (lane & 15) * 24 + ((lane >> 4) & 1) * 8);
    if (lane >= 32) a = (bf16x8){0, 0, 0, 0, 0, 0, 0, 0};
    return a;
}
template <bool K16>
__device__ __forceinline__ bf16x8 ld_tr(const bf16_t* X, int ld, int lane) {
    const int g = K16 ? ((lane >> 4) & 1) : (lane >> 4), q = (lane & 15) >> 2, p = lane & 3;
    const unsigned a0 = (unsigned)(size_t)(X + (8 * g + q) * ld + 4 * p), a1 = a0 + 8u * (unsigned)ld;
    u32x2 r0, r1;
    asm volatile("ds_read_b64_tr_b16 %0, %2\n\tds_read_b64_tr_b16 %1, %3\n\ts_waitcnt lgkmcnt(0)" : "=&v"(r0), "=&v"(r1) : "v"(a0), "v"(a1) : "memory");
    u32x4 v = {r0.x, r0.y, r1.x, r1.y};
    if (K16 && lane >= 32) v = (u32x4){0u, 0u, 0u, 0u};
    return __builtin_bit_cast(bf16x8, v);
}
template <bool K16>
__device__ __forceinline__ void ld_tr2(const bf16_t* X0, const bf16_t* X1, int ld, int lane, bf16x8& o0, bf16x8& o1) {
    const int g = K16 ? ((lane >> 4) & 1) : (lane >> 4), q = (lane & 15) >> 2, p = lane & 3;
    const unsigned off = (unsigned)(((8 * g + q) * ld + 4 * p) * 2), st = 8u * (unsigned)ld;
    const unsigned a0 = (unsigned)(size_t)X0 + off, a1 = (unsigned)(size_t)X1 + off;
    u32x2 r0, r1, r2, r3;
    asm volatile("ds_read_b64_tr_b16 %0, %4\n\tds_read_b64_tr_b16 %1, %5\n\tds_read_b64_tr_b16 %2, %6\n\tds_read_b64_tr_b16 %3, %7\n\ts_waitcnt lgkmcnt(0)"
                 : "=&v"(r0), "=&v"(r1), "=&v"(r2), "=&v"(r3) : "v"(a0), "v"(a0 + st), "v"(a1), "v"(a1 + st) : "memory");
    u32x4 v0 = {r0.x, r0.y, r1.x, r1.y}, v1 = {r2.x, r2.y, r3.x, r3.y};
    if (K16 && lane >= 32) { v0 = (u32x4){0u, 0u, 0u, 0u}; v1 = v0; }
    o0 = __builtin_bit_cast(bf16x8, v0); o1 = __builtin_bit_cast(bf16x8, v1);
}
template <bool K16>
__device__ __forceinline__ void ld_tr4(const bf16_t* X0, const bf16_t* X1, const bf16_t* X2, const bf16_t* X3, int ld, int lane, bf16x8& o0, bf16x8& o1, bf16x8& o2, bf16x8& o3) {
    const int g = K16 ? ((lane >> 4) & 1) : (lane >> 4), q = (lane & 15) >> 2, p = lane & 3;
    const unsigned off = (unsigned)(((8 * g + q) * ld + 4 * p) * 2), st = 8u * (unsigned)ld;
    const unsigned a0 = (unsigned)(size_t)X0 + off, a1 = (unsigned)(size_t)X1 + off, a2 = (unsigned)(size_t)X2 + off, a3 = (unsigned)(size_t)X3 + off;
    u32x2 r0, r1, r2, r3, r4, r5, r6, r7;
    asm volatile("ds_read_b64_tr_b16 %0, %8\n\tds_read_b64_tr_b16 %1, %9\n\tds_read_b64_tr_b16 %2, %10\n\tds_read_b64_tr_b16 %3, %11\n\t"
                 "ds_read_b64_tr_b16 %4, %12\n\tds_read_b64_tr_b16 %5, %13\n\tds_read_b64_tr_b16 %6, %14\n\tds_read_b64_tr_b16 %7, %15\n\ts_waitcnt lgkmcnt(0)"
                 : "=&v"(r0), "=&v"(r1), "=&v"(r2), "=&v"(r3), "=&v"(r4), "=&v"(r5), "=&v"(r6), "=&v"(r7)
                 : "v"(a0), "v"(a0 + st), "v"(a1), "v"(a1 + st), "v"(a2), "v"(a2 + st), "v"(a3), "v"(a3 + st) : "memory");
    u32x4 v0 = {r0.x, r0.y, r1.x, r1.y}, v1 = {r2.x, r2.y, r3.x, r3.y}, v2 = {r4.x, r4.y, r5.x, r5.y}, v3 = {r6.x, r6.y, r7.x, r7.y};
    if (K16 && lane >= 32) { v0 = (u32x4){0u, 0u, 0u, 0u}; v1 = v0; v2 = v0; v3 = v0; }
    o0 = __builtin_bit_cast(bf16x8, v0); o1 = __builtin_bit_cast(bf16x8, v1); o2 = __builtin_bit_cast(bf16x8, v2); o3 = __builtin_bit_cast(bf16x8, v3);
}
template <bool TRANS>
__device__ __forceinline__ f32x4 mma(const bf16x8 a, const bf16x8 b, const f32x4 acc) {
    return TRANS ? __builtin_amdgcn_mfma_f32_16x16x32_bf16(b, a, acc, 0, 0, 0) : __builtin_amdgcn_mfma_f32_16x16x32_bf16(a, b, acc, 0, 0, 0);
}

template <int NT>
__device__ __forceinline__ void n_ssd2(const Lay lay, const bf16_t* __restrict__ xc, const float* __restrict__ dtr, const float* __restrict__ A_log, const float* __restrict__ dt_bias,
                                       const float* __restrict__ Dp, const float* __restrict__ H0f, const float* __restrict__ H0b, bf16_t* __restrict__ yd,
                                       float* __restrict__ Hf_out, float* __restrict__ Hb_out, int item, char* lds,
                                       const int c0, const int c1, const float* __restrict__ Hinit, float* __restrict__ Hend) {
    static_assert(NT == 512, "n_ssd2 needs 8 waves");
    const int tid = TIDX, lane = tid & 63, wv = tid >> 6;
    const int dir = item & 1, h = (item >> 1) & 7, seq = lay.seqbase + (item >> 4), g = h >> 2;
    const bool latent = seq >= 16;
    const int L = latent ? 4096 : 256, row0 = (latent ? 4096 + (seq - 16) * 4096 : seq * 256) - lay.tbase;
    bf16_t* Cs = (bf16_t*)lds; bf16_t* Bs = Cs + 4608; bf16_t* Cd = Bs + 4608; bf16_t* Sc = Cd + 4608; bf16_t* Xs = Sc + 4608; bf16_t* Xd = Xs + 4608;
    bf16_t* Sb0 = Xd + 4608; bf16_t* Sb1 = Sb0 + 4608;
    float* acum = (float*)(Sb1 + 4608); float* dts = acum + 64;
    const int pt = tid >> 3, part = tid & 7;
    const int tT = wv >> 1, q0 = (wv & 1) * 2;
    const float A = -__expf(A_log[dir * 8 + h]), Dv = Dp[dir * 8 + h], dtb = dt_bias[dir * 8 + h];
    f32x4 S[2];
    __syncthreads();
    {
        const float* H0 = dir ? H0b : H0f;
#pragma unroll
        for (int q = 0; q < 2; ++q)
#pragma unroll
            for (int r = 0; r < 4; ++r) {
                const int p = tT * 16 + (lane >> 4) * 4 + r, n = (q0 + q) * 16 + (lane & 15);
                const float v = Hinit ? Hinit[p * 64 + n] : (latent ? H0[((size_t)((seq - 16) * 8 + h) * 64 + p) * 64 + n] : 0.f);
                S[q][r] = v; Sb0[p * 72 + n] = to_bf(v);
            }
    }
    uint4 g_b, g_c, g_x; float g_dt = 0.f;
#define SSD2_LOAD(cidx) { const int s_ = (cidx) * 64 + pt; const int pos_ = dir ? (L - 1 - s_) : s_; \
        const bf16_t* xr_ = xc + (size_t)(row0 + pos_) * 768; \
        g_b = *(const uint4*)(xr_ + 512 + g * 64 + part * 8); g_c = *(const uint4*)(xr_ + 640 + g * 64 + part * 8); g_x = *(const uint4*)(xr_ + h * 64 + part * 8); \
        if (part == 0) g_dt = dtr[(size_t)(row0 + pos_) * 8 + h]; }
    SSD2_LOAD(c0)
    int cur = 0;
    for (int c = c0; c < c1; ++c) {
        bf16_t* Sbc = cur ? Sb1 : Sb0; bf16_t* Sbn = cur ? Sb0 : Sb1;
        float fc[8], fx[8];
        {
            unpack8(g_c, fc); unpack8(g_x, fx);
            *(uint4*)(Cs + pt * 72 + part * 8) = g_c;
            *(uint4*)(Bs + pt * 72 + part * 8) = g_b;
            *(uint4*)(Xs + pt * 72 + part * 8) = g_x;
            if (part == 0) {
                const float xx = g_dt + dtb;
                const float dt = fmaxf(xx, 0.f) + __logf(1.f + __expf(-fabsf(xx)));
                dts[pt] = dt; acum[pt] = dt * A;
            }
        }
        if (c + 1 < c1) SSD2_LOAD(c + 1)
        __syncthreads();
        if (wv == 0) {
            float v = acum[lane];
#pragma unroll
            for (int o = 1; o < 64; o <<= 1) { const float u = __shfl_up(v, o); if (lane >= o) v += u; }
            acum[lane] = v;
        }
        __syncthreads();
        {
            const float ac = acum[pt], et = __expf(ac), sc = dts[pt] * __expf(acum[63] - ac);
            *(uint4*)(Cd + pt * 72 + part * 8) = make_uint4(pk_bf16(fc[0] * et, fc[1] * et), pk_bf16(fc[2] * et, fc[3] * et), pk_bf16(fc[4] * et, fc[5] * et), pk_bf16(fc[6] * et, fc[7] * et));
            *(uint4*)(Xd + pt * 72 + part * 8) = make_uint4(pk_bf16(fx[0] * sc, fx[1] * sc), pk_bf16(fx[2] * sc, fx[3] * sc), pk_bf16(fx[4] * sc, fx[5] * sc), pk_bf16(fx[6] * sc, fx[7] * sc));
        }
        __syncthreads();
        {
#pragma unroll
            for (int q = 0; q < 2; ++q) {
                f32x4 acc = mm_tile<2, false>(Cs + tT * 16 * 72, 72, Bs + (q0 + q) * 16 * 72, 72, (f32x4){0.f, 0.f, 0.f, 0.f}, lane);
                const int j = (q0 + q) * 16 + (lane & 15);
                const float aj = acum[j], dj = dts[j];
#pragma unroll
                for (int r = 0; r < 4; ++r) {
                    const int t = tT * 16 + (lane >> 4) * 4 + r;
                    Sc[t * 72 + j] = to_bf(j <= t ? acc[r] * __expf(acum[t] - aj) * dj : 0.f);
                }
            }
        }
        __syncthreads();
        {
#pragma unroll
            for (int q = 0; q < 2; ++q) {
                f32x4 acc = (f32x4){0.f, 0.f, 0.f, 0.f};
                bf16x8 x0, x1;
                ld_tr2<false>(Xs + (q0 + q) * 16, Xs + 32 * 72 + (q0 + q) * 16, 72, lane, x0, x1);
                acc = mma<true>(ld_row(Sc + tT * 16 * 72, 72, lane), x0, acc);
                acc = mma<true>(ld_row(Sc + tT * 16 * 72 + 32, 72, lane), x1, acc);
                acc = mm_tile<2, true>(Cd + tT * 16 * 72, 72, Sbc + (q0 + q) * 16 * 72, 72, acc, lane);
                const int t = tT * 16 + (lane & 15), p = (q0 + q) * 16 + (lane >> 4) * 4;
                const int s = c * 64 + t, pos = dir ? (L - 1 - s) : s;
                const uint2 ux = *(const uint2*)(xc + (size_t)(row0 + pos) * 768 + h * 64 + p);
                *(uint2*)(yd + ((size_t)dir * lay.Tloc + row0 + pos) * 512 + h * 64 + p) =
                    pk4(acc[0] + Dv * bf_lo(ux.x), acc[1] + Dv * bf_hi(ux.x), acc[2] + Dv * bf_lo(ux.y), acc[3] + Dv * bf_hi(ux.y));
            }
            const float eC = __expf(acum[63]);
            bf16x8 xd0, xd1, bb00, bb01, bb10, bb11;
            ld_tr2<false>(Xd + tT * 16, Xd + 32 * 72 + tT * 16, 72, lane, xd0, xd1);
            ld_tr4<false>(Bs + q0 * 16, Bs + (q0 + 1) * 16, Bs + 32 * 72 + q0 * 16, Bs + 32 * 72 + (q0 + 1) * 16, 72, lane, bb00, bb01, bb10, bb11);
#pragma unroll
            for (int q = 0; q < 2; ++q) {
                S[q] = S[q] * eC;
                S[q] = mma<false>(xd0, q ? bb01 : bb00, S[q]);
                S[q] = mma<false>(xd1, q ? bb11 : bb10, S[q]);
#pragma unroll
                for (int r = 0; r < 4; ++r) Sbn[(tT * 16 + (lane >> 4) * 4 + r) * 72 + (q0 + q) * 16 + (lane & 15)] = to_bf(S[q][r]);
            }
        }
        __syncthreads();
        cur ^= 1;
    }
    float* Ho = dir ? Hb_out : Hf_out;
    if (!latent) {
#pragma unroll
        for (int q = 0; q < 2; ++q)
#pragma unroll
            for (int r = 0; r < 4; ++r) Ho[((size_t)(seq * 8 + h) * 64 + tT * 16 + (lane >> 4) * 4 + r) * 64 + (q0 + q) * 16 + (lane & 15)] = S[q][r];
    }
    if (Hend) {
#pragma unroll
        for (int q = 0; q < 2; ++q)
#pragma unroll
            for (int r = 0; r < 4; ++r) Hend[(tT * 16 + (lane >> 4) * 4 + r) * 64 + (q0 + q) * 16 + (lane & 15)] = S[q][r];
    }
#undef SSD2_LOAD
}

template <int NT>
__device__ __forceinline__ void n_wkv2(const Lay lay, const bf16_t* __restrict__ zcm, const bf16_t* __restrict__ w2t, const bf16_t* __restrict__ a2t,
                                       const float* __restrict__ w0, const float* __restrict__ a0, const float* __restrict__ k_k, const float* __restrict__ k_a,
                                       const float* __restrict__ S0f, const float* __restrict__ S0b, bf16_t* __restrict__ y,
                                       float* __restrict__ Sf_out, float* __restrict__ Sb_out, int item, char* lds) {
    static_assert(NT == 512, "n_wkv2 needs 8 waves");
    const int tid = TIDX, lane = tid & 63, wv = tid >> 6;
    const int dir = item & 1, h = (item >> 1) & 7, seq = lay.seqbase + (item >> 4);
    const bool latent = seq >= 16;
    const int L = latent ? 4096 : 256, row0 = (latent ? 4096 + (seq - 16) * 4096 : seq * 256) - lay.tbase;
    bf16_t* W2s = (bf16_t*)lds; bf16_t* A2s = W2s + 4608; bf16_t* Sb0 = A2s + 4608; bf16_t* Sb1 = Sb0 + 4608;
    bf16_t* KR = Sb1 + 4608; bf16_t* RR = KR + 2304;
    constexpr int LG = 68;
    float* AA = (float*)(RR + 2304); float* GG = AA + 32 * LG; float* rsv = GG + 32 * LG; float* gC = rsv + 32;
    bf16_t* X1 = (bf16_t*)(gC + 128); bf16_t* X2 = X1 + 2304;
    bf16_t* OPS = X2 + 2304;
    constexpr int OPS_SC = 7 * 1152;
    bf16_t* TMP = OPS + 2 * OPS_SC;
    constexpr int TMP_SC = 512 + 4 * 384 + 1152 + 1152;
    bf16_t* Us = TMP + 2 * TMP_SC;
    __syncthreads();
    {
        const int c = tid >> 3, part = tid & 7;
        *(uint4*)(W2s + c * 72 + part * 8) = *(const uint4*)(w2t + ((size_t)dir * 512 + h * 64 + c) * 64 + part * 8);
        *(uint4*)(A2s + c * 72 + part * 8) = *(const uint4*)(a2t + ((size_t)dir * 512 + h * 64 + c) * 64 + part * 8);
    }
    const int pt = tid >> 4, part = tid & 15, ch0 = part * 4;
    const int psc = pt >> 4, ptl = pt & 15;
    float kkc[4], kac[4];
#pragma unroll
    for (int i = 0; i < 4; ++i) { kkc[i] = k_k[h * 64 + ch0 + i]; kac[i] = k_a[h * 64 + ch0 + i]; }
    const int lm = wv >> 2, lrt = (wv >> 1) & 1, lct0 = (wv & 1) * 2;
    float lc0[2];
#pragma unroll
    for (int q = 0; q < 2; ++q) { const int ch = dir * 512 + h * 64 + (lct0 + q) * 16 + (lane & 15); lc0[q] = lm ? a0[ch] : w0[ch]; }
    const int vT = wv >> 1, kT0 = (wv & 1) * 2;
    f32x4 S[2];
    f32x4 accU = (f32x4){0.f, 0.f, 0.f, 0.f};
    {
        const float* S0 = dir ? S0b : S0f;
#pragma unroll
        for (int q = 0; q < 2; ++q)
#pragma unroll
            for (int r = 0; r < 4; ++r) {
                const int v = vT * 16 + (lane >> 4) * 4 + r, k = (kT0 + q) * 16 + (lane & 15);
                const float x = latent ? S0[((size_t)((seq - 16) * 8 + h) * 64 + v) * 64 + k] : 0.f;
                S[q][r] = x; Sb0[v * 72 + k] = to_bf(x);
            }
    }
    uint2 g_r, g_k, g_wd, g_ad, g_v;
#define WKV2_LOAD(cidx) { const int s_ = (cidx) * 32 + pt; const int pos_ = dir ? (L - 1 - s_) : s_; \
        const bf16_t* zr_ = zcm + (size_t)(row0 + pos_) * CC; \
        g_r = *(const uint2*)(zr_ + h * 64 + ch0); g_k = *(const uint2*)(zr_ + 512 + h * 64 + ch0); g_v = *(const uint2*)(zr_ + 1024 + h * 64 + ch0); \
        g_wd = *(const uint2*)(zr_ + 1536 + dir * 64 + ch0); g_ad = *(const uint2*)(zr_ + 1664 + dir * 64 + ch0); }
    WKV2_LOAD(0)
    const int nb = L / 32;
    int cur = 0;
    for (int c = 0; c < nb; ++c) {
        float fr[4], fk[4];
        {
            fr[0] = bf_lo(g_r.x); fr[1] = bf_hi(g_r.x); fr[2] = bf_lo(g_r.y); fr[3] = bf_hi(g_r.y);
            fk[0] = bf_lo(g_k.x); fk[1] = bf_hi(g_k.x); fk[2] = bf_lo(g_k.y); fk[3] = bf_hi(g_k.y);
            float ss = 0.f;
#pragma unroll
            for (int i = 0; i < 4; ++i) { const float q = fk[i] * kkc[i]; ss += q * q; }
            ss = red16(ss);
            if (part == 0) rsv[pt] = rsqrtf(ss + 1e-12f);
            *(uint2*)(X1 + pt * 72 + ch0) = pk4(ftanh(bf_lo(g_wd.x)), ftanh(bf_hi(g_wd.x)), ftanh(bf_lo(g_wd.y)), ftanh(bf_hi(g_wd.y)));
            *(uint2*)(X2 + pt * 72 + ch0) = g_ad;
            *(uint2*)(OPS + psc * OPS_SC + 6 * 1152 + ptl * 72 + ch0) = g_v;
        }
        if (c + 1 < nb) WKV2_LOAD(c + 1)
        __syncthreads();
        for (int rp2_ = 0; rp2_ < REP_W2; ++rp2_) {
        {
            const bf16_t* Xm = lm ? X2 : X1; const bf16_t* Wm = lm ? A2s : W2s;
#pragma unroll
            for (int q = 0; q < 2; ++q) {
                const f32x4 acc = mm_tile<2, false>(Xm + lrt * 16 * 72, 72, Wm + (lct0 + q) * 16 * 72, 72, (f32x4){0.f, 0.f, 0.f, 0.f}, lane);
#pragma unroll
                for (int r = 0; r < 4; ++r) {
                    const int o = (lrt * 16 + (lane >> 4) * 4 + r) * LG + (lct0 + q) * 16 + (lane & 15);
                    const float sg = fsigmoid(lc0[q] + acc[r]);
                    if (lm == 0) GG[o] = -0.606531f * sg; else AA[o] = sg;
                }
            }
        }
        __syncthreads();
        }
        if (tid < 128) {
            const int sc = tid >> 6, ch = tid & 63;
            float lw[16];
#pragma unroll
            for (int t = 0; t < 16; ++t) lw[t] = GG[(sc * 16 + t) * LG + ch];
#pragma unroll
            for (int t = 1; t < 16; ++t) lw[t] += lw[t - 1];
#pragma unroll
            for (int t = 0; t < 16; ++t) GG[(sc * 16 + t) * LG + ch] = lw[t];
        }
        __syncthreads();
        for (int rp4_ = 0; rp4_ < REP_W4; ++rp4_) {
        {
            const float rs = rsv[pt];
            bf16_t* ops = OPS + psc * OPS_SC;
            float va[4], vb[4], vk[4], vr[4], vbh[4], vkh[4];
#pragma unroll
            for (int i = 0; i < 4; ++i) {
                const int ch = ch0 + i;
                const float G = GG[pt * LG + ch], Gp = ptl ? GG[(pt - 1) * LG + ch] : 0.f, GC = GG[(psc * 16 + 15) * LG + ch];
                const float a = AA[pt * LG + ch], kk = fk[i] * kkc[i] * rs, ki = fk[i] * (1.f + (a - 1.f) * kac[i]);
                const float enG = __expf(-G), gc = __expf(GC);
                va[i] = -kk * __expf(Gp); vb[i] = kk * a * enG; vk[i] = ki * enG; vr[i] = fr[i] * __expf(G);
                vbh[i] = vb[i] * gc; vkh[i] = vk[i] * gc;
                if (ptl == 15) gC[psc * 64 + ch] = gc;
            }
            *(uint2*)(ops + 0 * 1152 + ptl * 72 + ch0) = pk4(va[0], va[1], va[2], va[3]);
            *(uint2*)(ops + 1 * 1152 + ptl * 72 + ch0) = pk4(vb[0], vb[1], vb[2], vb[3]);
            *(uint2*)(ops + 2 * 1152 + ptl * 72 + ch0) = pk4(vk[0], vk[1], vk[2], vk[3]);
            *(uint2*)(ops + 3 * 1152 + ptl * 72 + ch0) = pk4(vr[0], vr[1], vr[2], vr[3]);
            *(uint2*)(ops + 4 * 1152 + ptl * 72 + ch0) = pk4(vbh[0], vbh[1], vbh[2], vbh[3]);
            *(uint2*)(ops + 5 * 1152 + ptl * 72 + ch0) = pk4(vkh[0], vkh[1], vkh[2], vkh[3]);
        }
        __syncthreads();
        }
        for (int rp5_ = 0; rp5_ < REP_W567; ++rp5_) {
        {
            const int sc = wv >> 2, prod = wv & 3;
            const bf16_t* ops = OPS + sc * OPS_SC;
            bf16_t* tmp = TMP + sc * TMP_SC;
            const f32x4 acc = mm_tile<2, false>(ops + (prod < 2 ? 0 : 3) * 1152, 72, ops + ((prod & 1) ? 2 : 1) * 1152, 72, (f32x4){0.f, 0.f, 0.f, 0.f}, lane);
            const int j = lane & 15;
#pragma unroll
            for (int r = 0; r < 4; ++r) {
                const int t = (lane >> 4) * 4 + r;
                const float v = (prod < 2 ? (j < t) : (j <= t)) ? acc[r] : 0.f;
                if (prod == 0) ((float*)tmp)[t * 16 + j] = v;
                else tmp[512 + (prod - 1) * 384 + t * 24 + j] = to_bf(v);
            }
        }
        __syncthreads();
        {
            const int sc = wv >> 2, vt = wv & 3;
            const bf16_t* ops = OPS + sc * OPS_SC;
            bf16_t* tmp = TMP + sc * TMP_SC;
            const f32x4 acc = mma<false>(ld_row16(tmp + 512 + 0 * 384, lane), ld_tr<true>(ops + 6 * 1152 + vt * 16, 72, lane), (f32x4){0.f, 0.f, 0.f, 0.f});
#pragma unroll
            for (int r = 0; r < 4; ++r) tmp[512 + 4 * 384 + ((lane >> 4) * 4 + r) * 72 + vt * 16 + (lane & 15)] = to_bf(acc[r]);
            if (tid < 32) {
                const int isc = tid >> 4, j = tid & 15;
                const float* N = (const float*)(TMP + isc * TMP_SC);
                bf16_t* Mb = TMP + isc * TMP_SC + 512 + 3 * 384;
                float m[16];
#pragma unroll
                for (int t = 0; t < 16; ++t) {
                    float p0 = (t == j) ? 1.f : 0.f, p1 = 0.f, p2 = 0.f, p3 = 0.f;
#pragma unroll
                    for (int s = 0; s < t; ++s) {
                        const float nv = N[t * 16 + s];
                        if ((s & 3) == 0) p0 += nv * m[s]; else if ((s & 3) == 1) p1 += nv * m[s]; else if ((s & 3) == 2) p2 += nv * m[s]; else p3 += nv * m[s];
                    }
                    m[t] = (t >= j) ? (p0 + p1) + (p2 + p3) : 0.f;
                    Mb[t * 24 + j] = to_bf(m[t]);
                }
            }
        }
        __syncthreads();
        {
            const int sc = wv >> 2, tl = wv & 3;
            const bf16_t* ops = OPS + sc * OPS_SC;
            bf16_t* tmp = TMP + sc * TMP_SC;
            const bf16_t* Mb = tmp + 512 + 3 * 384;
            const bf16x8 mrow = ld_row16(Mb, lane);
            bf16x8 tA, tT1;
            ld_tr2<true>(ops + 0 * 1152 + tl * 16, tmp + 512 + 4 * 384 + tl * 16, 72, lane, tA, tT1);
            const f32x4 accW = mma<false>(mrow, tA, (f32x4){0.f, 0.f, 0.f, 0.f});
            bf16_t* Wt = tmp + 512 + 4 * 384 + 1152;
#pragma unroll
            for (int r = 0; r < 4; ++r) Wt[((lane >> 4) * 4 + r) * 72 + tl * 16 + (lane & 15)] = to_bf(accW[r]);
            accU = mma<false>(mrow, tT1, (f32x4){0.f, 0.f, 0.f, 0.f});
        }
        __syncthreads();
        }
#pragma unroll
        for (int sc = 0; sc < 2; ++sc) {
            bf16_t* Sbc = cur ? Sb1 : Sb0; bf16_t* Sbn = cur ? Sb0 : Sb1;
            const bf16_t* ops = OPS + sc * OPS_SC;
            const bf16_t* tmp = TMP + sc * TMP_SC;
            if ((wv >> 2) == sc) {
                const int vt = wv & 3;
                const f32x4 u = mm_tile<2, false>(tmp + 512 + 4 * 384 + 1152, 72, Sbc + vt * 16 * 72, 72, accU, lane);
#pragma unroll
                for (int r = 0; r < 4; ++r) Us[((lane >> 4) * 4 + r) * 72 + vt * 16 + (lane & 15)] = to_bf(u[r]);
            }
            __syncthreads();
            if (wv < 4) {
                const int vt = wv;
                f32x4 yv = mm_tile<2, true>(ops + 3 * 1152, 72, Sbc + vt * 16 * 72, 72, (f32x4){0.f, 0.f, 0.f, 0.f}, lane);
                bf16x8 tU, tV;
                ld_tr2<true>(Us + vt * 16, ops + 6 * 1152 + vt * 16, 72, lane, tU, tV);
                yv = mma<true>(ld_row16(tmp + 512 + 1 * 384, lane), tU, yv);
                yv = mma<true>(ld_row16(tmp + 512 + 2 * 384, lane), tV, yv);
                const int s = c * 32 + sc * 16 + (lane & 15), pos = dir ? (L - 1 - s) : s;
                *(uint2*)(y + ((size_t)dir * lay.Tloc + row0 + pos) * 512 + h * 64 + vt * 16 + (lane >> 4) * 4) = pk4(yv[0], yv[1], yv[2], yv[3]);
            }
            {
                bf16x8 aU, aV, b0, b1, k0_, k1_;
                ld_tr2<true>(Us + vT * 16, ops + 6 * 1152 + vT * 16, 72, lane, aU, aV);
                ld_tr4<true>(ops + 4 * 1152 + kT0 * 16, ops + 4 * 1152 + (kT0 + 1) * 16, ops + 5 * 1152 + kT0 * 16, ops + 5 * 1152 + (kT0 + 1) * 16, 72, lane, b0, b1, k0_, k1_);
#pragma unroll
                for (int q = 0; q < 2; ++q) {
                    const int kt = kT0 + q;
                    S[q] = S[q] * gC[sc * 64 + kt * 16 + (lane & 15)];
                    S[q] = mma<false>(aU, q ? b1 : b0, S[q]);
                    S[q] = mma<false>(aV, q ? k1_ : k0_, S[q]);
#pragma unroll
                    for (int r = 0; r < 4; ++r) Sbn[(vT * 16 + (lane >> 4) * 4 + r) * 72 + kt * 16 + (lane & 15)] = to_bf(S[q][r]);
                }
            }
            __syncthreads();
            cur ^= 1;
        }
    }
    float* So = dir ? Sb_out : Sf_out;
    if (!latent) {
#pragma unroll
        for (int q = 0; q < 2; ++q)
#pragma unroll
            for (int r = 0; r < 4; ++r) So[((size_t)(seq * 8 + h) * 64 + vT * 16 + (lane >> 4) * 4 + r) * 64 + (kT0 + q) * 16 + (lane & 15)] = S[q][r];
    }
#undef WKV2_LOAD
}

template <int NT>
__device__ __forceinline__ void n_wkv3(const Lay lay, const bf16_t* __restrict__ zcm, const bf16_t* __restrict__ w2t, const bf16_t* __restrict__ a2t,
                                       const float* __restrict__ w0, const float* __restrict__ a0, const float* __restrict__ k_k, const float* __restrict__ k_a,
                                       const float* __restrict__ S0f, const float* __restrict__ S0b, bf16_t* __restrict__ y,
                                       float* __restrict__ Sf_out, float* __restrict__ Sb_out, int item, char* lds,
                                       const int c0, const int c1, const float* __restrict__ Sinit, const int pq, float* __restrict__ Send) {
    static_assert(NT == 512, "n_wkv3 needs 8 waves");
    const int tid = TIDX, lane = tid & 63, wv = tid >> 6;
    const int dir = item & 1, h = (item >> 1) & 7, seq = lay.seqbase + (item >> 4);
    const bool latent = seq >= 16;
    const int L = latent ? 4096 : 256, row0 = (latent ? 4096 + (seq - 16) * 4096 : seq * 256) - lay.tbase;
    constexpr int OPS_SC = 7 * 1152;
    constexpr int TMP_SC = 512 + 4 * 384 + 1152 + 1152;
    constexpr int LG = 68;
    bf16_t* W2s = (bf16_t*)lds; bf16_t* A2s = W2s + 4608; bf16_t* Sb0 = A2s + 4608; bf16_t* Sb1 = Sb0 + 4608;
    float* rsv = (float*)(Sb1 + 4608); float* gC = rsv + 64;
    bf16_t* OPS = (bf16_t*)(gC + 256);
    bf16_t* TMP = OPS + 4 * OPS_SC;
    bf16_t* Us = TMP + 4 * TMP_SC;
    float* AA = (float*)TMP; float* GG = AA + 64 * LG;
    bf16_t* X1 = OPS; bf16_t* X2 = OPS + OPS_SC;
    static_assert(2 * 64 * LG * 4 <= 4 * TMP_SC * 2, "staging must fit in TMP");
    __syncthreads();
    {
        const int c = tid >> 3, part = tid & 7;
        *(uint4*)(W2s + c * 72 + part * 8) = *(const uint4*)(w2t + ((size_t)dir * 512 + h * 64 + c) * 64 + part * 8);
        *(uint4*)(A2s + c * 72 + part * 8) = *(const uint4*)(a2t + ((size_t)dir * 512 + h * 64 + c) * 64 + part * 8);
    }
    const int pt = tid >> 3, part = tid & 7, ch0 = part * 8;
    const int psc = pt >> 4, ptl = pt & 15;
    const int jsc = wv >> 2, jq = wv & 3;
    float lc0[2];
    lc0[0] = w0[dir * 512 + h * 64 + jq * 16 + (lane & 15)]; lc0[1] = a0[dir * 512 + h * 64 + jq * 16 + (lane & 15)];
    const int vT = wv >> 1, kT0 = (wv & 1) * 2;
    f32x4 S[2];
    f32x4 accU[2];
    {
        const float* S0 = dir ? S0b : S0f;
#pragma unroll
        for (int q = 0; q < 2; ++q)
#pragma unroll
            for (int r = 0; r < 4; ++r) {
                const int v = vT * 16 + (lane >> 4) * 4 + r, k = (kT0 + q) * 16 + (lane & 15);
                const float x = Sinit ? Sinit[v * 64 + k] : (latent ? S0[((size_t)((seq - 16) * 8 + h) * 64 + v) * 64 + k] : 0.f);
                S[q][r] = x; Sb0[v * 72 + k] = to_bf(x);
            }
    }
    uint4 g_r, g_k, g_wd, g_ad, g_v;
#define WKV3_LOAD(cidx) { const int s_ = (cidx) * 64 + pt; const int pos_ = dir ? (L - 1 - s_) : s_; \
        const bf16_t* zr_ = zcm + (size_t)(row0 + pos_) * CC; \
        g_r = *(const uint4*)(zr_ + h * 64 + ch0); g_k = *(const uint4*)(zr_ + 512 + h * 64 + ch0); g_v = *(const uint4*)(zr_ + 1024 + h * 64 + ch0); \
        g_wd = *(const uint4*)(zr_ + 1536 + dir * 64 + ch0); g_ad = *(const uint4*)(zr_ + 1664 + dir * 64 + ch0); \
        if (pq == 1) g_v = make_uint4(0u, 0u, 0u, 0u); }
    WKV3_LOAD(c0)
    int cur = 0;
    for (int c = c0; c < c1; ++c) {
        const int tid = TIDX, lane = tid & 63, wv = tid >> 6;
        const int pt = tid >> 3, part = tid & 7, ch0 = part * 8, psc = pt >> 4, ptl = pt & 15;
        const int jsc = wv >> 2, jq = wv & 3, vT = wv >> 1, kT0 = (wv & 1) * 2;
        {
            float fk[8], fw[8];
            unpack8(g_k, fk); unpack8(g_wd, fw);
            const float4 kk0 = *(const float4*)(k_k + h * 64 + ch0), kk1 = *(const float4*)(k_k + h * 64 + ch0 + 4);
            const float kkc[8] = {kk0.x, kk0.y, kk0.z, kk0.w, kk1.x, kk1.y, kk1.z, kk1.w};
            float ss = 0.f;
#pragma unroll
            for (int i = 0; i < 8; ++i) { const float q = fk[i] * kkc[i]; ss += q * q; }
            ss = red8(ss);
            if (part == 0) rsv[pt] = rsqrtf(ss + 1e-12f);
            *(uint4*)(X1 + pt * 72 + ch0) = make_uint4(pk_bf16(ftanh(fw[0]), ftanh(fw[1])), pk_bf16(ftanh(fw[2]), ftanh(fw[3])), pk_bf16(ftanh(fw[4]), ftanh(fw[5])), pk_bf16(ftanh(fw[6]), ftanh(fw[7])));
            *(uint4*)(X2 + pt * 72 + ch0) = g_ad;
            *(uint4*)(OPS + psc * OPS_SC + 6 * 1152 + ptl * 72 + ch0) = g_v;
        }
        __syncthreads();
        {
#pragma unroll
            for (int lm = 0; lm < 2; ++lm)
#pragma unroll
                for (int ri = 0; ri < 2; ++ri) {
                    const int rt = jsc + 2 * ri;
                    const f32x4 acc = mm_tile<2, false>((lm ? X2 : X1) + rt * 16 * 72, 72, (lm ? A2s : W2s) + jq * 16 * 72, 72, (f32x4){0.f, 0.f, 0.f, 0.f}, lane);
                    float sg[4];
#pragma unroll
                    for (int r = 0; r < 4; ++r) sg[r] = fsigmoid(lc0[lm] + acc[r]);
                    asm volatile("" ::: "memory");
#pragma unroll
                    for (int r = 0; r < 4; ++r) {
                        const int o = (rt * 16 + (lane >> 4) * 4 + r) * LG + jq * 16 + (lane & 15);
                        if (lm == 0) GG[o] = -0.606531f * sg[r]; else AA[o] = sg[r];
                    }
                }
        }
        __syncthreads();
        if (tid < 256) {
            const int sc = tid >> 6, ch = tid & 63;
            float lw[16];
#pragma unroll
            for (int t = 0; t < 16; ++t) lw[t] = GG[(sc * 16 + t) * LG + ch];
#pragma unroll
            for (int t = 1; t < 16; ++t) lw[t] += lw[t - 1];
#pragma unroll
            for (int t = 0; t < 16; ++t) GG[(sc * 16 + t) * LG + ch] = lw[t];
        }
        __syncthreads();
        {
            const float rs = rsv[pt];
            bf16_t* ops = OPS + psc * OPS_SC;
            float fr[8], fk[8];
            unpack8(g_r, fr); unpack8(g_k, fk);
#pragma unroll
            for (int hf = 0; hf < 2; ++hf) {
                float va[4], vb[4], vk[4], vr[4], vbh[4], vkh[4];
                const float4 kk4 = *(const float4*)(k_k + h * 64 + ch0 + hf * 4), ka4 = *(const float4*)(k_a + h * 64 + ch0 + hf * 4);
                const float kkc[4] = {kk4.x, kk4.y, kk4.z, kk4.w}, kac[4] = {ka4.x, ka4.y, ka4.z, ka4.w};
#pragma unroll
                for (int i = 0; i < 4; ++i) {
                    const int ii = hf * 4 + i, ch = ch0 + ii;
                    const float G = GG[pt * LG + ch], Gp = ptl ? GG[(pt - 1) * LG + ch] : 0.f, GC = GG[(psc * 16 + 15) * LG + ch];
                    const float a = AA[pt * LG + ch], kk = fk[ii] * kkc[i] * rs, ki = fk[ii] * (1.f + (a - 1.f) * kac[i]);
                    const float enG = __expf(-G), gc = __expf(GC);
                    va[i] = -kk * __expf(Gp); vb[i] = kk * a * enG; vk[i] = ki * enG; vr[i] = fr[ii] * __expf(G);
                    vbh[i] = vb[i] * gc; vkh[i] = vk[i] * gc;
                    if (ptl == 15) gC[psc * 64 + ch] = gc;
                }
                bf16_t* o4 = ops + ptl * 72 + ch0 + hf * 4;
                *(uint2*)(o4 + 0 * 1152) = pk4(va[0], va[1], va[2], va[3]);
                *(uint2*)(o4 + 1 * 1152) = pk4(vb[0], vb[1], vb[2], vb[3]);
                *(uint2*)(o4 + 2 * 1152) = pk4(vk[0], vk[1], vk[2], vk[3]);
                *(uint2*)(o4 + 3 * 1152) = pk4(vr[0], vr[1], vr[2], vr[3]);
                *(uint2*)(o4 + 4 * 1152) = pk4(vbh[0], vbh[1], vbh[2], vbh[3]);
                *(uint2*)(o4 + 5 * 1152) = pk4(vkh[0], vkh[1], vkh[2], vkh[3]);
            }
            if (c + 1 < c1) WKV3_LOAD(c + 1)
        }
        __syncthreads();
#pragma unroll
        for (int si = 0; si < 2; ++si) {
            const int sc = jsc + 2 * si, prod = jq;
            const bf16_t* ops = OPS + sc * OPS_SC;
            bf16_t* tmp = TMP + sc * TMP_SC;
            const f32x4 acc = mm_tile<2, false>(ops + (prod < 2 ? 0 : 3) * 1152, 72, ops + ((prod & 1) ? 2 : 1) * 1152, 72, (f32x4){0.f, 0.f, 0.f, 0.f}, lane);
            const int j = lane & 15;
#pragma unroll
            for (int r = 0; r < 4; ++r) {
                const int t = (lane >> 4) * 4 + r;
                const float v = (prod < 2 ? (j < t) : (j <= t)) ? acc[r] : 0.f;
                if (prod == 0) ((float*)tmp)[t * 16 + j] = v;
                else tmp[512 + (prod - 1) * 384 + t * 24 + j] = to_bf(v);
            }
        }
        __syncthreads();
        {
#pragma unroll
            for (int si = 0; si < 2; ++si) {
                const int sc = jsc + 2 * si, vt = jq;
                const bf16_t* ops = OPS + sc * OPS_SC;
                bf16_t* tmp = TMP + sc * TMP_SC;
                const f32x4 acc = mma<false>(ld_row16(tmp + 512 + 0 * 384, lane), ld_tr<true>(ops + 6 * 1152 + vt * 16, 72, lane), (f32x4){0.f, 0.f, 0.f, 0.f});
#pragma unroll
                for (int r = 0; r < 4; ++r) tmp[512 + 4 * 384 + ((lane >> 4) * 4 + r) * 72 + vt * 16 + (lane & 15)] = to_bf(acc[r]);
            }
            if (tid < 64) {
                const int isc = tid >> 4, j = tid & 15;
                const float* N = (const float*)(TMP + isc * TMP_SC);
                bf16_t* Mb = TMP + isc * TMP_SC + 512 + 3 * 384;
                float m[16];
#pragma unroll
                for (int t = 0; t < 16; ++t) {
                    float p0 = (t == j) ? 1.f : 0.f, p1 = 0.f, p2 = 0.f, p3 = 0.f;
#pragma unroll
                    for (int s = 0; s < t; ++s) {
                        const float nv = N[t * 16 + s];
                        if ((s & 3) == 0) p0 += nv * m[s]; else if ((s & 3) == 1) p1 += nv * m[s]; else if ((s & 3) == 2) p2 += nv * m[s]; else p3 += nv * m[s];
                    }
                    m[t] = (t >= j) ? (p0 + p1) + (p2 + p3) : 0.f;
                    Mb[t * 24 + j] = to_bf(m[t]);
                }
            }
        }
        __syncthreads();
#pragma unroll
        for (int si = 0; si < 2; ++si) {
            const int sc = jsc + 2 * si, tl = jq;
            const bf16_t* ops = OPS + sc * OPS_SC;
            bf16_t* tmp = TMP + sc * TMP_SC;
            const bf16x8 mrow = ld_row16(tmp + 512 + 3 * 384, lane);
            bf16x8 tA, tT1;
            ld_tr2<true>(ops + 0 * 1152 + tl * 16, tmp + 512 + 4 * 384 + tl * 16, 72, lane, tA, tT1);
            const f32x4 accW = mma<false>(mrow, tA, (f32x4){0.f, 0.f, 0.f, 0.f});
            bf16_t* Wt = tmp + 512 + 4 * 384 + 1152;
#pragma unroll
            for (int r = 0; r < 4; ++r) Wt[((lane >> 4) * 4 + r) * 72 + tl * 16 + (lane & 15)] = to_bf(accW[r]);
            accU[si] = mma<false>(mrow, tT1, (f32x4){0.f, 0.f, 0.f, 0.f});
        }
        __syncthreads();
#pragma unroll
        for (int sc = 0; sc < 4; ++sc) {
            bf16_t* Sbc = cur ? Sb1 : Sb0; bf16_t* Sbn = cur ? Sb0 : Sb1;
            const bf16_t* ops = OPS + sc * OPS_SC;
            const bf16_t* tmp = TMP + sc * TMP_SC;
            if (jsc == (sc & 1)) {
                const int vt = jq;
                const f32x4 u = mm_tile<2, false>(tmp + 512 + 4 * 384 + 1152, 72, Sbc + vt * 16 * 72, 72, accU[sc >> 1], lane);
#pragma unroll
                for (int r = 0; r < 4; ++r) Us[((lane >> 4) * 4 + r) * 72 + vt * 16 + (lane & 15)] = to_bf(u[r]);
            }
            __syncthreads();
            if (wv < 4 && pq == 0) {
                const int vt = wv;
                f32x4 yv = mm_tile<2, true>(ops + 3 * 1152, 72, Sbc + vt * 16 * 72, 72, (f32x4){0.f, 0.f, 0.f, 0.f}, lane);
                bf16x8 tU, tV;
                ld_tr2<true>(Us + vt * 16, ops + 6 * 1152 + vt * 16, 72, lane, tU, tV);
                yv = mma<true>(ld_row16(tmp + 512 + 1 * 384, lane), tU, yv);
                yv = mma<true>(ld_row16(tmp + 512 + 2 * 384, lane), tV, yv);
                const int s = c * 64 + sc * 16 + (lane & 15), pos = dir ? (L - 1 - s) : s;
                *(uint2*)(y + ((size_t)dir * lay.Tloc + row0 + pos) * 512 + h * 64 + vt * 16 + (lane >> 4) * 4) = pk4(yv[0], yv[1], yv[2], yv[3]);
            }
            {
                bf16x8 aU, aV, b0, b1, k0_, k1_;
                ld_tr2<true>(Us + vT * 16, ops + 6 * 1152 + vT * 16, 72, lane, aU, aV);
                ld_tr4<true>(ops + 4 * 1152 + kT0 * 16, ops + 4 * 1152 + (kT0 + 1) * 16, ops + 5 * 1152 + kT0 * 16, ops + 5 * 1152 + (kT0 + 1) * 16, 72, lane, b0, b1, k0_, k1_);
#pragma unroll
                for (int q = 0; q < 2; ++q) {
                    const int kt = kT0 + q;
                    S[q] = S[q] * gC[sc * 64 + kt * 16 + (lane & 15)];
                    S[q] = mma<false>(aU, q ? b1 : b0, S[q]);
                    S[q] = mma<false>(aV, q ? k1_ : k0_, S[q]);
#pragma unroll
                    for (int r = 0; r < 4; ++r) Sbn[(vT * 16 + (lane >> 4) * 4 + r) * 72 + kt * 16 + (lane & 15)] = to_bf(S[q][r]);
                }
            }
            __syncthreads();
            cur ^= 1;
        }
    }
    float* So = dir ? Sb_out : Sf_out;
    if (!latent) {
#pragma unroll
        for (int q = 0; q < 2; ++q)
#pragma unroll
            for (int r = 0; r < 4; ++r) So[((size_t)(seq * 8 + h) * 64 + vT * 16 + (lane >> 4) * 4 + r) * 64 + (kT0 + q) * 16 + (lane & 15)] = S[q][r];
    }
    if (Send) {
#pragma unroll
        for (int q = 0; q < 2; ++q)
#pragma unroll
            for (int r = 0; r < 4; ++r) Send[(vT * 16 + (lane >> 4) * 4 + r) * 64 + (kT0 + q) * 16 + (lane & 15)] = S[q][r];
    }
#undef WKV3_LOAD
}

template <int NT>
__device__ __forceinline__ void wkv_seg_init(const float* __restrict__ E0, const float* __restrict__ PQ, int nst, float* __restrict__ out, char* lds) {
    static_assert(NT == 512, "wkv_seg_init needs 512 threads");
    const int tid = TIDX, v = tid >> 3, kg = (tid & 7) * 8;
    float* Sl = (float*)lds;
    __syncthreads();
    {
        const float4 a = *(const float4*)(E0 + v * 64 + kg), b = *(const float4*)(E0 + v * 64 + kg + 4);
        float* d = Sl + v * 65 + kg;
        d[0] = a.x; d[1] = a.y; d[2] = a.z; d[3] = a.w; d[4] = b.x; d[5] = b.y; d[6] = b.z; d[7] = b.w;
    }
    __syncthreads();
    float* Pl = Sl + 64 * 65;
    for (int st = 0; st < nst; ++st) {
        const float* Pm = PQ + (size_t)st * 8192; const float* Qm = Pm + 4096;
        {
            const float4 p0 = *(const float4*)(Pm + tid * 8), p1 = *(const float4*)(Pm + tid * 8 + 4);
            *(float4*)(Pl + v * 68 + kg) = p0; *(float4*)(Pl + v * 68 + kg + 4) = p1;
        }
        float4 a0 = *(const float4*)(Qm + v * 64 + kg), a1 = *(const float4*)(Qm + v * 64 + kg + 4);
        __syncthreads();
#pragma unroll 8
        for (int j = 0; j < 64; ++j) {
            const float s = Sl[v * 65 + j];
            const float4 p0 = *(const float4*)(Pl + j * 68 + kg), p1 = *(const float4*)(Pl + j * 68 + kg + 4);
            a0.x += s * p0.x; a0.y += s * p0.y; a0.z += s * p0.z; a0.w += s * p0.w;
            a1.x += s * p1.x; a1.y += s * p1.y; a1.z += s * p1.z; a1.w += s * p1.w;
        }
        __syncthreads();
        float* d = Sl + v * 65 + kg;
        d[0] = a0.x; d[1] = a0.y; d[2] = a0.z; d[3] = a0.w; d[4] = a1.x; d[5] = a1.y; d[6] = a1.z; d[7] = a1.w;
        if (st + 1 == nst) { *(float4*)(out + v * 64 + kg) = a0; *(float4*)(out + v * 64 + kg + 4) = a1; }
        __syncthreads();
    }
}

template <int NT, int NI = 4>
__device__ __forceinline__ void n_combine1(const Lay lay, const bf16_t* __restrict__ zcm, const bf16_t* __restrict__ g2t, const bf16_t* __restrict__ y, const bf16_t* __restrict__ yd,
                                           const bf16_t* __restrict__ zg, const float* __restrict__ r_k, const float* __restrict__ ln_w, const float* __restrict__ ln_b,
                                           const float* __restrict__ gnorm, bf16_t* __restrict__ merged, int item, char* lds) {
    static_assert(NT == 512, "n_combine1 needs 8 waves");
    const int tid = TIDX, lane = tid & 63, wv = tid >> 6, cq = (lane >> 4) * 4;
    bf16_t* As = (bf16_t*)lds;
    float* red = (float*)(lds + 64 * 136 * 2);
    const int m0 = item * (16 * NI);
    __syncthreads();
    if ((tid >> 3) < 16 * NI) {
        const int t = tid >> 3, part = tid & 7;
        const bf16_t* src = zcm + (size_t)(m0 + t) * CC + 1792 + part * 16;
        float f0[8], f1[8];
        unpack8(*(const uint4*)src, f0); unpack8(*(const uint4*)(src + 8), f1);
        *(uint4*)(As + t * 136 + part * 16) = make_uint4(pk_bf16(fsigmoid(f0[0]), fsigmoid(f0[1])), pk_bf16(fsigmoid(f0[2]), fsigmoid(f0[3])),
                                                         pk_bf16(fsigmoid(f0[4]), fsigmoid(f0[5])), pk_bf16(fsigmoid(f0[6]), fsigmoid(f0[7])));
        *(uint4*)(As + t * 136 + part * 16 + 8) = make_uint4(pk_bf16(fsigmoid(f1[0]), fsigmoid(f1[1])), pk_bf16(fsigmoid(f1[2]), fsigmoid(f1[3])),
                                                             pk_bf16(fsigmoid(f1[4]), fsigmoid(f1[5])), pk_bf16(fsigmoid(f1[6]), fsigmoid(f1[7])));
    }
    __syncthreads();
    f32x4 acc[NI][4];
#pragma unroll
    for (int i = 0; i < NI; ++i)
#pragma unroll
        for (int j = 0; j < 4; ++j) acc[i][j] = (f32x4){0.f, 0.f, 0.f, 0.f};
#pragma unroll
    for (int ks = 0; ks < 4; ++ks) {
        bf16x8 a[NI], b[4];
#pragma unroll
        for (int i = 0; i < NI; ++i) a[i] = *(const bf16x8*)(As + (i * 16 + (lane & 15)) * 136 + ks * 32 + (lane >> 4) * 8);
#pragma unroll
        for (int j = 0; j < 4; ++j) b[j] = *(const bf16x8*)(g2t + (size_t)(wv * 64 + j * 16 + (lane & 15)) * 128 + ks * 32 + (lane >> 4) * 8);
#pragma unroll
        for (int i = 0; i < NI; ++i)
#pragma unroll
            for (int j = 0; j < 4; ++j) acc[i][j] = __builtin_amdgcn_mfma_f32_16x16x32_bf16(b[j], a[i], acc[i][j], 0, 0, 0);
    }
#pragma unroll
    for (int i = 0; i < NI; ++i) {
        const size_t lrow = (size_t)m0 + i * 16 + (lane & 15);
        float yy[4][4], rk = 0.f, sm = 0.f, zsq = 0.f;
        float vv[4][4];
#pragma unroll
        for (int j = 0; j < 4; ++j) {
            const int e = wv * 64 + j * 16 + cq;
            const uint2 ya = *(const uint2*)(y + lrow * 512 + e), yb = *(const uint2*)(y + ((size_t)lay.Tloc + lrow) * 512 + e);
            const uint2 ur = *(const uint2*)(zcm + lrow * CC + e), uk = *(const uint2*)(zcm + lrow * CC + 512 + e), uv = *(const uint2*)(zcm + lrow * CC + 1024 + e);
            const float4 rk4 = *(const float4*)(r_k + e);
            yy[j][0] = bf_lo(ya.x) + bf_lo(yb.x); yy[j][1] = bf_hi(ya.x) + bf_hi(yb.x); yy[j][2] = bf_lo(ya.y) + bf_lo(yb.y); yy[j][3] = bf_hi(ya.y) + bf_hi(yb.y);
            vv[j][0] = bf_lo(uv.x); vv[j][1] = bf_hi(uv.x); vv[j][2] = bf_lo(uv.y); vv[j][3] = bf_hi(uv.y);
            rk += bf_lo(ur.x) * bf_lo(uk.x) * rk4.x + bf_hi(ur.x) * bf_hi(uk.x) * rk4.y + bf_lo(ur.y) * bf_lo(uk.y) * rk4.z + bf_hi(ur.y) * bf_hi(uk.y) * rk4.w;
            sm += (yy[j][0] + yy[j][1]) + (yy[j][2] + yy[j][3]);
            const uint2 da = *(const uint2*)(yd + lrow * 512 + e), db = *(const uint2*)(yd + ((size_t)lay.Tloc + lrow) * 512 + e), uz = *(const uint2*)(zg + lrow * 512 + e);
            const float z0 = bf_lo(uz.x), z1 = bf_hi(uz.x), z2 = bf_lo(uz.y), z3 = bf_hi(uz.y);
            const float q0 = (bf_lo(da.x) + bf_lo(db.x)) * z0 * fsigmoid(z0), q1 = (bf_hi(da.x) + bf_hi(db.x)) * z1 * fsigmoid(z1);
            const float q2 = (bf_lo(da.y) + bf_lo(db.y)) * z2 * fsigmoid(z2), q3 = (bf_hi(da.y) + bf_hi(db.y)) * z3 * fsigmoid(z3);
            zsq += (q0 * q0 + q1 * q1) + (q2 * q2 + q3 * q3);
        }
        sm += __shfl_xor(sm, 16); sm += __shfl_xor(sm, 32);
        rk += __shfl_xor(rk, 16); rk += __shfl_xor(rk, 32);
        const float mean = sm * (1.f / 64.f);
        float var = 0.f, zs = 0.f;
#pragma unroll
        for (int j = 0; j < 4; ++j)
#pragma unroll
            for (int r = 0; r < 4; ++r) { const float d = yy[j][r] - mean; var += d * d; }
        zs = zsq;
        var += __shfl_xor(var, 16); var += __shfl_xor(var, 32);
        zs += __shfl_xor(zs, 16); zs += __shfl_xor(zs, 32);
        const float rstd = rsqrtf(var * (1.f / 64.f) + 64e-5f);
        if (lane < 16) red[wv * 64 + i * 16 + lane] = zs;
#pragma unroll
        for (int j = 0; j < 4; ++j) {
            const int e = wv * 64 + j * 16 + cq;
            const float4 lw4 = *(const float4*)(ln_w + e), lb4 = *(const float4*)(ln_b + e);
            const float o0 = ((yy[j][0] - mean) * rstd * lw4.x + lb4.x + rk * vv[j][0]) * acc[i][j][0];
            const float o1 = ((yy[j][1] - mean) * rstd * lw4.y + lb4.y + rk * vv[j][1]) * acc[i][j][1];
            const float o2 = ((yy[j][2] - mean) * rstd * lw4.z + lb4.z + rk * vv[j][2]) * acc[i][j][2];
            const float o3 = ((yy[j][3] - mean) * rstd * lw4.w + lb4.w + rk * vv[j][3]) * acc[i][j][3];
            *(uint2*)(merged + lrow * DM + e) = pk4(o0, o1, o2, o3);
        }
    }
    __syncthreads();
#pragma unroll
    for (int i = 0; i < NI; ++i) {
        const int tk = i * 16 + (lane & 15);
        float ss = 0.f;
#pragma unroll
        for (int w = 0; w < 8; ++w) ss += red[w * 64 + tk];
        const float rs = rsqrtf(ss * (1.f / 512.f) + EPS);
        const size_t lrow = (size_t)m0 + tk;
#pragma unroll
        for (int j = 0; j < 4; ++j) {
            const int e = wv * 64 + j * 16 + cq;
            const float4 gn = *(const float4*)(gnorm + e);
            const uint2 da = *(const uint2*)(yd + lrow * 512 + e), db = *(const uint2*)(yd + ((size_t)lay.Tloc + lrow) * 512 + e), uz = *(const uint2*)(zg + lrow * 512 + e);
            const float z0 = bf_lo(uz.x), z1 = bf_hi(uz.x), z2 = bf_lo(uz.y), z3 = bf_hi(uz.y);
            const float q0 = (bf_lo(da.x) + bf_lo(db.x)) * z0 * fsigmoid(z0), q1 = (bf_hi(da.x) + bf_hi(db.x)) * z1 * fsigmoid(z1);
            const float q2 = (bf_lo(da.y) + bf_lo(db.y)) * z2 * fsigmoid(z2), q3 = (bf_hi(da.y) + bf_hi(db.y)) * z3 * fsigmoid(z3);
            *(uint2*)(merged + lrow * DM + 512 + e) = pk4(q0 * rs * gn.x, q1 * rs * gn.y, q2 * rs * gn.z, q3 * rs * gn.w);
        }
    }
    __syncthreads();
}

template <int NT>
__device__ __forceinline__ void n_final(const Lay lay, const float* __restrict__ h, const float* __restrict__ g, float* __restrict__ out, int vb, float* lds) {
    const int lrow = vb * (NT / 256) + (TIDX >> 8), tid = TIDX & 255;
    const float4 x = *(const float4*)(h + (size_t)lrow * DM + tid * 4);
    const float ss = group_sum256<NT>(x.x * x.x + x.y * x.y + x.z * x.z + x.w * x.w, lds);
    const float rstd = rsqrtf(ss * (1.f / DM) + EPS);
    const float4 gg = *(const float4*)(g + tid * 4);
    *(float4*)(out + (size_t)(lay.tbase + lrow) * DM + tid * 4) = make_float4(x.x * rstd * gg.x, x.y * rstd * gg.y, x.z * rstd * gg.z, x.w * rstd * gg.w);
}

template <int NT>
__device__ __forceinline__ void n_final_w2(const Lay lay, const bf16_t* __restrict__ h, const float* __restrict__ g, float* __restrict__ out, int vb) {
    const int lane = TIDX & 63, lrow0 = vb * (NT / 64) * 2 + (TIDX >> 6) * 2;
    float4 x[2][4];
#pragma unroll
    for (int k = 0; k < 2; ++k)
#pragma unroll
        for (int q = 0; q < 4; ++q) { const uint2 u = *(const uint2*)(h + (size_t)(lrow0 + k) * DM + q * 256 + lane * 4); x[k][q] = make_float4(bf_lo(u.x), bf_hi(u.x), bf_lo(u.y), bf_hi(u.y)); }
#pragma unroll
    for (int k = 0; k < 2; ++k) {
        float ss = 0.f;
#pragma unroll
        for (int q = 0; q < 4; ++q) ss += (x[k][q].x * x[k][q].x + x[k][q].y * x[k][q].y) + (x[k][q].z * x[k][q].z + x[k][q].w * x[k][q].w);
        ss = wave_sum(ss);
        const float rstd = rsqrtf(ss * (1.f / DM) + EPS);
#pragma unroll
        for (int q = 0; q < 4; ++q) {
            const int c = q * 256 + lane * 4;
            const float4 gg = *(const float4*)(g + c);
            *(float4*)(out + (size_t)(lay.tbase + lrow0 + k) * DM + c) = make_float4(x[k][q].x * rstd * gg.x, x[k][q].y * rstd * gg.y, x[k][q].z * rstd * gg.z, x[k][q].w * rstd * gg.w);
        }
    }
}

template <int NT>
__device__ __forceinline__ void n_cache_k4(const Lay lay, const float* __restrict__ ck, bf16_t* __restrict__ Ka, int vb) {
    const int e4 = vb * NT + TIDX;
    const int bb = e4 >> 16, rem = e4 & 65535, p = rem >> 7, c = (rem & 127) * 4, h = c >> 7, j = c & 127;
    if (bb >= lay.nb) return;
    const int b = lay.b0 + bb;
    const float4 v = *(const float4*)(ck + (((size_t)b * 4 + h) * 512 + p) * 128 + j);
    *(uint2*)(Ka + ((size_t)lay.Tloc + bb * 512 + p) * 512 + c) = pk4(v.x, v.y, v.z, v.w);
}
template <int NT>
__device__ __forceinline__ void n_cache_kv(const Lay lay, const float* __restrict__ ck, const float* __restrict__ cv, bf16_t* __restrict__ Ka, bf16_t* __restrict__ VtA, int vb) {
    const int idx = vb * NT + TIDX;
    const int per = 4 * 512 * 128;
    const int bb = idx / (2 * per), r = idx % (2 * per);
    if (bb >= lay.nb) return;
    const int b = lay.b0 + bb;
    if (r < per) {
        const int p = r / 512, c = r % 512, h = c >> 7, j = c & 127;
        Ka[((size_t)lay.Tloc + bb * 512 + p) * 512 + c] = to_bf(ck[(((size_t)b * 4 + h) * 512 + p) * 128 + j]);
    } else {
        const int q = r - per, key = q % 512, dv = (q / 512) % 128, h = q / (512 * 128);
        VtA[vt_off(lay, 16 + b, h) + (size_t)dv * VLD + key] = to_bf(cv[(((size_t)b * 4 + h) * 512 + key) * 128 + dv]);
    }
}

struct Args { const void* p[24]; int i[16]; };
enum { PH_CACHE = 11, PH_GEMM_IN1, PH_SCAN, PH_COMBINE1, PH_FINAL, PH_WCONV = 0, PH_ROPE, PH_RESNORM, PH_GEMM_IN0, PH_TAIL, PH_GEMM_UQ, PH_GEMM_UKV, PH_FLASH, PH_COMBINE0, PH_GEMM_RES, PH_FFN_UP };
template <int NT, int BNB, int PH>
__device__ __forceinline__ void phase_body(const Args& a, int vb, float* lds) {
    const Lay lay{a.i[0], a.i[1], a.i[2], a.i[3], a.i[4]};
    if constexpr (PH == PH_GEMM_IN1) {
        const HaloTile ht = halo_tile(a.i[5] + vb / 26);
        gemm_tile<256, BNB, NT>(ALoadHalo{(const bf16_t*)a.p[0], DM, ht.t0 - lay.tbase, ht.row0, ht.L}, (const bf16_t*)a.p[1], DM, 0, (vb % 26) * BNB,
                                EpiIn1{lay, ht, (const float*)a.p[2], (const float*)a.p[3], (const float*)a.p[4], (bf16_t*)a.p[5], (bf16_t*)a.p[6], (bf16_t*)a.p[7], (float*)a.p[8]}, (char*)lds);
    } else if constexpr (PH == PH_COMBINE1) {
        n_combine1<NT>(lay, (const bf16_t*)a.p[0], (const bf16_t*)a.p[1], (const bf16_t*)a.p[2], (const bf16_t*)a.p[3], (const bf16_t*)a.p[4], (const float*)a.p[5], (const float*)a.p[6],
                       (const float*)a.p[7], (const float*)a.p[8], (bf16_t*)a.p[9], vb, (char*)lds);
    } else if constexpr (PH == PH_FINAL) {
        n_final<NT>(lay, (const float*)a.p[0], (const float*)a.p[1], (float*)a.p[2], vb, lds);
    } else if constexpr (PH == PH_CACHE) {
        n_cache_kv<NT>(lay, (const float*)a.p[0], (const float*)a.p[1], (bf16_t*)a.p[2], (bf16_t*)a.p[3], vb);
    } else if constexpr (PH == PH_WCONV) {
        n_wconv<NT>((const float*)a.p[0], a.i[5], a.i[6], (bf16_t*)a.p[1], a.i[7], a.i[8], a.i[9], vb, lds);
    } else if constexpr (PH == PH_ROPE) {
        n_rope_tables((float*)a.p[0], (float*)a.p[1], (float*)a.p[2], (float*)a.p[3]);
    } else if constexpr (PH == PH_RESNORM) {
        n_resnorm<NT>(lay, (const float*)a.p[0], (const float*)a.p[1], (const float*)a.p[2], (const float*)a.p[3], (const float*)a.p[4], a.i[5], a.i[6], (bf16_t*)a.p[5], vb, lds);
    } else if constexpr (PH == PH_GEMM_IN0) {
        gemm_tile<256, BNB, NT>(ALoadBF{(const bf16_t*)a.p[0], DM}, (const bf16_t*)a.p[1], DM, (vb / (1920 / BNB)) * 256, (vb % (1920 / BNB)) * BNB,
                                EpiIn0{lay, (bf16_t*)a.p[2], (bf16_t*)a.p[3], (bf16_t*)a.p[4], (bf16_t*)a.p[5], (float*)a.p[6], (float*)a.p[7], (const float*)a.p[8], (const float*)a.p[9]}, (char*)lds);
    } else if constexpr (PH == PH_TAIL) {
        n_l0_tail<NT>(lay, (const bf16_t*)a.p[0], (const float*)a.p[1], (const float*)a.p[2], (const float*)a.p[3], (const float*)a.p[4], (const float*)a.p[5], (const float*)a.p[6],
                      (bf16_t*)a.p[7], (bf16_t*)a.p[8], (bf16_t*)a.p[9], (float*)a.p[10], (float*)a.p[11], vb, lds);
    } else if constexpr (PH == PH_GEMM_UQ) {
        gemm_tile<256, BNB, NT>(ALoadBF{(const bf16_t*)a.p[0], 192}, (const bf16_t*)a.p[1], 192, (vb / (384 / BNB)) * 256, (vb % (384 / BNB)) * BNB,
                                EpiQb{lay, (bf16_t*)a.p[2], (const float*)a.p[3], (const float*)a.p[4]}, (char*)lds);
    } else if constexpr (PH == PH_GEMM_UKV) {
        gemm_tile<256, BNB, NT>(ALoadBF{(const bf16_t*)a.p[0], 128}, (const bf16_t*)a.p[1], 128, (vb / (768 / BNB)) * 256, (vb % (768 / BNB)) * BNB,
                                EpiKV{lay, (bf16_t*)a.p[2], (bf16_t*)a.p[3]}, (char*)lds);
    } else if constexpr (PH == PH_FLASH) {
        const bf16_t *Qa = (const bf16_t*)a.p[0], *Ka = (const bf16_t*)a.p[1], *VtA = (const bf16_t*)a.p[2], *Qb = (const bf16_t*)a.p[3], *Kb = (const bf16_t*)a.p[4], *VtB = (const bf16_t*)a.p[5];
        bf16_t *oa1h = (bf16_t*)a.p[6], *oa2h = (bf16_t*)a.p[7], *mrg16 = (bf16_t*)a.p[8];
        const int nqb = lay.Tloc / 128;
        const int mp = vb / (4 * nqb), hd = (vb / nqb) & 3, q0 = (vb % nqb) * 128;
        const TokInfo ti = tokinfo(lay.tbase + q0);
        const int tok0 = ti.t0 - lay.tbase, crow = lay.Tloc + (ti.latent ? (ti.seq - 16 - lay.b0) * 512 : 0);
        FlashP p;
        p.n0 = ti.latent ? 512 : 0; p.Lk = ti.L + p.n0; p.O = nullptr;
        if (mp < 2) {
            p.Q = Qa + hd * 128 + mp * 64; p.q_ld = 512;
            p.K0 = Ka + (size_t)crow * 512 + hd * 128 + mp * 64;
            p.K1 = Ka + (size_t)tok0 * 512 + hd * 128 + mp * 64; p.k_ld = 512;
            p.Vt = VtA + vt_off(lay, ti.seq, hd); p.vt_ld = ti.latent ? VLD : 256;
            p.Ob = (mp ? oa2h : oa1h) + hd * 128; p.o_ld = 512;
            p.c = 0.125f * 1.4426950408889634f;
            flash_item<64, NT, true>(p, q0, (char*)lds);
        } else {
            p.Q = Qb + hd * 96; p.q_ld = 384;
            p.K0 = Kb + (size_t)crow * 384 + hd * 96;
            p.K1 = Kb + (size_t)tok0 * 384 + hd * 96; p.k_ld = 384;
            p.Vt = VtB + vt_off(lay, ti.seq, hd); p.vt_ld = ti.latent ? VLD : 256;
            p.Ob = mrg16 + 512 + hd * 128; p.o_ld = DM;
            p.c = 0.10206207261596577f * 1.4426950408889634f;
            flash_item<96, NT, true>(p, q0, (char*)lds);
        }
    } else if constexpr (PH == PH_COMBINE0) {
        n_combine0<NT>((const bf16_t*)a.p[0], (const bf16_t*)a.p[1], (const float*)a.p[2], (const float*)a.p[3], (const float*)a.p[4], (const float*)a.p[5], (const float*)a.p[6], (bf16_t*)a.p[7], vb);
    } else if constexpr (PH == PH_GEMM_RES) {
        const EpiResid ep{lay, (const float*)a.p[2], (const float*)a.p[3], (const bf16_t*)a.p[4], (bf16_t*)a.p[5], (const float*)a.p[6], a.i[6]};
        const int m0 = (vb / (1024 / BNB)) * 256, n0 = (vb % (1024 / BNB)) * BNB;
        if (a.i[5] == DM) gemm_tile<256, BNB, NT>(ALoadBF{(const bf16_t*)a.p[0], DM}, (const bf16_t*)a.p[1], DM, m0, n0, ep, (char*)lds);
        else              gemm_tile<256, BNB, NT>(ALoadBF{(const bf16_t*)a.p[0], FF}, (const bf16_t*)a.p[1], FF, m0, n0, ep, (char*)lds);
    } else if constexpr (PH == PH_FFN_UP) {
        const HaloTile ht = halo_tile(a.i[5] + vb / (FF2 / BNB));
        gemm_tile<256, BNB, NT>(ALoadHalo{(const bf16_t*)a.p[0], DM, ht.t0 - lay.tbase, ht.row0, ht.L}, (const bf16_t*)a.p[1], DM, 0, (vb % (FF2 / BNB)) * BNB,
                                EpiFFNUp{lay, ht, (const float*)a.p[2], (const float*)a.p[3], (bf16_t*)a.p[4]}, (char*)lds);
    }
}

constexpr size_t al(size_t x) { return (x + 255) & ~(size_t)255; }
struct WS {
    static constexpr size_t BAR = 0;
    static constexpr size_t ZERO = al(BAR + 16384);
    static constexpr size_t MOD = al(ZERO + 4096);
    static constexpr size_t ROPE = al(MOD + 2 * 3 * 6144 * 4);
    static constexpr size_t H = al(ROPE + 3072 * 4);
    static constexpr size_t WT_IN0 = al(H + (size_t)TT * DM * 4);
    static constexpr size_t WT_OUT0 = al(WT_IN0 + (size_t)1920 * 1024 * 2);
    static constexpr size_t WT_OUT1 = al(WT_OUT0 + (size_t)1024 * 1024 * 2);
    static constexpr size_t WT_UP0 = al(WT_OUT1 + (size_t)1024 * 1024 * 2);
    static constexpr size_t WT_UP1 = al(WT_UP0 + (size_t)FF2 * 1024 * 2);
    static constexpr size_t WT_DN0 = al(WT_UP1 + (size_t)FF2 * 1024 * 2);
    static constexpr size_t WT_DN1 = al(WT_DN0 + (size_t)1024 * FF * 2);
    static constexpr size_t WT_UQ = al(WT_DN1 + (size_t)1024 * FF * 2);
    static constexpr size_t WT_UKV = al(WT_UQ + (size_t)384 * 192 * 2);
    static constexpr size_t WT_IN1 = al(WT_UKV + (size_t)768 * 128 * 2);
    static constexpr size_t W2T = al(WT_IN1 + (size_t)3328 * 1024 * 2);
    static constexpr size_t A2T = al(W2T + (size_t)2 * 512 * 64 * 2);
    static constexpr size_t G2T = al(A2T + (size_t)2 * 512 * 64 * 2);
    static constexpr size_t HN = al(G2T + (size_t)512 * 128 * 2);
    static constexpr size_t BIG = al(HN + (size_t)TT * DM * 2);
    static constexpr size_t TAIL = BIG;
    static constexpr size_t QA = al(TAIL + (size_t)TT * 384 * 2);
    static constexpr size_t KA = al(QA + (size_t)TT * 512 * 2);
    static constexpr size_t VTA = al(KA + (size_t)(TT + 1024) * 512 * 2);
    static constexpr size_t VT_ELEMS = (size_t)16 * 4 * 128 * 256 + (size_t)2 * 4 * 128 * VLD;
    static constexpr size_t QDN = al(VTA + VT_ELEMS * 2);
    static constexpr size_t CKVN = al(QDN + (size_t)TT * 192 * 2);
    static constexpr size_t QB = al(CKVN + (size_t)(TT + 1024) * 128 * 2);
    static constexpr size_t KB = al(QB + (size_t)TT * 384 * 2);
    static constexpr size_t VTB = al(KB + (size_t)(TT + 1024) * 384 * 2);
    static constexpr size_t OA1 = al(VTB + VT_ELEMS * 2);
    static constexpr size_t OA2 = al(OA1 + (size_t)TT * 512 * 2);
    static constexpr size_t END0 = al(OA2 + (size_t)TT * 512 * 2);
    static constexpr size_t ZCM = BIG;
    static constexpr size_t ZG = al(ZCM + (size_t)TT * CC * 2);
    static constexpr size_t XC = al(ZG + (size_t)TT * 512 * 2);
    static constexpr size_t DTR = al(XC + (size_t)TT * 768 * 2);
    static constexpr size_t Y16 = al(DTR + (size_t)TT * 8 * 4);
    static constexpr size_t YD16 = al(Y16 + (size_t)2 * TT * 512 * 2);
    static constexpr size_t SEG_IZ = al(YD16 + (size_t)2 * TT * 512 * 2);
    static constexpr size_t SEG_E0 = al(SEG_IZ + 2 * 16384);
    static constexpr size_t SEG_PQ = al(SEG_E0 + 32 * 16384);
    static constexpr size_t SEG_SI = al(SEG_PQ + 192 * 16384);
    static constexpr size_t SEG_HS = al(SEG_SI + 128 * 16384);
    static constexpr size_t END1 = al(SEG_HS + 32 * 16384);
    static constexpr size_t ACT = BIG;
    static constexpr size_t END2 = al(ACT + (size_t)TT * FF * 2);
    static constexpr size_t TOTAL = END0 > END1 ? (END0 > END2 ? END0 : END2) : (END1 > END2 ? END1 : END2);
};
static_assert(WS::TOTAL <= (size_t)256 * 1024 * 1024, "workspace map exceeds the guaranteed 256 MiB");


__device__ __forceinline__ int xcd_remap(int vb, int n) {
    const int q = n >> 3, r = n & 7, x = vb & 7, o = vb >> 3;
    return (x < r ? x * (q + 1) : r * (q + 1) + (x - r) * q) + o;
}

struct MP { const float* in[59]; float* out; char* ws; };


__device__ __forceinline__ char* launder_c(char* p) { size_t z = 0; asm volatile("" : "+s"(z)); return p + z; }
__device__ __forceinline__ float* launder_f(float* p) { size_t z = 0; asm volatile("" : "+s"(z)); return p + z; }
__device__ __forceinline__ int bid_opaque() { int b = blockIdx.x; asm volatile("" : "+s"(b)); return b; }
typedef const __attribute__((address_space(1))) float* gcfptr;
struct InTab {
    const char* base;
    __device__ __forceinline__ const float* operator[](int k) const { return (const float*)(gcfptr)(((const float* const*)base)[k]); }
};
__device__ __forceinline__ InTab in_tab() { size_t z = 0; asm volatile("" : "+s"(z)); return InTab{(const char*)__builtin_amdgcn_kernarg_segment_ptr() + z}; }
#define PH_BEGIN(NVB) for (int vb = bid_opaque(); vb < (NVB); vb += gridDim.x) { char* ws = launder_c(ws0); float* out = launder_f(out0); const InTab in = in_tab(); (void)ws; (void)out; (void)in;
#define PH_END } xcd_barrier(xb);
#define PH_NEXT(NVB) } for (int vb = bid_opaque(); vb < (NVB); vb += gridDim.x) { char* ws = launder_c(ws0); float* out = launder_f(out0); const InTab in = in_tab(); (void)ws; (void)out; (void)in;

#define mod ((float*)(ws + WS::MOD))
#define h ((bf16_t*)(ws + WS::H))
#define wt_in0 ((bf16_t*)(ws + WS::WT_IN0))
#define wt_uq ((bf16_t*)(ws + WS::WT_UQ))
#define wt_ukv ((bf16_t*)(ws + WS::WT_UKV))
#define wt_in1 ((bf16_t*)(ws + WS::WT_IN1))
#define w2t ((bf16_t*)(ws + WS::W2T))
#define a2t ((bf16_t*)(ws + WS::A2T))
#define g2t ((bf16_t*)(ws + WS::G2T))
#define hn16 ((bf16_t*)(ws + WS::HN))
#define act16 ((bf16_t*)(ws + WS::ACT))
#define tail16 ((bf16_t*)(ws + WS::TAIL))
#define Qa ((bf16_t*)(ws + WS::QA))
#define Ka ((bf16_t*)(ws + WS::KA))
#define VtA ((bf16_t*)(ws + WS::VTA))
#define qdn16 ((bf16_t*)(ws + WS::QDN))
#define ckvn16 ((bf16_t*)(ws + WS::CKVN))
#define Qb ((bf16_t*)(ws + WS::QB))
#define Kb ((bf16_t*)(ws + WS::KB))
#define VtB ((bf16_t*)(ws + WS::VTB))
#define oa1h ((bf16_t*)(ws + WS::OA1))
#define oa2h ((bf16_t*)(ws + WS::OA2))
#define zcm16 ((bf16_t*)(ws + WS::ZCM))
#define zg16 ((bf16_t*)(ws + WS::ZG))
#define xc16 ((bf16_t*)(ws + WS::XC))
#define dtr ((float*)(ws + WS::DTR))
#define y16 ((bf16_t*)(ws + WS::Y16))
#define yd16 ((bf16_t*)(ws + WS::YD16))
#define c64 ((float*)(ws + WS::ROPE))
#define s64 ((float*)(ws + WS::ROPE) + 1024)
#define c32 ((float*)(ws + WS::ROPE) + 2048)
#define s32 ((float*)(ws + WS::ROPE) + 2560)
#define mrg16 ((bf16_t*)(ws + WS::HN))
#define o_k (out + (size_t)TT * DM)
#define o_v (o_k + 16 * 4 * 256 * 128)
#define o_ckv (o_v + 16 * 4 * 256 * 128)
#define o_kpe (o_ckv + 16 * 256 * 128)
#define o_wf (o_kpe + 16 * 256 * 32)
#define o_wb (o_wf + 16 * 8 * 64 * 64)
#define o_sf (o_wb + 16 * 8 * 64 * 64)
#define o_sb (o_sf + 16 * 8 * 64 * 64)
__global__ void __launch_bounds__(512) mega(MP P) {
    constexpr int NT = 512, BNB = 128, TPB = 2;
    __shared__ __attribute__((aligned(16))) float lds[LDS_BYTES / 4];
    volatile LAS unsigned* st = (volatile LAS unsigned*)(lds + LDS_BYTES / 4 - 4);
    if (TIDX == 0) { st[0] = 0u; st[1] = 0u; st[2] = 0u; st[3] = 0u; }
    __syncthreads();
    XcdBarrier xb = xcd_barrier_post((unsigned*)P.ws, st);
    const InTab in = in_tab();
    char* const ws0 = P.ws;
    float* const out0 = P.out;
    char* ws = ws0;
    float* out = out0;
    const Lay lay{0, TT, 0, 0, 2};
    constexpr int NCR = 1024, MT = TT / 256, MTC = (TT + NCR) / 256, NHT = 50;

    for (int rp0_ = 0; rp0_ < REP_P0; ++rp0_) {
    constexpr int P_IN0 = 16 * 30 / TPB / 2, P_UP0 = 16 * 88 / TPB / 2, P_DN0 = 44 * 16 / TPB / 2, P_OUT0 = 16 * 16 / TPB / 2, P_UQ = 5, P_UKV = 6, P_W2 = 4, P_A2 = 4, P_G2 = 4, P_CV = 32;
    constexpr int Q1 = P_IN0, Q2 = Q1 + P_UP0, Q3 = Q2 + P_DN0, Q4 = Q3 + P_OUT0, Q5 = Q4 + P_UQ, Q6 = Q5 + P_UKV, Q7 = Q6 + P_W2, Q8 = Q7 + P_A2, Q9 = Q8 + P_G2, Q10 = Q9 + P_CV;
    constexpr int QA = Q10 + 2 * 96, QK = QA + 2 * 512 * 128 / NT, QT = QK + 1;
    PH_BEGIN(QT)
        if (vb < Q10) {
            const float* W; bf16_t* Wt; int K_, N_, Np_, mode_ = 0, gh_ = 0, it_, ldo_ = 0;
            if (vb < Q1)      { W = in[20]; Wt = wt_in0; K_ = 1024; N_ = N0; Np_ = 1920; it_ = vb * 2; }
            else if (vb < Q2) { W = in[16]; Wt = (bf16_t*)(ws + WS::WT_UP0); K_ = 1024; N_ = FF2; Np_ = FF2; mode_ = 1; gh_ = BNB / 2; it_ = (vb - Q1) * 2; }
            else if (vb < Q3) { W = in[19]; Wt = (bf16_t*)(ws + WS::WT_DN0); K_ = FF; N_ = 1024; Np_ = 1024; it_ = (vb - Q2) * 2; }
            else if (vb < Q4) { W = in[30]; Wt = (bf16_t*)(ws + WS::WT_OUT0); K_ = 1024; N_ = 1024; Np_ = 1024; it_ = (vb - Q3) * 2; }
            else if (vb < Q5) { W = in[27]; Wt = wt_uq; K_ = 192; N_ = 384; Np_ = 384; it_ = (vb - Q4) * 2; }
            else if (vb < Q6) { W = in[29]; Wt = wt_ukv; K_ = 128; N_ = 768; Np_ = 768; mode_ = 2; it_ = (vb - Q5) * 2; }
            else if (vb < Q7) { const int j = vb - Q6; W = in[42] + (size_t)(j >> 1) * 64 * 512; Wt = w2t + (size_t)(j >> 1) * 512 * 64; K_ = 64; N_ = 512; Np_ = 512; it_ = (j & 1) * 2; }
            else if (vb < Q8) { const int j = vb - Q7; W = in[44] + (size_t)(j >> 1) * 64 * 512; Wt = a2t + (size_t)(j >> 1) * 512 * 64; K_ = 64; N_ = 512; Np_ = 512; it_ = (j & 1) * 2; }
            else if (vb < Q9) { W = in[45]; Wt = g2t; K_ = 128; N_ = 512; Np_ = 512; it_ = (vb - Q8) * 2; }
            else {
                const int j = vb - Q9; W = in[3] + (size_t)(j >> 2) * 512 * 128; Wt = VtA + vt_off(lay, 16 + (j >> 4), (j >> 2) & 3); K_ = 512; N_ = 128; Np_ = 128; it_ = (j & 3) * 2; ldo_ = VLD;
            }
            n_wconv_multi<NT, 2>(W, K_, N_, Wt, Np_, mode_, gh_, it_, lds, ldo_);
        } else if (vb < QA) n_ada<NT>(in[10], in[11], in[12], in[13], in[31], in[32], mod, vb - Q10, lds);
        else if (vb < QK) n_cache_k4<NT>(lay, in[2], Ka, vb - QA);
        else n_rope_tables(c64, s64, c32, s32);
    PH_END

    }
    constexpr int CV_IN1 = 16 * 52 / TPB, CV_OUT = 16 * 16 / TPB, CV_UP = 16 * 88 / TPB, CV_DN = 44 * 16 / TPB;
    static_assert(CV_IN1 % 2 == 0 && CV_OUT % 2 == 0 && CV_UP % 2 == 0 && CV_DN % 2 == 0, "item pairs must not straddle two weights");
#define CONV_PAIR(c_) { const int cc_ = (c_); \
        const float* W; bf16_t* Wt; int K_, N_, Np_, mode_, gh_, it_; \
        if (cc_ < CV_IN1) { W = in[39]; Wt = wt_in1; K_ = 1024; N_ = N1; Np_ = 3328; mode_ = 0; gh_ = 0; it_ = cc_; } \
        else if (cc_ < CV_IN1 + CV_OUT) { W = in[57]; Wt = (bf16_t*)(ws + WS::WT_OUT1); K_ = 1024; N_ = 1024; Np_ = 1024; mode_ = 0; gh_ = 0; it_ = cc_ - CV_IN1; } \
        else if (cc_ < CV_IN1 + CV_OUT + CV_UP) { W = in[35]; Wt = (bf16_t*)(ws + WS::WT_UP1); K_ = 1024; N_ = FF2; Np_ = FF2; mode_ = 1; gh_ = BNB / 2; it_ = cc_ - CV_IN1 - CV_OUT; } \
        else { W = in[38]; Wt = (bf16_t*)(ws + WS::WT_DN1); K_ = FF; N_ = 1024; Np_ = 1024; mode_ = 0; gh_ = 0; it_ = cc_ - CV_IN1 - CV_OUT - CV_UP; } \
        n_wconv_multi<NT, 2>(W, K_, N_, Wt, Np_, mode_, gh_, it_, lds); }
    for (int l = 0; l < 2; ++l) {
        const float* modl = mod + (size_t)l * 3 * 6144;
        const int cb = l ? 31 : 12;
#define wt_out ((const bf16_t*)(ws + (l ? WS::WT_OUT1 : WS::WT_OUT0)))
#define wt_up ((const bf16_t*)(ws + (l ? WS::WT_UP1 : WS::WT_UP0)))
#define wt_dn ((const bf16_t*)(ws + (l ? WS::WT_DN1 : WS::WT_DN0)))
        PH_BEGIN(TT / 16)
            n_resnorm_w2<NT>(lay, in[0], in[1], l ? h : nullptr, in[cb + 2], modl, 0, 1024, hn16, vb);
        PH_END
        if (l == 0) {
            PH_BEGIN(MT * (1920 / BNB))
                const int tb = xcd_remap(vb, MT * (1920 / BNB));
                gemm_tile<256, BNB, NT>(ALoadBF{hn16, DM}, wt_in0, DM, (tb / (1920 / BNB)) * 256, (tb % (1920 / BNB)) * BNB,
                                        EpiIn0{lay, Qa, Ka, VtA, tail16, o_k, o_v, c64, s64}, (char*)lds);
            PH_END
            PH_BEGIN((TT + NCR) / 8)
                n_l0_tail_w<NT>(lay, tail16, in[26], in[28], in[4], in[5], c32, s32, qdn16, ckvn16, Kb, o_ckv, o_kpe, vb);
            PH_END
            constexpr int UQT = MT * (384 / BNB), UKT = MTC * (768 / BNB);
            PH_BEGIN(UQT + UKT)
                if (vb < UKT) gemm_tile<256, BNB, NT>(ALoadBF{ckvn16, 128}, wt_ukv, 128, (vb / (768 / BNB)) * 256, (vb % (768 / BNB)) * BNB, EpiKV{lay, Kb, VtB}, (char*)lds);
                else { const int u = vb - UKT; gemm_tile<256, BNB, NT>(ALoadBF{qdn16, 192}, wt_uq, 192, (u / (384 / BNB)) * 256, (u % (384 / BNB)) * BNB, EpiQb{lay, Qb, c32, s32}, (char*)lds); }
            PH_END
            for (int rep_ = 0; rep_ < REP_FLASH; ++rep_) {
            for (int vb = bid_opaque(); vb < 1152; vb += gridDim.x) { char* ws = launder_c(ws0); float* out = launder_f(out0); const InTab in = in_tab(); (void)ws; (void)out; (void)in;
                int mp, hd, q0;
                if (vb < 768) {
                    const int r = vb >> 8, b = vb & 255, x = b & 7, j = b >> 3;
                    int batch;
                    if (r == 0) { mp = 2; hd = x & 3; batch = x >> 2; }
                    else { const int a = 2 * x + (r - 1); batch = a >> 3; hd = (a >> 1) & 3; mp = a & 1; }
                    q0 = 4096 + batch * 4096 + j * 128;
                } else { const int j = vb - 768; mp = j >> 7; hd = (j >> 5) & 3; q0 = (j & 31) * 128; }
                const TokInfo ti = tokinfo(q0);
                const int crow = TT + (ti.latent ? (ti.seq - 16) * 512 : 0);
                FlashP p;
                p.n0 = ti.latent ? 512 : 0; p.Lk = ti.L + p.n0; p.O = nullptr;
                if (mp < 2) {
                    p.Q = Qa + hd * 128 + mp * 64; p.q_ld = 512;
                    p.K0 = Ka + (size_t)crow * 512 + hd * 128 + mp * 64;
                    p.K1 = Ka + (size_t)ti.t0 * 512 + hd * 128 + mp * 64; p.k_ld = 512;
                    p.Vt = VtA + vt_off(lay, ti.seq, hd); p.vt_ld = ti.latent ? VLD : 256;
                    p.Ob = (mp ? oa2h : oa1h) + hd * 128; p.o_ld = 512;
                    p.c = 0.125f * 1.4426950408889634f;
                    flash_item<64, NT, true>(p, q0, (char*)lds);
                } else {
                    p.Q = Qb + hd * 96; p.q_ld = 384;
                    p.K0 = Kb + (size_t)crow * 384 + hd * 96;
                    p.K1 = Kb + (size_t)ti.t0 * 384 + hd * 96; p.k_ld = 384;
                    p.Vt = VtB + vt_off(lay, ti.seq, hd); p.vt_ld = ti.latent ? VLD : 256;
                    p.Ob = mrg16 + 512 + hd * 128; p.o_ld = DM;
                    p.c = 0.10206207261596577f * 1.4426950408889634f;
                    flash_item<96, NT, true>(p, q0, (char*)lds);
                }
            PH_END
            }
            PH_BEGIN(TT / TPB / 4)
                n_combine0_m<NT, 4>(oa1h, oa2h, in[21], in[22], in[23], in[24], in[25], mrg16, vb);
            PH_END
        } else {
            {
                float* segf = (float*)(ws + WS::SEG_IZ);
                for (int i = blockIdx.x * NT + TIDX; i < 8192; i += gridDim.x * NT) segf[i] = (i < 4096 && (i >> 6) == (i & 63)) ? 1.f : 0.f;
            }
            constexpr int IN1T = NHT * 13, IN1L = IN1T - 512, IN1F = 256 - IN1L, CVP = (CV_OUT + CV_UP + CV_DN) / 2;
            PH_BEGIN(256 * (2 + (CVP + IN1F - 1) / IN1F))
                const int slot = vb & 255, rnd = vb >> 8;
                if (vb < IN1T) {
                    const int tb = xcd_remap(vb, IN1T);
                    const HaloTile ht = halo_tile(tb / 13);
                    gemm256_tile<NT>(ALoadHalo{hn16, DM, ht.t0, ht.row0, ht.L, (const bf16_t*)(ws + WS::ZERO)}, wt_in1, DM, (tb % 13) * 256,
                                     EpiIn1{lay, ht, in[40], in[51], in[52], zcm16, zg16, xc16, dtr}, (char*)lds);
                } else if (slot >= IN1L) {
                    const int p = (slot - IN1L) + IN1F * (rnd - 2);
                    if (p < CVP) CONV_PAIR(CV_IN1 + 2 * p)
                }
            PH_END
            for (int rep_ = 0; rep_ < REP_SCAN; ++rep_)
            for (int pass = 0; pass < 2; ++pass) {
            for (int vb = bid_opaque();; vb += gridDim.x) { char* ws = launder_c(ws0); float* out = launder_f(out0); const InTab in = in_tab(); (void)ws; (void)out; (void)in;
                if (pass == 1) {
                    __syncthreads();
                    if (TIDX == 0) st[3] = xb_add((unsigned*)ws0, 1u);
                    __syncthreads();
                    vb = __builtin_amdgcn_readfirstlane((int)st[3]);
                }
                if (vb >= (pass == 0 ? 256 : 672)) break;
                const int slot = vb & 255, rnd = vb >> 8;
                int kind = 0, item = 0, c0 = 0, c1 = 0, pq = 0, nst = 0;
                const float* sinit = nullptr; float* send = nullptr; const float* pqsrc = nullptr; const float* e0src = nullptr; float* siout = nullptr;
                float* segf = (float*)(ws + WS::SEG_IZ);
                float* e0b = (float*)(ws + WS::SEG_E0); float* pqb = (float*)(ws + WS::SEG_PQ); float* sib = (float*)(ws + WS::SEG_SI); float* hsb = (float*)(ws + WS::SEG_HS);
                constexpr int SSD_CUT = 31;
                if (pass == 0) {
                    if (slot < 32) { kind = 1; item = ((16 + (slot >> 4)) << 4) | (slot & 15); c0 = 0; c1 = 12; send = e0b + (size_t)slot * 4096; }
                    else if (slot < 224) {
                        const int j = slot - 32, chain = j / 6, rem = j - chain * 6, seg = 1 + (rem >> 1); pq = 1 + (rem & 1);
                        kind = 1; item = ((16 + (chain >> 4)) << 4) | (chain & 15); c0 = 12 + 13 * (seg - 1); c1 = c0 + 13;
                        sinit = segf + (pq == 1 ? 0 : 4096); send = pqb + ((size_t)(chain * 3 + seg - 1) * 2 + (pq - 1)) * 4096;
                    } else { const int chain = slot - 224; kind = 2; item = ((16 + (chain >> 4)) << 4) | (chain & 15); c0 = 0; c1 = SSD_CUT; send = hsb + (size_t)chain * 4096; }
                } else {
                    if (vb < 128) {
                        const int chain = vb & 31, seg = 4 - (vb >> 5);
                        kind = 1; item = ((16 + (chain >> 4)) << 4) | (chain & 15); c0 = 12 + 13 * (seg - 1); c1 = c0 + 13;
                        e0src = e0b + (size_t)chain * 4096; pqsrc = pqb + (size_t)chain * 6 * 4096; nst = seg - 1; siout = sib + (size_t)vb * 4096;
                        sinit = nst ? siout : e0src;
                    } else if (vb < 160) { const int chain = vb - 128; kind = 2; item = ((16 + (chain >> 4)) << 4) | (chain & 15); c0 = SSD_CUT; c1 = 64; sinit = hsb + (size_t)chain * 4096; }
                    else if (vb < 416) { kind = 1; item = vb - 160; c0 = 0; c1 = 4; }
                    else { kind = 2; item = vb - 416; c0 = 0; c1 = 4; }
                }
                if (kind == 1) {
                    if (nst) wkv_seg_init<NT>(e0src, pqsrc, nst, siout, (char*)lds);
                    n_wkv3<NT>(lay, zcm16, w2t, a2t, in[41], in[43], in[46], in[47], in[6], in[7], y16, o_wf, o_wb, item, (char*)lds, c0, c1, sinit, pq, send);
                } else if (kind == 2) {
                    n_ssd2<NT>(lay, xc16, dtr, in[53], in[54], in[55], in[8], in[9], yd16, o_sf, o_sb, item, (char*)lds, c0, c1, sinit, send);
                }
            PH_END
            }
            PH_BEGIN(TT / 48)
                n_combine1<NT, 3>(lay, zcm16, g2t, y16, yd16, zg16, in[48], in[49], in[50], in[56], mrg16, vb, (char*)lds);
            PH_END
        }
        PH_BEGIN((TT / 128) * 8)
            const int tb = xcd_remap(vb, (TT / 128) * 8);
            gemm_tile<128, 128, NT, ALoadBF, EpiResid, 4>(ALoadBF{mrg16, DM}, wt_out, DM, (tb >> 3) * 128, (tb & 7) * 128,
                                    EpiResid{lay, in[0], in[1], l ? h : nullptr, h, modl, 2048}, (char*)lds);
        PH_END
        PH_BEGIN(TT / 16)
            n_resnorm_w2<NT>(lay, in[0], in[1], h, in[cb + 3], modl, 3072, 4096, hn16, vb);
        PH_END
        for (int rep_ = 0; rep_ < REP_UP; ++rep_) {
        constexpr int UPT = NHT * (FF2 / 256), UPF = (UPT / 256) * 256;
        PH_BEGIN(l == 0 ? 256 * 6 : UPF + 2 * (UPT - UPF))
            const int slot = vb & 255, rnd = vb >> 8;
            if (vb < UPF) {
                const int tb = xcd_remap(vb, UPF);
                const HaloTile ht = halo_tile(tb / (FF2 / 256));
                gemm256_tile<NT>(ALoadHalo{hn16, DM, ht.t0, ht.row0, ht.L, (const bf16_t*)(ws + WS::ZERO)}, wt_up, DM, (tb % (FF2 / 256)) * 256,
                                 EpiFFNUp{lay, ht, in[cb + 5], in[cb + 6], act16}, (char*)lds);
            } else if (rnd == 4 && slot < 2 * (UPT - UPF)) {
                const int v2 = slot, tb = UPF + (v2 >> 1);
                const HaloTile ht = halo_tile(tb / (FF2 / 256));
                gemm_tile<256, BNB, NT>(ALoadHalo{hn16, DM, ht.t0, ht.row0, ht.L, (const bf16_t*)(ws + WS::ZERO)}, wt_up, DM, 0, ((tb % (FF2 / 256)) * 2 + (v2 & 1)) * BNB,
                                        EpiFFNUp{lay, ht, in[cb + 5], in[cb + 6], act16}, (char*)lds);
            } else if (slot >= 2 * (UPT - UPF)) {
                const int p = (slot - 2 * (UPT - UPF)) + (256 - 2 * (UPT - UPF)) * (rnd - 4);
                if (p < CV_IN1 / 2) CONV_PAIR(2 * p)
            }
        PH_END
        }
        PH_BEGIN(256)
            const int tb = xcd_remap(vb, 256);
            gemm256_tile<NT, ALoadBF, EpiResid256<96>, 96>(ALoadBF{act16 + (size_t)(tb >> 2) * 192 * FF, FF}, wt_dn, FF, (tb & 3) * 256,
                             EpiResid256<96>{EpiResid{lay, in[0], in[1], h, h, modl, 5120}, (tb >> 2) * 192}, (char*)lds);
        PH_END
    }
    PH_BEGIN(TT / 16)
        n_final_w2<NT>(lay, h, in[58], out, vb);
    }
}
#undef mod
#undef h
#undef wt_in0
#undef wt_uq
#undef wt_ukv
#undef wt_in1
#undef w2t
#undef a2t
#undef g2t
#undef hn16
#undef act16
#undef tail16
#undef Qa
#undef Ka
#undef VtA
#undef qdn16
#undef ckvn16
#undef Qb
#undef Kb
#undef VtB
#undef oa1h
#undef oa2h
#undef zcm16
#undef zg16
#undef xc16
#undef dtr
#undef y16
#undef yd16
#undef c64
#undef s64
#undef c32
#undef s32
#undef mrg16
#undef o_k
#undef o_v
#undef o_ckv
#undef o_kpe
#undef o_wf
#undef o_wb
#undef o_sf
#undef o_sb
#undef wt_out
#undef wt_up
#undef wt_dn
}

extern "C" void kernel_launch(void* const* d_in, const int* in_sizes, int n_in, void* d_out, int out_size, void* d_ws, size_t ws_size,
                              hipStream_t stream) {
    if (n_in != 59 || ws_size < WS::TOTAL) return;
    static int grid = 0;
    if (grid == 0) {
        int dev = 0, cus = 0, per_cu = 0;
        (void)hipGetDevice(&dev);
        (void)hipDeviceGetAttribute(&cus, hipDeviceAttributeMultiprocessorCount, dev);
        (void)hipOccupancyMaxActiveBlocksPerMultiprocessor(&per_cu, (const void*)mega, 512, 0);
        grid = (per_cu >= 1) ? cus : 0;
        if (grid <= 0) grid = -1;
    }
    if (grid < 0) return;
    MP P{};
    for (int i = 0; i < 59; ++i) P.in[i] = (const float*)d_in[i];
    P.out = (float*)d_out;
    P.ws = (char*)d_ws;
    (void)hipMemsetAsync(d_ws, 0, WS::ZERO + 4096, stream);
    hipLaunchKernelGGL(mega, dim3(grid), dim3(512), 0, stream, P);
}
```

```cpp
#include <hip/hip_runtime.h>
#include <math.h>

namespace {
constexpr int DM = 1024, FF = 2816, FF2 = 5632;
constexpr int N0 = 1888, N1 = 3208, CC = 1920;
constexpr int TT = 12288;
constexpr float EPS = 1e-6f;
constexpr int LDS_BYTES = 151040;
#ifndef REP_UP
#define REP_UP 1
#endif
#ifndef REP_FLASH
#define REP_FLASH 1
#endif
#ifndef REP_W567
#define REP_W567 1
#endif
#ifndef REP_W2
#define REP_W2 1
#endif
#ifndef REP_W4
#define REP_W4 1
#endif
#ifndef REP_P0
#define REP_P0 1
#endif
#ifndef REP_SCAN
#define REP_SCAN 1
#endif

__device__ __forceinline__ int tid_opaque() { int t = threadIdx.x; asm volatile("" : "+v"(t)); return t; }
#define TIDX tid_opaque()

#define XB_TMO      128
#define XB_XCNT(j)  (256  + 64 * (j))
#define XB_XSUB(j)  (1280 + 64 * (j))
#define XB_XGEN(j)  (2304 + 64 * (j))
#define XB_TOP      3328
#define XB_TOPGEN   3392
#define XCD_BAR_WORDS 3456
#define XB_SPIN_CAP (1u << 22)
#define LAS __attribute__((address_space(3)))
__device__ __forceinline__ unsigned xb_ld(unsigned* p)              { return __hip_atomic_load(p, __ATOMIC_RELAXED, __HIP_MEMORY_SCOPE_AGENT); }
__device__ __forceinline__ unsigned xb_add(unsigned* p, unsigned v) { return __hip_atomic_fetch_add(p, v, __ATOMIC_RELAXED, __HIP_MEMORY_SCOPE_AGENT); }
__device__ __forceinline__ unsigned xb_xcc_id() { return (unsigned)__builtin_amdgcn_s_getreg((3 << 11) | 20) & 0xFu; }
#define XB_SPIN(cond, bar) do { unsigned _sp = 0; while (cond) { __builtin_amdgcn_s_sleep(1); \
    if ((++_sp & 255u) == 0u) { if (xb_ld(&(bar)[XB_TMO])) break; if (_sp > XB_SPIN_CAP) { atomicAdd(&(bar)[XB_TMO], 1u); break; } } } } while (0)
struct XcdBarrier { unsigned* bar; unsigned x; volatile LAS unsigned* st; };
__device__ __forceinline__ XcdBarrier xcd_barrier_post(unsigned* bar, volatile LAS unsigned* st) {
    XcdBarrier b; b.bar = bar; b.x = xb_xcc_id(); b.st = st;
    if (TIDX == 0) st[2] = xb_add(&bar[XB_XCNT(b.x)], 1u);
    return b;
}
__device__ __forceinline__ void xcd_barrier_complete(unsigned* bar, unsigned x, unsigned& nloc, unsigned& nx) {
    asm volatile("" : "+s"(x));
    const unsigned G = gridDim.x * gridDim.y * gridDim.z;
    unsigned sum, cnt, mine, sp = 0u;
    for (;;) {
        sum = 0u; cnt = 0u; mine = 0u;
#pragma unroll
        for (unsigned j = 0; j < 16; ++j) { const unsigned c = xb_ld(&bar[XB_XCNT(j)]); sum += c; cnt += (c > 0u) ? 1u : 0u; mine = (j == x) ? c : mine; }
        if (sum == G) break;
        __builtin_amdgcn_s_sleep(1);
        if ((++sp & 255u) == 0u) { if (xb_ld(&bar[XB_TMO])) break; if (sp > XB_SPIN_CAP) { atomicAdd(&bar[XB_TMO], 1u); break; } }
    }
    nloc = mine > 0u ? mine : 1u; nx = cnt > 0u ? cnt : 1u;
}
__device__ __forceinline__ int xcd_hw_index(const XcdBarrier& b) {
    if (TIDX == 0) {
        bool ok = gridDim.x == 256u;
#pragma unroll
        for (unsigned j = 0; j < 16; ++j) { const unsigned c = xb_ld(&b.bar[XB_XCNT(j)]); ok = ok && (j < 8u ? c == 32u : c == 0u); }
        const unsigned rank = b.st[2];
        b.st[3] = (ok && rank < 32u && b.x < 8u) ? rank * 8u + b.x : 0xFFFFFFFFu;
    }
    __syncthreads();
    const int r = (int)b.st[3];
    __syncthreads();
    return r;
}
__device__ __forceinline__ void xcd_barrier(const XcdBarrier& b) {
    asm volatile("s_waitcnt vmcnt(0)" ::: "memory");
    __syncthreads();
    if (TIDX == 0) {
        unsigned* bar = b.bar;
        __builtin_amdgcn_s_waitcnt(0);
        unsigned nloc = b.st[0], nx = b.st[1];
        if (nloc == 0u) { xcd_barrier_complete(bar, b.x, nloc, nx); b.st[0] = nloc; b.st[1] = nx; }
        const unsigned old = xb_add(&bar[XB_XSUB(b.x)], 1u);
        const unsigned gen = old / nloc;
        if (old + 1u == (gen + 1u) * nloc) {
            __builtin_amdgcn_fence(__ATOMIC_RELEASE, "agent");
            asm volatile("s_waitcnt vmcnt(0)" ::: "memory");
            const unsigned og = xb_add(&bar[XB_TOP], 1u);
            const unsigned tg = og / nx;
            if (og + 1u == (tg + 1u) * nx) xb_add(&bar[XB_TOPGEN], 1u);
            else XB_SPIN(xb_ld(&bar[XB_TOPGEN]) == tg, bar);
            __builtin_amdgcn_fence(__ATOMIC_ACQUIRE, "agent");
            xb_add(&bar[XB_XGEN(b.x)], 1u);
            asm volatile("s_waitcnt vmcnt(0)" ::: "memory");
        } else {
            XB_SPIN(xb_ld(&bar[XB_XGEN(b.x)]) == gen, bar);
            __builtin_amdgcn_fence(__ATOMIC_ACQUIRE, "agent");
            asm volatile("s_waitcnt vmcnt(0)" ::: "memory");
        }
    }
    __syncthreads();
}

__device__ __forceinline__ float silu_f(float x) { return x / (1.f + expf(-x)); }
__device__ __forceinline__ float sigmoid_f(float x) { return 1.f / (1.f + expf(-x)); }
template <int CTRL> __device__ __forceinline__ float dpp_mov(float x) {
    return __builtin_bit_cast(float, __builtin_amdgcn_mov_dpp(__builtin_bit_cast(int, x), CTRL, 0xF, 0xF, true));
}
__device__ __forceinline__ float wave_sum(float v) {
    v += dpp_mov<0xB1>(v);
    v += dpp_mov<0x4E>(v);
    v += dpp_mov<0x141>(v);
    v += dpp_mov<0x140>(v);
    v += __builtin_bit_cast(float, __builtin_amdgcn_update_dpp(0, __builtin_bit_cast(int, v), 0x142, 0xA, 0xF, false));
    v += __builtin_bit_cast(float, __builtin_amdgcn_update_dpp(0, __builtin_bit_cast(int, v), 0x143, 0xC, 0xF, false));
    return __builtin_bit_cast(float, __builtin_amdgcn_readlane(__builtin_bit_cast(int, v), 63));
}
__device__ __forceinline__ float block_sum256(float v, float* sh) {
    v = wave_sum(v);
    __syncthreads();
    if ((TIDX & 63) == 0) sh[TIDX >> 6] = v;
    __syncthreads();
    return sh[0] + sh[1] + sh[2] + sh[3];
}

template <int NT>
__device__ __forceinline__ void n_ada(const float* __restrict__ c, const float* __restrict__ c_ctx, const float* __restrict__ W0, const float* __restrict__ b0,
                                      const float* __restrict__ W1, const float* __restrict__ b1, float* __restrict__ mod, int vb, float* lds) {
    const int tid = TIDX, col = tid & 63, kp = tid >> 6;
    const int l = vb / 96, j = (vb % 96) * 64 + col;
    const float* W = (l ? W1 : W0) + j;
    float* sc = lds + 2048;
    __syncthreads();
    for (int i = tid; i < 3072; i += NT) sc[i] = silu_f(i < 1024 ? c_ctx[i] : c[i - 1024]);
    __syncthreads();
    float s0 = 0.f, s1 = 0.f, s2 = 0.f;
#pragma unroll 8
    for (int k = kp * 128; k < kp * 128 + 128; ++k) {
        const float w = W[(size_t)k * 6144];
        s0 += sc[k] * w; s1 += sc[1024 + k] * w; s2 += sc[2048 + k] * w;
    }
    __syncthreads();
    lds[(kp * 3 + 0) * 64 + col] = s0; lds[(kp * 3 + 1) * 64 + col] = s1; lds[(kp * 3 + 2) * 64 + col] = s2;
    __syncthreads();
    if (tid < 192) {
        const int ci = tid >> 6;
        float s = 0.f;
#pragma unroll
        for (int q = 0; q < 8; ++q) s += lds[(q * 3 + ci) * 64 + col];
        mod[(size_t)(l * 3 + ci) * 6144 + j] = s + (l ? b1 : b0)[j];
    }
}

typedef __attribute__((ext_vector_type(8))) short bf16x8;
typedef __attribute__((ext_vector_type(4))) float f32x4;
typedef __attribute__((ext_vector_type(2))) __bf16 bf16x2_t;
typedef __attribute__((ext_vector_type(2))) float f32x2_t;
typedef unsigned short bf16_t;
typedef __attribute__((ext_vector_type(4))) unsigned u32x4;
__device__ __forceinline__ unsigned pk_bf16(float a, float b) {
    bf16x2_t v = __builtin_convertvector((f32x2_t){a, b}, bf16x2_t);
    return __builtin_bit_cast(unsigned, v);
}
__device__ __forceinline__ int gt_lds_byte(int r, int c) {
    const int st = (r >> 4) * 2 + (c >> 5), ob = (r & 15) * 64 + (c & 31) * 2;
    return st * 1024 + (ob ^ (((ob >> 9) & 1) << 5));
}
template <int BM, int BN, int NT, class AL, class EP, int WN = BN / 64>
__device__ __forceinline__ void gemm_tile(const AL& al, const bf16_t* __restrict__ Wt, int K, int m0, int n0, const EP& ep, char* lds) {
    constexpr int NW = NT / 64, NJ = BN / WN / 16;
    constexpr int A_L = BM / 8 / NW, B_L = BN / 8 / NW;
    static_assert((BM / 64) * WN * 64 == NT && (NJ == 4 || NJ == 2), "wave layout");
    char* As = lds;
    char* Bs = lds + 3 * BM * 128;
    const int tid = TIDX, lane = tid & 63, wv = tid >> 6, wr = wv / WN, wc = wv % WN;
    f32x4 acc[4][NJ];
#pragma unroll
    for (int i = 0; i < 4; ++i)
#pragma unroll
        for (int j = 0; j < NJ; ++j) acc[i][j] = (f32x4){0.f, 0.f, 0.f, 0.f};
    const int sb = lane * 16, swz = sb ^ (((sb >> 9) & 1) << 5), lr = swz >> 6, lc = (swz & 63) >> 1;
    const bf16_t* ap[A_L];
    const bf16_t* bp[B_L];
#pragma unroll
    for (int i = 0; i < A_L; ++i) { const int st = wv + NW * i; ap[i] = al.ptr(m0 + (st >> 1) * 16 + lr, (st & 1) * 32 + lc); }
#pragma unroll
    for (int i = 0; i < B_L; ++i) { const int st = wv + NW * i; bp[i] = Wt + (size_t)(n0 + (st >> 1) * 16 + lr) * K + (st & 1) * 32 + lc; }
#define GT_STAGE(buf_, k0_) { \
        _Pragma("unroll") for (int i_ = 0; i_ < A_L; ++i_) \
            __builtin_amdgcn_global_load_lds((const unsigned*)(ap[i_] + (k0_)), (__attribute__((address_space(3))) unsigned*)(As + (buf_) * BM * 128 + (wv + NW * i_) * 1024), 16, 0, 0); \
        _Pragma("unroll") for (int i_ = 0; i_ < B_L; ++i_) \
            __builtin_amdgcn_global_load_lds((const unsigned*)(bp[i_] + (k0_)), (__attribute__((address_space(3))) unsigned*)(Bs + (buf_) * BN * 128 + (wv + NW * i_) * 1024), 16, 0, 0); }
    __syncthreads();
    const int nk = K / 64;
    GT_STAGE(0, 0)
    if (nk > 1) GT_STAGE(1, 64)
    const int fr = lane & 15, fq = lane >> 4;
    for (int kt = 0; kt < nk; ++kt) {
        if (kt + 1 < nk) asm volatile("s_waitcnt vmcnt(%0)" :: "n"(A_L + B_L) : "memory");
        else             asm volatile("s_waitcnt vmcnt(0)" ::: "memory");
        asm volatile("s_waitcnt lgkmcnt(0)" ::: "memory");
        __builtin_amdgcn_s_barrier();
        asm volatile("" ::: "memory");
        const int cb = kt % 3;
        if (kt + 2 < nk) { const int nb_ = (kt + 2) % 3; GT_STAGE(nb_, (kt + 2) * 64) }
        const char* Ab = As + cb * BM * 128;
        const char* Bb = Bs + cb * BN * 128;
        {
            u32x4 x0, x1, x2, x3, x4, x5, x6, x7, y0, y1, y2, y3, y4, y5, y6, y7;
            const unsigned aa0 = (unsigned)(size_t)(Ab + gt_lds_byte(wr * 64 + 0 + fr, fq * 8)), aa1 = (unsigned)(size_t)(Ab + gt_lds_byte(wr * 64 + 16 + fr, fq * 8));
            const unsigned aa2 = (unsigned)(size_t)(Ab + gt_lds_byte(wr * 64 + 32 + fr, fq * 8)), aa3 = (unsigned)(size_t)(Ab + gt_lds_byte(wr * 64 + 48 + fr, fq * 8));
            const unsigned ab0 = (unsigned)(size_t)(Bb + gt_lds_byte(wc * (16 * NJ) + 0 + fr, fq * 8)), ab1 = (unsigned)(size_t)(Bb + gt_lds_byte(wc * (16 * NJ) + 16 + fr, fq * 8));
            if constexpr (NJ == 4) {
                const unsigned ab2 = (unsigned)(size_t)(Bb + gt_lds_byte(wc * (16 * NJ) + 32 + fr, fq * 8)), ab3 = (unsigned)(size_t)(Bb + gt_lds_byte(wc * (16 * NJ) + 48 + fr, fq * 8));
                asm volatile("ds_read_b128 %0, %16\n\tds_read_b128 %1, %17\n\tds_read_b128 %2, %18\n\tds_read_b128 %3, %19\n\t"
                             "ds_read_b128 %4, %20\n\tds_read_b128 %5, %21\n\tds_read_b128 %6, %22\n\tds_read_b128 %7, %23\n\t"
                             "ds_read_b128 %8, %16 offset:1024\n\tds_read_b128 %9, %17 offset:1024\n\tds_read_b128 %10, %18 offset:1024\n\tds_read_b128 %11, %19 offset:1024\n\t"
                             "ds_read_b128 %12, %20 offset:1024\n\tds_read_b128 %13, %21 offset:1024\n\tds_read_b128 %14, %22 offset:1024\n\tds_read_b128 %15, %23 offset:1024\n\t"
                             "s_waitcnt lgkmcnt(8)"
                             : "=&v"(x0), "=&v"(x1), "=&v"(x2), "=&v"(x3), "=&v"(x4), "=&v"(x5), "=&v"(x6), "=&v"(x7),
                               "=&v"(y0), "=&v"(y1), "=&v"(y2), "=&v"(y3), "=&v"(y4), "=&v"(y5), "=&v"(y6), "=&v"(y7)
                             : "v"(aa0), "v"(aa1), "v"(aa2), "v"(aa3), "v"(ab0), "v"(ab1), "v"(ab2), "v"(ab3) : "memory");
            } else {
                asm volatile("ds_read_b128 %0, %12\n\tds_read_b128 %1, %13\n\tds_read_b128 %2, %14\n\tds_read_b128 %3, %15\n\t"
                             "ds_read_b128 %4, %16\n\tds_read_b128 %5, %17\n\t"
                             "ds_read_b128 %6, %12 offset:1024\n\tds_read_b128 %7, %13 offset:1024\n\tds_read_b128 %8, %14 offset:1024\n\tds_read_b128 %9, %15 offset:1024\n\t"
                             "ds_read_b128 %10, %16 offset:1024\n\tds_read_b128 %11, %17 offset:1024\n\t"
                             "s_waitcnt lgkmcnt(6)"
                             : "=&v"(x0), "=&v"(x1), "=&v"(x2), "=&v"(x3), "=&v"(x4), "=&v"(x5),
                               "=&v"(y0), "=&v"(y1), "=&v"(y2), "=&v"(y3), "=&v"(y4), "=&v"(y5)
                             : "v"(aa0), "v"(aa1), "v"(aa2), "v"(aa3), "v"(ab0), "v"(ab1) : "memory");
            }
            const bf16x8 a0[4] = {__builtin_bit_cast(bf16x8, x0), __builtin_bit_cast(bf16x8, x1), __builtin_bit_cast(bf16x8, x2), __builtin_bit_cast(bf16x8, x3)};
#pragma unroll
            for (int i = 0; i < 4; ++i) {
                acc[i][0] = __builtin_amdgcn_mfma_f32_16x16x32_bf16(__builtin_bit_cast(bf16x8, x4), a0[i], acc[i][0], 0, 0, 0);
                acc[i][1] = __builtin_amdgcn_mfma_f32_16x16x32_bf16(__builtin_bit_cast(bf16x8, x5), a0[i], acc[i][1], 0, 0, 0);
                if constexpr (NJ == 4) {
                    acc[i][2] = __builtin_amdgcn_mfma_f32_16x16x32_bf16(__builtin_bit_cast(bf16x8, x6), a0[i], acc[i][2], 0, 0, 0);
                    acc[i][3] = __builtin_amdgcn_mfma_f32_16x16x32_bf16(__builtin_bit_cast(bf16x8, x7), a0[i], acc[i][3], 0, 0, 0);
                }
            }
            if constexpr (NJ == 4)
                asm volatile("s_waitcnt lgkmcnt(0)" : "+v"(y0), "+v"(y1), "+v"(y2), "+v"(y3), "+v"(y4), "+v"(y5), "+v"(y6), "+v"(y7), "+v"(acc[3][3]) :: "memory");
            else
                asm volatile("s_waitcnt lgkmcnt(0)" : "+v"(y0), "+v"(y1), "+v"(y2), "+v"(y3), "+v"(y4), "+v"(y5), "+v"(acc[3][1]) :: "memory");
            const bf16x8 a1[4] = {__builtin_bit_cast(bf16x8, y0), __builtin_bit_cast(bf16x8, y1), __builtin_bit_cast(bf16x8, y2), __builtin_bit_cast(bf16x8, y3)};
#pragma unroll
            for (int i = 0; i < 4; ++i) {
                acc[i][0] = __builtin_amdgcn_mfma_f32_16x16x32_bf16(__builtin_bit_cast(bf16x8, y4), a1[i], acc[i][0], 0, 0, 0);
                acc[i][1] = __builtin_amdgcn_mfma_f32_16x16x32_bf16(__builtin_bit_cast(bf16x8, y5), a1[i], acc[i][1], 0, 0, 0);
                if constexpr (NJ == 4) {
                    acc[i][2] = __builtin_amdgcn_mfma_f32_16x16x32_bf16(__builtin_bit_cast(bf16x8, y6), a1[i], acc[i][2], 0, 0, 0);
                    acc[i][3] = __builtin_amdgcn_mfma_f32_16x16x32_bf16(__builtin_bit_cast(bf16x8, y7), a1[i], acc[i][3], 0, 0, 0);
                }
            }
        }
    }
    __syncthreads();
#undef GT_STAGE
    if constexpr (NJ == 4) ep.template run<BM, BN, NT>(acc, m0, n0, wr, wc, lane, lds);
    else ep.template run<BM, BN, NT, NJ>(acc, m0, n0, wr, wc, lane, lds);
}

template <int NT, class AL, class EP, int MH = 128>
__device__ __forceinline__ void gemm256_tile(const AL& al, const bf16_t* __restrict__ Wt, const int K, const int n0, const EP& ep, char* lds) {
    static_assert(NT == 512 && (MH == 128 || MH == 96), "gemm256_tile needs 8 waves; A halves of 128 or 96 rows");
    constexpr int NM = MH / 32;
    constexpr int HB = 128 * 64 * 2;
    const int tid = TIDX, lane = tid & 63, wid = tid >> 6, wr = wid >> 2, wc = wid & 3, fr = lane & 15, fq = lane >> 4;
    const int sb = lane * 16, swz = sb ^ (((sb >> 9) & 1) << 5);
    const int R0 = (wid >> 1) * 16 + (swz >> 6), C0 = (wid & 1) * 32 + ((swz & 63) >> 1);
    const unsigned ao00 = al.boff(R0, C0), ao10 = al.boff(R0 + MH, C0);
    const unsigned ao01 = (R0 + 64 < MH) ? al.boff(R0 + 64, C0) : ao00, ao11 = (R0 + 64 < MH) ? al.boff(R0 + MH + 64, C0) : ao10;
    const unsigned bo = (unsigned)(R0 * K + C0) * 2u;
    const char* const abase = al.ubase();
    const char* const bbase = (const char*)(Wt + (size_t)n0 * K);
    const size_t bK64 = (size_t)64 * K * 2;
    const unsigned stg = (unsigned)(size_t)lds + (unsigned)__builtin_amdgcn_readfirstlane(wid) * 1024u;
    f32x4 acc[2][2][NM][2];
#pragma unroll
    for (int a = 0; a < 2; ++a)
#pragma unroll
        for (int b = 0; b < 2; ++b)
#pragma unroll
            for (int m = 0; m < NM; ++m)
#pragma unroll
                for (int n = 0; n < 2; ++n) acc[a][b][m][n] = (f32x4){0.f, 0.f, 0.f, 0.f};
    bf16x8 At[NM][2], B0[2][2], B1[2][2];
#define G8_SA(b_, h_) (((b_) * 2 + (h_)) * HB)
#define G8_SB(b_, h_) ((4 + (b_) * 2 + (h_)) * HB)
#define G8_GLDS(vo_, sb_, m0_) asm volatile("s_mov_b32 m0, %2\n\tglobal_load_lds_dwordx4 %0, %1" :: "v"(vo_), "s"(sb_), "s"(m0_) : "memory", "m0")
#define G8_STAGE_A(b_, h_, kt_) { const char* kb_ = abase + (size_t)(kt_) * 128; \
        G8_GLDS(((h_) ? ao10 : ao00), kb_, stg + G8_SA(b_, h_)); G8_GLDS(((h_) ? ao11 : ao01), kb_, stg + G8_SA(b_, h_) + 8192); }
#define G8_STAGE_B(b_, h_, kt_) { const char* kb_ = bbase + (size_t)((h_) * 2) * bK64 + (size_t)(kt_) * 128; const char* kb2_ = kb_ + bK64; \
        G8_GLDS(bo, kb_, stg + G8_SB(b_, h_)); G8_GLDS(bo, kb2_, stg + G8_SB(b_, h_) + 8192); }
#define G8_LDA(b_, h_) { _Pragma("unroll") for (int m = 0; m < NM; ++m) _Pragma("unroll") for (int k = 0; k < 2; ++k) \
        At[m][k] = *(const bf16x8*)(lds + G8_SA(b_, h_) + gt_lds_byte(wr * (MH / 2) + m * 16 + fr, k * 32 + fq * 8)); }
#define G8_LDB(dst_, b_, h_) { _Pragma("unroll") for (int n = 0; n < 2; ++n) _Pragma("unroll") for (int k = 0; k < 2; ++k) \
        dst_[n][k] = *(const bf16x8*)(lds + G8_SB(b_, h_) + gt_lds_byte(wc * 32 + n * 16 + fr, k * 32 + fq * 8)); }
#define G8_MMA(ai_, bj_, Bx_) { __builtin_amdgcn_s_setprio(1); \
        _Pragma("unroll") for (int m = 0; m < NM; ++m) _Pragma("unroll") for (int n = 0; n < 2; ++n) _Pragma("unroll") for (int k = 0; k < 2; ++k) \
            acc[ai_][bj_][m][n] = __builtin_amdgcn_mfma_f32_16x16x32_bf16(Bx_[n][k], At[m][k], acc[ai_][bj_][m][n], 0, 0, 0); \
        __builtin_amdgcn_s_setprio(0); }
#define G8_WAIT_V(n_) asm volatile("s_waitcnt vmcnt(" #n_ ")" ::: "memory")
#define G8_WAIT_L(n_) asm volatile("s_waitcnt lgkmcnt(" #n_ ")" ::: "memory")
#define G8_WAIT_LA { if constexpr (NM == 4) { G8_WAIT_L(8); } else { G8_WAIT_L(6); } }
#define G8_BAR __builtin_amdgcn_s_barrier()
#define G8_SCHED __builtin_amdgcn_sched_barrier(0)
    const int nt = K / 64;
    __syncthreads();
    G8_STAGE_B(0, 0, 0) G8_STAGE_A(0, 0, 0) G8_STAGE_B(0, 1, 0) G8_STAGE_A(0, 1, 0)
    if (wr == 1) G8_BAR;
    G8_WAIT_V(4); G8_BAR;
    G8_STAGE_B(1, 0, 1) G8_STAGE_A(1, 0, 1) G8_STAGE_B(1, 1, 1)
    G8_WAIT_V(6); G8_BAR;
    for (int t = 0; t < nt; t += 2) {
        const bool more = t + 2 < nt;
        G8_LDB(B0, 0, 0) G8_SCHED; G8_LDA(0, 0) G8_STAGE_A(1, 1, t + 1)
        G8_WAIT_LA G8_BAR; G8_WAIT_L(0); G8_MMA(0, 0, B0) G8_BAR; G8_SCHED;
        G8_LDB(B1, 0, 1) if (more) G8_STAGE_B(0, 0, t + 2)
        G8_BAR; G8_WAIT_L(0); G8_MMA(0, 1, B1) G8_BAR;
        G8_LDA(0, 1) if (more) G8_STAGE_A(0, 0, t + 2)
        G8_BAR; G8_WAIT_L(0); G8_MMA(1, 0, B0) G8_BAR; G8_SCHED;
        if (more) { G8_STAGE_B(0, 1, t + 2) G8_WAIT_V(6); } else { G8_WAIT_V(0); }
        G8_BAR; G8_MMA(1, 1, B1) G8_BAR;
        G8_LDB(B0, 1, 0) G8_SCHED; G8_LDA(1, 0) if (more) G8_STAGE_A(0, 1, t + 2)
        G8_WAIT_LA G8_BAR; G8_WAIT_L(0); G8_MMA(0, 0, B0) G8_BAR; G8_SCHED;
        G8_LDB(B1, 1, 1) if (more) G8_STAGE_B(1, 0, t + 3)
        G8_BAR; G8_WAIT_L(0); G8_MMA(0, 1, B1) G8_BAR;
        G8_LDA(1, 1) if (more) G8_STAGE_A(1, 0, t + 3)
        G8_BAR; G8_WAIT_L(0); G8_MMA(1, 0, B0) G8_BAR; G8_SCHED;
        if (more) { G8_STAGE_B(1, 1, t + 3) G8_WAIT_V(6); }
        G8_BAR; G8_MMA(1, 1, B1) G8_BAR;
    }
    if (wr == 0) G8_BAR;
    __syncthreads();
#undef G8_SA
#undef G8_SB
#undef G8_GLDS
#undef G8_STAGE_A
#undef G8_STAGE_B
#undef G8_LDA
#undef G8_LDB
#undef G8_MMA
#undef G8_WAIT_V
#undef G8_WAIT_L
#undef G8_WAIT_LA
#undef G8_BAR
#undef G8_SCHED
    {
        const int t2 = TIDX;
        ep.template run256<NT>(acc, n0, t2 >> 8, (t2 >> 6) & 3, t2 & 63, lds);
    }
}

typedef __attribute__((ext_vector_type(16))) float f32x16;
__device__ __forceinline__ uint2 pk4(float a, float b, float c, float d) { return make_uint2(pk_bf16(a, b), pk_bf16(c, d)); }
constexpr float QSCALE_A = 0.125f * 1.4426950408889634f, QSCALE_B = 0.10206207261596577f * 1.4426950408889634f;
struct FlashP {
    const bf16_t* Q; int q_ld;
    const bf16_t* K0; const bf16_t* K1; int k_ld;
    const bf16_t* Vt; int vt_ld;
    int n0, Lk;
    float* O; bf16_t* Ob; int o_ld;
    float c;
};
template <int OFF> __device__ __forceinline__ void ds_rd128(u32x4& d, unsigned addr) { asm volatile("ds_read_b128 %0, %1 offset:%2" : "=&v"(d) : "v"(addr), "n"(OFF)); }
template <int O0, int O1> __device__ __forceinline__ void ds_rd2x64(u32x4& d, unsigned addr) { asm volatile("ds_read2_b64 %0, %1 offset0:%2 offset1:%3" : "=&v"(d) : "v"(addr), "n"(O0), "n"(O1)); }
template <int DQ, int NT, bool OBF>
__device__ __forceinline__ void flash_item(const FlashP& p, int q0, char* lds) {
    constexpr int G = NT / 256;
    constexpr int LDQ = DQ + 8, LDV = 68;
    constexpr int KCH = 64 * (DQ / 8) / 256;
    constexpr int KT_BYTES = 64 * LDQ * 2, VT_BYTES = 128 * LDV * 2, BUF_BYTES = KT_BYTES + VT_BYTES;
    const int tid = TIDX, lane = tid & 63, wv = (tid >> 6) & 3, grp = tid >> 8, gt = tid & 255;
    const int l31 = lane & 31, hh = lane >> 5;
    char* gl = lds + grp * 2 * BUF_BYTES;
    bf16x8 qf[DQ / 16];
    {
        const bf16_t* qr = p.Q + (size_t)(q0 + wv * 32 + l31) * p.q_ld + hh * 8;
#pragma unroll
        for (int ks = 0; ks < DQ / 16; ++ks) qf[ks] = *(const bf16x8*)(qr + ks * 16);
    }
    f32x16 o[4];
#pragma unroll
    for (int d = 0; d < 4; ++d)
#pragma unroll
        for (int r = 0; r < 16; ++r) o[d][r] = 0.f;
    float m_run = 0.f, l_run = 0.f;
    const u32x4 onesA = {hh == 0 ? 0x3F80u : 0u, 0u, 0u, 0u};
    const int ntile = p.Lk / 64, tpg = ntile / G, t_beg = grp * tpg, t_end = t_beg + tpg;
    uint4 rk0, rk1, rk2 = make_uint4(0u, 0u, 0u, 0u), rv0, rv1, rv2, rv3;
#define FL_KOFF(i) (unsigned)((((gt + (i) * 256) / (DQ / 8)) * p.k_ld + ((gt + (i) * 256) % (DQ / 8)) * 8) * 2)
    const unsigned ko0 = FL_KOFF(0), ko1 = FL_KOFF(1), ko2 = KCH > 2 ? FL_KOFF(2) : 0u;
    const unsigned vo0 = (unsigned)(((gt >> 3) * p.vt_ld + (gt & 7) * 8) * 2);
    const size_t vstep = (size_t)32 * p.vt_ld * 2;
#define FL_GLOAD(t) { const int j0_ = (t) * 64; \
        const char* kb_ = (const char*)((j0_ < p.n0) ? p.K0 + (size_t)j0_ * p.k_ld : p.K1 + (size_t)(j0_ - p.n0) * p.k_ld); \
        const char* vb0_ = (const char*)(p.Vt + j0_); \
        rk0 = *(const uint4*)(kb_ + (size_t)ko0); rk1 = *(const uint4*)(kb_ + (size_t)ko1); if (KCH > 2) rk2 = *(const uint4*)(kb_ + (size_t)ko2); \
        rv0 = *(const uint4*)(vb0_ + (size_t)vo0); rv1 = *(const uint4*)(vb0_ + vstep + (size_t)vo0); \
        rv2 = *(const uint4*)(vb0_ + 2 * vstep + (size_t)vo0); rv3 = *(const uint4*)(vb0_ + 3 * vstep + (size_t)vo0); }
#define FL_KST(i, R) { const int c_ = gt + (i) * 256; const int row_ = c_ / (DQ / 8), ch_ = c_ % (DQ / 8); *(uint4*)(ks_ + row_ * LDQ + ch_ * 8) = R; }
#define FL_VST(i, R) { const int c_ = gt + (i) * 256; const int row_ = c_ >> 3, ch_ = c_ & 7; bf16_t* d_ = vs_ + row_ * LDV + ch_ * 8; \
        *(uint2*)d_ = make_uint2(R.x, R.y); *(uint2*)(d_ + 4) = make_uint2(R.z, R.w); }
#define FL_SWRITE(b) { bf16_t* ks_ = (bf16_t*)(gl + (b) * BUF_BYTES); bf16_t* vs_ = (bf16_t*)(gl + (b) * BUF_BYTES + KT_BYTES); \
        FL_KST(0, rk0) FL_KST(1, rk1) if (KCH > 2) FL_KST(2, rk2) \
        FL_VST(0, rv0) FL_VST(1, rv1) FL_VST(2, rv2) FL_VST(3, rv3) }
    const int rot = (((q0 >> 7) & 31) * tpg) >> 5;
#define FL_TILE(i_) (t_beg + ((i_) + rot < tpg ? (i_) + rot : (i_) + rot - tpg))
    __syncthreads();
    FL_GLOAD(FL_TILE(0)) FL_SWRITE(0)
    __syncthreads();
    if (G == 2 && grp == 1) __builtin_amdgcn_s_barrier();
    for (int it = 0; it < tpg; ++it) {
        const int b = it & 1;
        if (it + 1 < tpg) FL_GLOAD(FL_TILE(it + 1))
        const bf16_t* ks = (const bf16_t*)(gl + b * BUF_BYTES);
        const bf16_t* vs = (const bf16_t*)(gl + b * BUF_BYTES + KT_BYTES);
        f32x16 s[2];
        {
            constexpr int NK = DQ / 16;
            const unsigned kaddr = (unsigned)(size_t)ks + (unsigned)((l31 * LDQ + hh * 8) * 2);
            u32x4 kf[2][NK];
#define FL_KR(kb_, kk_) ds_rd128<((kb_) * 32 * LDQ + (kk_) * 16) * 2>(kf[kb_][kk_], kaddr);
            FL_KR(0, 0) FL_KR(1, 0) FL_KR(0, 1) FL_KR(1, 1) FL_KR(0, 2) FL_KR(1, 2) FL_KR(0, 3) FL_KR(1, 3)
            if constexpr (NK > 4) { FL_KR(0, 4) FL_KR(1, 4) FL_KR(0, 5) FL_KR(1, 5) }
#undef FL_KR
            {
                const u32x4 qx = {hh == 0 ? (__builtin_bit_cast(unsigned, -m_run) >> 16) : 0u, 0u, 0u, 0u};
                f32x16 z16;
#pragma unroll
                for (int r = 0; r < 16; ++r) z16[r] = 0.f;
                s[0] = __builtin_amdgcn_mfma_f32_32x32x16_bf16(__builtin_bit_cast(bf16x8, onesA), __builtin_bit_cast(bf16x8, qx), z16, 0, 0, 0);
                s[1] = __builtin_amdgcn_mfma_f32_32x32x16_bf16(__builtin_bit_cast(bf16x8, onesA), __builtin_bit_cast(bf16x8, qx), z16, 0, 0, 0);
            }
            if constexpr (NK > 4) asm volatile("s_waitcnt lgkmcnt(8)" : "+v"(kf[0][0]), "+v"(kf[1][0]), "+v"(kf[0][1]), "+v"(kf[1][1]));
            else                  asm volatile("s_waitcnt lgkmcnt(4)" : "+v"(kf[0][0]), "+v"(kf[1][0]), "+v"(kf[0][1]), "+v"(kf[1][1]));
#pragma unroll
            for (int kk = 0; kk < 2; ++kk)
#pragma unroll
                for (int kb = 0; kb < 2; ++kb) s[kb] = __builtin_amdgcn_mfma_f32_32x32x16_bf16(__builtin_bit_cast(bf16x8, kf[kb][kk]), qf[kk], s[kb], 0, 0, 0);
            if constexpr (NK > 4) asm volatile("s_waitcnt lgkmcnt(4)" : "+v"(kf[0][2]), "+v"(kf[1][2]), "+v"(kf[0][3]), "+v"(kf[1][3]));
            else                  asm volatile("s_waitcnt lgkmcnt(0)" : "+v"(kf[0][2]), "+v"(kf[1][2]), "+v"(kf[0][3]), "+v"(kf[1][3]));
#pragma unroll
            for (int kk = 2; kk < 4; ++kk)
#pragma unroll
                for (int kb = 0; kb < 2; ++kb) s[kb] = __builtin_amdgcn_mfma_f32_32x32x16_bf16(__builtin_bit_cast(bf16x8, kf[kb][kk]), qf[kk], s[kb], 0, 0, 0);
            if constexpr (NK > 4) {
                asm volatile("s_waitcnt lgkmcnt(0)" : "+v"(kf[0][4]), "+v"(kf[1][4]), "+v"(kf[0][5]), "+v"(kf[1][5]));
#pragma unroll
                for (int kk = 4; kk < NK; ++kk)
#pragma unroll
                    for (int kb = 0; kb < 2; ++kb) s[kb] = __builtin_amdgcn_mfma_f32_32x32x16_bf16(__builtin_bit_cast(bf16x8, kf[kb][kk]), qf[kk], s[kb], 0, 0, 0);
            }
        }
        float mx = s[0][0];
#pragma unroll
        for (int r = 1; r < 16; ++r) mx = fmaxf(mx, s[0][r]);
#pragma unroll
        for (int r = 0; r < 16; ++r) mx = fmaxf(mx, s[1][r]);
        mx = fmaxf(mx, __shfl_xor(mx, 32));
        const bool first = it == 0;
        constexpr float FL_THR = 5.f;
        const bool grow = first || __builtin_amdgcn_ballot_w64(mx > FL_THR) != 0ull;
        if (grow) {
            const float dl = (first || mx > FL_THR) ? mx : 0.f;
            const float m_new = __builtin_bit_cast(float, pk_bf16(m_run + dl, 0.f) << 16);
            const float d = m_new - m_run, alpha = __builtin_amdgcn_exp2f(-d);
            m_run = m_new;
#pragma unroll
            for (int kb = 0; kb < 2; ++kb)
#pragma unroll
                for (int r = 0; r < 16; ++r) s[kb][r] -= d;
            l_run *= alpha;
#pragma unroll
            for (int dd = 0; dd < 4; ++dd)
#pragma unroll
                for (int r = 0; r < 16; ++r) o[dd][r] *= alpha;
        }
#pragma unroll
        for (int r = 0; r < 16; ++r) s[0][r] = __builtin_amdgcn_exp2f(s[0][r]);
        if (G == 2) __builtin_amdgcn_s_barrier();
        {
            const unsigned vb_ = (unsigned)(size_t)vs + (unsigned)((l31 * LDV + 4 * hh) * 2);
            const unsigned va0 = vb_, va1 = vb_ + 32 * LDV * 2, va2 = vb_ + 64 * LDV * 2, va3 = vb_ + 96 * LDV * 2;
            u32x4 fa0, fa1, fa2, fa3, fb0, fb1, fb2, fb3;
#define FL_VR(S_, g_) ds_rd2x64<(g_) * 4, (g_) * 4 + 2>(f##S_##0, va0); ds_rd2x64<(g_) * 4, (g_) * 4 + 2>(f##S_##1, va1); \
                      ds_rd2x64<(g_) * 4, (g_) * 4 + 2>(f##S_##2, va2); ds_rd2x64<(g_) * 4, (g_) * 4 + 2>(f##S_##3, va3);
#define FL_PV(S_, g_, W_) { asm volatile("s_waitcnt lgkmcnt(" #W_ ")" : "+v"(f##S_##0), "+v"(f##S_##1), "+v"(f##S_##2), "+v"(f##S_##3)); \
            constexpr int kb_ = (g_) >> 1, sp_ = (g_) & 1; \
            const u32x4 pbu = {pk_bf16(s[kb_][8 * sp_ + 0], s[kb_][8 * sp_ + 1]), pk_bf16(s[kb_][8 * sp_ + 2], s[kb_][8 * sp_ + 3]), \
                               pk_bf16(s[kb_][8 * sp_ + 4], s[kb_][8 * sp_ + 5]), pk_bf16(s[kb_][8 * sp_ + 6], s[kb_][8 * sp_ + 7])}; \
            const bf16x8 pbv = __builtin_bit_cast(bf16x8, pbu); \
            o[0] = __builtin_amdgcn_mfma_f32_32x32x16_bf16(__builtin_bit_cast(bf16x8, f##S_##0), pbv, o[0], 0, 0, 0); \
            o[1] = __builtin_amdgcn_mfma_f32_32x32x16_bf16(__builtin_bit_cast(bf16x8, f##S_##1), pbv, o[1], 0, 0, 0); \
            o[2] = __builtin_amdgcn_mfma_f32_32x32x16_bf16(__builtin_bit_cast(bf16x8, f##S_##2), pbv, o[2], 0, 0, 0); \
            o[3] = __builtin_amdgcn_mfma_f32_32x32x16_bf16(__builtin_bit_cast(bf16x8, f##S_##3), pbv, o[3], 0, 0, 0); \
            l_run += ((s[kb_][8 * sp_ + 0] + s[kb_][8 * sp_ + 1]) + (s[kb_][8 * sp_ + 2] + s[kb_][8 * sp_ + 3])) + ((s[kb_][8 * sp_ + 4] + s[kb_][8 * sp_ + 5]) + (s[kb_][8 * sp_ + 6] + s[kb_][8 * sp_ + 7])); }
            FL_VR(a, 0) FL_VR(b, 1)
            FL_PV(a, 0, 4)
            FL_VR(a, 2)
            FL_PV(b, 1, 4)
            FL_VR(b, 3)
#pragma unroll
            for (int r = 0; r < 16; ++r) s[1][r] = __builtin_amdgcn_exp2f(s[1][r]);
            FL_PV(a, 2, 4)
            FL_PV(b, 3, 0)
#undef FL_VR
#undef FL_PV
        }
        if (it + 1 < tpg) FL_SWRITE(b ^ 1)
        __syncthreads();
    }
#undef FL_TILE
    if (G == 2 && grp == 0) __builtin_amdgcn_s_barrier();
    l_run += __shfl_xor(l_run, 32);
    const int tid_ = TIDX, lane_ = tid_ & 63, wv_ = (tid_ >> 6) & 3, grp_ = tid_ >> 8, l31_ = lane_ & 31, hh_ = lane_ >> 5;
#define lane lane_
#define wv wv_
#define grp grp_
#define l31 l31_
#define hh hh_
    if (G == 2) {
        float* mb = (float*)lds;
        __syncthreads();
        if (grp == 1) {
            float* w = mb + wv * 66 * 64 + lane;
#pragma unroll
            for (int d = 0; d < 4; ++d)
#pragma unroll
                for (int r = 0; r < 16; ++r) w[(d * 16 + r) * 64] = o[d][r];
            w[64 * 64] = m_run; w[65 * 64] = l_run;
        }
        __syncthreads();
        if (grp == 0) {
            const float* w = mb + wv * 66 * 64 + lane;
            const float m1 = w[64 * 64], l1 = w[65 * 64];
            const float m = fmaxf(m_run, m1), a0 = __builtin_amdgcn_exp2f(m_run - m), a1 = __builtin_amdgcn_exp2f(m1 - m);
            l_run = l_run * a0 + l1 * a1;
#pragma unroll
            for (int d = 0; d < 4; ++d)
#pragma unroll
                for (int r = 0; r < 16; ++r) o[d][r] = o[d][r] * a0 + w[(d * 16 + r) * 64] * a1;
        }
    }
    if (grp == 0) {
        const float inv = 1.f / l_run;
        const size_t ro = (size_t)(q0 + wv * 32 + l31) * p.o_ld;
#pragma unroll
        for (int d = 0; d < 4; ++d)
#pragma unroll
            for (int g4 = 0; g4 < 4; ++g4) {
                const int co = d * 32 + g4 * 8 + 4 * hh;
                if (OBF) *(uint2*)(p.Ob + ro + co) = pk4(o[d][g4 * 4] * inv, o[d][g4 * 4 + 1] * inv, o[d][g4 * 4 + 2] * inv, o[d][g4 * 4 + 3] * inv);
                else *(float4*)(p.O + ro + co) = make_float4(o[d][g4 * 4] * inv, o[d][g4 * 4 + 1] * inv, o[d][g4 * 4 + 2] * inv, o[d][g4 * 4 + 3] * inv);
            }
    }
    __syncthreads();
#undef lane
#undef wv
#undef grp
#undef l31
#undef hh
}


struct TokInfo { int seq, pos, L, ci, t0, latent; };
__device__ __forceinline__ TokInfo tokinfo(int t) {
    TokInfo r;
    if (t < 4096) { r.seq = t >> 8; r.pos = t & 255; r.L = 256; r.ci = 0; r.t0 = t & ~255; r.latent = 0; }
    else { const int u = t - 4096, b = u >> 12; r.seq = 16 + b; r.pos = u & 4095; r.L = 4096; r.ci = 1 + b; r.t0 = 4096 + (b << 12); r.latent = 1; }
    return r;
}
constexpr int VLD = 4608 + 128;
struct Lay { int tbase, Tloc, seqbase, b0, nb; };
__device__ __forceinline__ size_t vt_off(const Lay& l, int seq, int h) {
    if (seq < 16) return ((size_t)(seq - l.seqbase) * 4 + h) * 128 * 256;
    const size_t ctxpart = l.seqbase < 16 ? (size_t)(16 - l.seqbase) * 4 * 128 * 256 : 0;
    return ctxpart + ((size_t)(seq - 16 - l.b0) * 4 + h) * 128 * VLD;
}
__device__ __forceinline__ const float* xrow(const float* xp, const float* xs, int t) { return t < 4096 ? xp + (size_t)t * DM : xs + (size_t)(t - 4096) * DM; }
__device__ __forceinline__ float bf_lo(unsigned u) { return __builtin_bit_cast(float, u << 16); }
__device__ __forceinline__ float bf_hi(unsigned u) { return __builtin_bit_cast(float, u & 0xffff0000u); }
__device__ __forceinline__ float bf1(bf16_t u) { return __builtin_bit_cast(float, (unsigned)u << 16); }
__device__ __forceinline__ bf16_t to_bf(float x) { return (bf16_t)(pk_bf16(x, 0.f) & 0xffffu); }
template <int NT>
__device__ __forceinline__ float group_sum256(float v, float* sh) {
    v = wave_sum(v);
    __syncthreads();
    if ((TIDX & 63) == 0) sh[TIDX >> 6] = v;
    __syncthreads();
    const int g = (TIDX >> 8) * 4;
    return sh[g] + sh[g + 1] + sh[g + 2] + sh[g + 3];
}

__device__ __forceinline__ void n_rope_tables(float* c64, float* s64, float* c32, float* s32) {
    for (int i = TIDX; i < 64 * 16; i += blockDim.x) {
        const int val = i >> 4, f = i & 15;
        const float ang = (float)val * powf(10000.f, -(float)f / 16.f);
        c64[i] = cosf(ang); s64[i] = sinf(ang);
    }
    for (int i = TIDX; i < 64 * 8; i += blockDim.x) {
        const int val = i >> 3, f = i & 7;
        const float ang = (float)val * powf(10000.f, -(float)f / 8.f);
        c32[i] = cosf(ang); s32[i] = sinf(ang);
    }
}

__device__ __forceinline__ int wsrc(int mode, int gh, int n, int N) {
    if (mode == 0) return n < N ? n : -1;
    if (mode == 1) { const int tile = n / (2 * gh), j = n % (2 * gh); return j < gh ? tile * gh + j : FF + tile * gh + (j - gh); }
    if (n < 256) return (n >> 6) * 192 + (n & 63);
    const int c = n - 256; return (c >> 7) * 192 + 64 + (c & 127);
}
template <int NT>
__device__ __forceinline__ void n_wconv(const float* __restrict__ W, int K, int N, bf16_t* __restrict__ Wt, int Npad, int mode, int gh, int vb0, float* lds) {
    const int grp = TIDX >> 8, tid = TIDX & 255;
    const int ntn = Npad / 64, ntiles = (K / 64) * ntn;
    const int vb = vb0 * (NT / 256) + grp;
    float (*tile)[65] = (float (*)[65])(lds + grp * 64 * 65);
    const bool act = vb < ntiles;
    const int k0 = act ? (vb / ntn) * 64 : 0, n0 = act ? (vb % ntn) * 64 : 0;
    __syncthreads();
    if (act) {
#pragma unroll
        for (int p = 0; p < 4; ++p) {
            const int r = p * 16 + (tid >> 4), c = (tid & 15) * 4;
            const int sc = wsrc(mode, gh, n0 + c, N);
            float4 v = make_float4(0.f, 0.f, 0.f, 0.f);
            if (sc >= 0) v = *(const float4*)(W + (size_t)(k0 + r) * N + sc);
            tile[r][c] = v.x; tile[r][c + 1] = v.y; tile[r][c + 2] = v.z; tile[r][c + 3] = v.w;
        }
    }
    __syncthreads();
    if (act) {
#pragma unroll
        for (int p = 0; p < 4; ++p) {
            const int n = p * 16 + (tid >> 4), k = (tid & 15) * 4;
            *(uint2*)(Wt + (size_t)(n0 + n) * K + k0 + k) = pk4(tile[k][n], tile[k + 1][n], tile[k + 2][n], tile[k + 3][n]);
        }
    }
}

template <int NT, int NI>
__device__ __forceinline__ void n_wconv_multi(const float* __restrict__ W, int K, int N, bf16_t* __restrict__ Wt, int Npad, int mode, int gh, int it0, float* lds, int ldo = 0) {
    if (ldo == 0) ldo = K;
    const int grp = TIDX >> 8, tid = TIDX & 255;
    const int ntn = Npad / 64, ntiles = (K / 64) * ntn;
    float4 v[NI][4];
    __syncthreads();
#pragma unroll
    for (int u = 0; u < NI; ++u) {
        const int vb = (it0 + u) * (NT / 256) + grp;
        const bool act = vb < ntiles;
        const int k0 = act ? (vb / ntn) * 64 : 0, n0 = act ? (vb % ntn) * 64 : 0;
#pragma unroll
        for (int p = 0; p < 4; ++p) {
            const int r = p * 16 + (tid >> 4), c = (tid & 15) * 4;
            const int sc = wsrc(mode, gh, n0 + c, N);
            v[u][p] = make_float4(0.f, 0.f, 0.f, 0.f);
            if (act && sc >= 0) v[u][p] = *(const float4*)(W + (size_t)(k0 + r) * N + sc);
        }
    }
#pragma unroll
    for (int u = 0; u < NI; ++u) {
        float (*tile)[65] = (float (*)[65])(lds + (u * (NT / 256) + grp) * 64 * 65);
#pragma unroll
        for (int p = 0; p < 4; ++p) {
            const int r = p * 16 + (tid >> 4), c = (tid & 15) * 4;
            tile[r][c] = v[u][p].x; tile[r][c + 1] = v[u][p].y; tile[r][c + 2] = v[u][p].z; tile[r][c + 3] = v[u][p].w;
        }
    }
    __syncthreads();
#pragma unroll
    for (int u = 0; u < NI; ++u) {
        const int vb = (it0 + u) * (NT / 256) + grp;
        if (vb < ntiles) {
            const int k0 = (vb / ntn) * 64, n0 = (vb % ntn) * 64;
            float (*tile)[65] = (float (*)[65])(lds + (u * (NT / 256) + grp) * 64 * 65);
#pragma unroll
            for (int p = 0; p < 4; ++p) {
                const int n = p * 16 + (tid >> 4), k = (tid & 15) * 4;
                *(uint2*)(Wt + (size_t)(n0 + n) * ldo + k0 + k) = pk4(tile[k][n], tile[k + 1][n], tile[k + 2][n], tile[k + 3][n]);
            }
        }
    }
}

template <int NT>
__device__ __forceinline__ void n_resnorm(const Lay lay, const float* xp, const float* xs, const float* __restrict__ src, const float* __restrict__ g,
                          const float* __restrict__ modl, int shoff, int scoff, bf16_t* __restrict__ out, int vb, float* lds) {
    const int lrow = vb * (NT / 256) + (TIDX >> 8), tid = TIDX & 255;
    const int t = lay.tbase + lrow;
    const TokInfo ti = tokinfo(t);
    const float* xr = src ? src + (size_t)lrow * DM : xrow(xp, xs, t);
    const float4 x = *(const float4*)(xr + tid * 4);
    const float ss = group_sum256<NT>(x.x * x.x + x.y * x.y + x.z * x.z + x.w * x.w, lds);
    const float rstd = rsqrtf(ss * (1.f / DM) + EPS);
    const float4 gg = *(const float4*)(g + tid * 4);
    const float* md = modl + (size_t)ti.ci * 6144;
    const float4 a = *(const float4*)(md + scoff + tid * 4), b = *(const float4*)(md + shoff + tid * 4);
    *(uint2*)(out + (size_t)lrow * DM + tid * 4) = pk4(x.x * rstd * gg.x * (1.f + a.x) + b.x, x.y * rstd * gg.y * (1.f + a.y) + b.y,
                                                       x.z * rstd * gg.z * (1.f + a.z) + b.z, x.w * rstd * gg.w * (1.f + a.w) + b.w);
}

template <int NT>
__device__ __forceinline__ void n_resnorm_w2(const Lay lay, const float* xp, const float* xs, const bf16_t* __restrict__ src, const float* __restrict__ g,
                          const float* __restrict__ modl, int shoff, int scoff, bf16_t* __restrict__ out, int vb) {
    const int lane = TIDX & 63, lrow0 = vb * (NT / 64) * 2 + (TIDX >> 6) * 2;
    float4 x[2][4];
#pragma unroll
    for (int k = 0; k < 2; ++k) {
        const int lrow = lrow0 + k;
        const float* xr = xrow(xp, xs, lay.tbase + lrow);
#pragma unroll
        for (int q = 0; q < 4; ++q) {
            if (src) { const uint2 u = *(const uint2*)(src + (size_t)lrow * DM + q * 256 + lane * 4); x[k][q] = make_float4(bf_lo(u.x), bf_hi(u.x), bf_lo(u.y), bf_hi(u.y)); }
            else x[k][q] = *(const float4*)(xr + q * 256 + lane * 4);
        }
    }
#pragma unroll
    for (int k = 0; k < 2; ++k) {
        const int lrow = lrow0 + k;
        const TokInfo ti = tokinfo(lay.tbase + lrow);
        float ss = 0.f;
#pragma unroll
        for (int q = 0; q < 4; ++q) ss += (x[k][q].x * x[k][q].x + x[k][q].y * x[k][q].y) + (x[k][q].z * x[k][q].z + x[k][q].w * x[k][q].w);
        ss = wave_sum(ss);
        const float rstd = rsqrtf(ss * (1.f / DM) + EPS);
        const float* md = modl + (size_t)ti.ci * 6144;
#pragma unroll
        for (int q = 0; q < 4; ++q) {
            const int c = q * 256 + lane * 4;
            const float4 gg = *(const float4*)(g + c), a = *(const float4*)(md + scoff + c), b = *(const float4*)(md + shoff + c);
            *(uint2*)(out + (size_t)lrow * DM + c) = pk4(x[k][q].x * rstd * gg.x * (1.f + a.x) + b.x, x[k][q].y * rstd * gg.y * (1.f + a.y) + b.y,
                                                         x[k][q].z * rstd * gg.z * (1.f + a.z) + b.z, x[k][q].w * rstd * gg.w * (1.f + a.w) + b.w);
        }
    }
}

struct ALoadBF {
    const bf16_t* A; int lda;
    __device__ __forceinline__ const bf16_t* ptr(int row, int k) const { return A + (size_t)row * lda + k; }
    __device__ __forceinline__ const char* ubase() const { return (const char*)A; }
    __device__ __forceinline__ unsigned boff(int row, int k) const { return (unsigned)(row * lda + k) * 2u; }
};
struct ALoadHalo {
    const bf16_t* A; int lda, base, row0, L; const bf16_t* zero;
    __device__ __forceinline__ const bf16_t* ptr(int r, int k) const {
        const int pos = row0 + r;
        if (pos < 0 || pos >= L) return zero;
        return A + (size_t)(base + pos) * lda + k;
    }
    __device__ __forceinline__ const char* ubase() const { return (const char*)zero; }
    __device__ __forceinline__ unsigned boff(int r, int k) const {
        const int pos = row0 + r;
        if (pos < 0 || pos >= L) return 0u;
        return (unsigned)((const char*)A - (const char*)zero) + (unsigned)((base + pos) * lda + k) * 2u;
    }
};
struct HaloTile { int seq, t0, L, row0, lo, hi; };
__device__ __forceinline__ HaloTile halo_tile(int g) {
    HaloTile h;
    if (g < 16) { h.seq = g; h.t0 = g * 256; h.L = 256; h.row0 = 0; h.lo = 0; h.hi = 256; }
    else { const int b = (g - 16) / 17, i = (g - 16) % 17; h.seq = 16 + b; h.t0 = 4096 + b * 4096; h.L = 4096; h.row0 = 254 * i - 1; h.lo = 1;
           const int last = 4096 - h.row0; h.hi = last < 255 ? last : 255; }
    return h;
}

template <int BM, int BN, int NT, class RowPtr>
__device__ __forceinline__ void store_transposed(const f32x4 (&acc)[4][4], int wr, int wc, int lane, char* lds, const RowPtr& rp) {
    constexpr int LDT = BM + 8;
    bf16_t* Lt = (bf16_t*)lds;
#pragma unroll
    for (int i = 0; i < 4; ++i)
#pragma unroll
        for (int j = 0; j < 4; ++j)
#pragma unroll
            for (int r = 0; r < 4; ++r)
                Lt[(wc * 64 + j * 16 + (lane >> 4) * 4 + r) * LDT + wr * 64 + i * 16 + (lane & 15)] = to_bf(acc[i][j][r]);
    __syncthreads();
    constexpr int CH = BN * (BM / 8) / NT;
#pragma unroll
    for (int k = 0; k < CH; ++k) {
        const int c = TIDX + k * NT, col = c / (BM / 8), kc = c % (BM / 8);
        *(uint4*)(rp(col) + kc * 8) = *(const uint4*)(Lt + col * LDT + kc * 8);
    }
    __syncthreads();
}

struct EpiIn0 {
    Lay lay; bf16_t *Qa, *Ka, *VtA, *tail; float *out_k, *out_v; const float *c64, *s64;
    template <int BM, int BN, int NT>
    __device__ __forceinline__ void run(f32x4 (&acc)[4][4], int m0, int n0, int wr, int wc, int lane, char* lds) const {
        const int nw = n0 + wc * 64, region = nw >> 9, cq = (lane >> 4) * 4;
        if (region <= 1) {
#pragma unroll
            for (int i = 0; i < 4; ++i) {
                const int lrow = m0 + wr * 64 + i * 16 + (lane & 15);
                const TokInfo ti = tokinfo(lay.tbase + lrow);
                if (ti.latent) {
#pragma unroll
                    for (int pg = 0; pg < 2; ++pg) {
                        const int val = pg ? (ti.pos & 63) : (ti.pos >> 6);
                        const float4 c4 = *(const float4*)(c64 + val * 16 + cq), s4 = *(const float4*)(s64 + val * 16 + cq);
                        const float cc[4] = {c4.x, c4.y, c4.z, c4.w}, sn[4] = {s4.x, s4.y, s4.z, s4.w};
#pragma unroll
                        for (int r = 0; r < 4; ++r) {
                            const float x1 = acc[i][2 * pg][r], x2 = acc[i][2 * pg + 1][r];
                            acc[i][2 * pg][r] = x1 * cc[r] - x2 * sn[r];
                            acc[i][2 * pg + 1][r] = x1 * sn[r] + x2 * cc[r];
                        }
                    }
                }
                bf16_t* dst = (region ? Ka : Qa) + (size_t)lrow * 512 + (nw & 511) + cq;
                const float qs = region ? 1.f : QSCALE_A;
#pragma unroll
                for (int j = 0; j < 4; ++j) *(uint2*)(dst + j * 16) = pk4(acc[i][j][0] * qs, acc[i][j][1] * qs, acc[i][j][2] * qs, acc[i][j][3] * qs);
                if (region == 1 && !ti.latent) {
                    float* ok = out_k + ((size_t)(ti.seq * 4 + ((nw - 512) >> 7)) * 256 + ti.pos) * 128 + ((nw - 512) & 127) + cq;
#pragma unroll
                    for (int j = 0; j < 4; ++j) *(float4*)(ok + j * 16) = make_float4(acc[i][j][0], acc[i][j][1], acc[i][j][2], acc[i][j][3]);
                }
            }
        } else if (region == 2) {
            const TokInfo t0 = tokinfo(lay.tbase + m0);
            if (!t0.latent) {
#pragma unroll
                for (int i = 0; i < 4; ++i) {
                    const int lrow = m0 + wr * 64 + i * 16 + (lane & 15);
                    const TokInfo ti = tokinfo(lay.tbase + lrow);
                    float* ov = out_v + ((size_t)(ti.seq * 4 + ((nw - 1024) >> 7)) * 256 + ti.pos) * 128 + ((nw - 1024) & 127) + cq;
#pragma unroll
                    for (int j = 0; j < 4; ++j) *(float4*)(ov + j * 16) = make_float4(acc[i][j][0], acc[i][j][1], acc[i][j][2], acc[i][j][3]);
                }
            }
            const int Lk = t0.latent ? VLD : 256, key0 = (t0.latent ? 512 : 0) + t0.pos;
            bf16_t* vb = VtA; const Lay l = lay; const int seq = t0.seq;
            store_transposed<BM, BN, NT>(acc, wr, wc, lane, lds, [=](int col) {
                const int c = n0 - 1024 + col;
                return vb + vt_off(l, seq, c >> 7) + (size_t)(c & 127) * Lk + key0;
            });
        } else {
#pragma unroll
            for (int i = 0; i < 4; ++i) {
                const int lrow = m0 + wr * 64 + i * 16 + (lane & 15);
                bf16_t* dst = tail + (size_t)lrow * 384 + (nw - 1536) + cq;
#pragma unroll
                for (int j = 0; j < 4; ++j) *(uint2*)(dst + j * 16) = pk4(acc[i][j][0], acc[i][j][1], acc[i][j][2], acc[i][j][3]);
            }
        }
    }
};

template <int NT>
__device__ __forceinline__ void n_l0_tail(const Lay lay, const bf16_t* __restrict__ tail, const float* __restrict__ q_norm, const float* __restrict__ kv_norm,
                          const float* __restrict__ cache_ckv, const float* __restrict__ cache_kpe, const float* c32, const float* s32,
                          bf16_t* __restrict__ qdn, bf16_t* __restrict__ ckvn, bf16_t* __restrict__ Kb, float* __restrict__ out_ckv, float* __restrict__ out_kpe,
                          int vb, float* lds) {
    const int lrow = vb * (NT / 256) + (TIDX >> 8), tid = TIDX & 255;
    if (lrow >= lay.Tloc) {
        const int cr = lrow - lay.Tloc, b = lay.b0 + (cr >> 9), p = cr & 511;
        if (tid < 128) ckvn[(size_t)lrow * 128 + tid] = to_bf(cache_ckv[((size_t)b * 512 + p) * 128 + tid]);
        else if (tid < 160) {
            const bf16_t v = to_bf(cache_kpe[((size_t)b * 512 + p) * 32 + (tid - 128)]);
#pragma unroll
            for (int h = 0; h < 4; ++h) Kb[(size_t)lrow * 384 + h * 96 + 64 + (tid - 128)] = v;
        }
        return;
    }
    const int t = lay.tbase + lrow;
    const TokInfo ti = tokinfo(t);
    const bf16_t* p = tail + (size_t)lrow * 384;
    {
        const float v = tid < 192 ? bf1(p[tid]) : 0.f;
        const float ss = group_sum256<NT>(v * v, lds);
        const float rstd = rsqrtf(ss * (1.f / 192.f) + EPS);
        if (tid < 192) qdn[(size_t)lrow * 192 + tid] = to_bf(v * rstd * q_norm[tid]);
    }
    {
        const float v = tid < 128 ? bf1(p[192 + tid]) : 0.f;
        const float ss = group_sum256<NT>(v * v, lds);
        const float rstd = rsqrtf(ss * (1.f / 128.f) + EPS);
        if (tid < 128) {
            const float val = v * rstd * kv_norm[tid];
            ckvn[(size_t)lrow * 128 + tid] = to_bf(val);
            if (!ti.latent) out_ckv[(size_t)t * 128 + tid] = val;
        }
    }
    if (tid < 32) {
        float val;
        if (ti.latent) {
            const int i = tid & 7, part = tid >> 3;
            const int vv = (part < 2) ? (ti.pos >> 6) : (ti.pos & 63);
            const float cs = c32[vv * 8 + i], sn = s32[vv * 8 + i];
            const int base = 320 + (part >> 1) * 16;
            const float x1 = bf1(p[base + i]), x2 = bf1(p[base + 8 + i]);
            val = (part & 1) ? (x1 * sn + x2 * cs) : (x1 * cs - x2 * sn);
        } else {
            val = bf1(p[320 + tid]);
            out_kpe[(size_t)t * 32 + tid] = val;
        }
        const bf16_t vb16 = to_bf(val);
#pragma unroll
        for (int h = 0; h < 4; ++h) Kb[(size_t)lrow * 384 + h * 96 + 64 + tid] = vb16;
    }
}

template <int NT>
__device__ __forceinline__ void n_l0_tail_w(const Lay lay, const bf16_t* __restrict__ tail, const float* __restrict__ q_norm, const float* __restrict__ kv_norm,
                          const float* __restrict__ cache_ckv, const float* __restrict__ cache_kpe, const float* c32, const float* s32,
                          bf16_t* __restrict__ qdn, bf16_t* __restrict__ ckvn, bf16_t* __restrict__ Kb, float* __restrict__ out_ckv, float* __restrict__ out_kpe, int vb) {
    const int lane = TIDX & 63, lrow = vb * (NT / 64) + (TIDX >> 6);
    if (lrow >= lay.Tloc) {
        const int cr = lrow - lay.Tloc, b = lay.b0 + (cr >> 9), p = cr & 511;
        const float2 c2 = *(const float2*)(cache_ckv + ((size_t)b * 512 + p) * 128 + lane * 2);
        *(unsigned*)(ckvn + (size_t)lrow * 128 + lane * 2) = pk_bf16(c2.x, c2.y);
        if (lane < 32) {
            const bf16_t v = to_bf(cache_kpe[((size_t)b * 512 + p) * 32 + lane]);
#pragma unroll
            for (int h = 0; h < 4; ++h) Kb[(size_t)lrow * 384 + h * 96 + 64 + lane] = v;
        }
        return;
    }
    const int t = lay.tbase + lrow;
    const TokInfo ti = tokinfo(t);
    const bf16_t* p = tail + (size_t)lrow * 384;
    {
        const float v0 = bf1(p[lane]), v1 = bf1(p[lane + 64]), v2 = bf1(p[lane + 128]);
        const float ss = wave_sum(v0 * v0 + v1 * v1 + v2 * v2);
        const float rstd = rsqrtf(ss * (1.f / 192.f) + EPS);
        bf16_t* q = qdn + (size_t)lrow * 192;
        q[lane] = to_bf(v0 * rstd * q_norm[lane]); q[lane + 64] = to_bf(v1 * rstd * q_norm[lane + 64]); q[lane + 128] = to_bf(v2 * rstd * q_norm[lane + 128]);
    }
    {
        const unsigned u = *(const unsigned*)(p + 192 + lane * 2);
        const float v0 = bf_lo(u), v1 = bf_hi(u);
        const float ss = wave_sum(v0 * v0 + v1 * v1);
        const float rstd = rsqrtf(ss * (1.f / 128.f) + EPS);
        const float2 kn = *(const float2*)(kv_norm + lane * 2);
        const float a = v0 * rstd * kn.x, b = v1 * rstd * kn.y;
        *(unsigned*)(ckvn + (size_t)lrow * 128 + lane * 2) = pk_bf16(a, b);
        if (!ti.latent) *(float2*)(out_ckv + (size_t)t * 128 + lane * 2) = make_float2(a, b);
    }
    if (lane < 32) {
        float val;
        if (ti.latent) {
            const int i = lane & 7, part = lane >> 3;
            const int vv = (part < 2) ? (ti.pos >> 6) : (ti.pos & 63);
            const float cs = c32[vv * 8 + i], sn = s32[vv * 8 + i];
            const int base = 320 + (part >> 1) * 16;
            const float x1 = bf1(p[base + i]), x2 = bf1(p[base + 8 + i]);
            val = (part & 1) ? (x1 * sn + x2 * cs) : (x1 * cs - x2 * sn);
        } else {
            val = bf1(p[320 + lane]);
            out_kpe[(size_t)t * 32 + lane] = val;
        }
        const bf16_t vb16 = to_bf(val);
#pragma unroll
        for (int h = 0; h < 4; ++h) Kb[(size_t)lrow * 384 + h * 96 + 64 + lane] = vb16;
    }
}

struct EpiQb {
    Lay lay; bf16_t* Qb; const float *c32, *s32;
    template <int BM, int BN, int NT>
    __device__ __forceinline__ void run(f32x4 (&acc)[4][4], int m0, int n0, int wr, int wc, int lane, char*) const {
        const int nw = n0 + wc * 64, cq = (lane >> 4) * 4;
#pragma unroll
        for (int i = 0; i < 4; ++i) {
            const int lrow = m0 + wr * 64 + i * 16 + (lane & 15);
            const TokInfo ti = tokinfo(lay.tbase + lrow);
#pragma unroll
            for (int j = 0; j < 4; ++j) {
                const int tix = ((nw >> 4) + j) % 6;
                if (tix >= 4) {
                    const int val = (tix == 4) ? (ti.pos >> 6) : (ti.pos & 63);
                    const int fo = ((lane >> 4) & 1) * 4;
                    const float4 c4 = *(const float4*)(c32 + val * 8 + fo), s4 = *(const float4*)(s32 + val * 8 + fo);
                    const float cc[4] = {c4.x, c4.y, c4.z, c4.w}, sn[4] = {s4.x, s4.y, s4.z, s4.w};
                    const bool isx2 = (lane >> 5) != 0;
#pragma unroll
                    for (int r = 0; r < 4; ++r) {
                        const float mine = acc[i][j][r], other = __shfl_xor(mine, 32);
                        const float rot = isx2 ? (other * sn[r] + mine * cc[r]) : (mine * cc[r] - other * sn[r]);
                        acc[i][j][r] = ti.latent ? rot : mine;
                    }
                }
                *(uint2*)(Qb + (size_t)lrow * 384 + nw + j * 16 + cq) = pk4(acc[i][j][0] * QSCALE_B, acc[i][j][1] * QSCALE_B, acc[i][j][2] * QSCALE_B, acc[i][j][3] * QSCALE_B);
            }
        }
    }
};
struct EpiKV {
    Lay lay; bf16_t *Kb, *VtB;
    template <int BM, int BN, int NT>
    __device__ __forceinline__ void run(f32x4 (&acc)[4][4], int m0, int n0, int wr, int wc, int lane, char* lds) const {
        const int nw = n0 + wc * 64, cq = (lane >> 4) * 4;
        if (n0 < 256) {
#pragma unroll
            for (int i = 0; i < 4; ++i) {
                const int lrow = m0 + wr * 64 + i * 16 + (lane & 15);
                bf16_t* dst = Kb + (size_t)lrow * 384 + (nw >> 6) * 96 + cq;
#pragma unroll
                for (int j = 0; j < 4; ++j) *(uint2*)(dst + j * 16) = pk4(acc[i][j][0], acc[i][j][1], acc[i][j][2], acc[i][j][3]);
            }
        } else {
            int seq, key0, Lk;
            if (m0 < lay.Tloc) { const TokInfo t0 = tokinfo(lay.tbase + m0); seq = t0.seq; Lk = t0.latent ? VLD : 256; key0 = (t0.latent ? 512 : 0) + t0.pos; }
            else { const int cr = m0 - lay.Tloc; seq = 16 + lay.b0 + (cr >> 9); Lk = VLD; key0 = cr & 511; }
            bf16_t* vb = VtB; const Lay l = lay;
            store_transposed<BM, BN, NT>(acc, wr, wc, lane, lds, [=](int col) {
                const int c = n0 - 256 + col;
                return vb + vt_off(l, seq, c >> 7) + (size_t)(c & 127) * Lk + key0;
            });
        }
    }
};

template <int NT>
__device__ __forceinline__ void n_combine0(const bf16_t* __restrict__ oa1, const bf16_t* __restrict__ oa2, const float* lq1, const float* lk1, const float* lq2, const float* lk2,
                           const float* __restrict__ subln, bf16_t* __restrict__ merged, int vb) {
    const int lrow = vb * (NT / 256) + (TIDX >> 8), tid = TIDX & 255, lane = tid & 63;
    const float la = wave_sum(lq1[lane] * lk1[lane]), lb = wave_sum(lq2[lane] * lk2[lane]);
    const float lam = expf(la) - expf(lb) + 0.2f;
    const unsigned u1 = *(const unsigned*)(oa1 + (size_t)lrow * 512 + tid * 2), u2 = *(const unsigned*)(oa2 + (size_t)lrow * 512 + tid * 2);
    const float x0 = bf_lo(u1) - lam * bf_lo(u2), x1 = bf_hi(u1) - lam * bf_hi(u2);
    const float ss = wave_sum(x0 * x0 + x1 * x1);
    const float rs = rsqrtf(ss * (1.f / 128.f) + EPS) * 0.8f;
    const int e = (tid * 2) & 127;
    *(unsigned*)(merged + (size_t)lrow * DM + tid * 2) = pk_bf16(x0 * rs * subln[e], x1 * rs * subln[e + 1]);
}

template <int NT, int R>
__device__ __forceinline__ void n_combine0_m(const bf16_t* __restrict__ oa1, const bf16_t* __restrict__ oa2, const float* lq1, const float* lk1, const float* lq2, const float* lk2,
                           const float* __restrict__ subln, bf16_t* __restrict__ merged, int vb) {
    const int lrow0 = vb * (NT / 256) * R + (TIDX >> 8), tid = TIDX & 255, lane = tid & 63;
    unsigned u1[R], u2[R];
#pragma unroll
    for (int k = 0; k < R; ++k) {
        const size_t lrow = (size_t)(lrow0 + k * (NT / 256));
        u1[k] = *(const unsigned*)(oa1 + lrow * 512 + tid * 2); u2[k] = *(const unsigned*)(oa2 + lrow * 512 + tid * 2);
    }
    const float la = wave_sum(lq1[lane] * lk1[lane]), lb = wave_sum(lq2[lane] * lk2[lane]);
    const float lam = expf(la) - expf(lb) + 0.2f;
    const int e = (tid * 2) & 127;
    const float s0 = subln[e], s1 = subln[e + 1];
#pragma unroll
    for (int k = 0; k < R; ++k) {
        const size_t lrow = (size_t)(lrow0 + k * (NT / 256));
        const float x0 = bf_lo(u1[k]) - lam * bf_lo(u2[k]), x1 = bf_hi(u1[k]) - lam * bf_hi(u2[k]);
        const float ss = wave_sum(x0 * x0 + x1 * x1);
        const float rs = rsqrtf(ss * (1.f / 128.f) + EPS) * 0.8f;
        *(unsigned*)(merged + lrow * DM + tid * 2) = pk_bf16(x0 * rs * s0, x1 * rs * s1);
    }
}

struct EpiResid {
    Lay lay; const float *xp, *xs; const bf16_t* src; bf16_t* h; const float* modl; int goff;
    template <int BM, int BN, int NT>
    __device__ __forceinline__ void run(f32x4 (&acc)[4][4], int m0, int n0, int wr, int wc, int lane, char* l) const { run<BM, BN, NT, 4>(acc, m0, n0, wr, wc, lane, l); }
    template <int BM, int BN, int NT, int NJ>
    __device__ __forceinline__ void run(f32x4 (&acc)[4][NJ], int m0, int n0, int wr, int wc, int lane, char*) const {
        const int nw = n0 + wc * (16 * NJ), cq = (lane >> 4) * 4;
#pragma unroll
        for (int i = 0; i < 4; ++i) {
            const int lrow = m0 + wr * 64 + i * 16 + (lane & 15), t = lay.tbase + lrow;
            const TokInfo ti = tokinfo(t);
            const float* xr = xrow(xp, xs, t);
            const float* gt = modl + (size_t)ti.ci * 6144 + goff;
#pragma unroll
            for (int j = 0; j < NJ; ++j) {
                const int col = nw + j * 16 + cq;
                float4 b4;
                if (src) { const uint2 u = *(const uint2*)(src + (size_t)lrow * DM + col); b4 = make_float4(bf_lo(u.x), bf_hi(u.x), bf_lo(u.y), bf_hi(u.y)); }
                else b4 = *(const float4*)(xr + col);
                const float4 g4 = *(const float4*)(gt + col);
                *(uint2*)(h + (size_t)lrow * DM + col) = pk4(b4.x + g4.x * acc[i][j][0], b4.y + g4.y * acc[i][j][1], b4.z + g4.z * acc[i][j][2], b4.w + g4.w * acc[i][j][3]);
            }
        }
    }
};

template <int MH = 128>
struct EpiResid256 {
    EpiResid e; int m0;
    template <int NT>
    __device__ __forceinline__ void run256(f32x4 (&acc)[2][2][MH / 32][2], int n0, int wr, int wc, int lane, char*) const {
        const int cq = (lane >> 4) * 4;
#pragma unroll
        for (int ai = 0; ai < 2; ++ai)
#pragma unroll
            for (int m = 0; m < MH / 32; ++m) {
                const int lrow = m0 + ai * MH + wr * (MH / 2) + m * 16 + (lane & 15), t = e.lay.tbase + lrow;
                const TokInfo ti = tokinfo(t);
                const float* xr = xrow(e.xp, e.xs, t);
                const float* gt = e.modl + (size_t)ti.ci * 6144 + e.goff;
#pragma unroll
                for (int bj = 0; bj < 2; ++bj)
#pragma unroll
                    for (int n = 0; n < 2; ++n) {
                        const int col = n0 + bj * 128 + wc * 32 + n * 16 + cq;
                        float4 b4;
                        if (e.src) { const uint2 u = *(const uint2*)(e.src + (size_t)lrow * DM + col); b4 = make_float4(bf_lo(u.x), bf_hi(u.x), bf_lo(u.y), bf_hi(u.y)); }
                        else b4 = *(const float4*)(xr + col);
                        const float4 g4 = *(const float4*)(gt + col);
                        *(uint2*)(e.h + (size_t)lrow * DM + col) = pk4(b4.x + g4.x * acc[ai][bj][m][n][0], b4.y + g4.y * acc[ai][bj][m][n][1],
                                                                       b4.z + g4.z * acc[ai][bj][m][n][2], b4.w + g4.w * acc[ai][bj][m][n][3]);
                    }
            }
    }
};

struct EpiFFNUp {
    Lay lay; HaloTile ht; const float* cw; const float* cb; bf16_t* act;
    struct CW { float2 wg0, wg1, wg2, bg, wv0, wv1, wv2, bv; };
    template <int NT>
    __device__ __forceinline__ CW conv_w(int t128) const {
        constexpr int GH = 64, NP = GH / 2;
        const int fg = t128 * GH + 2 * (TIDX % NP);
        CW w;
        w.wg0 = *(const float2*)(cw + fg); w.wg1 = *(const float2*)(cw + FF2 + fg); w.wg2 = *(const float2*)(cw + 2 * FF2 + fg); w.bg = *(const float2*)(cb + fg);
        w.wv0 = *(const float2*)(cw + FF + fg); w.wv1 = *(const float2*)(cw + FF2 + FF + fg); w.wv2 = *(const float2*)(cw + 2 * FF2 + FF + fg); w.bv = *(const float2*)(cb + FF + fg);
        return w;
    }
    template <int NT>
    __device__ __forceinline__ void conv(const float* U, int t128, const CW& w) const {
        constexpr int BM = 256, GH = 64, LDU = 132, NP = GH / 2, NG = NT / NP, RPG = BM / NG;
        const int tid = TIDX, fp = tid % NP, grp = tid / NP, fg = t128 * GH + 2 * fp;
        const float2 wg0 = w.wg0, wg1 = w.wg1, wg2 = w.wg2, bg = w.bg, wv0 = w.wv0, wv1 = w.wv1, wv2 = w.wv2, bv = w.bv;
        const int r0 = grp * RPG;
        const float* Ug = U + 2 * fp;
        const float2 z2 = make_float2(0.f, 0.f);
        float2 gq[RPG + 2], vq[RPG + 2];
        {
            const int rm = r0 > 0 ? r0 - 1 : 0, rp = r0 + RPG < BM ? r0 + RPG : BM - 1;
            gq[0] = *(const float2*)(Ug + rm * LDU); vq[0] = *(const float2*)(Ug + rm * LDU + GH);
#pragma unroll
            for (int k = 0; k < RPG; ++k) { gq[k + 1] = *(const float2*)(Ug + (r0 + k) * LDU); vq[k + 1] = *(const float2*)(Ug + (r0 + k) * LDU + GH); }
            gq[RPG + 1] = *(const float2*)(Ug + rp * LDU); vq[RPG + 1] = *(const float2*)(Ug + rp * LDU + GH);
            if (r0 == 0) { gq[0] = z2; vq[0] = z2; }
            if (r0 + RPG == BM) { gq[RPG + 1] = z2; vq[RPG + 1] = z2; }
        }
        bf16_t* ap = act + (size_t)(ht.t0 + ht.row0 + r0 - lay.tbase) * FF + fg;
#pragma unroll
        for (int k = 0; k < RPG; ++k) {
            const int r = r0 + k;
            if (r >= ht.lo && r < ht.hi) {
                const float2 gp = gq[k], gc = gq[k + 1], gn = gq[k + 2], vp = vq[k], vc = vq[k + 1], vn = vq[k + 2];
                const float ga = wg0.x * gp.x + wg1.x * gc.x + wg2.x * gn.x + bg.x, gb = wg0.y * gp.y + wg1.y * gc.y + wg2.y * gn.y + bg.y;
                const float va = wv0.x * vp.x + wv1.x * vc.x + wv2.x * vn.x + bv.x, vb = wv0.y * vp.y + wv1.y * vc.y + wv2.y * vn.y + bv.y;
                *(unsigned*)(ap + (size_t)k * FF) = pk_bf16(ga * __builtin_amdgcn_rcpf(1.f + __expf(-ga)) * va, gb * __builtin_amdgcn_rcpf(1.f + __expf(-gb)) * vb);
            }
        }
    }
    template <int BM, int BN, int NT>
    __device__ __forceinline__ void run(f32x4 (&acc)[4][4], int m0, int n0, int wr, int wc, int lane, char* lds) const {
        static_assert(BM == 256 && BN == 128, "tile");
        constexpr int LDU = BN + 4;
        float* U = (float*)lds;
        const CW w = conv_w<NT>(n0 / BN);
#pragma unroll
        for (int i = 0; i < 4; ++i)
#pragma unroll
            for (int j = 0; j < 4; ++j)
                *(f32x4*)(U + (wr * 64 + i * 16 + (lane & 15)) * LDU + wc * 64 + j * 16 + (lane >> 4) * 4) = acc[i][j];
        __syncthreads();
        conv<NT>(U, n0 / BN, w);
        __syncthreads();
    }
    template <int NT>
    __device__ __forceinline__ void run256(f32x4 (&acc)[2][2][4][2], int n0, int wr, int wc, int lane, char* lds) const {
        constexpr int LDU = 132;
        float* U = (float*)lds;
        const CW w0 = conv_w<NT>(n0 / 128), w1 = conv_w<NT>(n0 / 128 + 1);
#pragma unroll
        for (int bj = 0; bj < 2; ++bj) {
#pragma unroll
            for (int ai = 0; ai < 2; ++ai)
#pragma unroll
                for (int m = 0; m < 4; ++m)
#pragma unroll
                    for (int n = 0; n < 2; ++n)
                        *(f32x4*)(U + (ai * 128 + wr * 64 + m * 16 + (lane & 15)) * LDU + wc * 32 + n * 16 + (lane >> 4) * 4) = acc[ai][bj][m][n];
            __syncthreads();
            conv<NT>(U, n0 / 128 + bj, bj == 0 ? w0 : w1);
            __syncthreads();
        }
    }
};


template <int CTRL> __device__ __forceinline__ float dppf(float x) {
    return __builtin_bit_cast(float, __builtin_amdgcn_mov_dpp(__builtin_bit_cast(int, x), CTRL, 0xF, 0xF, true));
}
__device__ __forceinline__ float sfma(float a, float b, float c) { float d; asm("v_fma_f32 %0, %1, %2, %3" : "=v"(d) : "v"(a), "v"(b), "v"(c)); return d; }
__device__ __forceinline__ float smul(float a, float b) { float d; asm("v_mul_f32 %0, %1, %2" : "=v"(d) : "v"(a), "v"(b)); return d; }
__device__ __forceinline__ float sadd(float a, float b) { float d; asm("v_add_f32 %0, %1, %2" : "=v"(d) : "v"(a), "v"(b)); return d; }
__device__ __forceinline__ float red8(float x) { x += dppf<0xB1>(x); x += dppf<0x4E>(x); x += dppf<0x141>(x); return x; }
__device__ __forceinline__ float red16(float x) { x = red8(x); x += dppf<0x140>(x); return x; }
__device__ __forceinline__ float fsigmoid(float x) { return __builtin_amdgcn_rcpf(1.f + __expf(-x)); }
__device__ __forceinline__ float ftanh(float x) { return 1.f - 2.f * __builtin_amdgcn_rcpf(1.f + __expf(2.f * x)); }
__device__ __forceinline__ void unpack8(const uint4 u, float (&f)[8]) {
    f[0] = bf_lo(u.x); f[1] = bf_hi(u.x); f[2] = bf_lo(u.y); f[3] = bf_hi(u.y); f[4] = bf_lo(u.z); f[5] = bf_hi(u.z); f[6] = bf_lo(u.w); f[7] = bf_hi(u.w);
}

struct EpiIn1 {
    Lay lay; HaloTile ht; const float *mu, *conv_w, *conv_b; bf16_t *zcm, *zg, *xc; float* dtr;
    struct SW { float2 k0, k1, k2, kb; };
    template <int NT>
    __device__ __forceinline__ SW staged_w(int nt) const {
        constexpr int BN = 128, NP = BN / 2;
        const bool mix = nt < 15;
        const int c = (mix ? nt * BN : nt * BN - 2432) + 2 * (TIDX % NP);
        const float2 z2 = make_float2(0.f, 0.f);
        SW w;
        w.k0 = mix ? z2 : *(const float2*)(conv_w + c); w.k1 = mix ? *(const float2*)(mu + c) : *(const float2*)(conv_w + 768 + c);
        w.k2 = mix ? z2 : *(const float2*)(conv_w + 2 * 768 + c); w.kb = mix ? z2 : *(const float2*)(conv_b + c);
        return w;
    }
    template <int NT>
    __device__ __forceinline__ void staged(const float* U, int nt, const SW& w) const {
        constexpr int BM = 256, BN = 128, LDU = BN + 4, NP = BN / 2, NG = NT / NP, RPG = BM / NG;
        const int n0 = nt * BN;
        const int tid = TIDX, fp = tid % NP, grp = tid / NP, r0 = grp * RPG;
        const bool mix = nt < 15;
        const int c = (mix ? n0 : n0 - 2432) + 2 * fp;
        const float2 z2 = make_float2(0.f, 0.f);
        const float2 k0 = w.k0, k1 = w.k1, k2 = w.k2, kb = w.kb;
        const float* Uc = U + 2 * fp;
        float2 xq[RPG + 2];
        {
            const int rm = r0 > 0 ? r0 - 1 : 0, rp = r0 + RPG < BM ? r0 + RPG : BM - 1;
            xq[0] = *(const float2*)(Uc + rm * LDU);
#pragma unroll
            for (int k = 0; k < RPG; ++k) xq[k + 1] = *(const float2*)(Uc + (r0 + k) * LDU);
            xq[RPG + 1] = *(const float2*)(Uc + rp * LDU);
            if (r0 == 0) xq[0] = z2;
            if (r0 + RPG == BM) xq[RPG + 1] = z2;
        }
        const size_t lrow0 = (size_t)(ht.t0 + ht.row0 + r0 - lay.tbase);
        const int ostr = mix ? CC : 768;
        bf16_t* op = zcm + ((mix ? (ptrdiff_t)0 : xc - zcm) + (ptrdiff_t)lrow0 * ostr + c);
#pragma unroll
        for (int k = 0; k < RPG; ++k) {
            const int r = r0 + k;
            if (r >= ht.lo && r < ht.hi) {
                const float2 xp = xq[k], xv = xq[k + 1], xn = xq[k + 2];
                float oa, ob;
                if (mix) { oa = xv.x + k1.x * (0.5f * (xp.x + xn.x) - xv.x); ob = xv.y + k1.y * (0.5f * (xp.y + xn.y) - xv.y); }
                else {
                    const float sa = k0.x * xp.x + k1.x * xv.x + k2.x * xn.x + kb.x, sb = k0.y * xp.y + k1.y * xv.y + k2.y * xn.y + kb.y;
                    oa = sa * __builtin_amdgcn_rcpf(1.f + __expf(-sa)); ob = sb * __builtin_amdgcn_rcpf(1.f + __expf(-sb));
                }
                *(unsigned*)(op + (size_t)k * ostr) = pk_bf16(oa, ob);
            }
        }
    }
    template <int BM, int BN, int NT>
    __device__ __forceinline__ void run(f32x4 (&acc)[4][4], int m0, int n0, int wr, int wc, int lane, char* lds) const {
        static_assert(BN == 128 && BM == 256, "tile");
        const int nt = n0 / BN, cq = (lane >> 4) * 4;
        if (nt >= 15 && nt < 19) {
#pragma unroll
            for (int i = 0; i < 4; ++i) {
                const int r = wr * 64 + i * 16 + (lane & 15);
                if (r >= ht.lo && r < ht.hi) {
                    bf16_t* dst = zg + (size_t)(ht.t0 + ht.row0 + r - lay.tbase) * 512 + (n0 - 1920) + wc * 64 + cq;
#pragma unroll
                    for (int j = 0; j < 4; ++j) *(uint2*)(dst + j * 16) = pk4(acc[i][j][0], acc[i][j][1], acc[i][j][2], acc[i][j][3]);
                }
            }
            return;
        }
        if (nt == 25) {
            if (wc == 0 && lane < 32) {
#pragma unroll
                for (int i = 0; i < 4; ++i) {
                    const int r = wr * 64 + i * 16 + (lane & 15);
                    if (r >= ht.lo && r < ht.hi)
                        *(float4*)(dtr + (size_t)(ht.t0 + ht.row0 + r - lay.tbase) * 8 + cq) = make_float4(acc[i][0][0], acc[i][0][1], acc[i][0][2], acc[i][0][3]);
                }
            }
            return;
        }
        constexpr int LDU = BN + 4;
        float* U = (float*)lds;
        const SW w = staged_w<NT>(nt);
#pragma unroll
        for (int i = 0; i < 4; ++i)
#pragma unroll
            for (int j = 0; j < 4; ++j)
                *(f32x4*)(U + (wr * 64 + i * 16 + (lane & 15)) * LDU + wc * 64 + j * 16 + cq) = acc[i][j];
        __syncthreads();
        staged<NT>(U, nt, w);
        __syncthreads();
    }
    template <int NT>
    __device__ __forceinline__ void run256(f32x4 (&acc)[2][2][4][2], int n0, int wr, int wc, int lane, char* lds) const {
        constexpr int LDU = 132;
        const int cq = (lane >> 4) * 4;
        float* U = (float*)lds;
#pragma unroll
        for (int bj = 0; bj < 2; ++bj) {
            const int nt = n0 / 128 + bj;
            if (nt >= 15 && nt < 19) {
#pragma unroll
                for (int ai = 0; ai < 2; ++ai)
#pragma unroll
                    for (int m = 0; m < 4; ++m) {
                        const int r = ai * 128 + wr * 64 + m * 16 + (lane & 15);
                        if (r >= ht.lo && r < ht.hi) {
                            bf16_t* dst = zg + (size_t)(ht.t0 + ht.row0 + r - lay.tbase) * 512 + (nt * 128 - 1920) + wc * 32 + cq;
#pragma unroll
                            for (int n = 0; n < 2; ++n) *(uint2*)(dst + n * 16) = pk4(acc[ai][bj][m][n][0], acc[ai][bj][m][n][1], acc[ai][bj][m][n][2], acc[ai][bj][m][n][3]);
                        }
                    }
            } else if (nt == 25) {
                if (wc == 0 && lane < 32) {
#pragma unroll
                    for (int ai = 0; ai < 2; ++ai)
#pragma unroll
                        for (int m = 0; m < 4; ++m) {
                            const int r = ai * 128 + wr * 64 + m * 16 + (lane & 15);
                            if (r >= ht.lo && r < ht.hi)
                                *(float4*)(dtr + (size_t)(ht.t0 + ht.row0 + r - lay.tbase) * 8 + cq) =
                                    make_float4(acc[ai][bj][m][0][0], acc[ai][bj][m][0][1], acc[ai][bj][m][0][2], acc[ai][bj][m][0][3]);
                        }
                }
            } else {
                const SW w = staged_w<NT>(nt);
#pragma unroll
                for (int ai = 0; ai < 2; ++ai)
#pragma unroll
                    for (int m = 0; m < 4; ++m)
#pragma unroll
                        for (int n = 0; n < 2; ++n)
                            *(f32x4*)(U + (ai * 128 + wr * 64 + m * 16 + (lane & 15)) * LDU + wc * 32 + n * 16 + cq) = acc[ai][bj][m][n];
                __syncthreads();
                staged<NT>(U, nt, w);
                __syncthreads();
            }
        }
    }
};


template <int KS, bool TRANS>
__device__ __forceinline__ f32x4 mm_tile(const bf16_t* A, int lda, const bf16_t* Bt, int ldb, f32x4 acc, int lane) {
#pragma unroll
    for (int ks = 0; ks < KS; ++ks) {
        const bf16x8 a = *(const bf16x8*)(A + (lane & 15) * lda + ks * 32 + (lane >> 4) * 8);
        const bf16x8 b = *(const bf16x8*)(Bt + (lane & 15) * ldb + ks * 32 + (lane >> 4) * 8);
        acc = TRANS ? __builtin_amdgcn_mfma_f32_16x16x32_bf16(b, a, acc, 0, 0, 0) : __builtin_amdgcn_mfma_f32_16x16x32_bf16(a, b, acc, 0, 0, 0);
    }
    return acc;
}
typedef __attribute__((ext_vector_type(2))) unsigned u32x2;
__device__ __forceinline__ bf16x8 ld_row(const bf16_t* A, int lda, int lane) { return *(const bf16x8*)(A + (lane & 15) * lda + (lane >> 4) * 8); }
__device__ __forceinline__ bf16x8 ld_row16(const bf16_t* A, int lane) {
    bf16x8 a = *(const bf16x8*)(A + (lane & 15) * 24 + ((lane >> 4) & 1) * 8);
    if (lane >= 32) a = (bf16x8){0, 0, 0, 0, 0, 0, 0, 0};
    return a;
}
template <bool K16>
__device__ __forceinline__ bf16x8 ld_tr(const bf16_t* X, int ld, int lane) {
    const int g = K16 ? ((lane >> 4) & 1) : (lane >> 4), q = (lane & 15) >> 2, p = lane & 3;
    const unsigned a0 = (unsigned)(size_t)(X + (8 * g + q) * ld + 4 * p), a1 = a0 + 8u * (unsigned)ld;
    u32x2 r0, r1;
    asm volatile("ds_read_b64_tr_b16 %0, %2\n\tds_read_b64_tr_b16 %1, %3\n\ts_waitcnt lgkmcnt(0)" : "=&v"(r0), "=&v"(r1) : "v"(a0), "v"(a1) : "memory");
    u32x4 v = {r0.x, r0.y, r1.x, r1.y};
    if (K16 && lane >= 32) v = (u32x4){0u, 0u, 0u, 0u};
    return __builtin_bit_cast(bf16x8, v);
}
template <bool K16>
__device__ __forceinline__ void ld_tr2(const bf16_t* X0, const bf16_t* X1, int ld, int lane, bf16x8& o0, bf16x8& o1) {
    const int g = K16 ? ((lane >> 4) & 1) : (lane >> 4), q = (lane & 15) >> 2, p = lane & 3;
    const unsigned off = (unsigned)(((8 * g + q) * ld + 4 * p) * 2), st = 8u * (unsigned)ld;
    const unsigned a0 = (unsigned)(size_t)X0 + off, a1 = (unsigned)(size_t)X1 + off;
    u32x2 r0, r1, r2, r3;
    asm volatile("ds_read_b64_tr_b16 %0, %4\n\tds_read_b64_tr_b16 %1, %5\n\tds_read_b64_tr_b16 %2, %6\n\tds_read_b64_tr_b16 %3, %7\n\ts_waitcnt lgkmcnt(0)"
                 : "=&v"(r0), "=&v"(r1), "=&v"(r2), "=&v"(r3) : "v"(a0), "v"(a0 + st), "v"(a1), "v"(a1 + st) : "memory");
    u32x4 v0 = {r0.x, r0.y, r1.x, r1.y}, v1 = {r2.x, r2.y, r3.x, r3.y};
    if (K16 && lane >= 32) { v0 = (u32x4){0u, 0u, 0u, 0u}; v1 = v0; }
    o0 = __builtin_bit_cast(bf16x8, v0); o1 = __builtin_bit_cast(bf16x8, v1);
}
template <bool K16>
__device__ __forceinline__ void ld_tr4(const bf16_t* X0, const bf16_t* X1, const bf16_t* X2, const bf16_t* X3, int ld, int lane, bf16x8& o0, bf16x8& o1, bf16x8& o2, bf16x8& o3) {
    const int g = K16 ? ((lane >> 4) & 1) : (lane >> 4), q = (lane & 15) >> 2, p = lane & 3;
    const unsigned off = (unsigned)(((8 * g + q) * ld + 4 * p) * 2), st = 8u * (unsigned)ld;
    const unsigned a0 = (unsigned)(size_t)X0 + off, a1 = (unsigned)(size_t)X1 + off, a2 = (unsigned)(size_t)X2 + off, a3 = (unsigned)(size_t)X3 + off;
    u32x2 r0, r1, r2, r3, r4, r5, r6, r7;
    asm volatile("ds_read_b64_tr_b16 %0, %8\n\tds_read_b64_tr_b16 %1, %9\n\tds_read_b64_tr_b16 %2, %10\n\tds_read_b64_tr_b16 %3, %11\n\t"
                 "ds_read_b64_tr_b16 %4, %12\n\tds_read_b64_tr_b16 %5, %13\n\tds_read_b64_tr_b16 %6, %14\n\tds_read_b64_tr_b16 %7, %15\n\ts_waitcnt lgkmcnt(0)"
                 : "=&v"(r0), "=&v"(r1), "=&v"(r2), "=&v"(r3), "=&v"(r4), "=&v"(r5), "=&v"(r6), "=&v"(r7)
                 : "v"(a0), "v"(a0 + st), "v"(a1), "v"(a1 + st), "v"(a2), "v"(a2 + st), "v"(a3), "v"(a3 + st) : "memory");
    u32x4 v0 = {r0.x, r0.y, r1.x, r1.y}, v1 = {r2.x, r2.y, r3.x, r3.y}, v2 = {r4.x, r4.y, r5.x, r5.y}, v3 = {r6.x, r6.y, r7.x, r7.y};
    if (K16 && lane >= 32) { v0 = (u32x4){0u, 0u, 0u, 0u}; v1 = v0; v2 = v0; v3 = v0; }
    o0 = __builtin_bit_cast(bf16x8, v0); o1 = __builtin_bit_cast(bf16x8, v1); o2 = __builtin_bit_cast(bf16x8, v2); o3 = __builtin_bit_cast(bf16x8, v3);
}
template <bool TRANS>
__device__ __forceinline__ f32x4 mma(const bf16x8 a, const bf16x8 b, const f32x4 acc) {
    return TRANS ? __builtin_amdgcn_mfma_f32_16x16x32_bf16(b, a, acc, 0, 0, 0) : __builtin_amdgcn_mfma_f32_16x16x32_bf16(a, b, acc, 0, 0, 0);
}

template <int NT>
__device__ __forceinline__ void n_ssd2(const Lay lay, const bf16_t* __restrict__ xc, const float* __restrict__ dtr, const float* __restrict__ A_log, const float* __restrict__ dt_bias,
                                       const float* __restrict__ Dp, const float* __restrict__ H0f, const float* __restrict__ H0b, bf16_t* __restrict__ yd,
                                       float* __restrict__ Hf_out, float* __restrict__ Hb_out, int item, char* lds,
                                       const int c0, const int c1, const float* __restrict__ Hinit, float* __restrict__ Hend) {
    static_assert(NT == 512, "n_ssd2 needs 8 waves");
    const int tid = TIDX, lane = tid & 63, wv = tid >> 6;
    const int dir = item & 1, h = (item >> 1) & 7, seq = lay.seqbase + (item >> 4), g = h >> 2;
    const bool latent = seq >= 16;
    const int L = latent ? 4096 : 256, row0 = (latent ? 4096 + (seq - 16) * 4096 : seq * 256) - lay.tbase;
    bf16_t* Cs = (bf16_t*)lds; bf16_t* Bs = Cs + 4608; bf16_t* Cd = Bs + 4608; bf16_t* Sc = Cd + 4608; bf16_t* Xs = Sc + 4608; bf16_t* Xd = Xs + 4608;
    bf16_t* Sb0 = Xd + 4608; bf16_t* Sb1 = Sb0 + 4608;
    float* acum = (float*)(Sb1 + 4608); float* dts = acum + 64;
    const int pt = tid >> 3, part = tid & 7;
    const int tT = wv >> 1, q0 = (wv & 1) * 2;
    const float A = -__expf(A_log[dir * 8 + h]), Dv = Dp[dir * 8 + h], dtb = dt_bias[dir * 8 + h];
    f32x4 S[2];
    __syncthreads();
    {
        const float* H0 = dir ? H0b : H0f;
#pragma unroll
        for (int q = 0; q < 2; ++q)
#pragma unroll
            for (int r = 0; r < 4; ++r) {
                const int p = tT * 16 + (lane >> 4) * 4 + r, n = (q0 + q) * 16 + (lane & 15);
                const float v = Hinit ? Hinit[p * 64 + n] : (latent ? H0[((size_t)((seq - 16) * 8 + h) * 64 + p) * 64 + n] : 0.f);
                S[q][r] = v; Sb0[p * 72 + n] = to_bf(v);
            }
    }
    uint4 g_b, g_c, g_x; float g_dt = 0.f;
#define SSD2_LOAD(cidx) { const int s_ = (cidx) * 64 + pt; const int pos_ = dir ? (L - 1 - s_) : s_; \
        const bf16_t* xr_ = xc + (size_t)(row0 + pos_) * 768; \
        g_b = *(const uint4*)(xr_ + 512 + g * 64 + part * 8); g_c = *(const uint4*)(xr_ + 640 + g * 64 + part * 8); g_x = *(const uint4*)(xr_ + h * 64 + part * 8); \
        if (part == 0) g_dt = dtr[(size_t)(row0 + pos_) * 8 + h]; }
    SSD2_LOAD(c0)
    int cur = 0;
    for (int c = c0; c < c1; ++c) {
        bf16_t* Sbc = cur ? Sb1 : Sb0; bf16_t* Sbn = cur ? Sb0 : Sb1;
        float fc[8], fx[8];
        {
            unpack8(g_c, fc); unpack8(g_x, fx);
            *(uint4*)(Cs + pt * 72 + part * 8) = g_c;
            *(uint4*)(Bs + pt * 72 + part * 8) = g_b;
            *(uint4*)(Xs + pt * 72 + part * 8) = g_x;
            if (part == 0) {
                const float xx = g_dt + dtb;
                const float dt = fmaxf(xx, 0.f) + __logf(1.f + __expf(-fabsf(xx)));
                dts[pt] = dt; acum[pt] = dt * A;
            }
        }
        if (c + 1 < c1) SSD2_LOAD(c + 1)
        __syncthreads();
        if (wv == 0) {
            float v = acum[lane];
#pragma unroll
            for (int o = 1; o < 64; o <<= 1) { const float u = __shfl_up(v, o); if (lane >= o) v += u; }
            acum[lane] = v;
        }
        __syncthreads();
        {
            const float ac = acum[pt], et = __expf(ac), sc = dts[pt] * __expf(acum[63] - ac);
            *(uint4*)(Cd + pt * 72 + part * 8) = make_uint4(pk_bf16(fc[0] * et, fc[1] * et), pk_bf16(fc[2] * et, fc[3] * et), pk_bf16(fc[4] * et, fc[5] * et), pk_bf16(fc[6] * et, fc[7] * et));
            *(uint4*)(Xd + pt * 72 + part * 8) = make_uint4(pk_bf16(fx[0] * sc, fx[1] * sc), pk_bf16(fx[2] * sc, fx[3] * sc), pk_bf16(fx[4] * sc, fx[5] * sc), pk_bf16(fx[6] * sc, fx[7] * sc));
        }
        __syncthreads();
        {
#pragma unroll
            for (int q = 0; q < 2; ++q) {
                f32x4 acc = mm_tile<2, false>(Cs + tT * 16 * 72, 72, Bs + (q0 + q) * 16 * 72, 72, (f32x4){0.f, 0.f, 0.f, 0.f}, lane);
                const int j = (q0 + q) * 16 + (lane & 15);
                const float aj = acum[j], dj = dts[j];
#pragma unroll
                for (int r = 0; r < 4; ++r) {
                    const int t = tT * 16 + (lane >> 4) * 4 + r;
                    Sc[t * 72 + j] = to_bf(j <= t ? acc[r] * __expf(acum[t] - aj) * dj : 0.f);
                }
            }
        }
        __syncthreads();
        {
#pragma unroll
            for (int q = 0; q < 2; ++q) {
                f32x4 acc = (f32x4){0.f, 0.f, 0.f, 0.f};
                bf16x8 x0, x1;
                ld_tr2<false>(Xs + (q0 + q) * 16, Xs + 32 * 72 + (q0 + q) * 16, 72, lane, x0, x1);
                acc = mma<true>(ld_row(Sc + tT * 16 * 72, 72, lane), x0, acc);
                acc = mma<true>(ld_row(Sc + tT * 16 * 72 + 32, 72, lane), x1, acc);
                acc = mm_tile<2, true>(Cd + tT * 16 * 72, 72, Sbc + (q0 + q) * 16 * 72, 72, acc, lane);
                const int t = tT * 16 + (lane & 15), p = (q0 + q) * 16 + (lane >> 4) * 4;
                const int s = c * 64 + t, pos = dir ? (L - 1 - s) : s;
                const uint2 ux = *(const uint2*)(xc + (size_t)(row0 + pos) * 768 + h * 64 + p);
                *(uint2*)(yd + ((size_t)dir * lay.Tloc + row0 + pos) * 512 + h * 64 + p) =
                    pk4(acc[0] + Dv * bf_lo(ux.x), acc[1] + Dv * bf_hi(ux.x), acc[2] + Dv * bf_lo(ux.y), acc[3] + Dv * bf_hi(ux.y));
            }
            const float eC = __expf(acum[63]);
            bf16x8 xd0, xd1, bb00, bb01, bb10, bb11;
            ld_tr2<false>(Xd + tT * 16, Xd + 32 * 72 + tT * 16, 72, lane, xd0, xd1);
            ld_tr4<false>(Bs + q0 * 16, Bs + (q0 + 1) * 16, Bs + 32 * 72 + q0 * 16, Bs + 32 * 72 + (q0 + 1) * 16, 72, lane, bb00, bb01, bb10, bb11);
#pragma unroll
            for (int q = 0; q < 2; ++q) {
                S[q] = S[q] * eC;
                S[q] = mma<false>(xd0, q ? bb01 : bb00, S[q]);
                S[q] = mma<false>(xd1, q ? bb11 : bb10, S[q]);
#pragma unroll
                for (int r = 0; r < 4; ++r) Sbn[(tT * 16 + (lane >> 4) * 4 + r) * 72 + (q0 + q) * 16 + (lane & 15)] = to_bf(S[q][r]);
            }
        }
        __syncthreads();
        cur ^= 1;
    }
    float* Ho = dir ? Hb_out : Hf_out;
    if (!latent) {
#pragma unroll
        for (int q = 0; q < 2; ++q)
#pragma unroll
            for (int r = 0; r < 4; ++r) Ho[((size_t)(seq * 8 + h) * 64 + tT * 16 + (lane >> 4) * 4 + r) * 64 + (q0 + q) * 16 + (lane & 15)] = S[q][r];
    }
    if (Hend) {
#pragma unroll
        for (int q = 0; q < 2; ++q)
#pragma unroll
            for (int r = 0; r < 4; ++r) Hend[(tT * 16 + (lane >> 4) * 4 + r) * 64 + (q0 + q) * 16 + (lane & 15)] = S[q][r];
    }
#undef SSD2_LOAD
}

template <int NT>
__device__ __forceinline__ void n_wkv2(const Lay lay, const bf16_t* __restrict__ zcm, const bf16_t* __restrict__ w2t, const bf16_t* __restrict__ a2t,
                                       const float* __restrict__ w0, const float* __restrict__ a0, const float* __restrict__ k_k, const float* __restrict__ k_a,
                                       const float* __restrict__ S0f, const float* __restrict__ S0b, bf16_t* __restrict__ y,
                                       float* __restrict__ Sf_out, float* __restrict__ Sb_out, int item, char* lds) {
    static_assert(NT == 512, "n_wkv2 needs 8 waves");
    const int tid = TIDX, lane = tid & 63, wv = tid >> 6;
    const int dir = item & 1, h = (item >> 1) & 7, seq = lay.seqbase + (item >> 4);
    const bool latent = seq >= 16;
    const int L = latent ? 4096 : 256, row0 = (latent ? 4096 + (seq - 16) * 4096 : seq * 256) - lay.tbase;
    bf16_t* W2s = (bf16_t*)lds; bf16_t* A2s = W2s + 4608; bf16_t* Sb0 = A2s + 4608; bf16_t* Sb1 = Sb0 + 4608;
    bf16_t* KR = Sb1 + 4608; bf16_t* RR = KR + 2304;
    constexpr int LG = 68;
    float* AA = (float*)(RR + 2304); float* GG = AA + 32 * LG; float* rsv = GG + 32 * LG; float* gC = rsv + 32;
    bf16_t* X1 = (bf16_t*)(gC + 128); bf16_t* X2 = X1 + 2304;
    bf16_t* OPS = X2 + 2304;
    constexpr int OPS_SC = 7 * 1152;
    bf16_t* TMP = OPS + 2 * OPS_SC;
    constexpr int TMP_SC = 512 + 4 * 384 + 1152 + 1152;
    bf16_t* Us = TMP + 2 * TMP_SC;
    __syncthreads();
    {
        const int c = tid >> 3, part = tid & 7;
        *(uint4*)(W2s + c * 72 + part * 8) = *(const uint4*)(w2t + ((size_t)dir * 512 + h * 64 + c) * 64 + part * 8);
        *(uint4*)(A2s + c * 72 + part * 8) = *(const uint4*)(a2t + ((size_t)dir * 512 + h * 64 + c) * 64 + part * 8);
    }
    const int pt = tid >> 4, part = tid & 15, ch0 = part * 4;
    const int psc = pt >> 4, ptl = pt & 15;
    float kkc[4], kac[4];
#pragma unroll
    for (int i = 0; i < 4; ++i) { kkc[i] = k_k[h * 64 + ch0 + i]; kac[i] = k_a[h * 64 + ch0 + i]; }
    const int lm = wv >> 2, lrt = (wv >> 1) & 1, lct0 = (wv & 1) * 2;
    float lc0[2];
#pragma unroll
    for (int q = 0; q < 2; ++q) { const int ch = dir * 512 + h * 64 + (lct0 + q) * 16 + (lane & 15); lc0[q] = lm ? a0[ch] : w0[ch]; }
    const int vT = wv >> 1, kT0 = (wv & 1) * 2;
    f32x4 S[2];
    f32x4 accU = (f32x4){0.f, 0.f, 0.f, 0.f};
    {
        const float* S0 = dir ? S0b : S0f;
#pragma unroll
        for (int q = 0; q < 2; ++q)
#pragma unroll
            for (int r = 0; r < 4; ++r) {
                const int v = vT * 16 + (lane >> 4) * 4 + r, k = (kT0 + q) * 16 + (lane & 15);
                const float x = latent ? S0[((size_t)((seq - 16) * 8 + h) * 64 + v) * 64 + k] : 0.f;
                S[q][r] = x; Sb0[v * 72 + k] = to_bf(x);
            }
    }
    uint2 g_r, g_k, g_wd, g_ad, g_v;
#define WKV2_LOAD(cidx) { const int s_ = (cidx) * 32 + pt; const int pos_ = dir ? (L - 1 - s_) : s_; \
        const bf16_t* zr_ = zcm + (size_t)(row0 + pos_) * CC; \
        g_r = *(const uint2*)(zr_ + h * 64 + ch0); g_k = *(const uint2*)(zr_ + 512 + h * 64 + ch0); g_v = *(const uint2*)(zr_ + 1024 + h * 64 + ch0); \
        g_wd = *(const uint2*)(zr_ + 1536 + dir * 64 + ch0); g_ad = *(const uint2*)(zr_ + 1664 + dir * 64 + ch0); }
    WKV2_LOAD(0)
    const int nb = L / 32;
    int cur = 0;
    for (int c = 0; c < nb; ++c) {
        float fr[4], fk[4];
        {
            fr[0] = bf_lo(g_r.x); fr[1] = bf_hi(g_r.x); fr[2] = bf_lo(g_r.y); fr[3] = bf_hi(g_r.y);
            fk[0] = bf_lo(g_k.x); fk[1] = bf_hi(g_k.x); fk[2] = bf_lo(g_k.y); fk[3] = bf_hi(g_k.y);
            float ss = 0.f;
#pragma unroll
            for (int i = 0; i < 4; ++i) { const float q = fk[i] * kkc[i]; ss += q * q; }
            ss = red16(ss);
            if (part == 0) rsv[pt] = rsqrtf(ss + 1e-12f);
            *(uint2*)(X1 + pt * 72 + ch0) = pk4(ftanh(bf_lo(g_wd.x)), ftanh(bf_hi(g_wd.x)), ftanh(bf_lo(g_wd.y)), ftanh(bf_hi(g_wd.y)));
            *(uint2*)(X2 + pt * 72 + ch0) = g_ad;
            *(uint2*)(OPS + psc * OPS_SC + 6 * 1152 + ptl * 72 + ch0) = g_v;
        }
        if (c + 1 < nb) WKV2_LOAD(c + 1)
        __syncthreads();
        for (int rp2_ = 0; rp2_ < REP_W2; ++rp2_) {
        {
            const bf16_t* Xm = lm ? X2 : X1; const bf16_t* Wm = lm ? A2s : W2s;
#pragma unroll
            for (int q = 0; q < 2; ++q) {
                const f32x4 acc = mm_tile<2, false>(Xm + lrt * 16 * 72, 72, Wm + (lct0 + q) * 16 * 72, 72, (f32x4){0.f, 0.f, 0.f, 0.f}, lane);
#pragma unroll
                for (int r = 0; r < 4; ++r) {
                    const int o = (lrt * 16 + (lane >> 4) * 4 + r) * LG + (lct0 + q) * 16 + (lane & 15);
                    const float sg = fsigmoid(lc0[q] + acc[r]);
                    if (lm == 0) GG[o] = -0.606531f * sg; else AA[o] = sg;
                }
            }
        }
        __syncthreads();
        }
        if (tid < 128) {
            const int sc = tid >> 6, ch = tid & 63;
            float lw[16];
#pragma unroll
            for (int t = 0; t < 16; ++t) lw[t] = GG[(sc * 16 + t) * LG + ch];
#pragma unroll
            for (int t = 1; t < 16; ++t) lw[t] += lw[t - 1];
#pragma unroll
            for (int t = 0; t < 16; ++t) GG[(sc * 16 + t) * LG + ch] = lw[t];
        }
        __syncthreads();
        for (int rp4_ = 0; rp4_ < REP_W4; ++rp4_) {
        {
            const float rs = rsv[pt];
            bf16_t* ops = OPS + psc * OPS_SC;
            float va[4], vb[4], vk[4], vr[4], vbh[4], vkh[4];
#pragma unroll
            for (int i = 0; i < 4; ++i) {
                const int ch = ch0 + i;
                const float G = GG[pt * LG + ch], Gp = ptl ? GG[(pt - 1) * LG + ch] : 0.f, GC = GG[(psc * 16 + 15) * LG + ch];
                const float a = AA[pt * LG + ch], kk = fk[i] * kkc[i] * rs, ki = fk[i] * (1.f + (a - 1.f) * kac[i]);
                const float enG = __expf(-G), gc = __expf(GC);
                va[i] = -kk * __expf(Gp); vb[i] = kk * a * enG; vk[i] = ki * enG; vr[i] = fr[i] * __expf(G);
                vbh[i] = vb[i] * gc; vkh[i] = vk[i] * gc;
                if (ptl == 15) gC[psc * 64 + ch] = gc;
            }
            *(uint2*)(ops + 0 * 1152 + ptl * 72 + ch0) = pk4(va[0], va[1], va[2], va[3]);
            *(uint2*)(ops + 1 * 1152 + ptl * 72 + ch0) = pk4(vb[0], vb[1], vb[2], vb[3]);
            *(uint2*)(ops + 2 * 1152 + ptl * 72 + ch0) = pk4(vk[0], vk[1], vk[2], vk[3]);
            *(uint2*)(ops + 3 * 1152 + ptl * 72 + ch0) = pk4(vr[0], vr[1], vr[2], vr[3]);
            *(uint2*)(ops + 4 * 1152 + ptl * 72 + ch0) = pk4(vbh[0], vbh[1], vbh[2], vbh[3]);
            *(uint2*)(ops + 5 * 1152 + ptl * 72 + ch0) = pk4(vkh[0], vkh[1], vkh[2], vkh[3]);
        }
        __syncthreads();
        }
        for (int rp5_ = 0; rp5_ < REP_W567; ++rp5_) {
        {
            const int sc = wv >> 2, prod = wv & 3;
            const bf16_t* ops = OPS + sc * OPS_SC;
            bf16_t* tmp = TMP + sc * TMP_SC;
            const f32x4 acc = mm_tile<2, false>(ops + (prod < 2 ? 0 : 3) * 1152, 72, ops + ((prod & 1) ? 2 : 1) * 1152, 72, (f32x4){0.f, 0.f, 0.f, 0.f}, lane);
            const int j = lane & 15;
#pragma unroll
            for (int r = 0; r < 4; ++r) {
                const int t = (lane >> 4) * 4 + r;
                const float v = (prod < 2 ? (j < t) : (j <= t)) ? acc[r] : 0.f;
                if (prod == 0) ((float*)tmp)[t * 16 + j] = v;
                else tmp[512 + (prod - 1) * 384 + t * 24 + j] = to_bf(v);
            }
        }
        __syncthreads();
        {
            const int sc = wv >> 2, vt = wv & 3;
            const bf16_t* ops = OPS + sc * OPS_SC;
            bf16_t* tmp = TMP + sc * TMP_SC;
            const f32x4 acc = mma<false>(ld_row16(tmp + 512 + 0 * 384, lane), ld_tr<true>(ops + 6 * 1152 + vt * 16, 72, lane), (f32x4){0.f, 0.f, 0.f, 0.f});
#pragma unroll
            for (int r = 0; r < 4; ++r) tmp[512 + 4 * 384 + ((lane >> 4) * 4 + r) * 72 + vt * 16 + (lane & 15)] = to_bf(acc[r]);
            if (tid < 32) {
                const int isc = tid >> 4, j = tid & 15;
                const float* N = (const float*)(TMP + isc * TMP_SC);
                bf16_t* Mb = TMP + isc * TMP_SC + 512 + 3 * 384;
                float m[16];
#pragma unroll
                for (int t = 0; t < 16; ++t) {
                    float p0 = (t == j) ? 1.f : 0.f, p1 = 0.f, p2 = 0.f, p3 = 0.f;
#pragma unroll
                    for (int s = 0; s < t; ++s) {
                        const float nv = N[t * 16 + s];
                        if ((s & 3) == 0) p0 += nv * m[s]; else if ((s & 3) == 1) p1 += nv * m[s]; else if ((s & 3) == 2) p2 += nv * m[s]; else p3 += nv * m[s];
                    }
                    m[t] = (t >= j) ? (p0 + p1) + (p2 + p3) : 0.f;
                    Mb[t * 24 + j] = to_bf(m[t]);
                }
            }
        }
        __syncthreads();
        {
            const int sc = wv >> 2, tl = wv & 3;
            const bf16_t* ops = OPS + sc * OPS_SC;
            bf16_t* tmp = TMP + sc * TMP_SC;
            const bf16_t* Mb = tmp + 512 + 3 * 384;
            const bf16x8 mrow = ld_row16(Mb, lane);
            bf16x8 tA, tT1;
            ld_tr2<true>(ops + 0 * 1152 + tl * 16, tmp + 512 + 4 * 384 + tl * 16, 72, lane, tA, tT1);
            const f32x4 accW = mma<false>(mrow, tA, (f32x4){0.f, 0.f, 0.f, 0.f});
            bf16_t* Wt = tmp + 512 + 4 * 384 + 1152;
#pragma unroll
            for (int r = 0; r < 4; ++r) Wt[((lane >> 4) * 4 + r) * 72 + tl * 16 + (lane & 15)] = to_bf(accW[r]);
            accU = mma<false>(mrow, tT1, (f32x4){0.f, 0.f, 0.f, 0.f});
        }
        __syncthreads();
        }
#pragma unroll
        for (int sc = 0; sc < 2; ++sc) {
            bf16_t* Sbc = cur ? Sb1 : Sb0; bf16_t* Sbn = cur ? Sb0 : Sb1;
            const bf16_t* ops = OPS + sc * OPS_SC;
            const bf16_t* tmp = TMP + sc * TMP_SC;
            if ((wv >> 2) == sc) {
                const int vt = wv & 3;
                const f32x4 u = mm_tile<2, false>(tmp + 512 + 4 * 384 + 1152, 72, Sbc + vt * 16 * 72, 72, accU, lane);
#pragma unroll
                for (int r = 0; r < 4; ++r) Us[((lane >> 4) * 4 + r) * 72 + vt * 16 + (lane & 15)] = to_bf(u[r]);
            }
            __syncthreads();
            if (wv < 4) {
                const int vt = wv;
                f32x4 yv = mm_tile<2, true>(ops + 3 * 1152, 72, Sbc + vt * 16 * 72, 72, (f32x4){0.f, 0.f, 0.f, 0.f}, lane);
                bf16x8 tU, tV;
                ld_tr2<true>(Us + vt * 16, ops + 6 * 1152 + vt * 16, 72, lane, tU, tV);
                yv = mma<true>(ld_row16(tmp + 512 + 1 * 384, lane), tU, yv);
                yv = mma<true>(ld_row16(tmp + 512 + 2 * 384, lane), tV, yv);
                const int s = c * 32 + sc * 16 + (lane & 15), pos = dir ? (L - 1 - s) : s;
                *(uint2*)(y + ((size_t)dir * lay.Tloc + row0 + pos) * 512 + h * 64 + vt * 16 + (lane >> 4) * 4) = pk4(yv[0], yv[1], yv[2], yv[3]);
            }
            {
                bf16x8 aU, aV, b0, b1, k0_, k1_;
                ld_tr2<true>(Us + vT * 16, ops + 6 * 1152 + vT * 16, 72, lane, aU, aV);
                ld_tr4<true>(ops + 4 * 1152 + kT0 * 16, ops + 4 * 1152 + (kT0 + 1) * 16, ops + 5 * 1152 + kT0 * 16, ops + 5 * 1152 + (kT0 + 1) * 16, 72, lane, b0, b1, k0_, k1_);
#pragma unroll
                for (int q = 0; q < 2; ++q) {
                    const int kt = kT0 + q;
                    S[q] = S[q] * gC[sc * 64 + kt * 16 + (lane & 15)];
                    S[q] = mma<false>(aU, q ? b1 : b0, S[q]);
                    S[q] = mma<false>(aV, q ? k1_ : k0_, S[q]);
#pragma unroll
                    for (int r = 0; r < 4; ++r) Sbn[(vT * 16 + (lane >> 4) * 4 + r) * 72 + kt * 16 + (lane & 15)] = to_bf(S[q][r]);
                }
            }
            __syncthreads();
            cur ^= 1;
        }
    }
    float* So = dir ? Sb_out : Sf_out;
    if (!latent) {
#pragma unroll
        for (int q = 0; q < 2; ++q)
#pragma unroll
            for (int r = 0; r < 4; ++r) So[((size_t)(seq * 8 + h) * 64 + vT * 16 + (lane >> 4) * 4 + r) * 64 + (kT0 + q) * 16 + (lane & 15)] = S[q][r];
    }
#undef WKV2_LOAD
}

template <int NT>
__device__ __forceinline__ void n_wkv3(const Lay lay, const bf16_t* __restrict__ zcm, const bf16_t* __restrict__ w2t, const bf16_t* __restrict__ a2t,
                                       const float* __restrict__ w0, const float* __restrict__ a0, const float* __restrict__ k_k, const float* __restrict__ k_a,
                                       const float* __restrict__ S0f, const float* __restrict__ S0b, bf16_t* __restrict__ y,
                                       float* __restrict__ Sf_out, float* __restrict__ Sb_out, int item, char* lds,
                                       const int c0, const int c1, const float* __restrict__ Sinit, const int pq, float* __restrict__ Send) {
    static_assert(NT == 512, "n_wkv3 needs 8 waves");
    const int tid = TIDX, lane = tid & 63, wv = tid >> 6;
    const int dir = item & 1, h = (item >> 1) & 7, seq = lay.seqbase + (item >> 4);
    const bool latent = seq >= 16;
    const int L = latent ? 4096 : 256, row0 = (latent ? 4096 + (seq - 16) * 4096 : seq * 256) - lay.tbase;
    constexpr int OPS_SC = 7 * 1152;
    constexpr int TMP_SC = 512 + 4 * 384 + 1152 + 1152;
    constexpr int LG = 68;
    bf16_t* W2s = (bf16_t*)lds; bf16_t* A2s = W2s + 4608; bf16_t* Sb0 = A2s + 4608; bf16_t* Sb1 = Sb0 + 4608;
    float* rsv = (float*)(Sb1 + 4608); float* gC = rsv + 64;
    bf16_t* OPS = (bf16_t*)(gC + 256);
    bf16_t* TMP = OPS + 4 * OPS_SC;
    bf16_t* Us = TMP + 4 * TMP_SC;
    float* AA = (float*)TMP; float* GG = AA + 64 * LG;
    bf16_t* X1 = OPS; bf16_t* X2 = OPS + OPS_SC;
    static_assert(2 * 64 * LG * 4 <= 4 * TMP_SC * 2, "staging must fit in TMP");
    __syncthreads();
    {
        const int c = tid >> 3, part = tid & 7;
        *(uint4*)(W2s + c * 72 + part * 8) = *(const uint4*)(w2t + ((size_t)dir * 512 + h * 64 + c) * 64 + part * 8);
        *(uint4*)(A2s + c * 72 + part * 8) = *(const uint4*)(a2t + ((size_t)dir * 512 + h * 64 + c) * 64 + part * 8);
    }
    const int pt = tid >> 3, part = tid & 7, ch0 = part * 8;
    const int psc = pt >> 4, ptl = pt & 15;
    const int jsc = wv >> 2, jq = wv & 3;
    float lc0[2];
    lc0[0] = w0[dir * 512 + h * 64 + jq * 16 + (lane & 15)]; lc0[1] = a0[dir * 512 + h * 64 + jq * 16 + (lane & 15)];
    const int vT = wv >> 1, kT0 = (wv & 1) * 2;
    f32x4 S[2];
    f32x4 accU[2];
    {
        const float* S0 = dir ? S0b : S0f;
#pragma unroll
        for (int q = 0; q < 2; ++q)
#pragma unroll
            for (int r = 0; r < 4; ++r) {
                const int v = vT * 16 + (lane >> 4) * 4 + r, k = (kT0 + q) * 16 + (lane & 15);
                const float x = Sinit ? Sinit[v * 64 + k] : (latent ? S0[((size_t)((seq - 16) * 8 + h) * 64 + v) * 64 + k] : 0.f);
                S[q][r] = x; Sb0[v * 72 + k] = to_bf(x);
            }
    }
    uint4 g_r, g_k, g_wd, g_ad, g_v;
#define WKV3_LOAD(cidx) { const int s_ = (cidx) * 64 + pt; const int pos_ = dir ? (L - 1 - s_) : s_; \
        const bf16_t* zr_ = zcm + (size_t)(row0 + pos_) * CC; \
        g_r = *(const uint4*)(zr_ + h * 64 + ch0); g_k = *(const uint4*)(zr_ + 512 + h * 64 + ch0); g_v = *(const uint4*)(zr_ + 1024 + h * 64 + ch0); \
        g_wd = *(const uint4*)(zr_ + 1536 + dir * 64 + ch0); g_ad = *(const uint4*)(zr_ + 1664 + dir * 64 + ch0); \
        if (pq == 1) g_v = make_uint4(0u, 0u, 0u, 0u); }
    WKV3_LOAD(c0)
    int cur = 0;
    for (int c = c0; c < c1; ++c) {
        const int tid = TIDX, lane = tid & 63, wv = tid >> 6;
        const int pt = tid >> 3, part = tid & 7, ch0 = part * 8, psc = pt >> 4, ptl = pt & 15;
        const int jsc = wv >> 2, jq = wv & 3, vT = wv >> 1, kT0 = (wv & 1) * 2;
        {
            float fk[8], fw[8];
            unpack8(g_k, fk); unpack8(g_wd, fw);
            const float4 kk0 = *(const float4*)(k_k + h * 64 + ch0), kk1 = *(const float4*)(k_k + h * 64 + ch0 + 4);
            const float kkc[8] = {kk0.x, kk0.y, kk0.z, kk0.w, kk1.x, kk1.y, kk1.z, kk1.w};
            float ss = 0.f;
#pragma unroll
            for (int i = 0; i < 8; ++i) { const float q = fk[i] * kkc[i]; ss += q * q; }
            ss = red8(ss);
            if (part == 0) rsv[pt] = rsqrtf(ss + 1e-12f);
            *(uint4*)(X1 + pt * 72 + ch0) = make_uint4(pk_bf16(ftanh(fw[0]), ftanh(fw[1])), pk_bf16(ftanh(fw[2]), ftanh(fw[3])), pk_bf16(ftanh(fw[4]), ftanh(fw[5])), pk_bf16(ftanh(fw[6]), ftanh(fw[7])));
            *(uint4*)(X2 + pt * 72 + ch0) = g_ad;
            *(uint4*)(OPS + psc * OPS_SC + 6 * 1152 + ptl * 72 + ch0) = g_v;
        }
        __syncthreads();
        {
#pragma unroll
            for (int lm = 0; lm < 2; ++lm)
#pragma unroll
                for (int ri = 0; ri < 2; ++ri) {
                    const int rt = jsc + 2 * ri;
                    const f32x4 acc = mm_tile<2, false>((lm ? X2 : X1) + rt * 16 * 72, 72, (lm ? A2s : W2s) + jq * 16 * 72, 72, (f32x4){0.f, 0.f, 0.f, 0.f}, lane);
                    float sg[4];
#pragma unroll
                    for (int r = 0; r < 4; ++r) sg[r] = fsigmoid(lc0[lm] + acc[r]);
                    asm volatile("" ::: "memory");
#pragma unroll
                    for (int r = 0; r < 4; ++r) {
                        const int o = (rt * 16 + (lane >> 4) * 4 + r) * LG + jq * 16 + (lane & 15);
                        if (lm == 0) GG[o] = -0.606531f * sg[r]; else AA[o] = sg[r];
                    }
                }
        }
        __syncthreads();
        if (tid < 256) {
            const int sc = tid >> 6, ch = tid & 63;
            float lw[16];
#pragma unroll
            for (int t = 0; t < 16; ++t) lw[t] = GG[(sc * 16 + t) * LG + ch];
#pragma unroll
            for (int t = 1; t < 16; ++t) lw[t] += lw[t - 1];
#pragma unroll
            for (int t = 0; t < 16; ++t) GG[(sc * 16 + t) * LG + ch] = lw[t];
        }
        __syncthreads();
        {
            const float rs = rsv[pt];
            bf16_t* ops = OPS + psc * OPS_SC;
            float fr[8], fk[8];
            unpack8(g_r, fr); unpack8(g_k, fk);
#pragma unroll
            for (int hf = 0; hf < 2; ++hf) {
                float va[4], vb[4], vk[4], vr[4], vbh[4], vkh[4];
                const float4 kk4 = *(const float4*)(k_k + h * 64 + ch0 + hf * 4), ka4 = *(const float4*)(k_a + h * 64 + ch0 + hf * 4);
                const float kkc[4] = {kk4.x, kk4.y, kk4.z, kk4.w}, kac[4] = {ka4.x, ka4.y, ka4.z, ka4.w};
#pragma unroll
                for (int i = 0; i < 4; ++i) {
                    const int ii = hf * 4 + i, ch = ch0 + ii;
                    const float G = GG[pt * LG + ch], Gp = ptl ? GG[(pt - 1) * LG + ch] : 0.f, GC = GG[(psc * 16 + 15) * LG + ch];
                    const float a = AA[pt * LG + ch], kk = fk[ii] * kkc[i] * rs, ki = fk[ii] * (1.f + (a - 1.f) * kac[i]);
                    const float enG = __expf(-G), gc = __expf(GC);
                    va[i] = -kk * __expf(Gp); vb[i] = kk * a * enG; vk[i] = ki * enG; vr[i] = fr[ii] * __expf(G);
                    vbh[i] = vb[i] * gc; vkh[i] = vk[i] * gc;
                    if (ptl == 15) gC[psc * 64 + ch] = gc;
                }
                bf16_t* o4 = ops + ptl * 72 + ch0 + hf * 4;
                *(uint2*)(o4 + 0 * 1152) = pk4(va[0], va[1], va[2], va[3]);
                *(uint2*)(o4 + 1 * 1152) = pk4(vb[0], vb[1], vb[2], vb[3]);
                *(uint2*)(o4 + 2 * 1152) = pk4(vk[0], vk[1], vk[2], vk[3]);
                *(uint2*)(o4 + 3 * 1152) = pk4(vr[0], vr[1], vr[2], vr[3]);
                *(uint2*)(o4 + 4 * 1152) = pk4(vbh[0], vbh[1], vbh[2], vbh[3]);
                *(uint2*)(o4 + 5 * 1152) = pk4(vkh[0], vkh[1], vkh[2], vkh[3]);
            }
            if (c + 1 < c1) WKV3_LOAD(c + 1)
        }
        __syncthreads();
#pragma unroll
        for (int si = 0; si < 2; ++si) {
            const int sc = jsc + 2 * si, prod = jq;
            const bf16_t* ops = OPS + sc * OPS_SC;
            bf16_t* tmp = TMP + sc * TMP_SC;
            const f32x4 acc = mm_tile<2, false>(ops + (prod < 2 ? 0 : 3) * 1152, 72, ops + ((prod & 1) ? 2 : 1) * 1152, 72, (f32x4){0.f, 0.f, 0.f, 0.f}, lane);
            const int j = lane & 15;
#pragma unroll
            for (int r = 0; r < 4; ++r) {
                const int t = (lane >> 4) * 4 + r;
                const float v = (prod < 2 ? (j < t) : (j <= t)) ? acc[r] : 0.f;
                if (prod == 0) ((float*)tmp)[t * 16 + j] = v;
                else tmp[512 + (prod - 1) * 384 + t * 24 + j] = to_bf(v);
            }
        }
        __syncthreads();
        {
#pragma unroll
            for (int si = 0; si < 2; ++si) {
                const int sc = jsc + 2 * si, vt = jq;
                const bf16_t* ops = OPS + sc * OPS_SC;
                bf16_t* tmp = TMP + sc * TMP_SC;
                const f32x4 acc = mma<false>(ld_row16(tmp + 512 + 0 * 384, lane), ld_tr<true>(ops + 6 * 1152 + vt * 16, 72, lane), (f32x4){0.f, 0.f, 0.f, 0.f});
#pragma unroll
                for (int r = 0; r < 4; ++r) tmp[512 + 4 * 384 + ((lane >> 4) * 4 + r) * 72 + vt * 16 + (lane & 15)] = to_bf(acc[r]);
            }
            if (tid < 64) {
                const int isc = tid >> 4, j = tid & 15;
                const float* N = (const float*)(TMP + isc * TMP_SC);
                bf16_t* Mb = TMP + isc * TMP_SC + 512 + 3 * 384;
                float m[16];
#pragma unroll
                for (int t = 0; t < 16; ++t) {
                    float p0 = (t == j) ? 1.f : 0.f, p1 = 0.f, p2 = 0.f, p3 = 0.f;
#pragma unroll
                    for (int s = 0; s < t; ++s) {
                        const float nv = N[t * 16 + s];
                        if ((s & 3) == 0) p0 += nv * m[s]; else if ((s & 3) == 1) p1 += nv * m[s]; else if ((s & 3) == 2) p2 += nv * m[s]; else p3 += nv * m[s];
                    }
                    m[t] = (t >= j) ? (p0 + p1) + (p2 + p3) : 0.f;
                    Mb[t * 24 + j] = to_bf(m[t]);
                }
            }
        }
        __syncthreads();
#pragma unroll
        for (int si = 0; si < 2; ++si) {
            const int sc = jsc + 2 * si, tl = jq;
            const bf16_t* ops = OPS + sc * OPS_SC;
            bf16_t* tmp = TMP + sc * TMP_SC;
            const bf16x8 mrow = ld_row16(tmp + 512 + 3 * 384, lane);
            bf16x8 tA, tT1;
            ld_tr2<true>(ops + 0 * 1152 + tl * 16, tmp + 512 + 4 * 384 + tl * 16, 72, lane, tA, tT1);
            const f32x4 accW = mma<false>(mrow, tA, (f32x4){0.f, 0.f, 0.f, 0.f});
            bf16_t* Wt = tmp + 512 + 4 * 384 + 1152;
#pragma unroll
            for (int r = 0; r < 4; ++r) Wt[((lane >> 4) * 4 + r) * 72 + tl * 16 + (lane & 15)] = to_bf(accW[r]);
            accU[si] = mma<false>(mrow, tT1, (f32x4){0.f, 0.f, 0.f, 0.f});
        }
        __syncthreads();
#pragma unroll
        for (int sc = 0; sc < 4; ++sc) {
            bf16_t* Sbc = cur ? Sb1 : Sb0; bf16_t* Sbn = cur ? Sb0 : Sb1;
            const bf16_t* ops = OPS + sc * OPS_SC;
            const bf16_t* tmp = TMP + sc * TMP_SC;
            if (jsc == (sc & 1)) {
                const int vt = jq;
                const f32x4 u = mm_tile<2, false>(tmp + 512 + 4 * 384 + 1152, 72, Sbc + vt * 16 * 72, 72, accU[sc >> 1], lane);
#pragma unroll
                for (int r = 0; r < 4; ++r) Us[((lane >> 4) * 4 + r) * 72 + vt * 16 + (lane & 15)] = to_bf(u[r]);
            }
            __syncthreads();
            if (wv < 4 && pq == 0) {
                const int vt = wv;
                f32x4 yv = mm_tile<2, true>(ops + 3 * 1152, 72, Sbc + vt * 16 * 72, 72, (f32x4){0.f, 0.f, 0.f, 0.f}, lane);
                bf16x8 tU, tV;
                ld_tr2<true>(Us + vt * 16, ops + 6 * 1152 + vt * 16, 72, lane, tU, tV);
                yv = mma<true>(ld_row16(tmp + 512 + 1 * 384, lane), tU, yv);
                yv = mma<true>(ld_row16(tmp + 512 + 2 * 384, lane), tV, yv);
                const int s = c * 64 + sc * 16 + (lane & 15), pos = dir ? (L - 1 - s) : s;
                *(uint2*)(y + ((size_t)dir * lay.Tloc + row0 + pos) * 512 + h * 64 + vt * 16 + (lane >> 4) * 4) = pk4(yv[0], yv[1], yv[2], yv[3]);
            }
            {
                bf16x8 aU, aV, b0, b1, k0_, k1_;
                ld_tr2<true>(Us + vT * 16, ops + 6 * 1152 + vT * 16, 72, lane, aU, aV);
                ld_tr4<true>(ops + 4 * 1152 + kT0 * 16, ops + 4 * 1152 + (kT0 + 1) * 16, ops + 5 * 1152 + kT0 * 16, ops + 5 * 1152 + (kT0 + 1) * 16, 72, lane, b0, b1, k0_, k1_);
#pragma unroll
                for (int q = 0; q < 2; ++q) {
                    const int kt = kT0 + q;
                    S[q] = S[q] * gC[sc * 64 + kt * 16 + (lane & 15)];
                    S[q] = mma<false>(aU, q ? b1 : b0, S[q]);
                    S[q] = mma<false>(aV, q ? k1_ : k0_, S[q]);
#pragma unroll
                    for (int r = 0; r < 4; ++r) Sbn[(vT * 16 + (lane >> 4) * 4 + r) * 72 + kt * 16 + (lane & 15)] = to_bf(S[q][r]);
                }
            }
            __syncthreads();
            cur ^= 1;
        }
    }
    float* So = dir ? Sb_out : Sf_out;
    if (!latent) {
#pragma unroll
        for (int q = 0; q < 2; ++q)
#pragma unroll
            for (int r = 0; r < 4; ++r) So[((size_t)(seq * 8 + h) * 64 + vT * 16 + (lane >> 4) * 4 + r) * 64 + (kT0 + q) * 16 + (lane & 15)] = S[q][r];
    }
    if (Send) {
#pragma unroll
        for (int q = 0; q < 2; ++q)
#pragma unroll
            for (int r = 0; r < 4; ++r) Send[(vT * 16 + (lane >> 4) * 4 + r) * 64 + (kT0 + q) * 16 + (lane & 15)] = S[q][r];
    }
#undef WKV3_LOAD
}

template <int NT>
__device__ __forceinline__ void wkv_seg_init(const float* __restrict__ E0, const float* __restrict__ PQ, int nst, float* __restrict__ out, char* lds) {
    static_assert(NT == 512, "wkv_seg_init needs 512 threads");
    const int tid = TIDX, v = tid >> 3, kg = (tid & 7) * 8;
    float* Sl = (float*)lds;
    __syncthreads();
    {
        const float4 a = *(const float4*)(E0 + v * 64 + kg), b = *(const float4*)(E0 + v * 64 + kg + 4);
        float* d = Sl + v * 65 + kg;
        d[0] = a.x; d[1] = a.y; d[2] = a.z; d[3] = a.w; d[4] = b.x; d[5] = b.y; d[6] = b.z; d[7] = b.w;
    }
    __syncthreads();
    float* Pl = Sl + 64 * 65;
    for (int st = 0; st < nst; ++st) {
        const float* Pm = PQ + (size_t)st * 8192; const float* Qm = Pm + 4096;
        {
            const float4 p0 = *(const float4*)(Pm + tid * 8), p1 = *(const float4*)(Pm + tid * 8 + 4);
            *(float4*)(Pl + v * 68 + kg) = p0; *(float4*)(Pl + v * 68 + kg + 4) = p1;
        }
        float4 a0 = *(const float4*)(Qm + v * 64 + kg), a1 = *(const float4*)(Qm + v * 64 + kg + 4);
        __syncthreads();
#pragma unroll 8
        for (int j = 0; j < 64; ++j) {
            const float s = Sl[v * 65 + j];
            const float4 p0 = *(const float4*)(Pl + j * 68 + kg), p1 = *(const float4*)(Pl + j * 68 + kg + 4);
            a0.x += s * p0.x; a0.y += s * p0.y; a0.z += s * p0.z; a0.w += s * p0.w;
            a1.x += s * p1.x; a1.y += s * p1.y; a1.z += s * p1.z; a1.w += s * p1.w;
        }
        __syncthreads();
        float* d = Sl + v * 65 + kg;
        d[0] = a0.x; d[1] = a0.y; d[2] = a0.z; d[3] = a0.w; d[4] = a1.x; d[5] = a1.y; d[6] = a1.z; d[7] = a1.w;
        if (st + 1 == nst) { *(float4*)(out + v * 64 + kg) = a0; *(float4*)(out + v * 64 + kg + 4) = a1; }
        __syncthreads();
    }
}

template <int NT, int NI = 4>
__device__ __forceinline__ void n_combine1(const Lay lay, const bf16_t* __restrict__ zcm, const bf16_t* __restrict__ g2t, const bf16_t* __restrict__ y, const bf16_t* __restrict__ yd,
                                           const bf16_t* __restrict__ zg, const float* __restrict__ r_k, const float* __restrict__ ln_w, const float* __restrict__ ln_b,
                                           const float* __restrict__ gnorm, bf16_t* __restrict__ merged, int item, char* lds) {
    static_assert(NT == 512, "n_combine1 needs 8 waves");
    const int tid = TIDX, lane = tid & 63, wv = tid >> 6, cq = (lane >> 4) * 4;
    bf16_t* As = (bf16_t*)lds;
    float* red = (float*)(lds + 64 * 136 * 2);
    const int m0 = item * (16 * NI);
    __syncthreads();
    if ((tid >> 3) < 16 * NI) {
        const int t = tid >> 3, part = tid & 7;
        const bf16_t* src = zcm + (size_t)(m0 + t) * CC + 1792 + part * 16;
        float f0[8], f1[8];
        unpack8(*(const uint4*)src, f0); unpack8(*(const uint4*)(src + 8), f1);
        *(uint4*)(As + t * 136 + part * 16) = make_uint4(pk_bf16(fsigmoid(f0[0]), fsigmoid(f0[1])), pk_bf16(fsigmoid(f0[2]), fsigmoid(f0[3])),
                                                         pk_bf16(fsigmoid(f0[4]), fsigmoid(f0[5])), pk_bf16(fsigmoid(f0[6]), fsigmoid(f0[7])));
        *(uint4*)(As + t * 136 + part * 16 + 8) = make_uint4(pk_bf16(fsigmoid(f1[0]), fsigmoid(f1[1])), pk_bf16(fsigmoid(f1[2]), fsigmoid(f1[3])),
                                                             pk_bf16(fsigmoid(f1[4]), fsigmoid(f1[5])), pk_bf16(fsigmoid(f1[6]), fsigmoid(f1[7])));
    }
    __syncthreads();
    f32x4 acc[NI][4];
#pragma unroll
    for (int i = 0; i < NI; ++i)
#pragma unroll
        for (int j = 0; j < 4; ++j) acc[i][j] = (f32x4){0.f, 0.f, 0.f, 0.f};
    const int brow = wv * 64 + ((lane & 15) >> 2) * 16 + (lane & 3);
#pragma unroll
    for (int ks = 0; ks < 4; ++ks) {
        bf16x8 a[NI], b[4];
#pragma unroll
        for (int i = 0; i < NI; ++i) a[i] = *(const bf16x8*)(As + (i * 16 + (lane & 15)) * 136 + ks * 32 + (lane >> 4) * 8);
#pragma unroll
        for (int j = 0; j < 4; ++j) b[j] = *(const bf16x8*)(g2t + (size_t)(brow + j * 4) * 128 + ks * 32 + (lane >> 4) * 8);
#pragma unroll
        for (int i = 0; i < NI; ++i)
#pragma unroll
            for (int j = 0; j < 4; ++j) acc[i][j] = __builtin_amdgcn_mfma_f32_16x16x32_bf16(b[j], a[i], acc[i][j], 0, 0, 0);
    }
    const int e0 = wv * 64 + cq * 4;
#pragma unroll
    for (int i = 0; i < NI; ++i) {
        const size_t lrow = (size_t)m0 + i * 16 + (lane & 15);
        float yy[16], vv[16], rk = 0.f, sm = 0.f, zsq = 0.f;
#pragma unroll
        for (int hf = 0; hf < 2; ++hf) {
            const int e = e0 + hf * 8;
            const uint4 ya = *(const uint4*)(y + lrow * 512 + e), yb = *(const uint4*)(y + ((size_t)lay.Tloc + lrow) * 512 + e);
            const uint4 ur = *(const uint4*)(zcm + lrow * CC + e), uk = *(const uint4*)(zcm + lrow * CC + 512 + e), uv = *(const uint4*)(zcm + lrow * CC + 1024 + e);
            const uint4 da = *(const uint4*)(yd + lrow * 512 + e), db = *(const uint4*)(yd + ((size_t)lay.Tloc + lrow) * 512 + e), uz = *(const uint4*)(zg + lrow * 512 + e);
            const float4 rka = *(const float4*)(r_k + e), rkb = *(const float4*)(r_k + e + 4);
            const float rkk[8] = {rka.x, rka.y, rka.z, rka.w, rkb.x, rkb.y, rkb.z, rkb.w};
            float fa[8], fb[8], fr[8], fk[8], fv[8], fd[8], fe[8], fz[8];
            unpack8(ya, fa); unpack8(yb, fb); unpack8(ur, fr); unpack8(uk, fk); unpack8(uv, fv); unpack8(da, fd); unpack8(db, fe); unpack8(uz, fz);
#pragma unroll
            for (int c = 0; c < 8; ++c) {
                yy[hf * 8 + c] = fa[c] + fb[c]; vv[hf * 8 + c] = fv[c];
                rk += fr[c] * fk[c] * rkk[c];
                sm += yy[hf * 8 + c];
                const float q = (fd[c] + fe[c]) * fz[c] * fsigmoid(fz[c]);
                zsq += q * q;
            }
        }
        sm += __shfl_xor(sm, 16); sm += __shfl_xor(sm, 32);
        rk += __shfl_xor(rk, 16); rk += __shfl_xor(rk, 32);
        const float mean = sm * (1.f / 64.f);
        float var = 0.f, zs = zsq;
#pragma unroll
        for (int c = 0; c < 16; ++c) { const float d = yy[c] - mean; var += d * d; }
        var += __shfl_xor(var, 16); var += __shfl_xor(var, 32);
        zs += __shfl_xor(zs, 16); zs += __shfl_xor(zs, 32);
        const float rstd = rsqrtf(var * (1.f / 64.f) + 64e-5f);
        if (lane < 16) red[wv * 64 + i * 16 + lane] = zs;
#pragma unroll
        for (int hf = 0; hf < 2; ++hf) {
            float o[8];
#pragma unroll
            for (int jj = 0; jj < 2; ++jj) {
                const int j = hf * 2 + jj;
                const float4 lw4 = *(const float4*)(ln_w + e0 + j * 4), lb4 = *(const float4*)(ln_b + e0 + j * 4);
                o[jj * 4 + 0] = ((yy[j * 4 + 0] - mean) * rstd * lw4.x + lb4.x + rk * vv[j * 4 + 0]) * acc[i][j][0];
                o[jj * 4 + 1] = ((yy[j * 4 + 1] - mean) * rstd * lw4.y + lb4.y + rk * vv[j * 4 + 1]) * acc[i][j][1];
                o[jj * 4 + 2] = ((yy[j * 4 + 2] - mean) * rstd * lw4.z + lb4.z + rk * vv[j * 4 + 2]) * acc[i][j][2];
                o[jj * 4 + 3] = ((yy[j * 4 + 3] - mean) * rstd * lw4.w + lb4.w + rk * vv[j * 4 + 3]) * acc[i][j][3];
            }
            *(uint4*)(merged + lrow * DM + e0 + hf * 8) = make_uint4(pk_bf16(o[0], o[1]), pk_bf16(o[2], o[3]), pk_bf16(o[4], o[5]), pk_bf16(o[6], o[7]));
        }
    }
    __syncthreads();
#pragma unroll
    for (int i = 0; i < NI; ++i) {
        const int tk = i * 16 + (lane & 15);
        float ss = 0.f;
#pragma unroll
        for (int w = 0; w < 8; ++w) ss += red[w * 64 + tk];
        const float rs = rsqrtf(ss * (1.f / 512.f) + EPS);
        const size_t lrow = (size_t)m0 + tk;
#pragma unroll
        for (int hf = 0; hf < 2; ++hf) {
            const int e = e0 + hf * 8;
            const float4 gna = *(const float4*)(gnorm + e), gnb = *(const float4*)(gnorm + e + 4);
            const float gn[8] = {gna.x, gna.y, gna.z, gna.w, gnb.x, gnb.y, gnb.z, gnb.w};
            const uint4 da = *(const uint4*)(yd + lrow * 512 + e), db = *(const uint4*)(yd + ((size_t)lay.Tloc + lrow) * 512 + e), uz = *(const uint4*)(zg + lrow * 512 + e);
            float fd[8], fe[8], fz[8], o[8];
            unpack8(da, fd); unpack8(db, fe); unpack8(uz, fz);
#pragma unroll
            for (int c = 0; c < 8; ++c) o[c] = (fd[c] + fe[c]) * fz[c] * fsigmoid(fz[c]) * rs * gn[c];
            *(uint4*)(merged + lrow * DM + 512 + e) = make_uint4(pk_bf16(o[0], o[1]), pk_bf16(o[2], o[3]), pk_bf16(o[4], o[5]), pk_bf16(o[6], o[7]));
        }
    }
    __syncthreads();
}

template <int NT>
__device__ __forceinline__ void n_final(const Lay lay, const float* __restrict__ h, const float* __restrict__ g, float* __restrict__ out, int vb, float* lds) {
    const int lrow = vb * (NT / 256) + (TIDX >> 8), tid = TIDX & 255;
    const float4 x = *(const float4*)(h + (size_t)lrow * DM + tid * 4);
    const float ss = group_sum256<NT>(x.x * x.x + x.y * x.y + x.z * x.z + x.w * x.w, lds);
    const float rstd = rsqrtf(ss * (1.f / DM) + EPS);
    const float4 gg = *(const float4*)(g + tid * 4);
    *(float4*)(out + (size_t)(lay.tbase + lrow) * DM + tid * 4) = make_float4(x.x * rstd * gg.x, x.y * rstd * gg.y, x.z * rstd * gg.z, x.w * rstd * gg.w);
}

template <int NT>
__device__ __forceinline__ void n_final_w2(const Lay lay, const bf16_t* __restrict__ h, const float* __restrict__ g, float* __restrict__ out, int vb) {
    const int lane = TIDX & 63, lrow0 = vb * (NT / 64) * 2 + (TIDX >> 6) * 2;
    float4 x[2][4];
#pragma unroll
    for (int k = 0; k < 2; ++k)
#pragma unroll
        for (int q = 0; q < 4; ++q) { const uint2 u = *(const uint2*)(h + (size_t)(lrow0 + k) * DM + q * 256 + lane * 4); x[k][q] = make_float4(bf_lo(u.x), bf_hi(u.x), bf_lo(u.y), bf_hi(u.y)); }
#pragma unroll
    for (int k = 0; k < 2; ++k) {
        float ss = 0.f;
#pragma unroll
        for (int q = 0; q < 4; ++q) ss += (x[k][q].x * x[k][q].x + x[k][q].y * x[k][q].y) + (x[k][q].z * x[k][q].z + x[k][q].w * x[k][q].w);
        ss = wave_sum(ss);
        const float rstd = rsqrtf(ss * (1.f / DM) + EPS);
#pragma unroll
        for (int q = 0; q < 4; ++q) {
            const int c = q * 256 + lane * 4;
            const float4 gg = *(const float4*)(g + c);
            *(float4*)(out + (size_t)(lay.tbase + lrow0 + k) * DM + c) = make_float4(x[k][q].x * rstd * gg.x, x[k][q].y * rstd * gg.y, x[k][q].z * rstd * gg.z, x[k][q].w * rstd * gg.w);
        }
    }
}

template <int NT>
__device__ __forceinline__ void n_cache_k4(const Lay lay, const float* __restrict__ ck, bf16_t* __restrict__ Ka, int vb) {
    const int e4 = vb * NT + TIDX;
    const int bb = e4 >> 16, rem = e4 & 65535, p = rem >> 7, c = (rem & 127) * 4, h = c >> 7, j = c & 127;
    if (bb >= lay.nb) return;
    const int b = lay.b0 + bb;
    const float4 v = *(const float4*)(ck + (((size_t)b * 4 + h) * 512 + p) * 128 + j);
    *(uint2*)(Ka + ((size_t)lay.Tloc + bb * 512 + p) * 512 + c) = pk4(v.x, v.y, v.z, v.w);
}
template <int NT>
__device__ __forceinline__ void n_cache_kv(const Lay lay, const float* __restrict__ ck, const float* __restrict__ cv, bf16_t* __restrict__ Ka, bf16_t* __restrict__ VtA, int vb) {
    const int idx = vb * NT + TIDX;
    const int per = 4 * 512 * 128;
    const int bb = idx / (2 * per), r = idx % (2 * per);
    if (bb >= lay.nb) return;
    const int b = lay.b0 + bb;
    if (r < per) {
        const int p = r / 512, c = r % 512, h = c >> 7, j = c & 127;
        Ka[((size_t)lay.Tloc + bb * 512 + p) * 512 + c] = to_bf(ck[(((size_t)b * 4 + h) * 512 + p) * 128 + j]);
    } else {
        const int q = r - per, key = q % 512, dv = (q / 512) % 128, h = q / (512 * 128);
        VtA[vt_off(lay, 16 + b, h) + (size_t)dv * VLD + key] = to_bf(cv[(((size_t)b * 4 + h) * 512 + key) * 128 + dv]);
    }
}

struct Args { const void* p[24]; int i[16]; };
enum { PH_CACHE = 11, PH_GEMM_IN1, PH_SCAN, PH_COMBINE1, PH_FINAL, PH_WCONV = 0, PH_ROPE, PH_RESNORM, PH_GEMM_IN0, PH_TAIL, PH_GEMM_UQ, PH_GEMM_UKV, PH_FLASH, PH_COMBINE0, PH_GEMM_RES, PH_FFN_UP };
template <int NT, int BNB, int PH>
__device__ __forceinline__ void phase_body(const Args& a, int vb, float* lds) {
    const Lay lay{a.i[0], a.i[1], a.i[2], a.i[3], a.i[4]};
    if constexpr (PH == PH_GEMM_IN1) {
        const HaloTile ht = halo_tile(a.i[5] + vb / 26);
        gemm_tile<256, BNB, NT>(ALoadHalo{(const bf16_t*)a.p[0], DM, ht.t0 - lay.tbase, ht.row0, ht.L}, (const bf16_t*)a.p[1], DM, 0, (vb % 26) * BNB,
                                EpiIn1{lay, ht, (const float*)a.p[2], (const float*)a.p[3], (const float*)a.p[4], (bf16_t*)a.p[5], (bf16_t*)a.p[6], (bf16_t*)a.p[7], (float*)a.p[8]}, (char*)lds);
    } else if constexpr (PH == PH_COMBINE1) {
        n_combine1<NT>(lay, (const bf16_t*)a.p[0], (const bf16_t*)a.p[1], (const bf16_t*)a.p[2], (const bf16_t*)a.p[3], (const bf16_t*)a.p[4], (const float*)a.p[5], (const float*)a.p[6],
                       (const float*)a.p[7], (const float*)a.p[8], (bf16_t*)a.p[9], vb, (char*)lds);
    } else if constexpr (PH == PH_FINAL) {
        n_final<NT>(lay, (const float*)a.p[0], (const float*)a.p[1], (float*)a.p[2], vb, lds);
    } else if constexpr (PH == PH_CACHE) {
        n_cache_kv<NT>(lay, (const float*)a.p[0], (const float*)a.p[1], (bf16_t*)a.p[2], (bf16_t*)a.p[3], vb);
    } else if constexpr (PH == PH_WCONV) {
        n_wconv<NT>((const float*)a.p[0], a.i[5], a.i[6], (bf16_t*)a.p[1], a.i[7], a.i[8], a.i[9], vb, lds);
    } else if constexpr (PH == PH_ROPE) {
        n_rope_tables((float*)a.p[0], (float*)a.p[1], (float*)a.p[2], (float*)a.p[3]);
    } else if constexpr (PH == PH_RESNORM) {
        n_resnorm<NT>(lay, (const float*)a.p[0], (const float*)a.p[1], (const float*)a.p[2], (const float*)a.p[3], (const float*)a.p[4], a.i[5], a.i[6], (bf16_t*)a.p[5], vb, lds);
    } else if constexpr (PH == PH_GEMM_IN0) {
        gemm_tile<256, BNB, NT>(ALoadBF{(const bf16_t*)a.p[0], DM}, (const bf16_t*)a.p[1], DM, (vb / (1920 / BNB)) * 256, (vb % (1920 / BNB)) * BNB,
                                EpiIn0{lay, (bf16_t*)a.p[2], (bf16_t*)a.p[3], (bf16_t*)a.p[4], (bf16_t*)a.p[5], (float*)a.p[6], (float*)a.p[7], (const float*)a.p[8], (const float*)a.p[9]}, (char*)lds);
    } else if constexpr (PH == PH_TAIL) {
        n_l0_tail<NT>(lay, (const bf16_t*)a.p[0], (const float*)a.p[1], (const float*)a.p[2], (const float*)a.p[3], (const float*)a.p[4], (const float*)a.p[5], (const float*)a.p[6],
                      (bf16_t*)a.p[7], (bf16_t*)a.p[8], (bf16_t*)a.p[9], (float*)a.p[10], (float*)a.p[11], vb, lds);
    } else if constexpr (PH == PH_GEMM_UQ) {
        gemm_tile<256, BNB, NT>(ALoadBF{(const bf16_t*)a.p[0], 192}, (const bf16_t*)a.p[1], 192, (vb / (384 / BNB)) * 256, (vb % (384 / BNB)) * BNB,
                                EpiQb{lay, (bf16_t*)a.p[2], (const float*)a.p[3], (const float*)a.p[4]}, (char*)lds);
    } else if constexpr (PH == PH_GEMM_UKV) {
        gemm_tile<256, BNB, NT>(ALoadBF{(const bf16_t*)a.p[0], 128}, (const bf16_t*)a.p[1], 128, (vb / (768 / BNB)) * 256, (vb % (768 / BNB)) * BNB,
                                EpiKV{lay, (bf16_t*)a.p[2], (bf16_t*)a.p[3]}, (char*)lds);
    } else if constexpr (PH == PH_FLASH) {
        const bf16_t *Qa = (const bf16_t*)a.p[0], *Ka = (const bf16_t*)a.p[1], *VtA = (const bf16_t*)a.p[2], *Qb = (const bf16_t*)a.p[3], *Kb = (const bf16_t*)a.p[4], *VtB = (const bf16_t*)a.p[5];
        bf16_t *oa1h = (bf16_t*)a.p[6], *oa2h = (bf16_t*)a.p[7], *mrg16 = (bf16_t*)a.p[8];
        const int nqb = lay.Tloc / 128;
        const int mp = vb / (4 * nqb), hd = (vb / nqb) & 3, q0 = (vb % nqb) * 128;
        const TokInfo ti = tokinfo(lay.tbase + q0);
        const int tok0 = ti.t0 - lay.tbase, crow = lay.Tloc + (ti.latent ? (ti.seq - 16 - lay.b0) * 512 : 0);
        FlashP p;
        p.n0 = ti.latent ? 512 : 0; p.Lk = ti.L + p.n0; p.O = nullptr;
        if (mp < 2) {
            p.Q = Qa + hd * 128 + mp * 64; p.q_ld = 512;
            p.K0 = Ka + (size_t)crow * 512 + hd * 128 + mp * 64;
            p.K1 = Ka + (size_t)tok0 * 512 + hd * 128 + mp * 64; p.k_ld = 512;
            p.Vt = VtA + vt_off(lay, ti.seq, hd); p.vt_ld = ti.latent ? VLD : 256;
            p.Ob = (mp ? oa2h : oa1h) + hd * 128; p.o_ld = 512;
            p.c = 0.125f * 1.4426950408889634f;
            flash_item<64, NT, true>(p, q0, (char*)lds);
        } else {
            p.Q = Qb + hd * 96; p.q_ld = 384;
            p.K0 = Kb + (size_t)crow * 384 + hd * 96;
            p.K1 = Kb + (size_t)tok0 * 384 + hd * 96; p.k_ld = 384;
            p.Vt = VtB + vt_off(lay, ti.seq, hd); p.vt_ld = ti.latent ? VLD : 256;
            p.Ob = mrg16 + 512 + hd * 128; p.o_ld = DM;
            p.c = 0.10206207261596577f * 1.4426950408889634f;
            flash_item<96, NT, true>(p, q0, (char*)lds);
        }
    } else if constexpr (PH == PH_COMBINE0) {
        n_combine0<NT>((const bf16_t*)a.p[0], (const bf16_t*)a.p[1], (const float*)a.p[2], (const float*)a.p[3], (const float*)a.p[4], (const float*)a.p[5], (const float*)a.p[6], (bf16_t*)a.p[7], vb);
    } else if constexpr (PH == PH_GEMM_RES) {
        const EpiResid ep{lay, (const float*)a.p[2], (const float*)a.p[3], (const bf16_t*)a.p[4], (bf16_t*)a.p[5], (const float*)a.p[6], a.i[6]};
        const int m0 = (vb / (1024 / BNB)) * 256, n0 = (vb % (1024 / BNB)) * BNB;
        if (a.i[5] == DM) gemm_tile<256, BNB, NT>(ALoadBF{(const bf16_t*)a.p[0], DM}, (const bf16_t*)a.p[1], DM, m0, n0, ep, (char*)lds);
        else              gemm_tile<256, BNB, NT>(ALoadBF{(const bf16_t*)a.p[0], FF}, (const bf16_t*)a.p[1], FF, m0, n0, ep, (char*)lds);
    } else if constexpr (PH == PH_FFN_UP) {
        const HaloTile ht = halo_tile(a.i[5] + vb / (FF2 / BNB));
        gemm_tile<256, BNB, NT>(ALoadHalo{(const bf16_t*)a.p[0], DM, ht.t0 - lay.tbase, ht.row0, ht.L}, (const bf16_t*)a.p[1], DM, 0, (vb % (FF2 / BNB)) * BNB,
                                EpiFFNUp{lay, ht, (const float*)a.p[2], (const float*)a.p[3], (bf16_t*)a.p[4]}, (char*)lds);
    }
}

constexpr size_t al(size_t x) { return (x + 255) & ~(size_t)255; }
struct WS {
    static constexpr size_t BAR = 0;
    static constexpr size_t ZERO = al(BAR + 16384);
    static constexpr size_t MOD = al(ZERO + 4096);
    static constexpr size_t ROPE = al(MOD + 2 * 3 * 6144 * 4);
    static constexpr size_t H = al(ROPE + 3072 * 4);
    static constexpr size_t WT_IN0 = al(H + (size_t)TT * DM * 4);
    static constexpr size_t WT_OUT0 = al(WT_IN0 + (size_t)1920 * 1024 * 2);
    static constexpr size_t WT_OUT1 = al(WT_OUT0 + (size_t)1024 * 1024 * 2);
    static constexpr size_t WT_UP0 = al(WT_OUT1 + (size_t)1024 * 1024 * 2);
    static constexpr size_t WT_UP1 = al(WT_UP0 + (size_t)FF2 * 1024 * 2);
    static constexpr size_t WT_DN0 = al(WT_UP1 + (size_t)FF2 * 1024 * 2);
    static constexpr size_t WT_DN1 = al(WT_DN0 + (size_t)1024 * FF * 2);
    static constexpr size_t WT_UQ = al(WT_DN1 + (size_t)1024 * FF * 2);
    static constexpr size_t WT_UKV = al(WT_UQ + (size_t)384 * 192 * 2);
    static constexpr size_t WT_IN1 = al(WT_UKV + (size_t)768 * 128 * 2);
    static constexpr size_t W2T = al(WT_IN1 + (size_t)3328 * 1024 * 2);
    static constexpr size_t A2T = al(W2T + (size_t)2 * 512 * 64 * 2);
    static constexpr size_t G2T = al(A2T + (size_t)2 * 512 * 64 * 2);
    static constexpr size_t HN = al(G2T + (size_t)512 * 128 * 2);
    static constexpr size_t BIG = al(HN + (size_t)TT * DM * 2);
    static constexpr size_t TAIL = BIG;
    static constexpr size_t QA = al(TAIL + (size_t)TT * 384 * 2);
    static constexpr size_t KA = al(QA + (size_t)TT * 512 * 2);
    static constexpr size_t VTA = al(KA + (size_t)(TT + 1024) * 512 * 2);
    static constexpr size_t VT_ELEMS = (size_t)16 * 4 * 128 * 256 + (size_t)2 * 4 * 128 * VLD;
    static constexpr size_t QDN = al(VTA + VT_ELEMS * 2);
    static constexpr size_t CKVN = al(QDN + (size_t)TT * 192 * 2);
    static constexpr size_t QB = al(CKVN + (size_t)(TT + 1024) * 128 * 2);
    static constexpr size_t KB = al(QB + (size_t)TT * 384 * 2);
    static constexpr size_t VTB = al(KB + (size_t)(TT + 1024) * 384 * 2);
    static constexpr size_t OA1 = al(VTB + VT_ELEMS * 2);
    static constexpr size_t OA2 = al(OA1 + (size_t)TT * 512 * 2);
    static constexpr size_t END0 = al(OA2 + (size_t)TT * 512 * 2);
    static constexpr size_t ZCM = BIG;
    static constexpr size_t ZG = al(ZCM + (size_t)TT * CC * 2);
    static constexpr size_t XC = al(ZG + (size_t)TT * 512 * 2);
    static constexpr size_t DTR = al(XC + (size_t)TT * 768 * 2);
    static constexpr size_t Y16 = al(DTR + (size_t)TT * 8 * 4);
    static constexpr size_t YD16 = al(Y16 + (size_t)2 * TT * 512 * 2);
    static constexpr size_t SEG_IZ = al(YD16 + (size_t)2 * TT * 512 * 2);
    static constexpr size_t SEG_E0 = al(SEG_IZ + 2 * 16384);
    static constexpr size_t SEG_PQ = al(SEG_E0 + 32 * 16384);
    static constexpr size_t SEG_SI = al(SEG_PQ + 192 * 16384);
    static constexpr size_t SEG_HS = al(SEG_SI + 128 * 16384);
    static constexpr size_t END1 = al(SEG_HS + 32 * 16384);
    static constexpr size_t ACT = BIG;
    static constexpr size_t END2 = al(ACT + (size_t)TT * FF * 2);
    static constexpr size_t TOTAL = END0 > END1 ? (END0 > END2 ? END0 : END2) : (END1 > END2 ? END1 : END2);
};
static_assert(WS::TOTAL <= (size_t)256 * 1024 * 1024, "workspace map exceeds the guaranteed 256 MiB");


__device__ __forceinline__ int xcd_remap(int vb, int n) {
    const int q = n >> 3, r = n & 7, x = vb & 7, o = vb >> 3;
    return (x < r ? x * (q + 1) : r * (q + 1) + (x - r) * q) + o;
}

struct MP { const float* in[59]; float* out; char* ws; };


__device__ __forceinline__ char* launder_c(char* p) { size_t z = 0; asm volatile("" : "+s"(z)); return p + z; }
__device__ __forceinline__ float* launder_f(float* p) { size_t z = 0; asm volatile("" : "+s"(z)); return p + z; }
__device__ __forceinline__ int bid_opaque() { int b = blockIdx.x; asm volatile("" : "+s"(b)); return b; }
typedef const __attribute__((address_space(1))) float* gcfptr;
struct InTab {
    const char* base;
    __device__ __forceinline__ const float* operator[](int k) const { return (const float*)(gcfptr)(((const float* const*)base)[k]); }
};
__device__ __forceinline__ InTab in_tab() { size_t z = 0; asm volatile("" : "+s"(z)); return InTab{(const char*)__builtin_amdgcn_kernarg_segment_ptr() + z}; }
#define PH_BEGIN(NVB) for (int vb = bid_opaque(); vb < (NVB); vb += gridDim.x) { char* ws = launder_c(ws0); float* out = launder_f(out0); const InTab in = in_tab(); (void)ws; (void)out; (void)in;
#define PH_END } xcd_barrier(xb);
#define PH_NEXT(NVB) } for (int vb = bid_opaque(); vb < (NVB); vb += gridDim.x) { char* ws = launder_c(ws0); float* out = launder_f(out0); const InTab in = in_tab(); (void)ws; (void)out; (void)in;

#define mod ((float*)(ws + WS::MOD))
#define h ((bf16_t*)(ws + WS::H))
#define wt_in0 ((bf16_t*)(ws + WS::WT_IN0))
#define wt_uq ((bf16_t*)(ws + WS::WT_UQ))
#define wt_ukv ((bf16_t*)(ws + WS::WT_UKV))
#define wt_in1 ((bf16_t*)(ws + WS::WT_IN1))
#define w2t ((bf16_t*)(ws + WS::W2T))
#define a2t ((bf16_t*)(ws + WS::A2T))
#define g2t ((bf16_t*)(ws + WS::G2T))
#define hn16 ((bf16_t*)(ws + WS::HN))
#define act16 ((bf16_t*)(ws + WS::ACT))
#define tail16 ((bf16_t*)(ws + WS::TAIL))
#define Qa ((bf16_t*)(ws + WS::QA))
#define Ka ((bf16_t*)(ws + WS::KA))
#define VtA ((bf16_t*)(ws + WS::VTA))
#define qdn16 ((bf16_t*)(ws + WS::QDN))
#define ckvn16 ((bf16_t*)(ws + WS::CKVN))
#define Qb ((bf16_t*)(ws + WS::QB))
#define Kb ((bf16_t*)(ws + WS::KB))
#define VtB ((bf16_t*)(ws + WS::VTB))
#define oa1h ((bf16_t*)(ws + WS::OA1))
#define oa2h ((bf16_t*)(ws + WS::OA2))
#define zcm16 ((bf16_t*)(ws + WS::ZCM))
#define zg16 ((bf16_t*)(ws + WS::ZG))
#define xc16 ((bf16_t*)(ws + WS::XC))
#define dtr ((float*)(ws + WS::DTR))
#define y16 ((bf16_t*)(ws + WS::Y16))
#define yd16 ((bf16_t*)(ws + WS::YD16))
#define c64 ((float*)(ws + WS::ROPE))
#define s64 ((float*)(ws + WS::ROPE) + 1024)
#define c32 ((float*)(ws + WS::ROPE) + 2048)
#define s32 ((float*)(ws + WS::ROPE) + 2560)
#define mrg16 ((bf16_t*)(ws + WS::HN))
#define o_k (out + (size_t)TT * DM)
#define o_v (o_k + 16 * 4 * 256 * 128)
#define o_ckv (o_v + 16 * 4 * 256 * 128)
#define o_kpe (o_ckv + 16 * 256 * 128)
#define o_wf (o_kpe + 16 * 256 * 32)
#define o_wb (o_wf + 16 * 8 * 64 * 64)
#define o_sf (o_wb + 16 * 8 * 64 * 64)
#define o_sb (o_sf + 16 * 8 * 64 * 64)
__global__ void __launch_bounds__(512) mega(MP P) {
    constexpr int NT = 512, BNB = 128, TPB = 2;
    __shared__ __attribute__((aligned(16))) float lds[LDS_BYTES / 4];
    volatile LAS unsigned* st = (volatile LAS unsigned*)(lds + LDS_BYTES / 4 - 4);
    if (TIDX == 0) { st[0] = 0u; st[1] = 0u; st[2] = 0u; st[3] = 0u; }
    __syncthreads();
    XcdBarrier xb = xcd_barrier_post((unsigned*)P.ws, st);
    const InTab in = in_tab();
    char* const ws0 = P.ws;
    float* const out0 = P.out;
    char* ws = ws0;
    float* out = out0;
    const Lay lay{0, TT, 0, 0, 2};
    constexpr int NCR = 1024, MT = TT / 256, MTC = (TT + NCR) / 256, NHT = 50;

    for (int rp0_ = 0; rp0_ < REP_P0; ++rp0_) {
    constexpr int P_IN0 = 16 * 30 / TPB / 2, P_UP0 = 16 * 88 / TPB / 2, P_DN0 = 44 * 16 / TPB / 2, P_OUT0 = 16 * 16 / TPB / 2, P_UQ = 5, P_UKV = 6, P_W2 = 4, P_A2 = 4, P_G2 = 4, P_CV = 32;
    constexpr int Q1 = P_IN0, Q2 = Q1 + P_UP0, Q3 = Q2 + P_DN0, Q4 = Q3 + P_OUT0, Q5 = Q4 + P_UQ, Q6 = Q5 + P_UKV, Q7 = Q6 + P_W2, Q8 = Q7 + P_A2, Q9 = Q8 + P_G2, Q10 = Q9 + P_CV;
    constexpr int QA = Q10 + 2 * 96, QK = QA + 2 * 512 * 128 / NT, QT = QK + 1;
    PH_BEGIN(QT)
        if (vb < Q10) {
            const float* W; bf16_t* Wt; int K_, N_, Np_, mode_ = 0, gh_ = 0, it_, ldo_ = 0;
            if (vb < Q1)      { W = in[20]; Wt = wt_in0; K_ = 1024; N_ = N0; Np_ = 1920; it_ = vb * 2; }
            else if (vb < Q2) { W = in[16]; Wt = (bf16_t*)(ws + WS::WT_UP0); K_ = 1024; N_ = FF2; Np_ = FF2; mode_ = 1; gh_ = BNB / 2; it_ = (vb - Q1) * 2; }
            else if (vb < Q3) { W = in[19]; Wt = (bf16_t*)(ws + WS::WT_DN0); K_ = FF; N_ = 1024; Np_ = 1024; it_ = (vb - Q2) * 2; }
            else if (vb < Q4) { W = in[30]; Wt = (bf16_t*)(ws + WS::WT_OUT0); K_ = 1024; N_ = 1024; Np_ = 1024; it_ = (vb - Q3) * 2; }
            else if (vb < Q5) { W = in[27]; Wt = wt_uq; K_ = 192; N_ = 384; Np_ = 384; it_ = (vb - Q4) * 2; }
            else if (vb < Q6) { W = in[29]; Wt = wt_ukv; K_ = 128; N_ = 768; Np_ = 768; mode_ = 2; it_ = (vb - Q5) * 2; }
            else if (vb < Q7) { const int j = vb - Q6; W = in[42] + (size_t)(j >> 1) * 64 * 512; Wt = w2t + (size_t)(j >> 1) * 512 * 64; K_ = 64; N_ = 512; Np_ = 512; it_ = (j & 1) * 2; }
            else if (vb < Q8) { const int j = vb - Q7; W = in[44] + (size_t)(j >> 1) * 64 * 512; Wt = a2t + (size_t)(j >> 1) * 512 * 64; K_ = 64; N_ = 512; Np_ = 512; it_ = (j & 1) * 2; }
            else if (vb < Q9) { W = in[45]; Wt = g2t; K_ = 128; N_ = 512; Np_ = 512; it_ = (vb - Q8) * 2; }
            else {
                const int j = vb - Q9; W = in[3] + (size_t)(j >> 2) * 512 * 128; Wt = VtA + vt_off(lay, 16 + (j >> 4), (j >> 2) & 3); K_ = 512; N_ = 128; Np_ = 128; it_ = (j & 3) * 2; ldo_ = VLD;
            }
            n_wconv_multi<NT, 2>(W, K_, N_, Wt, Np_, mode_, gh_, it_, lds, ldo_);
        } else if (vb < QA) n_ada<NT>(in[10], in[11], in[12], in[13], in[31], in[32], mod, vb - Q10, lds);
        else if (vb < QK) n_cache_k4<NT>(lay, in[2], Ka, vb - QA);
        else n_rope_tables(c64, s64, c32, s32);
    PH_END

    }
    constexpr int CV_IN1 = 16 * 52 / TPB, CV_OUT = 16 * 16 / TPB, CV_UP = 16 * 88 / TPB, CV_DN = 44 * 16 / TPB;
    static_assert(CV_IN1 % 2 == 0 && CV_OUT % 2 == 0 && CV_UP % 2 == 0 && CV_DN % 2 == 0, "item pairs must not straddle two weights");
#define CONV_PAIR(c_) { const int cc_ = (c_); \
        const float* W; bf16_t* Wt; int K_, N_, Np_, mode_, gh_, it_; \
        if (cc_ < CV_IN1) { W = in[39]; Wt = wt_in1; K_ = 1024; N_ = N1; Np_ = 3328; mode_ = 0; gh_ = 0; it_ = cc_; } \
        else if (cc_ < CV_IN1 + CV_OUT) { W = in[57]; Wt = (bf16_t*)(ws + WS::WT_OUT1); K_ = 1024; N_ = 1024; Np_ = 1024; mode_ = 0; gh_ = 0; it_ = cc_ - CV_IN1; } \
        else if (cc_ < CV_IN1 + CV_OUT + CV_UP) { W = in[35]; Wt = (bf16_t*)(ws + WS::WT_UP1); K_ = 1024; N_ = FF2; Np_ = FF2; mode_ = 1; gh_ = BNB / 2; it_ = cc_ - CV_IN1 - CV_OUT; } \
        else { W = in[38]; Wt = (bf16_t*)(ws + WS::WT_DN1); K_ = FF; N_ = 1024; Np_ = 1024; mode_ = 0; gh_ = 0; it_ = cc_ - CV_IN1 - CV_OUT - CV_UP; } \
        n_wconv_multi<NT, 2>(W, K_, N_, Wt, Np_, mode_, gh_, it_, lds); }
    for (int l = 0; l < 2; ++l) {
        const float* modl = mod + (size_t)l * 3 * 6144;
        const int cb = l ? 31 : 12;
#define wt_out ((const bf16_t*)(ws + (l ? WS::WT_OUT1 : WS::WT_OUT0)))
#define wt_up ((const bf16_t*)(ws + (l ? WS::WT_UP1 : WS::WT_UP0)))
#define wt_dn ((const bf16_t*)(ws + (l ? WS::WT_DN1 : WS::WT_DN0)))
        PH_BEGIN(TT / 16)
            n_resnorm_w2<NT>(lay, in[0], in[1], l ? h : nullptr, in[cb + 2], modl, 0, 1024, hn16, vb);
        PH_END
        if (l == 0) {
            PH_BEGIN(MT * (1920 / BNB))
                const int tb = xcd_remap(vb, MT * (1920 / BNB));
                gemm_tile<256, BNB, NT>(ALoadBF{hn16, DM}, wt_in0, DM, (tb / (1920 / BNB)) * 256, (tb % (1920 / BNB)) * BNB,
                                        EpiIn0{lay, Qa, Ka, VtA, tail16, o_k, o_v, c64, s64}, (char*)lds);
            PH_END
            PH_BEGIN((TT + NCR) / 8)
                n_l0_tail_w<NT>(lay, tail16, in[26], in[28], in[4], in[5], c32, s32, qdn16, ckvn16, Kb, o_ckv, o_kpe, vb);
            PH_END
            constexpr int UQT = MT * (384 / BNB), UKT = MTC * (768 / BNB);
            PH_BEGIN(UQT + UKT)
                if (vb < UKT) gemm_tile<256, BNB, NT>(ALoadBF{ckvn16, 128}, wt_ukv, 128, (vb / (768 / BNB)) * 256, (vb % (768 / BNB)) * BNB, EpiKV{lay, Kb, VtB}, (char*)lds);
                else { const int u = vb - UKT; gemm_tile<256, BNB, NT>(ALoadBF{qdn16, 192}, wt_uq, 192, (u / (384 / BNB)) * 256, (u % (384 / BNB)) * BNB, EpiQb{lay, Qb, c32, s32}, (char*)lds); }
            PH_END
            for (int rep_ = 0; rep_ < REP_FLASH; ++rep_) {
            for (int vb = bid_opaque(); vb < 1152; vb += gridDim.x) { char* ws = launder_c(ws0); float* out = launder_f(out0); const InTab in = in_tab(); (void)ws; (void)out; (void)in;
                int mp, hd, q0;
                if (vb < 768) {
                    const int r = vb >> 8, b = vb & 255, x = b & 7, j = b >> 3;
                    int batch;
                    if (r == 0) { mp = 2; hd = x & 3; batch = x >> 2; }
                    else { const int a = 2 * x + (r - 1); batch = a >> 3; hd = (a >> 1) & 3; mp = a & 1; }
                    q0 = 4096 + batch * 4096 + j * 128;
                } else { const int j = vb - 768; mp = j >> 7; hd = (j >> 5) & 3; q0 = (j & 31) * 128; }
                const TokInfo ti = tokinfo(q0);
                const int crow = TT + (ti.latent ? (ti.seq - 16) * 512 : 0);
                FlashP p;
                p.n0 = ti.latent ? 512 : 0; p.Lk = ti.L + p.n0; p.O = nullptr;
                if (mp < 2) {
                    p.Q = Qa + hd * 128 + mp * 64; p.q_ld = 512;
                    p.K0 = Ka + (size_t)crow * 512 + hd * 128 + mp * 64;
                    p.K1 = Ka + (size_t)ti.t0 * 512 + hd * 128 + mp * 64; p.k_ld = 512;
                    p.Vt = VtA + vt_off(lay, ti.seq, hd); p.vt_ld = ti.latent ? VLD : 256;
                    p.Ob = (mp ? oa2h : oa1h) + hd * 128; p.o_ld = 512;
                    p.c = 0.125f * 1.4426950408889634f;
                    flash_item<64, NT, true>(p, q0, (char*)lds);
                } else {
                    p.Q = Qb + hd * 96; p.q_ld = 384;
                    p.K0 = Kb + (size_t)crow * 384 + hd * 96;
                    p.K1 = Kb + (size_t)ti.t0 * 384 + hd * 96; p.k_ld = 384;
                    p.Vt = VtB + vt_off(lay, ti.seq, hd); p.vt_ld = ti.latent ? VLD : 256;
                    p.Ob = mrg16 + 512 + hd * 128; p.o_ld = DM;
                    p.c = 0.10206207261596577f * 1.4426950408889634f;
                    flash_item<96, NT, true>(p, q0, (char*)lds);
                }
            PH_END
            }
            PH_BEGIN(TT / TPB / 4)
                n_combine0_m<NT, 4>(oa1h, oa2h, in[21], in[22], in[23], in[24], in[25], mrg16, vb);
            PH_END
        } else {
            {
                float* segf = (float*)(ws + WS::SEG_IZ);
                for (int i = blockIdx.x * NT + TIDX; i < 8192; i += gridDim.x * NT) segf[i] = (i < 4096 && (i >> 6) == (i & 63)) ? 1.f : 0.f;
            }
            constexpr int IN1T = NHT * 13, IN1L = IN1T - 512, IN1F = 256 - IN1L, CVP = (CV_OUT + CV_UP + CV_DN) / 2;
            PH_BEGIN(256 * (2 + (CVP + IN1F - 1) / IN1F))
                const int slot = vb & 255, rnd = vb >> 8;
                if (vb < IN1T) {
                    const int tb = xcd_remap(vb, IN1T);
                    const HaloTile ht = halo_tile(tb / 13);
                    gemm256_tile<NT>(ALoadHalo{hn16, DM, ht.t0, ht.row0, ht.L, (const bf16_t*)(ws + WS::ZERO)}, wt_in1, DM, (tb % 13) * 256,
                                     EpiIn1{lay, ht, in[40], in[51], in[52], zcm16, zg16, xc16, dtr}, (char*)lds);
                } else if (slot >= IN1L) {
                    const int p = (slot - IN1L) + IN1F * (rnd - 2);
                    if (p < CVP) CONV_PAIR(CV_IN1 + 2 * p)
                }
            PH_END
            for (int rep_ = 0; rep_ < REP_SCAN; ++rep_)
            for (int pass = 0; pass < 2; ++pass) {
            for (int vb = bid_opaque();; vb += gridDim.x) { char* ws = launder_c(ws0); float* out = launder_f(out0); const InTab in = in_tab(); (void)ws; (void)out; (void)in;
                if (pass == 1) {
                    __syncthreads();
                    if (TIDX == 0) st[3] = xb_add((unsigned*)ws0, 1u);
                    __syncthreads();
                    vb = __builtin_amdgcn_readfirstlane((int)st[3]);
                }
                if (vb >= (pass == 0 ? 256 : 672)) break;
                const int slot = vb & 255, rnd = vb >> 8;
                int kind = 0, item = 0, c0 = 0, c1 = 0, pq = 0, nst = 0;
                const float* sinit = nullptr; float* send = nullptr; const float* pqsrc = nullptr; const float* e0src = nullptr; float* siout = nullptr;
                float* segf = (float*)(ws + WS::SEG_IZ);
                float* e0b = (float*)(ws + WS::SEG_E0); float* pqb = (float*)(ws + WS::SEG_PQ); float* sib = (float*)(ws + WS::SEG_SI); float* hsb = (float*)(ws + WS::SEG_HS);
                constexpr int SSD_CUT = 31;
                if (pass == 0) {
                    if (slot < 32) { kind = 1; item = ((16 + (slot >> 4)) << 4) | (slot & 15); c0 = 0; c1 = 12; send = e0b + (size_t)slot * 4096; }
                    else if (slot < 224) {
                        const int j = slot - 32, chain = j / 6, rem = j - chain * 6, seg = 1 + (rem >> 1); pq = 1 + (rem & 1);
                        kind = 1; item = ((16 + (chain >> 4)) << 4) | (chain & 15); c0 = 12 + 13 * (seg - 1); c1 = c0 + 13;
                        sinit = segf + (pq == 1 ? 0 : 4096); send = pqb + ((size_t)(chain * 3 + seg - 1) * 2 + (pq - 1)) * 4096;
                    } else { const int chain = slot - 224; kind = 2; item = ((16 + (chain >> 4)) << 4) | (chain & 15); c0 = 0; c1 = SSD_CUT; send = hsb + (size_t)chain * 4096; }
                } else {
                    if (vb < 128) {
                        const int chain = vb & 31, seg = 4 - (vb >> 5);
                        kind = 1; item = ((16 + (chain >> 4)) << 4) | (chain & 15); c0 = 12 + 13 * (seg - 1); c1 = c0 + 13;
                        e0src = e0b + (size_t)chain * 4096; pqsrc = pqb + (size_t)chain * 6 * 4096; nst = seg - 1; siout = sib + (size_t)vb * 4096;
                        sinit = nst ? siout : e0src;
                    } else if (vb < 160) { const int chain = vb - 128; kind = 2; item = ((16 + (chain >> 4)) << 4) | (chain & 15); c0 = SSD_CUT; c1 = 64; sinit = hsb + (size_t)chain * 4096; }
                    else if (vb < 416) { kind = 1; item = vb - 160; c0 = 0; c1 = 4; }
                    else { kind = 2; item = vb - 416; c0 = 0; c1 = 4; }
                }
                if (kind == 1) {
                    if (nst) wkv_seg_init<NT>(e0src, pqsrc, nst, siout, (char*)lds);
                    n_wkv3<NT>(lay, zcm16, w2t, a2t, in[41], in[43], in[46], in[47], in[6], in[7], y16, o_wf, o_wb, item, (char*)lds, c0, c1, sinit, pq, send);
                } else if (kind == 2) {
                    n_ssd2<NT>(lay, xc16, dtr, in[53], in[54], in[55], in[8], in[9], yd16, o_sf, o_sb, item, (char*)lds, c0, c1, sinit, send);
                }
            PH_END
            }
            PH_BEGIN(TT / 48)
                n_combine1<NT, 3>(lay, zcm16, g2t, y16, yd16, zg16, in[48], in[49], in[50], in[56], mrg16, vb, (char*)lds);
            PH_END
        }
        PH_BEGIN((TT / 128) * 8)
            const int tb = xcd_remap(vb, (TT / 128) * 8);
            gemm_tile<128, 128, NT, ALoadBF, EpiResid, 4>(ALoadBF{mrg16, DM}, wt_out, DM, (tb >> 3) * 128, (tb & 7) * 128,
                                    EpiResid{lay, in[0], in[1], l ? h : nullptr, h, modl, 2048}, (char*)lds);
        PH_END
        PH_BEGIN(TT / 16)
            n_resnorm_w2<NT>(lay, in[0], in[1], h, in[cb + 3], modl, 3072, 4096, hn16, vb);
        PH_END
        for (int rep_ = 0; rep_ < REP_UP; ++rep_) {
        constexpr int UPT = NHT * (FF2 / 256), UPF = (UPT / 256) * 256;
        PH_BEGIN(l == 0 ? 256 * 6 : UPF + 2 * (UPT - UPF))
            const int slot = vb & 255, rnd = vb >> 8;
            if (vb < UPF) {
                const int tb = xcd_remap(vb, UPF);
                const HaloTile ht = halo_tile(tb / (FF2 / 256));
                gemm256_tile<NT>(ALoadHalo{hn16, DM, ht.t0, ht.row0, ht.L, (const bf16_t*)(ws + WS::ZERO)}, wt_up, DM, (tb % (FF2 / 256)) * 256,
                                 EpiFFNUp{lay, ht, in[cb + 5], in[cb + 6], act16}, (char*)lds);
            } else if (rnd == 4 && slot < 2 * (UPT - UPF)) {
                const int v2 = slot, tb = UPF + (v2 >> 1);
                const HaloTile ht = halo_tile(tb / (FF2 / 256));
                gemm_tile<256, BNB, NT>(ALoadHalo{hn16, DM, ht.t0, ht.row0, ht.L, (const bf16_t*)(ws + WS::ZERO)}, wt_up, DM, 0, ((tb % (FF2 / 256)) * 2 + (v2 & 1)) * BNB,
                                        EpiFFNUp{lay, ht, in[cb + 5], in[cb + 6], act16}, (char*)lds);
            } else if (slot >= 2 * (UPT - UPF)) {
                const int p = (slot - 2 * (UPT - UPF)) + (256 - 2 * (UPT - UPF)) * (rnd - 4);
                if (p < CV_IN1 / 2) CONV_PAIR(2 * p)
            }
        PH_END
        }
        PH_BEGIN(256)
            const int tb = xcd_remap(vb, 256);
            gemm256_tile<NT, ALoadBF, EpiResid256<96>, 96>(ALoadBF{act16 + (size_t)(tb >> 2) * 192 * FF, FF}, wt_dn, FF, (tb & 3) * 256,
                             EpiResid256<96>{EpiResid{lay, in[0], in[1], h, h, modl, 5120}, (tb >> 2) * 192}, (char*)lds);
        PH_END
    }
    PH_BEGIN(TT / 16)
        n_final_w2<NT>(lay, h, in[58], out, vb);
    }
}
#undef mod
#undef h
#undef wt_in0
#undef wt_uq
#undef wt_ukv
#undef wt_in1
#undef w2t
#undef a2t
#undef g2t
#undef hn16
#undef act16
#undef tail16
#undef Qa
#undef Ka
#undef VtA
#undef qdn16
#undef ckvn16
#undef Qb
#undef Kb
#undef VtB
#undef oa1h
#undef oa2h
#undef zcm16
#undef zg16
#undef xc16
#undef dtr
#undef y16
#undef yd16
#undef c64
#undef s64
#undef c32
#undef s32
#undef mrg16
#undef o_k
#undef o_v
#undef o_ckv
#undef o_kpe
#undef o_wf
#undef o_wb
#undef o_sf
#undef o_sb
#undef wt_out
#undef wt_up
#undef wt_dn
}

extern "C" void kernel_launch(void* const* d_in, const int* in_sizes, int n_in, void* d_out, int out_size, void* d_ws, size_t ws_size,
                              hipStream_t stream) {
    if (n_in != 59 || ws_size < WS::TOTAL) return;
    static int grid = 0;
    if (grid == 0) {
        int dev = 0, cus = 0, per_cu = 0;
        (void)hipGetDevice(&dev);
        (void)hipDeviceGetAttribute(&cus, hipDeviceAttributeMultiprocessorCount, dev);
        (void)hipOccupancyMaxActiveBlocksPerMultiprocessor(&per_cu, (const void*)mega, 512, 0);
        grid = (per_cu >= 1) ? cus : 0;
        if (grid <= 0) grid = -1;
    }
    if (grid < 0) return;
    MP P{};
    for (int i = 0; i < 59; ++i) P.in[i] = (const float*)d_in[i];
    P.out = (float*)d_out;
    P.ws = (char*)d_ws;
    (void)hipMemsetAsync(d_ws, 0, WS::ZERO + 4096, stream);
    hipLaunchKernelGGL(mega, dim3(grid), dim3(512), 0, stream, P);
}
```

```cpp
#include <hip/hip_runtime.h>
#include <math.h>

namespace {
constexpr int DM = 1024, FF = 2816, FF2 = 5632;
constexpr int N0 = 1888, N1 = 3208, CC = 1920;
constexpr int TT = 12288;
constexpr float EPS = 1e-6f;
constexpr int LDS_BYTES = 151040;
#ifndef REP_UP
#define REP_UP 1
#endif
#ifndef REP_FLASH
#define REP_FLASH 1
#endif
#ifndef REP_W567
#define REP_W567 1
#endif
#ifndef REP_W2
#define REP_W2 1
#endif
#ifndef REP_W4
#define REP_W4 1
#endif
#ifndef REP_P0
#define REP_P0 1
#endif
#ifndef REP_SCAN
#define REP_SCAN 1
#endif

__device__ __forceinline__ int tid_opaque() { int t = threadIdx.x; asm volatile("" : "+v"(t)); return t; }
#define TIDX tid_opaque()

#define XB_TMO      128
#define XB_XCNT(j)  (256  + 64 * (j))
#define XB_XSUB(j)  (1280 + 64 * (j))
#define XB_XGEN(j)  (2304 + 64 * (j))
#define XB_TOP      3328
#define XB_TOPGEN   3392
#define XCD_BAR_WORDS 3456
#define XB_SPIN_CAP (1u << 22)
#define LAS __attribute__((address_space(3)))
__device__ __forceinline__ unsigned xb_ld(unsigned* p)              { return __hip_atomic_load(p, __ATOMIC_RELAXED, __HIP_MEMORY_SCOPE_AGENT); }
__device__ __forceinline__ unsigned xb_add(unsigned* p, unsigned v) { return __hip_atomic_fetch_add(p, v, __ATOMIC_RELAXED, __HIP_MEMORY_SCOPE_AGENT); }
__device__ __forceinline__ unsigned xb_xcc_id() { return (unsigned)__builtin_amdgcn_s_getreg((3 << 11) | 20) & 0xFu; }
#define XB_SPIN(cond, bar) do { unsigned _sp = 0; while (cond) { __builtin_amdgcn_s_sleep(1); \
    if ((++_sp & 255u) == 0u) { if (xb_ld(&(bar)[XB_TMO])) break; if (_sp > XB_SPIN_CAP) { atomicAdd(&(bar)[XB_TMO], 1u); break; } } } } while (0)
struct XcdBarrier { unsigned* bar; unsigned x; volatile LAS unsigned* st; };
__device__ __forceinline__ XcdBarrier xcd_barrier_post(unsigned* bar, volatile LAS unsigned* st) {
    XcdBarrier b; b.bar = bar; b.x = xb_xcc_id(); b.st = st;
    if (TIDX == 0) st[2] = xb_add(&bar[XB_XCNT(b.x)], 1u);
    return b;
}
__device__ __forceinline__ void xcd_barrier_complete(unsigned* bar, unsigned x, unsigned& nloc, unsigned& nx) {
    asm volatile("" : "+s"(x));
    const unsigned G = gridDim.x * gridDim.y * gridDim.z;
    unsigned sum, cnt, mine, sp = 0u;
    for (;;) {
        sum = 0u; cnt = 0u; mine = 0u;
#pragma unroll
        for (unsigned j = 0; j < 16; ++j) { const unsigned c = xb_ld(&bar[XB_XCNT(j)]); sum += c; cnt += (c > 0u) ? 1u : 0u; mine = (j == x) ? c : mine; }
        if (sum == G) break;
        __builtin_amdgcn_s_sleep(1);
        if ((++sp & 255u) == 0u) { if (xb_ld(&bar[XB_TMO])) break; if (sp > XB_SPIN_CAP) { atomicAdd(&bar[XB_TMO], 1u); break; } }
    }
    nloc = mine > 0u ? mine : 1u; nx = cnt > 0u ? cnt : 1u;
}
__device__ __forceinline__ int xcd_hw_index(const XcdBarrier& b) {
    if (TIDX == 0) {
        bool ok = gridDim.x == 256u;
#pragma unroll
        for (unsigned j = 0; j < 16; ++j) { const unsigned c = xb_ld(&b.bar[XB_XCNT(j)]); ok = ok && (j < 8u ? c == 32u : c == 0u); }
        const unsigned rank = b.st[2];
        b.st[3] = (ok && rank < 32u && b.x < 8u) ? rank * 8u + b.x : 0xFFFFFFFFu;
    }
    __syncthreads();
    const int r = (int)b.st[3];
    __syncthreads();
    return r;
}
__device__ __forceinline__ void xcd_barrier(const XcdBarrier& b) {
    asm volatile("s_waitcnt vmcnt(0)" ::: "memory");
    __syncthreads();
    if (TIDX == 0) {
        unsigned* bar = b.bar;
        __builtin_amdgcn_s_waitcnt(0);
        unsigned nloc = b.st[0], nx = b.st[1];
        if (nloc == 0u) { xcd_barrier_complete(bar, b.x, nloc, nx); b.st[0] = nloc; b.st[1] = nx; }
        const unsigned old = xb_add(&bar[XB_XSUB(b.x)], 1u);
        const unsigned gen = old / nloc;
        if (old + 1u == (gen + 1u) * nloc) {
            __builtin_amdgcn_fence(__ATOMIC_RELEASE, "agent");
            asm volatile("s_waitcnt vmcnt(0)" ::: "memory");
            const unsigned og = xb_add(&bar[XB_TOP], 1u);
            const unsigned tg = og / nx;
            if (og + 1u == (tg + 1u) * nx) xb_add(&bar[XB_TOPGEN], 1u);
            else XB_SPIN(xb_ld(&bar[XB_TOPGEN]) == tg, bar);
            __builtin_amdgcn_fence(__ATOMIC_ACQUIRE, "agent");
            xb_add(&bar[XB_XGEN(b.x)], 1u);
            asm volatile("s_waitcnt vmcnt(0)" ::: "memory");
        } else {
            XB_SPIN(xb_ld(&bar[XB_XGEN(b.x)]) == gen, bar);
            __builtin_amdgcn_fence(__ATOMIC_ACQUIRE, "agent");
            asm volatile("s_waitcnt vmcnt(0)" ::: "memory");
        }
    }
    __syncthreads();
}

__device__ __forceinline__ float silu_f(float x) { return x / (1.f + expf(-x)); }
__device__ __forceinline__ float sigmoid_f(float x) { return 1.f / (1.f + expf(-x)); }
template <int CTRL> __device__ __forceinline__ float dpp_mov(float x) {
    return __builtin_bit_cast(float, __builtin_amdgcn_mov_dpp(__builtin_bit_cast(int, x), CTRL, 0xF, 0xF, true));
}
__device__ __forceinline__ float wave_sum(float v) {
    v += dpp_mov<0xB1>(v);
    v += dpp_mov<0x4E>(v);
    v += dpp_mov<0x141>(v);
    v += dpp_mov<0x140>(v);
    v += __builtin_bit_cast(float, __builtin_amdgcn_update_dpp(0, __builtin_bit_cast(int, v), 0x142, 0xA, 0xF, false));
    v += __builtin_bit_cast(float, __builtin_amdgcn_update_dpp(0, __builtin_bit_cast(int, v), 0x143, 0xC, 0xF, false));
    return __builtin_bit_cast(float, __builtin_amdgcn_readlane(__builtin_bit_cast(int, v), 63));
}
__device__ __forceinline__ float block_sum256(float v, float* sh) {
    v = wave_sum(v);
    __syncthreads();
    if ((TIDX & 63) == 0) sh[TIDX >> 6] = v;
    __syncthreads();
    return sh[0] + sh[1] + sh[2] + sh[3];
}

template <int NT>
__device__ __forceinline__ void n_ada(const float* __restrict__ c, const float* __restrict__ c_ctx, const float* __restrict__ W0, const float* __restrict__ b0,
                                      const float* __restrict__ W1, const float* __restrict__ b1, float* __restrict__ mod, int vb, float* lds) {
    const int tid = TIDX, col = tid & 63, kp = tid >> 6;
    const int l = vb / 96, j = (vb % 96) * 64 + col;
    const float* W = (l ? W1 : W0) + j;
    float* sc = lds + 2048;
    __syncthreads();
    for (int i = tid; i < 3072; i += NT) sc[i] = silu_f(i < 1024 ? c_ctx[i] : c[i - 1024]);
    __syncthreads();
    float s0 = 0.f, s1 = 0.f, s2 = 0.f;
#pragma unroll 8
    for (int k = kp * 128; k < kp * 128 + 128; ++k) {
        const float w = W[(size_t)k * 6144];
        s0 += sc[k] * w; s1 += sc[1024 + k] * w; s2 += sc[2048 + k] * w;
    }
    __syncthreads();
    lds[(kp * 3 + 0) * 64 + col] = s0; lds[(kp * 3 + 1) * 64 + col] = s1; lds[(kp * 3 + 2) * 64 + col] = s2;
    __syncthreads();
    if (tid < 192) {
        const int ci = tid >> 6;
        float s = 0.f;
#pragma unroll
        for (int q = 0; q < 8; ++q) s += lds[(q * 3 + ci) * 64 + col];
        mod[(size_t)(l * 3 + ci) * 6144 + j] = s + (l ? b1 : b0)[j];
    }
}

typedef __attribute__((ext_vector_type(8))) short bf16x8;
typedef __attribute__((ext_vector_type(4))) float f32x4;
typedef __attribute__((ext_vector_type(2))) __bf16 bf16x2_t;
typedef __attribute__((ext_vector_type(2))) float f32x2_t;
typedef unsigned short bf16_t;
typedef __attribute__((ext_vector_type(4))) unsigned u32x4;
__device__ __forceinline__ unsigned pk_bf16(float a, float b) {
    bf16x2_t v = __builtin_convertvector((f32x2_t){a, b}, bf16x2_t);
    return __builtin_bit_cast(unsigned, v);
}
__device__ __forceinline__ int gt_lds_byte(int r, int c) {
    const int st = (r >> 4) * 2 + (c >> 5), ob = (r & 15) * 64 + (c & 31) * 2;
    return st * 1024 + (ob ^ (((ob >> 9) & 1) << 5));
}
template <int BM, int BN, int NT, class AL, class EP, int WN = BN / 64>
__device__ __forceinline__ void gemm_tile(const AL& al, const bf16_t* __restrict__ Wt, int K, int m0, int n0, const EP& ep, char* lds) {
    constexpr int NW = NT / 64, NJ = BN / WN / 16;
    constexpr int A_L = BM / 8 / NW, B_L = BN / 8 / NW;
    static_assert((BM / 64) * WN * 64 == NT && (NJ == 4 || NJ == 2), "wave layout");
    char* As = lds;
    char* Bs = lds + 3 * BM * 128;
    const int tid = TIDX, lane = tid & 63, wv = tid >> 6, wr = wv / WN, wc = wv % WN;
    f32x4 acc[4][NJ];
#pragma unroll
    for (int i = 0; i < 4; ++i)
#pragma unroll
        for (int j = 0; j < NJ; ++j) acc[i][j] = (f32x4){0.f, 0.f, 0.f, 0.f};
    const int sb = lane * 16, swz = sb ^ (((sb >> 9) & 1) << 5), lr = swz >> 6, lc = (swz & 63) >> 1;
    const bf16_t* ap[A_L];
    const bf16_t* bp[B_L];
#pragma unroll
    for (int i = 0; i < A_L; ++i) { const int st = wv + NW * i; ap[i] = al.ptr(m0 + (st >> 1) * 16 + lr, (st & 1) * 32 + lc); }
#pragma unroll
    for (int i = 0; i < B_L; ++i) { const int st = wv + NW * i; bp[i] = Wt + (size_t)(n0 + (st >> 1) * 16 + lr) * K + (st & 1) * 32 + lc; }
#define GT_STAGE(buf_, k0_) { \
        _Pragma("unroll") for (int i_ = 0; i_ < A_L; ++i_) \
            __builtin_amdgcn_global_load_lds((const unsigned*)(ap[i_] + (k0_)), (__attribute__((address_space(3))) unsigned*)(As + (buf_) * BM * 128 + (wv + NW * i_) * 1024), 16, 0, 0); \
        _Pragma("unroll") for (int i_ = 0; i_ < B_L; ++i_) \
            __builtin_amdgcn_global_load_lds((const unsigned*)(bp[i_] + (k0_)), (__attribute__((address_space(3))) unsigned*)(Bs + (buf_) * BN * 128 + (wv + NW * i_) * 1024), 16, 0, 0); }
    __syncthreads();
    const int nk = K / 64;
    GT_STAGE(0, 0)
    if (nk > 1) GT_STAGE(1, 64)
    const int fr = lane & 15, fq = lane >> 4;
    for (int kt = 0; kt < nk; ++kt) {
        if (kt + 1 < nk) asm volatile("s_waitcnt vmcnt(%0)" :: "n"(A_L + B_L) : "memory");
        else             asm volatile("s_waitcnt vmcnt(0)" ::: "memory");
        asm volatile("s_waitcnt lgkmcnt(0)" ::: "memory");
        __builtin_amdgcn_s_barrier();
        asm volatile("" ::: "memory");
        const int cb = kt % 3;
        if (kt + 2 < nk) { const int nb_ = (kt + 2) % 3; GT_STAGE(nb_, (kt + 2) * 64) }
        const char* Ab = As + cb * BM * 128;
        const char* Bb = Bs + cb * BN * 128;
        {
            u32x4 x0, x1, x2, x3, x4, x5, x6, x7, y0, y1, y2, y3, y4, y5, y6, y7;
            const unsigned aa0 = (unsigned)(size_t)(Ab + gt_lds_byte(wr * 64 + 0 + fr, fq * 8)), aa1 = (unsigned)(size_t)(Ab + gt_lds_byte(wr * 64 + 16 + fr, fq * 8));
            const unsigned aa2 = (unsigned)(size_t)(Ab + gt_lds_byte(wr * 64 + 32 + fr, fq * 8)), aa3 = (unsigned)(size_t)(Ab + gt_lds_byte(wr * 64 + 48 + fr, fq * 8));
            const unsigned ab0 = (unsigned)(size_t)(Bb + gt_lds_byte(wc * (16 * NJ) + 0 + fr, fq * 8)), ab1 = (unsigned)(size_t)(Bb + gt_lds_byte(wc * (16 * NJ) + 16 + fr, fq * 8));
            if constexpr (NJ == 4) {
                const unsigned ab2 = (unsigned)(size_t)(Bb + gt_lds_byte(wc * (16 * NJ) + 32 + fr, fq * 8)), ab3 = (unsigned)(size_t)(Bb + gt_lds_byte(wc * (16 * NJ) + 48 + fr, fq * 8));
                asm volatile("ds_read_b128 %0, %16\n\tds_read_b128 %1, %17\n\tds_read_b128 %2, %18\n\tds_read_b128 %3, %19\n\t"
                             "ds_read_b128 %4, %20\n\tds_read_b128 %5, %21\n\tds_read_b128 %6, %22\n\tds_read_b128 %7, %23\n\t"
                             "ds_read_b128 %8, %16 offset:1024\n\tds_read_b128 %9, %17 offset:1024\n\tds_read_b128 %10, %18 offset:1024\n\tds_read_b128 %11, %19 offset:1024\n\t"
                             "ds_read_b128 %12, %20 offset:1024\n\tds_read_b128 %13, %21 offset:1024\n\tds_read_b128 %14, %22 offset:1024\n\tds_read_b128 %15, %23 offset:1024\n\t"
                             "s_waitcnt lgkmcnt(8)"
                             : "=&v"(x0), "=&v"(x1), "=&v"(x2), "=&v"(x3), "=&v"(x4), "=&v"(x5), "=&v"(x6), "=&v"(x7),
                               "=&v"(y0), "=&v"(y1), "=&v"(y2), "=&v"(y3), "=&v"(y4), "=&v"(y5), "=&v"(y6), "=&v"(y7)
                             : "v"(aa0), "v"(aa1), "v"(aa2), "v"(aa3), "v"(ab0), "v"(ab1), "v"(ab2), "v"(ab3) : "memory");
            } else {
                asm volatile("ds_read_b128 %0, %12\n\tds_read_b128 %1, %13\n\tds_read_b128 %2, %14\n\tds_read_b128 %3, %15\n\t"
                             "ds_read_b128 %4, %16\n\tds_read_b128 %5, %17\n\t"
                             "ds_read_b128 %6, %12 offset:1024\n\tds_read_b128 %7, %13 offset:1024\n\tds_read_b128 %8, %14 offset:1024\n\tds_read_b128 %9, %15 offset:1024\n\t"
                             "ds_read_b128 %10, %16 offset:1024\n\tds_read_b128 %11, %17 offset:1024\n\t"
                             "s_waitcnt lgkmcnt(6)"
                             : "=&v"(x0), "=&v"(x1), "=&v"(x2), "=&v"(x3), "=&v"(x4), "=&v"(x5),
                               "=&v"(y0), "=&v"(y1), "=&v"(y2), "=&v"(y3), "=&v"(y4), "=&v"(y5)
                             : "v"(aa0), "v"(aa1), "v"(aa2), "v"(aa3), "v"(ab0), "v"(ab1) : "memory");
            }
            const bf16x8 a0[4] = {__builtin_bit_cast(bf16x8, x0), __builtin_bit_cast(bf16x8, x1), __builtin_bit_cast(bf16x8, x2), __builtin_bit_cast(bf16x8, x3)};
#pragma unroll
            for (int i = 0; i < 4; ++i) {
                acc[i][0] = __builtin_amdgcn_mfma_f32_16x16x32_bf16(__builtin_bit_cast(bf16x8, x4), a0[i], acc[i][0], 0, 0, 0);
                acc[i][1] = __builtin_amdgcn_mfma_f32_16x16x32_bf16(__builtin_bit_cast(bf16x8, x5), a0[i], acc[i][1], 0, 0, 0);
                if constexpr (NJ == 4) {
                    acc[i][2] = __builtin_amdgcn_mfma_f32_16x16x32_bf16(__builtin_bit_cast(bf16x8, x6), a0[i], acc[i][2], 0, 0, 0);
                    acc[i][3] = __builtin_amdgcn_mfma_f32_16x16x32_bf16(__builtin_bit_cast(bf16x8, x7), a0[i], acc[i][3], 0, 0, 0);
                }
            }
            if constexpr (NJ == 4)
                asm volatile("s_waitcnt lgkmcnt(0)" : "+v"(y0), "+v"(y1), "+v"(y2), "+v"(y3), "+v"(y4), "+v"(y5), "+v"(y6), "+v"(y7), "+v"(acc[3][3]) :: "memory");
            else
                asm volatile("s_waitcnt lgkmcnt(0)" : "+v"(y0), "+v"(y1), "+v"(y2), "+v"(y3), "+v"(y4), "+v"(y5), "+v"(acc[3][1]) :: "memory");
            const bf16x8 a1[4] = {__builtin_bit_cast(bf16x8, y0), __builtin_bit_cast(bf16x8, y1), __builtin_bit_cast(bf16x8, y2), __builtin_bit_cast(bf16x8, y3)};
#pragma unroll
            for (int i = 0; i < 4; ++i) {
                acc[i][0] = __builtin_amdgcn_mfma_f32_16x16x32_bf16(__builtin_bit_cast(bf16x8, y4), a1[i], acc[i][0], 0, 0, 0);
                acc[i][1] = __builtin_amdgcn_mfma_f32_16x16x32_bf16(__builtin_bit_cast(bf16x8, y5), a1[i], acc[i][1], 0, 0, 0);
                if constexpr (NJ == 4) {
                    acc[i][2] = __builtin_amdgcn_mfma_f32_16x16x32_bf16(__builtin_bit_cast(bf16x8, y6), a1[i], acc[i][2], 0, 0, 0);
                    acc[i][3] = __builtin_amdgcn_mfma_f32_16x16x32_bf16(__builtin_bit_cast(bf16x8, y7), a1[i], acc[i][3], 0, 0, 0);
                }
            }
        }
    }
    __syncthreads();
#undef GT_STAGE
    if constexpr (NJ == 4) ep.template run<BM, BN, NT>(acc, m0, n0, wr, wc, lane, lds);
    else ep.template run<BM, BN, NT, NJ>(acc, m0, n0, wr, wc, lane, lds);
}

template <int NT, class AL, class EP, int MH = 128>
__device__ __forceinline__ void gemm256_tile(const AL& al, const bf16_t* __restrict__ Wt, const int K, const int n0, const EP& ep, char* lds) {
    static_assert(NT == 512 && (MH == 128 || MH == 96), "gemm256_tile needs 8 waves; A halves of 128 or 96 rows");
    constexpr int NM = MH / 32;
    constexpr int HB = 128 * 64 * 2;
    const int tid = TIDX, lane = tid & 63, wid = tid >> 6, wr = wid >> 2, wc = wid & 3, fr = lane & 15, fq = lane >> 4;
    const int sb = lane * 16, swz = sb ^ (((sb >> 9) & 1) << 5);
    const int R0 = (wid >> 1) * 16 + (swz >> 6), C0 = (wid & 1) * 32 + ((swz & 63) >> 1);
    const unsigned ao00 = al.boff(R0, C0), ao10 = al.boff(R0 + MH, C0);
    const unsigned ao01 = (R0 + 64 < MH) ? al.boff(R0 + 64, C0) : ao00, ao11 = (R0 + 64 < MH) ? al.boff(R0 + MH + 64, C0) : ao10;
    const unsigned bo = (unsigned)(R0 * K + C0) * 2u;
    const char* const abase = al.ubase();
    const char* const bbase = (const char*)(Wt + (size_t)n0 * K);
    const size_t bK64 = (size_t)64 * K * 2;
    const unsigned stg = (unsigned)(size_t)lds + (unsigned)__builtin_amdgcn_readfirstlane(wid) * 1024u;
    f32x4 acc[2][2][NM][2];
#pragma unroll
    for (int a = 0; a < 2; ++a)
#pragma unroll
        for (int b = 0; b < 2; ++b)
#pragma unroll
            for (int m = 0; m < NM; ++m)
#pragma unroll
                for (int n = 0; n < 2; ++n) acc[a][b][m][n] = (f32x4){0.f, 0.f, 0.f, 0.f};
    bf16x8 At[NM][2], B0[2][2], B1[2][2];
#define G8_SA(b_, h_) (((b_) * 2 + (h_)) * HB)
#define G8_SB(b_, h_) ((4 + (b_) * 2 + (h_)) * HB)
#define G8_GLDS(vo_, sb_, m0_) asm volatile("s_mov_b32 m0, %2\n\tglobal_load_lds_dwordx4 %0, %1" :: "v"(vo_), "s"(sb_), "s"(m0_) : "memory", "m0")
#define G8_STAGE_A(b_, h_, kt_) { const char* kb_ = abase + (size_t)(kt_) * 128; \
        G8_GLDS(((h_) ? ao10 : ao00), kb_, stg + G8_SA(b_, h_)); G8_GLDS(((h_) ? ao11 : ao01), kb_, stg + G8_SA(b_, h_) + 8192); }
#define G8_STAGE_B(b_, h_, kt_) { const char* kb_ = bbase + (size_t)((h_) * 2) * bK64 + (size_t)(kt_) * 128; const char* kb2_ = kb_ + bK64; \
        G8_GLDS(bo, kb_, stg + G8_SB(b_, h_)); G8_GLDS(bo, kb2_, stg + G8_SB(b_, h_) + 8192); }
#define G8_LDA(b_, h_) { _Pragma("unroll") for (int m = 0; m < NM; ++m) _Pragma("unroll") for (int k = 0; k < 2; ++k) \
        At[m][k] = *(const bf16x8*)(lds + G8_SA(b_, h_) + gt_lds_byte(wr * (MH / 2) + m * 16 + fr, k * 32 + fq * 8)); }
#define G8_LDB(dst_, b_, h_) { _Pragma("unroll") for (int n = 0; n < 2; ++n) _Pragma("unroll") for (int k = 0; k < 2; ++k) \
        dst_[n][k] = *(const bf16x8*)(lds + G8_SB(b_, h_) + gt_lds_byte(wc * 32 + n * 16 + fr, k * 32 + fq * 8)); }
#define G8_MMA(ai_, bj_, Bx_) { __builtin_amdgcn_s_setprio(1); \
        _Pragma("unroll") for (int m = 0; m < NM; ++m) _Pragma("unroll") for (int n = 0; n < 2; ++n) _Pragma("unroll") for (int k = 0; k < 2; ++k) \
            acc[ai_][bj_][m][n] = __builtin_amdgcn_mfma_f32_16x16x32_bf16(Bx_[n][k], At[m][k], acc[ai_][bj_][m][n], 0, 0, 0); \
        __builtin_amdgcn_s_setprio(0); }
#define G8_WAIT_V(n_) asm volatile("s_waitcnt vmcnt(" #n_ ")" ::: "memory")
#define G8_WAIT_L(n_) asm volatile("s_waitcnt lgkmcnt(" #n_ ")" ::: "memory")
#define G8_WAIT_LA { if constexpr (NM == 4) { G8_WAIT_L(8); } else { G8_WAIT_L(6); } }
#define G8_BAR __builtin_amdgcn_s_barrier()
#define G8_SCHED __builtin_amdgcn_sched_barrier(0)
    const int nt = K / 64;
    __syncthreads();
    G8_STAGE_B(0, 0, 0) G8_STAGE_A(0, 0, 0) G8_STAGE_B(0, 1, 0) G8_STAGE_A(0, 1, 0)
    if (wr == 1) G8_BAR;
    G8_WAIT_V(4); G8_BAR;
    G8_STAGE_B(1, 0, 1) G8_STAGE_A(1, 0, 1) G8_STAGE_B(1, 1, 1)
    G8_WAIT_V(6); G8_BAR;
    for (int t = 0; t < nt; t += 2) {
        const bool more = t + 2 < nt;
        G8_LDB(B0, 0, 0) G8_SCHED; G8_LDA(0, 0) G8_STAGE_A(1, 1, t + 1)
        G8_WAIT_LA G8_BAR; G8_WAIT_L(0); G8_MMA(0, 0, B0) G8_BAR; G8_SCHED;
        G8_LDB(B1, 0, 1) if (more) G8_STAGE_B(0, 0, t + 2)
        G8_BAR; G8_WAIT_L(0); G8_MMA(0, 1, B1) G8_BAR;
        G8_LDA(0, 1) if (more) G8_STAGE_A(0, 0, t + 2)
        G8_BAR; G8_WAIT_L(0); G8_MMA(1, 0, B0) G8_BAR; G8_SCHED;
        if (more) { G8_STAGE_B(0, 1, t + 2) G8_WAIT_V(6); } else { G8_WAIT_V(0); }
        G8_BAR; G8_MMA(1, 1, B1) G8_BAR;
        G8_LDB(B0, 1, 0) G8_SCHED; G8_LDA(1, 0) if (more) G8_STAGE_A(0, 1, t + 2)
        G8_WAIT_LA G8_BAR; G8_WAIT_L(0); G8_MMA(0, 0, B0) G8_BAR; G8_SCHED;
        G8_LDB(B1, 1, 1) if (more) G8_STAGE_B(1, 0, t + 3)
        G8_BAR; G8_WAIT_L(0); G8_MMA(0, 1, B1) G8_BAR;
        G8_LDA(1, 1) if (more) G8_STAGE_A(1, 0, t + 3)
        G8_BAR; G8_WAIT_L(0); G8_MMA(1, 0, B0) G8_BAR; G8_SCHED;
        if (more) { G8_STAGE_B(1, 1, t + 3) G8_WAIT_V(6); }
        G8_BAR; G8_MMA(1, 1, B1) G8_BAR;
    }
    if (wr == 0) G8_BAR;
    __syncthreads();
#undef G8_SA
#undef G8_SB
#undef G8_GLDS
#undef G8_STAGE_A
#undef G8_STAGE_B
#undef G8_LDA
#undef G8_LDB
#undef G8_MMA
#undef G8_WAIT_V
#undef G8_WAIT_L
#undef G8_WAIT_LA
#undef G8_BAR
#undef G8_SCHED
    {
        const int t2 = TIDX;
        ep.template run256<NT>(acc, n0, t2 >> 8, (t2 >> 6) & 3, t2 & 63, lds);
    }
}

typedef __attribute__((ext_vector_type(16))) float f32x16;
__device__ __forceinline__ uint2 pk4(float a, float b, float c, float d) { return make_uint2(pk_bf16(a, b), pk_bf16(c, d)); }
constexpr float QSCALE_A = 0.125f * 1.4426950408889634f, QSCALE_B = 0.10206207261596577f * 1.4426950408889634f;
struct FlashP {
    const bf16_t* Q; int q_ld;
    const bf16_t* K0; const bf16_t* K1; int k_ld;
    const bf16_t* Vt; int vt_ld;
    int n0, Lk;
    float* O; bf16_t* Ob; int o_ld;
    float c;
};
template <int OFF> __device__ __forceinline__ void ds_rd128(u32x4& d, unsigned addr) { asm volatile("ds_read_b128 %0, %1 offset:%2" : "=&v"(d) : "v"(addr), "n"(OFF)); }
template <int O0, int O1> __device__ __forceinline__ void ds_rd2x64(u32x4& d, unsigned addr) { asm volatile("ds_read2_b64 %0, %1 offset0:%2 offset1:%3" : "=&v"(d) : "v"(addr), "n"(O0), "n"(O1)); }
template <int DQ, int NT, bool OBF>
__device__ __forceinline__ void flash_item(const FlashP& p, int q0, char* lds) {
    constexpr int G = NT / 256;
    constexpr int LDQ = DQ + 8, LDV = 68;
    constexpr int KCH = 64 * (DQ / 8) / 256;
    constexpr int KT_BYTES = 64 * LDQ * 2, VT_BYTES = 128 * LDV * 2, BUF_BYTES = KT_BYTES + VT_BYTES;
    const int tid = TIDX, lane = tid & 63, wv = (tid >> 6) & 3, grp = tid >> 8, gt = tid & 255;
    const int l31 = lane & 31, hh = lane >> 5;
    char* gl = lds + grp * 2 * BUF_BYTES;
    bf16x8 qf[DQ / 16];
    {
        const bf16_t* qr = p.Q + (size_t)(q0 + wv * 32 + l31) * p.q_ld + hh * 8;
#pragma unroll
        for (int ks = 0; ks < DQ / 16; ++ks) qf[ks] = *(const bf16x8*)(qr + ks * 16);
    }
    f32x16 o[4];
#pragma unroll
    for (int d = 0; d < 4; ++d)
#pragma unroll
        for (int r = 0; r < 16; ++r) o[d][r] = 0.f;
    float m_run = 0.f, l_run = 0.f;
    const u32x4 onesA = {hh == 0 ? 0x3F80u : 0u, 0u, 0u, 0u};
    const int ntile = p.Lk / 64, tpg = ntile / G, t_beg = grp * tpg, t_end = t_beg + tpg;
    uint4 rk0, rk1, rk2 = make_uint4(0u, 0u, 0u, 0u), rv0, rv1, rv2, rv3;
#define FL_KOFF(i) (unsigned)((((gt + (i) * 256) / (DQ / 8)) * p.k_ld + ((gt + (i) * 256) % (DQ / 8)) * 8) * 2)
    const unsigned ko0 = FL_KOFF(0), ko1 = FL_KOFF(1), ko2 = KCH > 2 ? FL_KOFF(2) : 0u;
    const unsigned vo0 = (unsigned)(((gt >> 3) * p.vt_ld + (gt & 7) * 8) * 2);
    const size_t vstep = (size_t)32 * p.vt_ld * 2;
#define FL_GLOAD(t) { const int j0_ = (t) * 64; \
        const char* kb_ = (const char*)((j0_ < p.n0) ? p.K0 + (size_t)j0_ * p.k_ld : p.K1 + (size_t)(j0_ - p.n0) * p.k_ld); \
        const char* vb0_ = (const char*)(p.Vt + j0_); \
        rk0 = *(const uint4*)(kb_ + (size_t)ko0); rk1 = *(const uint4*)(kb_ + (size_t)ko1); if (KCH > 2) rk2 = *(const uint4*)(kb_ + (size_t)ko2); \
        rv0 = *(const uint4*)(vb0_ + (size_t)vo0); rv1 = *(const uint4*)(vb0_ + vstep + (size_t)vo0); \
        rv2 = *(const uint4*)(vb0_ + 2 * vstep + (size_t)vo0); rv3 = *(const uint4*)(vb0_ + 3 * vstep + (size_t)vo0); }
#define FL_KST(i, R) { const int c_ = gt + (i) * 256; const int row_ = c_ / (DQ / 8), ch_ = c_ % (DQ / 8); *(uint4*)(ks_ + row_ * LDQ + ch_ * 8) = R; }
#define FL_VST(i, R) { const int c_ = gt + (i) * 256; const int row_ = c_ >> 3, ch_ = c_ & 7; bf16_t* d_ = vs_ + row_ * LDV + ch_ * 8; \
        *(uint2*)d_ = make_uint2(R.x, R.y); *(uint2*)(d_ + 4) = make_uint2(R.z, R.w); }
#define FL_SWRITE(b) { bf16_t* ks_ = (bf16_t*)(gl + (b) * BUF_BYTES); bf16_t* vs_ = (bf16_t*)(gl + (b) * BUF_BYTES + KT_BYTES); \
        FL_KST(0, rk0) FL_KST(1, rk1) if (KCH > 2) FL_KST(2, rk2) \
        FL_VST(0, rv0) FL_VST(1, rv1) FL_VST(2, rv2) FL_VST(3, rv3) }
    const int rot = (((q0 >> 7) & 31) * tpg) >> 5;
#define FL_TILE(i_) (t_beg + ((i_) + rot < tpg ? (i_) + rot : (i_) + rot - tpg))
    __syncthreads();
    FL_GLOAD(FL_TILE(0)) FL_SWRITE(0)
    __syncthreads();
    if (G == 2 && grp == 1) __builtin_amdgcn_s_barrier();
    for (int it = 0; it < tpg; ++it) {
        const int b = it & 1;
        if (it + 1 < tpg) FL_GLOAD(FL_TILE(it + 1))
        const bf16_t* ks = (const bf16_t*)(gl + b * BUF_BYTES);
        const bf16_t* vs = (const bf16_t*)(gl + b * BUF_BYTES + KT_BYTES);
        f32x16 s[2];
        {
            constexpr int NK = DQ / 16;
            const unsigned kaddr = (unsigned)(size_t)ks + (unsigned)((l31 * LDQ + hh * 8) * 2);
            u32x4 kf[2][NK];
#define FL_KR(kb_, kk_) ds_rd128<((kb_) * 32 * LDQ + (kk_) * 16) * 2>(kf[kb_][kk_], kaddr);
            FL_KR(0, 0) FL_KR(1, 0) FL_KR(0, 1) FL_KR(1, 1) FL_KR(0, 2) FL_KR(1, 2) FL_KR(0, 3) FL_KR(1, 3)
            if constexpr (NK > 4) { FL_KR(0, 4) FL_KR(1, 4) FL_KR(0, 5) FL_KR(1, 5) }
#undef FL_KR
            {
                const u32x4 qx = {hh == 0 ? (__builtin_bit_cast(unsigned, -m_run) >> 16) : 0u, 0u, 0u, 0u};
                f32x16 z16;
#pragma unroll
                for (int r = 0; r < 16; ++r) z16[r] = 0.f;
                s[0] = __builtin_amdgcn_mfma_f32_32x32x16_bf16(__builtin_bit_cast(bf16x8, onesA), __builtin_bit_cast(bf16x8, qx), z16, 0, 0, 0);
                s[1] = __builtin_amdgcn_mfma_f32_32x32x16_bf16(__builtin_bit_cast(bf16x8, onesA), __builtin_bit_cast(bf16x8, qx), z16, 0, 0, 0);
            }
            if constexpr (NK > 4) asm volatile("s_waitcnt lgkmcnt(8)" : "+v"(kf[0][0]), "+v"(kf[1][0]), "+v"(kf[0][1]), "+v"(kf[1][1]));
            else                  asm volatile("s_waitcnt lgkmcnt(4)" : "+v"(kf[0][0]), "+v"(kf[1][0]), "+v"(kf[0][1]), "+v"(kf[1][1]));
#pragma unroll
            for (int kk = 0; kk < 2; ++kk)
#pragma unroll
                for (int kb = 0; kb < 2; ++kb) s[kb] = __builtin_amdgcn_mfma_f32_32x32x16_bf16(__builtin_bit_cast(bf16x8, kf[kb][kk]), qf[kk], s[kb], 0, 0, 0);
            if constexpr (NK > 4) asm volatile("s_waitcnt lgkmcnt(4)" : "+v"(kf[0][2]), "+v"(kf[1][2]), "+v"(kf[0][3]), "+v"(kf[1][3]));
            else                  asm volatile("s_waitcnt lgkmcnt(0)" : "+v"(kf[0][2]), "+v"(kf[1][2]), "+v"(kf[0][3]), "+v"(kf[1][3]));
#pragma unroll
            for (int kk = 2; kk < 4; ++kk)
#pragma unroll
                for (int kb = 0; kb < 2; ++kb) s[kb] = __builtin_amdgcn_mfma_f32_32x32x16_bf16(__builtin_bit_cast(bf16x8, kf[kb][kk]), qf[kk], s[kb], 0, 0, 0);
            if constexpr (NK > 4) {
                asm volatile("s_waitcnt lgkmcnt(0)" : "+v"(kf[0][4]), "+v"(kf[1][4]), "+v"(kf[0][5]), "+v"(kf[1][5]));
#pragma unroll
                for (int kk = 4; kk < NK; ++kk)
#pragma unroll
                    for (int kb = 0; kb < 2; ++kb) s[kb] = __builtin_amdgcn_mfma_f32_32x32x16_bf16(__builtin_bit_cast(bf16x8, kf[kb][kk]), qf[kk], s[kb], 0, 0, 0);
            }
        }
        float mx = s[0][0];
#pragma unroll
        for (int r = 1; r < 16; ++r) mx = fmaxf(mx, s[0][r]);
#pragma unroll
        for (int r = 0; r < 16; ++r) mx = fmaxf(mx, s[1][r]);
        mx = fmaxf(mx, __shfl_xor(mx, 32));
        const bool first = it == 0;
        constexpr float FL_THR = 5.f;
        const bool grow = first || __builtin_amdgcn_ballot_w64(mx > FL_THR) != 0ull;
        if (grow) {
            const float dl = (first || mx > FL_THR) ? mx : 0.f;
            const float m_new = __builtin_bit_cast(float, pk_bf16(m_run + dl, 0.f) << 16);
            const float d = m_new - m_run, alpha = __builtin_amdgcn_exp2f(-d);
            m_run = m_new;
#pragma unroll
            for (int kb = 0; kb < 2; ++kb)
#pragma unroll
                for (int r = 0; r < 16; ++r) s[kb][r] -= d;
            l_run *= alpha;
#pragma unroll
            for (int dd = 0; dd < 4; ++dd)
#pragma unroll
                for (int r = 0; r < 16; ++r) o[dd][r] *= alpha;
        }
#pragma unroll
        for (int r = 0; r < 16; ++r) s[0][r] = __builtin_amdgcn_exp2f(s[0][r]);
        if (G == 2) __builtin_amdgcn_s_barrier();
        {
            const unsigned vb_ = (unsigned)(size_t)vs + (unsigned)((l31 * LDV + 4 * hh) * 2);
            const unsigned va0 = vb_, va1 = vb_ + 32 * LDV * 2, va2 = vb_ + 64 * LDV * 2, va3 = vb_ + 96 * LDV * 2;
            u32x4 fa0, fa1, fa2, fa3, fb0, fb1, fb2, fb3;
#define FL_VR(S_, g_) ds_rd2x64<(g_) * 4, (g_) * 4 + 2>(f##S_##0, va0); ds_rd2x64<(g_) * 4, (g_) * 4 + 2>(f##S_##1, va1); \
                      ds_rd2x64<(g_) * 4, (g_) * 4 + 2>(f##S_##2, va2); ds_rd2x64<(g_) * 4, (g_) * 4 + 2>(f##S_##3, va3);
#define FL_PV(S_, g_, W_) { asm volatile("s_waitcnt lgkmcnt(" #W_ ")" : "+v"(f##S_##0), "+v"(f##S_##1), "+v"(f##S_##2), "+v"(f##S_##3)); \
            constexpr int kb_ = (g_) >> 1, sp_ = (g_) & 1; \
            const u32x4 pbu = {pk_bf16(s[kb_][8 * sp_ + 0], s[kb_][8 * sp_ + 1]), pk_bf16(s[kb_][8 * sp_ + 2], s[kb_][8 * sp_ + 3]), \
                               pk_bf16(s[kb_][8 * sp_ + 4], s[kb_][8 * sp_ + 5]), pk_bf16(s[kb_][8 * sp_ + 6], s[kb_][8 * sp_ + 7])}; \
            const bf16x8 pbv = __builtin_bit_cast(bf16x8, pbu); \
            o[0] = __builtin_amdgcn_mfma_f32_32x32x16_bf16(__builtin_bit_cast(bf16x8, f##S_##0), pbv, o[0], 0, 0, 0); \
            o[1] = __builtin_amdgcn_mfma_f32_32x32x16_bf16(__builtin_bit_cast(bf16x8, f##S_##1), pbv, o[1], 0, 0, 0); \
            o[2] = __builtin_amdgcn_mfma_f32_32x32x16_bf16(__builtin_bit_cast(bf16x8, f##S_##2), pbv, o[2], 0, 0, 0); \
            o[3] = __builtin_amdgcn_mfma_f32_32x32x16_bf16(__builtin_bit_cast(bf16x8, f##S_##3), pbv, o[3], 0, 0, 0); \
            l_run += ((s[kb_][8 * sp_ + 0] + s[kb_][8 * sp_ + 1]) + (s[kb_][8 * sp_ + 2] + s[kb_][8 * sp_ + 3])) + ((s[kb_][8 * sp_ + 4] + s[kb_][8 * sp_ + 5]) + (s[kb_][8 * sp_ + 6] + s[kb_][8 * sp_ + 7])); }
            FL_VR(a, 0) FL_VR(b, 1)
            FL_PV(a, 0, 4)
            FL_VR(a, 2)
            FL_PV(b, 1, 4)
            FL_VR(b, 3)
#pragma unroll
            for (int r = 0; r < 16; ++r) s[1][r] = __builtin_amdgcn_exp2f(s[1][r]);
            FL_PV(a, 2, 4)
            FL_PV(b, 3, 0)
#undef FL_VR
#undef FL_PV
        }
        if (it + 1 < tpg) FL_SWRITE(b ^ 1)
        __syncthreads();
    }
#undef FL_TILE
    if (G == 2 && grp == 0) __builtin_amdgcn_s_barrier();
    l_run += __shfl_xor(l_run, 32);
    const int tid_ = TIDX, lane_ = tid_ & 63, wv_ = (tid_ >> 6) & 3, grp_ = tid_ >> 8, l31_ = lane_ & 31, hh_ = lane_ >> 5;
#define lane lane_
#define wv wv_
#define grp grp_
#define l31 l31_
#define hh hh_
    if (G == 2) {
        float* mb = (float*)lds;
        __syncthreads();
        if (grp == 1) {
            float* w = mb + wv * 66 * 64 + lane;
#pragma unroll
            for (int d = 0; d < 4; ++d)
#pragma unroll
                for (int r = 0; r < 16; ++r) w[(d * 16 + r) * 64] = o[d][r];
            w[64 * 64] = m_run; w[65 * 64] = l_run;
        }
        __syncthreads();
        if (grp == 0) {
            const float* w = mb + wv * 66 * 64 + lane;
            const float m1 = w[64 * 64], l1 = w[65 * 64];
            const float m = fmaxf(m_run, m1), a0 = __builtin_amdgcn_exp2f(m_run - m), a1 = __builtin_amdgcn_exp2f(m1 - m);
            l_run = l_run * a0 + l1 * a1;
#pragma unroll
            for (int d = 0; d < 4; ++d)
#pragma unroll
                for (int r = 0; r < 16; ++r) o[d][r] = o[d][r] * a0 + w[(d * 16 + r) * 64] * a1;
        }
    }
    if (grp == 0) {
        const float inv = 1.f / l_run;
        const size_t ro = (size_t)(q0 + wv * 32 + l31) * p.o_ld;
#pragma unroll
        for (int d = 0; d < 4; ++d)
#pragma unroll
            for (int g4 = 0; g4 < 4; ++g4) {
                const int co = d * 32 + g4 * 8 + 4 * hh;
                if (OBF) *(uint2*)(p.Ob + ro + co) = pk4(o[d][g4 * 4] * inv, o[d][g4 * 4 + 1] * inv, o[d][g4 * 4 + 2] * inv, o[d][g4 * 4 + 3] * inv);
                else *(float4*)(p.O + ro + co) = make_float4(o[d][g4 * 4] * inv, o[d][g4 * 4 + 1] * inv, o[d][g4 * 4 + 2] * inv, o[d][g4 * 4 + 3] * inv);
            }
    }
    __syncthreads();
#undef lane
#undef wv
#undef grp
#undef l31
#undef hh
}


struct TokInfo { int seq, pos, L, ci, t0, latent; };
__device__ __forceinline__ TokInfo tokinfo(int t) {
    TokInfo r;
    if (t < 4096) { r.seq = t >> 8; r.pos = t & 255; r.L = 256; r.ci = 0; r.t0 = t & ~255; r.latent = 0; }
    else { const int u = t - 4096, b = u >> 12; r.seq = 16 + b; r.pos = u & 4095; r.L = 4096; r.ci = 1 + b; r.t0 = 4096 + (b << 12); r.latent = 1; }
    return r;
}
constexpr int VLD = 4608 + 128;
struct Lay { int tbase, Tloc, seqbase, b0, nb; };
__device__ __forceinline__ size_t vt_off(const Lay& l, int seq, int h) {
    if (seq < 16) return ((size_t)(seq - l.seqbase) * 4 + h) * 128 * 256;
    const size_t ctxpart = l.seqbase < 16 ? (size_t)(16 - l.seqbase) * 4 * 128 * 256 : 0;
    return ctxpart + ((size_t)(seq - 16 - l.b0) * 4 + h) * 128 * VLD;
}
__device__ __forceinline__ const float* xrow(const float* xp, const float* xs, int t) { return t < 4096 ? xp + (size_t)t * DM : xs + (size_t)(t - 4096) * DM; }
__device__ __forceinline__ float bf_lo(unsigned u) { return __builtin_bit_cast(float, u << 16); }
__device__ __forceinline__ float bf_hi(unsigned u) { return __builtin_bit_cast(float, u & 0xffff0000u); }
__device__ __forceinline__ float bf1(bf16_t u) { return __builtin_bit_cast(float, (unsigned)u << 16); }
__device__ __forceinline__ bf16_t to_bf(float x) { return (bf16_t)(pk_bf16(x, 0.f) & 0xffffu); }
template <int NT>
__device__ __forceinline__ float group_sum256(float v, float* sh) {
    v = wave_sum(v);
    __syncthreads();
    if ((TIDX & 63) == 0) sh[TIDX >> 6] = v;
    __syncthreads();
    const int g = (TIDX >> 8) * 4;
    return sh[g] + sh[g + 1] + sh[g + 2] + sh[g + 3];
}

__device__ __forceinline__ void n_rope_tables(float* c64, float* s64, float* c32, float* s32) {
    for (int i = TIDX; i < 64 * 16; i += blockDim.x) {
        const int val = i >> 4, f = i & 15;
        const float ang = (float)val * powf(10000.f, -(float)f / 16.f);
        c64[i] = cosf(ang); s64[i] = sinf(ang);
    }
    for (int i = TIDX; i < 64 * 8; i += blockDim.x) {
        const int val = i >> 3, f = i & 7;
        const float ang = (float)val * powf(10000.f, -(float)f / 8.f);
        c32[i] = cosf(ang); s32[i] = sinf(ang);
    }
}

__device__ __forceinline__ int wsrc(int mode, int gh, int n, int N) {
    if (mode == 0) return n < N ? n : -1;
    if (mode == 1) { const int tile = n / (2 * gh), j = n % (2 * gh); return j < gh ? tile * gh + j : FF + tile * gh + (j - gh); }
    if (n < 256) return (n >> 6) * 192 + (n & 63);
    const int c = n - 256; return (c >> 7) * 192 + 64 + (c & 127);
}
template <int NT>
__device__ __forceinline__ void n_wconv(const float* __restrict__ W, int K, int N, bf16_t* __restrict__ Wt, int Npad, int mode, int gh, int vb0, float* lds) {
    const int grp = TIDX >> 8, tid = TIDX & 255;
    const int ntn = Npad / 64, ntiles = (K / 64) * ntn;
    const int vb = vb0 * (NT / 256) + grp;
    float (*tile)[65] = (float (*)[65])(lds + grp * 64 * 65);
    const bool act = vb < ntiles;
    const int k0 = act ? (vb / ntn) * 64 : 0, n0 = act ? (vb % ntn) * 64 : 0;
    __syncthreads();
    if (act) {
#pragma unroll
        for (int p = 0; p < 4; ++p) {
            const int r = p * 16 + (tid >> 4), c = (tid & 15) * 4;
            const int sc = wsrc(mode, gh, n0 + c, N);
            float4 v = make_float4(0.f, 0.f, 0.f, 0.f);
            if (sc >= 0) v = *(const float4*)(W + (size_t)(k0 + r) * N + sc);
            tile[r][c] = v.x; tile[r][c + 1] = v.y; tile[r][c + 2] = v.z; tile[r][c + 3] = v.w;
        }
    }
    __syncthreads();
    if (act) {
#pragma unroll
        for (int p = 0; p < 4; ++p) {
            const int n = p * 16 + (tid >> 4), k = (tid & 15) * 4;
            *(uint2*)(Wt + (size_t)(n0 + n) * K + k0 + k) = pk4(tile[k][n], tile[k + 1][n], tile[k + 2][n], tile[k + 3][n]);
        }
    }
}

template <int NT, int NI>
__device__ __forceinline__ void n_wconv_multi(const float* __restrict__ W, int K, int N, bf16_t* __restrict__ Wt, int Npad, int mode, int gh, int it0, float* lds, int ldo = 0) {
    if (ldo == 0) ldo = K;
    const int grp = TIDX >> 8, tid = TIDX & 255;
    const int ntn = Npad / 64, ntiles = (K / 64) * ntn;
    float4 v[NI][4];
    __syncthreads();
#pragma unroll
    for (int u = 0; u < NI; ++u) {
        const int vb = (it0 + u) * (NT / 256) + grp;
        const bool act = vb < ntiles;
        const int k0 = act ? (vb / ntn) * 64 : 0, n0 = act ? (vb % ntn) * 64 : 0;
#pragma unroll
        for (int p = 0; p < 4; ++p) {
            const int r = p * 16 + (tid >> 4), c = (tid & 15) * 4;
            const int sc = wsrc(mode, gh, n0 + c, N);
            v[u][p] = make_float4(0.f, 0.f, 0.f, 0.f);
            if (act && sc >= 0) v[u][p] = *(const float4*)(W + (size_t)(k0 + r) * N + sc);
        }
    }
#pragma unroll
    for (int u = 0; u < NI; ++u) {
        float (*tile)[65] = (float (*)[65])(lds + (u * (NT / 256) + grp) * 64 * 65);
#pragma unroll
        for (int p = 0; p < 4; ++p) {
            const int r = p * 16 + (tid >> 4), c = (tid & 15) * 4;
            tile[r][c] = v[u][p].x; tile[r][c + 1] = v[u][p].y; tile[r][c + 2] = v[u][p].z; tile[r][c + 3] = v[u][p].w;
        }
    }
    __syncthreads();
#pragma unroll
    for (int u = 0; u < NI; ++u) {
        const int vb = (it0 + u) * (NT / 256) + grp;
        if (vb < ntiles) {
            const int k0 = (vb / ntn) * 64, n0 = (vb % ntn) * 64;
            float (*tile)[65] = (float (*)[65])(lds + (u * (NT / 256) + grp) * 64 * 65);
#pragma unroll
            for (int p = 0; p < 4; ++p) {
                const int n = p * 16 + (tid >> 4), k = (tid & 15) * 4;
                *(uint2*)(Wt + (size_t)(n0 + n) * ldo + k0 + k) = pk4(tile[k][n], tile[k + 1][n], tile[k + 2][n], tile[k + 3][n]);
            }
        }
    }
}

template <int NT>
__device__ __forceinline__ void n_resnorm(const Lay lay, const float* xp, const float* xs, const float* __restrict__ src, const float* __restrict__ g,
                          const float* __restrict__ modl, int shoff, int scoff, bf16_t* __restrict__ out, int vb, float* lds) {
    const int lrow = vb * (NT / 256) + (TIDX >> 8), tid = TIDX & 255;
    const int t = lay.tbase + lrow;
    const TokInfo ti = tokinfo(t);
    const float* xr = src ? src + (size_t)lrow * DM : xrow(xp, xs, t);
    const float4 x = *(const float4*)(xr + tid * 4);
    const float ss = group_sum256<NT>(x.x * x.x + x.y * x.y + x.z * x.z + x.w * x.w, lds);
    const float rstd = rsqrtf(ss * (1.f / DM) + EPS);
    const float4 gg = *(const float4*)(g + tid * 4);
    const float* md = modl + (size_t)ti.ci * 6144;
    const float4 a = *(const float4*)(md + scoff + tid * 4), b = *(const float4*)(md + shoff + tid * 4);
    *(uint2*)(out + (size_t)lrow * DM + tid * 4) = pk4(x.x * rstd * gg.x * (1.f + a.x) + b.x, x.y * rstd * gg.y * (1.f + a.y) + b.y,
                                                       x.z * rstd * gg.z * (1.f + a.z) + b.z, x.w * rstd * gg.w * (1.f + a.w) + b.w);
}

template <int NT>
__device__ __forceinline__ void n_resnorm_w2(const Lay lay, const float* xp, const float* xs, const bf16_t* __restrict__ src, const float* __restrict__ g,
                          const float* __restrict__ modl, int shoff, int scoff, bf16_t* __restrict__ out, int vb) {
    const int lane = TIDX & 63, lrow0 = vb * (NT / 64) * 2 + (TIDX >> 6) * 2;
    float4 x[2][4];
#pragma unroll
    for (int k = 0; k < 2; ++k) {
        const int lrow = lrow0 + k;
        const float* xr = xrow(xp, xs, lay.tbase + lrow);
#pragma unroll
        for (int q = 0; q < 4; ++q) {
            if (src) { const uint2 u = *(const uint2*)(src + (size_t)lrow * DM + q * 256 + lane * 4); x[k][q] = make_float4(bf_lo(u.x), bf_hi(u.x), bf_lo(u.y), bf_hi(u.y)); }
            else x[k][q] = *(const float4*)(xr + q * 256 + lane * 4);
        }
    }
#pragma unroll
    for (int k = 0; k < 2; ++k) {
        const int lrow = lrow0 + k;
        const TokInfo ti = tokinfo(lay.tbase + lrow);
        float ss = 0.f;
#pragma unroll
        for (int q = 0; q < 4; ++q) ss += (x[k][q].x * x[k][q].x + x[k][q].y * x[k][q].y) + (x[k][q].z * x[k][q].z + x[k][q].w * x[k][q].w);
        ss = wave_sum(ss);
        const float rstd = rsqrtf(ss * (1.f / DM) + EPS);
        const float* md = modl + (size_t)ti.ci * 6144;
#pragma unroll
        for (int q = 0; q < 4; ++q) {
            const int c = q * 256 + lane * 4;
            const float4 gg = *(const float4*)(g + c), a = *(const float4*)(md + scoff + c), b = *(const float4*)(md + shoff + c);
            *(uint2*)(out + (size_t)lrow * DM + c) = pk4(x[k][q].x * rstd * gg.x * (1.f + a.x) + b.x, x[k][q].y * rstd * gg.y * (1.f + a.y) + b.y,
                                                         x[k][q].z * rstd * gg.z * (1.f + a.z) + b.z, x[k][q].w * rstd * gg.w * (1.f + a.w) + b.w);
        }
    }
}

struct ALoadBF {
    const bf16_t* A; int lda;
    __device__ __forceinline__ const bf16_t* ptr(int row, int k) const { return A + (size_t)row * lda + k; }
    __device__ __forceinline__ const char* ubase() const { return (const char*)A; }
    __device__ __forceinline__ unsigned boff(int row, int k) const { return (unsigned)(row * lda + k) * 2u; }
};
struct ALoadHalo {
    const bf16_t* A; int lda, base, row0, L; const bf16_t* zero;
    __device__ __forceinline__ const bf16_t* ptr(int r, int k) const {
        const int pos = row0 + r;
        if (pos < 0 || pos >= L) return zero;
        return A + (size_t)(base + pos) * lda + k;
    }
    __device__ __forceinline__ const char* ubase() const { return (const char*)zero; }
    __device__ __forceinline__ unsigned boff(int r, int k) const {
        const int pos = row0 + r;
        if (pos < 0 || pos >= L) return 0u;
        return (unsigned)((const char*)A - (const char*)zero) + (unsigned)((base + pos) * lda + k) * 2u;
    }
};
struct HaloTile { int seq, t0, L, row0, lo, hi; };
__device__ __forceinline__ HaloTile halo_tile(int g) {
    HaloTile h;
    if (g < 16) { h.seq = g; h.t0 = g * 256; h.L = 256; h.row0 = 0; h.lo = 0; h.hi = 256; }
    else { const int b = (g - 16) / 17, i = (g - 16) % 17; h.seq = 16 + b; h.t0 = 4096 + b * 4096; h.L = 4096; h.row0 = 254 * i - 1; h.lo = 1;
           const int last = 4096 - h.row0; h.hi = last < 255 ? last : 255; }
    return h;
}

template <int BM, int BN, int NT, class RowPtr>
__device__ __forceinline__ void store_transposed(const f32x4 (&acc)[4][4], int wr, int wc, int lane, char* lds, const RowPtr& rp) {
    constexpr int LDT = BM + 8;
    bf16_t* Lt = (bf16_t*)lds;
#pragma unroll
    for (int i = 0; i < 4; ++i)
#pragma unroll
        for (int j = 0; j < 4; ++j)
#pragma unroll
            for (int r = 0; r < 4; ++r)
                Lt[(wc * 64 + j * 16 + (lane >> 4) * 4 + r) * LDT + wr * 64 + i * 16 + (lane & 15)] = to_bf(acc[i][j][r]);
    __syncthreads();
    constexpr int CH = BN * (BM / 8) / NT;
#pragma unroll
    for (int k = 0; k < CH; ++k) {
        const int c = TIDX + k * NT, col = c / (BM / 8), kc = c % (BM / 8);
        *(uint4*)(rp(col) + kc * 8) = *(const uint4*)(Lt + col * LDT + kc * 8);
    }
    __syncthreads();
}

struct EpiIn0 {
    Lay lay; bf16_t *Qa, *Ka, *VtA, *tail; float *out_k, *out_v; const float *c64, *s64;
    template <int BM, int BN, int NT>
    __device__ __forceinline__ void run(f32x4 (&acc)[4][4], int m0, int n0, int wr, int wc, int lane, char* lds) const {
        const int nw = n0 + wc * 64, region = nw >> 9, cq = (lane >> 4) * 4;
        if (region <= 1) {
#pragma unroll
            for (int i = 0; i < 4; ++i) {
                const int lrow = m0 + wr * 64 + i * 16 + (lane & 15);
                const TokInfo ti = tokinfo(lay.tbase + lrow);
                if (ti.latent) {
#pragma unroll
                    for (int pg = 0; pg < 2; ++pg) {
                        const int val = pg ? (ti.pos & 63) : (ti.pos >> 6);
                        const float4 c4 = *(const float4*)(c64 + val * 16 + cq), s4 = *(const float4*)(s64 + val * 16 + cq);
                        const float cc[4] = {c4.x, c4.y, c4.z, c4.w}, sn[4] = {s4.x, s4.y, s4.z, s4.w};
#pragma unroll
                        for (int r = 0; r < 4; ++r) {
                            const float x1 = acc[i][2 * pg][r], x2 = acc[i][2 * pg + 1][r];
                            acc[i][2 * pg][r] = x1 * cc[r] - x2 * sn[r];
                            acc[i][2 * pg + 1][r] = x1 * sn[r] + x2 * cc[r];
                        }
                    }
                }
                bf16_t* dst = (region ? Ka : Qa) + (size_t)lrow * 512 + (nw & 511) + cq;
                const float qs = region ? 1.f : QSCALE_A;
#pragma unroll
                for (int j = 0; j < 4; ++j) *(uint2*)(dst + j * 16) = pk4(acc[i][j][0] * qs, acc[i][j][1] * qs, acc[i][j][2] * qs, acc[i][j][3] * qs);
                if (region == 1 && !ti.latent) {
                    float* ok = out_k + ((size_t)(ti.seq * 4 + ((nw - 512) >> 7)) * 256 + ti.pos) * 128 + ((nw - 512) & 127) + cq;
#pragma unroll
                    for (int j = 0; j < 4; ++j) *(float4*)(ok + j * 16) = make_float4(acc[i][j][0], acc[i][j][1], acc[i][j][2], acc[i][j][3]);
                }
            }
        } else if (region == 2) {
            const TokInfo t0 = tokinfo(lay.tbase + m0);
            if (!t0.latent) {
#pragma unroll
                for (int i = 0; i < 4; ++i) {
                    const int lrow = m0 + wr * 64 + i * 16 + (lane & 15);
                    const TokInfo ti = tokinfo(lay.tbase + lrow);
                    float* ov = out_v + ((size_t)(ti.seq * 4 + ((nw - 1024) >> 7)) * 256 + ti.pos) * 128 + ((nw - 1024) & 127) + cq;
#pragma unroll
                    for (int j = 0; j < 4; ++j) *(float4*)(ov + j * 16) = make_float4(acc[i][j][0], acc[i][j][1], acc[i][j][2], acc[i][j][3]);
                }
            }
            const int Lk = t0.latent ? VLD : 256, key0 = (t0.latent ? 512 : 0) + t0.pos;
            bf16_t* vb = VtA; const Lay l = lay; const int seq = t0.seq;
            store_transposed<BM, BN, NT>(acc, wr, wc, lane, lds, [=](int col) {
                const int c = n0 - 1024 + col;
                return vb + vt_off(l, seq, c >> 7) + (size_t)(c & 127) * Lk + key0;
            });
        } else {
#pragma unroll
            for (int i = 0; i < 4; ++i) {
                const int lrow = m0 + wr * 64 + i * 16 + (lane & 15);
                bf16_t* dst = tail + (size_t)lrow * 384 + (nw - 1536) + cq;
#pragma unroll
                for (int j = 0; j < 4; ++j) *(uint2*)(dst + j * 16) = pk4(acc[i][j][0], acc[i][j][1], acc[i][j][2], acc[i][j][3]);
            }
        }
    }
};

template <int NT>
__device__ __forceinline__ void n_l0_tail(const Lay lay, const bf16_t* __restrict__ tail, const float* __restrict__ q_norm, const float* __restrict__ kv_norm,
                          const float* __restrict__ cache_ckv, const float* __restrict__ cache_kpe, const float* c32, const float* s32,
                          bf16_t* __restrict__ qdn, bf16_t* __restrict__ ckvn, bf16_t* __restrict__ Kb, float* __restrict__ out_ckv, float* __restrict__ out_kpe,
                          int vb, float* lds) {
    const int lrow = vb * (NT / 256) + (TIDX >> 8), tid = TIDX & 255;
    if (lrow >= lay.Tloc) {
        const int cr = lrow - lay.Tloc, b = lay.b0 + (cr >> 9), p = cr & 511;
        if (tid < 128) ckvn[(size_t)lrow * 128 + tid] = to_bf(cache_ckv[((size_t)b * 512 + p) * 128 + tid]);
        else if (tid < 160) {
            const bf16_t v = to_bf(cache_kpe[((size_t)b * 512 + p) * 32 + (tid - 128)]);
#pragma unroll
            for (int h = 0; h < 4; ++h) Kb[(size_t)lrow * 384 + h * 96 + 64 + (tid - 128)] = v;
        }
        return;
    }
    const int t = lay.tbase + lrow;
    const TokInfo ti = tokinfo(t);
    const bf16_t* p = tail + (size_t)lrow * 384;
    {
        const float v = tid < 192 ? bf1(p[tid]) : 0.f;
        const float ss = group_sum256<NT>(v * v, lds);
        const float rstd = rsqrtf(ss * (1.f / 192.f) + EPS);
        if (tid < 192) qdn[(size_t)lrow * 192 + tid] = to_bf(v * rstd * q_norm[tid]);
    }
    {
        const float v = tid < 128 ? bf1(p[192 + tid]) : 0.f;
        const float ss = group_sum256<NT>(v * v, lds);
        const float rstd = rsqrtf(ss * (1.f / 128.f) + EPS);
        if (tid < 128) {
            const float val = v * rstd * kv_norm[tid];
            ckvn[(size_t)lrow * 128 + tid] = to_bf(val);
            if (!ti.latent) out_ckv[(size_t)t * 128 + tid] = val;
        }
    }
    if (tid < 32) {
        float val;
        if (ti.latent) {
            const int i = tid & 7, part = tid >> 3;
            const int vv = (part < 2) ? (ti.pos >> 6) : (ti.pos & 63);
            const float cs = c32[vv * 8 + i], sn = s32[vv * 8 + i];
            const int base = 320 + (part >> 1) * 16;
            const float x1 = bf1(p[base + i]), x2 = bf1(p[base + 8 + i]);
            val = (part & 1) ? (x1 * sn + x2 * cs) : (x1 * cs - x2 * sn);
        } else {
            val = bf1(p[320 + tid]);
            out_kpe[(size_t)t * 32 + tid] = val;
        }
        const bf16_t vb16 = to_bf(val);
#pragma unroll
        for (int h = 0; h < 4; ++h) Kb[(size_t)lrow * 384 + h * 96 + 64 + tid] = vb16;
    }
}

template <int NT>
__device__ __forceinline__ void n_l0_tail_w(const Lay lay, const bf16_t* __restrict__ tail, const float* __restrict__ q_norm, const float* __restrict__ kv_norm,
                          const float* __restrict__ cache_ckv, const float* __restrict__ cache_kpe, const float* c32, const float* s32,
                          bf16_t* __restrict__ qdn, bf16_t* __restrict__ ckvn, bf16_t* __restrict__ Kb, float* __restrict__ out_ckv, float* __restrict__ out_kpe, int vb) {
    const int lane = TIDX & 63, lrow = vb * (NT / 64) + (TIDX >> 6);
    if (lrow >= lay.Tloc) {
        const int cr = lrow - lay.Tloc, b = lay.b0 + (cr >> 9), p = cr & 511;
        const float2 c2 = *(const float2*)(cache_ckv + ((size_t)b * 512 + p) * 128 + lane * 2);
        *(unsigned*)(ckvn + (size_t)lrow * 128 + lane * 2) = pk_bf16(c2.x, c2.y);
        if (lane < 32) {
            const bf16_t v = to_bf(cache_kpe[((size_t)b * 512 + p) * 32 + lane]);
#pragma unroll
            for (int h = 0; h < 4; ++h) Kb[(size_t)lrow * 384 + h * 96 + 64 + lane] = v;
        }
        return;
    }
    const int t = lay.tbase + lrow;
    const TokInfo ti = tokinfo(t);
    const bf16_t* p = tail + (size_t)lrow * 384;
    {
        const float v0 = bf1(p[lane]), v1 = bf1(p[lane + 64]), v2 = bf1(p[lane + 128]);
        const float ss = wave_sum(v0 * v0 + v1 * v1 + v2 * v2);
        const float rstd = rsqrtf(ss * (1.f / 192.f) + EPS);
        bf16_t* q = qdn + (size_t)lrow * 192;
        q[lane] = to_bf(v0 * rstd * q_norm[lane]); q[lane + 64] = to_bf(v1 * rstd * q_norm[lane + 64]); q[lane + 128] = to_bf(v2 * rstd * q_norm[lane + 128]);
    }
    {
        const unsigned u = *(const unsigned*)(p + 192 + lane * 2);
        const float v0 = bf_lo(u), v1 = bf_hi(u);
        const float ss = wave_sum(v0 * v0 + v1 * v1);
        const float rstd = rsqrtf(ss * (1.f / 128.f) + EPS);
        const float2 kn = *(const float2*)(kv_norm + lane * 2);
        const float a = v0 * rstd * kn.x, b = v1 * rstd * kn.y;
        *(unsigned*)(ckvn + (size_t)lrow * 128 + lane * 2) = pk_bf16(a, b);
        if (!ti.latent) *(float2*)(out_ckv + (size_t)t * 128 + lane * 2) = make_float2(a, b);
    }
    if (lane < 32) {
        float val;
        if (ti.latent) {
            const int i = lane & 7, part = lane >> 3;
            const int vv = (part < 2) ? (ti.pos >> 6) : (ti.pos & 63);
            const float cs = c32[vv * 8 + i], sn = s32[vv * 8 + i];
            const int base = 320 + (part >> 1) * 16;
            const float x1 = bf1(p[base + i]), x2 = bf1(p[base + 8 + i]);
            val = (part & 1) ? (x1 * sn + x2 * cs) : (x1 * cs - x2 * sn);
        } else {
            val = bf1(p[320 + lane]);
            out_kpe[(size_t)t * 32 + lane] = val;
        }
        const bf16_t vb16 = to_bf(val);
#pragma unroll
        for (int h = 0; h < 4; ++h) Kb[(size_t)lrow * 384 + h * 96 + 64 + lane] = vb16;
    }
}

struct EpiQb {
    Lay lay; bf16_t* Qb; const float *c32, *s32;
    template <int BM, int BN, int NT>
    __device__ __forceinline__ void run(f32x4 (&acc)[4][4], int m0, int n0, int wr, int wc, int lane, char*) const {
        const int nw = n0 + wc * 64, cq = (lane >> 4) * 4;
#pragma unroll
        for (int i = 0; i < 4; ++i) {
            const int lrow = m0 + wr * 64 + i * 16 + (lane & 15);
            const TokInfo ti = tokinfo(lay.tbase + lrow);
#pragma unroll
            for (int j = 0; j < 4; ++j) {
                const int tix = ((nw >> 4) + j) % 6;
                if (tix >= 4) {
                    const int val = (tix == 4) ? (ti.pos >> 6) : (ti.pos & 63);
                    const int fo = ((lane >> 4) & 1) * 4;
                    const float4 c4 = *(const float4*)(c32 + val * 8 + fo), s4 = *(const float4*)(s32 + val * 8 + fo);
                    const float cc[4] = {c4.x, c4.y, c4.z, c4.w}, sn[4] = {s4.x, s4.y, s4.z, s4.w};
                    const bool isx2 = (lane >> 5) != 0;
#pragma unroll
                    for (int r = 0; r < 4; ++r) {
                        const float mine = acc[i][j][r], other = __shfl_xor(mine, 32);
                        const float rot = isx2 ? (other * sn[r] + mine * cc[r]) : (mine * cc[r] - other * sn[r]);
                        acc[i][j][r] = ti.latent ? rot : mine;
                    }
                }
                *(uint2*)(Qb + (size_t)lrow * 384 + nw + j * 16 + cq) = pk4(acc[i][j][0] * QSCALE_B, acc[i][j][1] * QSCALE_B, acc[i][j][2] * QSCALE_B, acc[i][j][3] * QSCALE_B);
            }
        }
    }
};
struct EpiKV {
    Lay lay; bf16_t *Kb, *VtB;
    template <int BM, int BN, int NT>
    __device__ __forceinline__ void run(f32x4 (&acc)[4][4], int m0, int n0, int wr, int wc, int lane, char* lds) const {
        const int nw = n0 + wc * 64, cq = (lane >> 4) * 4;
        if (n0 < 256) {
#pragma unroll
            for (int i = 0; i < 4; ++i) {
                const int lrow = m0 + wr * 64 + i * 16 + (lane & 15);
                bf16_t* dst = Kb + (size_t)lrow * 384 + (nw >> 6) * 96 + cq;
#pragma unroll
                for (int j = 0; j < 4; ++j) *(uint2*)(dst + j * 16) = pk4(acc[i][j][0], acc[i][j][1], acc[i][j][2], acc[i][j][3]);
            }
        } else {
            int seq, key0, Lk;
            if (m0 < lay.Tloc) { const TokInfo t0 = tokinfo(lay.tbase + m0); seq = t0.seq; Lk = t0.latent ? VLD : 256; key0 = (t0.latent ? 512 : 0) + t0.pos; }
            else { const int cr = m0 - lay.Tloc; seq = 16 + lay.b0 + (cr >> 9); Lk = VLD; key0 = cr & 511; }
            bf16_t* vb = VtB; const Lay l = lay;
            store_transposed<BM, BN, NT>(acc, wr, wc, lane, lds, [=](int col) {
                const int c = n0 - 256 + col;
                return vb + vt_off(l, seq, c >> 7) + (size_t)(c & 127) * Lk + key0;
            });
        }
    }
};

template <int NT>
__device__ __forceinline__ void n_combine0(const bf16_t* __restrict__ oa1, const bf16_t* __restrict__ oa2, const float* lq1, const float* lk1, const float* lq2, const float* lk2,
                           const float* __restrict__ subln, bf16_t* __restrict__ merged, int vb) {
    const int lrow = vb * (NT / 256) + (TIDX >> 8), tid = TIDX & 255, lane = tid & 63;
    const float la = wave_sum(lq1[lane] * lk1[lane]), lb = wave_sum(lq2[lane] * lk2[lane]);
    const float lam = expf(la) - expf(lb) + 0.2f;
    const unsigned u1 = *(const unsigned*)(oa1 + (size_t)lrow * 512 + tid * 2), u2 = *(const unsigned*)(oa2 + (size_t)lrow * 512 + tid * 2);
    const float x0 = bf_lo(u1) - lam * bf_lo(u2), x1 = bf_hi(u1) - lam * bf_hi(u2);
    const float ss = wave_sum(x0 * x0 + x1 * x1);
    const float rs = rsqrtf(ss * (1.f / 128.f) + EPS) * 0.8f;
    const int e = (tid * 2) & 127;
    *(unsigned*)(merged + (size_t)lrow * DM + tid * 2) = pk_bf16(x0 * rs * subln[e], x1 * rs * subln[e + 1]);
}

__device__ __forceinline__ float row16_sum(float x) { x += dpp_mov<0xB1>(x); x += dpp_mov<0x4E>(x); x += dpp_mov<0x141>(x); x += dpp_mov<0x140>(x); return x; }
__device__ __forceinline__ void unpack8w(const uint4 u, float (&f)[8]) {
    f[0] = bf_lo(u.x); f[1] = bf_hi(u.x); f[2] = bf_lo(u.y); f[3] = bf_hi(u.y); f[4] = bf_lo(u.z); f[5] = bf_hi(u.z); f[6] = bf_lo(u.w); f[7] = bf_hi(u.w);
}
template <int NT, int R>
__device__ __forceinline__ void n_combine0_m(const bf16_t* __restrict__ oa1, const bf16_t* __restrict__ oa2, const float* lq1, const float* lk1, const float* lq2, const float* lk2,
                           const float* __restrict__ subln, bf16_t* __restrict__ merged, int vb) {
    const int lane = TIDX & 63, lrow0 = (vb * (NT / 64) + (TIDX >> 6)) * R;
    uint4 u1[R], u2[R];
#pragma unroll
    for (int k = 0; k < R; ++k) {
        const size_t lrow = (size_t)(lrow0 + k);
        u1[k] = *(const uint4*)(oa1 + lrow * 512 + lane * 8); u2[k] = *(const uint4*)(oa2 + lrow * 512 + lane * 8);
    }
    const float la = wave_sum(lq1[lane] * lk1[lane]), lb = wave_sum(lq2[lane] * lk2[lane]);
    const float lam = expf(la) - expf(lb) + 0.2f;
    const int e = (lane & 15) * 8;
    const float4 sa = *(const float4*)(subln + e), sb = *(const float4*)(subln + e + 4);
    const float sw[8] = {sa.x, sa.y, sa.z, sa.w, sb.x, sb.y, sb.z, sb.w};
#pragma unroll
    for (int k = 0; k < R; ++k) {
        const size_t lrow = (size_t)(lrow0 + k);
        float f1[8], f2[8], x[8];
        unpack8w(u1[k], f1); unpack8w(u2[k], f2);
        float ss = 0.f;
#pragma unroll
        for (int c = 0; c < 8; ++c) { x[c] = f1[c] - lam * f2[c]; ss += x[c] * x[c]; }
        ss = row16_sum(ss);
        const float rs = rsqrtf(ss * (1.f / 128.f) + EPS) * 0.8f;
        *(uint4*)(merged + lrow * DM + lane * 8) = make_uint4(pk_bf16(x[0] * rs * sw[0], x[1] * rs * sw[1]), pk_bf16(x[2] * rs * sw[2], x[3] * rs * sw[3]),
                                                               pk_bf16(x[4] * rs * sw[4], x[5] * rs * sw[5]), pk_bf16(x[6] * rs * sw[6], x[7] * rs * sw[7]));
    }
}

struct EpiResid {
    Lay lay; const float *xp, *xs; const bf16_t* src; bf16_t* h; const float* modl; int goff;
    template <int BM, int BN, int NT>
    __device__ __forceinline__ void run(f32x4 (&acc)[4][4], int m0, int n0, int wr, int wc, int lane, char* l) const { run<BM, BN, NT, 4>(acc, m0, n0, wr, wc, lane, l); }
    template <int BM, int BN, int NT, int NJ>
    __device__ __forceinline__ void run(f32x4 (&acc)[4][NJ], int m0, int n0, int wr, int wc, int lane, char*) const {
        const int nw = n0 + wc * (16 * NJ), cq = (lane >> 4) * 4;
#pragma unroll
        for (int i = 0; i < 4; ++i) {
            const int lrow = m0 + wr * 64 + i * 16 + (lane & 15), t = lay.tbase + lrow;
            const TokInfo ti = tokinfo(t);
            const float* xr = xrow(xp, xs, t);
            const float* gt = modl + (size_t)ti.ci * 6144 + goff;
#pragma unroll
            for (int j = 0; j < NJ; ++j) {
                const int col = nw + j * 16 + cq;
                float4 b4;
                if (src) { const uint2 u = *(const uint2*)(src + (size_t)lrow * DM + col); b4 = make_float4(bf_lo(u.x), bf_hi(u.x), bf_lo(u.y), bf_hi(u.y)); }
                else b4 = *(const float4*)(xr + col);
                const float4 g4 = *(const float4*)(gt + col);
                *(uint2*)(h + (size_t)lrow * DM + col) = pk4(b4.x + g4.x * acc[i][j][0], b4.y + g4.y * acc[i][j][1], b4.z + g4.z * acc[i][j][2], b4.w + g4.w * acc[i][j][3]);
            }
        }
    }
};

template <int MH = 128>
struct EpiResid256 {
    EpiResid e; int m0;
    template <int NT>
    __device__ __forceinline__ void run256(f32x4 (&acc)[2][2][MH / 32][2], int n0, int wr, int wc, int lane, char*) const {
        const int cq = (lane >> 4) * 4;
#pragma unroll
        for (int ai = 0; ai < 2; ++ai)
#pragma unroll
            for (int m = 0; m < MH / 32; ++m) {
                const int lrow = m0 + ai * MH + wr * (MH / 2) + m * 16 + (lane & 15), t = e.lay.tbase + lrow;
                const TokInfo ti = tokinfo(t);
                const float* xr = xrow(e.xp, e.xs, t);
                const float* gt = e.modl + (size_t)ti.ci * 6144 + e.goff;
#pragma unroll
                for (int bj = 0; bj < 2; ++bj)
#pragma unroll
                    for (int n = 0; n < 2; ++n) {
                        const int col = n0 + bj * 128 + wc * 32 + n * 16 + cq;
                        float4 b4;
                        if (e.src) { const uint2 u = *(const uint2*)(e.src + (size_t)lrow * DM + col); b4 = make_float4(bf_lo(u.x), bf_hi(u.x), bf_lo(u.y), bf_hi(u.y)); }
                        else b4 = *(const float4*)(xr + col);
                        const float4 g4 = *(const float4*)(gt + col);
                        *(uint2*)(e.h + (size_t)lrow * DM + col) = pk4(b4.x + g4.x * acc[ai][bj][m][n][0], b4.y + g4.y * acc[ai][bj][m][n][1],
                                                                       b4.z + g4.z * acc[ai][bj][m][n][2], b4.w + g4.w * acc[ai][bj][m][n][3]);
                    }
            }
    }
};

struct EpiFFNUp {
    Lay lay; HaloTile ht; const float* cw; const float* cb; bf16_t* act;
    struct CW { float2 wg0, wg1, wg2, bg, wv0, wv1, wv2, bv; };
    template <int NT>
    __device__ __forceinline__ CW conv_w(int t128) const {
        constexpr int GH = 64, NP = GH / 2;
        const int fg = t128 * GH + 2 * (TIDX % NP);
        CW w;
        w.wg0 = *(const float2*)(cw + fg); w.wg1 = *(const float2*)(cw + FF2 + fg); w.wg2 = *(const float2*)(cw + 2 * FF2 + fg); w.bg = *(const float2*)(cb + fg);
        w.wv0 = *(const float2*)(cw + FF + fg); w.wv1 = *(const float2*)(cw + FF2 + FF + fg); w.wv2 = *(const float2*)(cw + 2 * FF2 + FF + fg); w.bv = *(const float2*)(cb + FF + fg);
        return w;
    }
    template <int NT>
    __device__ __forceinline__ void conv(const float* U, int t128, const CW& w) const {
        constexpr int BM = 256, GH = 64, LDU = 132, NP = GH / 2, NG = NT / NP, RPG = BM / NG;
        const int tid = TIDX, fp = tid % NP, grp = tid / NP, fg = t128 * GH + 2 * fp;
        const float2 wg0 = w.wg0, wg1 = w.wg1, wg2 = w.wg2, bg = w.bg, wv0 = w.wv0, wv1 = w.wv1, wv2 = w.wv2, bv = w.bv;
        const int r0 = grp * RPG;
        const float* Ug = U + 2 * fp;
        const float2 z2 = make_float2(0.f, 0.f);
        float2 gq[RPG + 2], vq[RPG + 2];
        {
            const int rm = r0 > 0 ? r0 - 1 : 0, rp = r0 + RPG < BM ? r0 + RPG : BM - 1;
            gq[0] = *(const float2*)(Ug + rm * LDU); vq[0] = *(const float2*)(Ug + rm * LDU + GH);
#pragma unroll
            for (int k = 0; k < RPG; ++k) { gq[k + 1] = *(const float2*)(Ug + (r0 + k) * LDU); vq[k + 1] = *(const float2*)(Ug + (r0 + k) * LDU + GH); }
            gq[RPG + 1] = *(const float2*)(Ug + rp * LDU); vq[RPG + 1] = *(const float2*)(Ug + rp * LDU + GH);
            if (r0 == 0) { gq[0] = z2; vq[0] = z2; }
            if (r0 + RPG == BM) { gq[RPG + 1] = z2; vq[RPG + 1] = z2; }
        }
        bf16_t* ap = act + (size_t)(ht.t0 + ht.row0 + r0 - lay.tbase) * FF + fg;
#pragma unroll
        for (int k = 0; k < RPG; ++k) {
            const int r = r0 + k;
            if (r >= ht.lo && r < ht.hi) {
                const float2 gp = gq[k], gc = gq[k + 1], gn = gq[k + 2], vp = vq[k], vc = vq[k + 1], vn = vq[k + 2];
                const float ga = wg0.x * gp.x + wg1.x * gc.x + wg2.x * gn.x + bg.x, gb = wg0.y * gp.y + wg1.y * gc.y + wg2.y * gn.y + bg.y;
                const float va = wv0.x * vp.x + wv1.x * vc.x + wv2.x * vn.x + bv.x, vb = wv0.y * vp.y + wv1.y * vc.y + wv2.y * vn.y + bv.y;
                *(unsigned*)(ap + (size_t)k * FF) = pk_bf16(ga * __builtin_amdgcn_rcpf(1.f + __expf(-ga)) * va, gb * __builtin_amdgcn_rcpf(1.f + __expf(-gb)) * vb);
            }
        }
    }
    template <int BM, int BN, int NT>
    __device__ __forceinline__ void run(f32x4 (&acc)[4][4], int m0, int n0, int wr, int wc, int lane, char* lds) const {
        static_assert(BM == 256 && BN == 128, "tile");
        constexpr int LDU = BN + 4;
        float* U = (float*)lds;
        const CW w = conv_w<NT>(n0 / BN);
#pragma unroll
        for (int i = 0; i < 4; ++i)
#pragma unroll
            for (int j = 0; j < 4; ++j)
                *(f32x4*)(U + (wr * 64 + i * 16 + (lane & 15)) * LDU + wc * 64 + j * 16 + (lane >> 4) * 4) = acc[i][j];
        __syncthreads();
        conv<NT>(U, n0 / BN, w);
        __syncthreads();
    }
    template <int NT>
    __device__ __forceinline__ void run256(f32x4 (&acc)[2][2][4][2], int n0, int wr, int wc, int lane, char* lds) const {
        constexpr int LDU = 132;
        float* U = (float*)lds;
        const CW w0 = conv_w<NT>(n0 / 128), w1 = conv_w<NT>(n0 / 128 + 1);
#pragma unroll
        for (int bj = 0; bj < 2; ++bj) {
#pragma unroll
            for (int ai = 0; ai < 2; ++ai)
#pragma unroll
                for (int m = 0; m < 4; ++m)
#pragma unroll
                    for (int n = 0; n < 2; ++n)
                        *(f32x4*)(U + (ai * 128 + wr * 64 + m * 16 + (lane & 15)) * LDU + wc * 32 + n * 16 + (lane >> 4) * 4) = acc[ai][bj][m][n];
            __syncthreads();
            conv<NT>(U, n0 / 128 + bj, bj == 0 ? w0 : w1);
            __syncthreads();
        }
    }
};


template <int CTRL> __device__ __forceinline__ float dppf(float x) {
    return __builtin_bit_cast(float, __builtin_amdgcn_mov_dpp(__builtin_bit_cast(int, x), CTRL, 0xF, 0xF, true));
}
__device__ __forceinline__ float sfma(float a, float b, float c) { float d; asm("v_fma_f32 %0, %1, %2, %3" : "=v"(d) : "v"(a), "v"(b), "v"(c)); return d; }
__device__ __forceinline__ float smul(float a, float b) { float d; asm("v_mul_f32 %0, %1, %2" : "=v"(d) : "v"(a), "v"(b)); return d; }
__device__ __forceinline__ float sadd(float a, float b) { float d; asm("v_add_f32 %0, %1, %2" : "=v"(d) : "v"(a), "v"(b)); return d; }
__device__ __forceinline__ float red8(float x) { x += dppf<0xB1>(x); x += dppf<0x4E>(x); x += dppf<0x141>(x); return x; }
__device__ __forceinline__ float red16(float x) { x = red8(x); x += dppf<0x140>(x); return x; }
__device__ __forceinline__ float fsigmoid(float x) { return __builtin_amdgcn_rcpf(1.f + __expf(-x)); }
__device__ __forceinline__ float ftanh(float x) { return 1.f - 2.f * __builtin_amdgcn_rcpf(1.f + __expf(2.f * x)); }
__device__ __forceinline__ void unpack8(const uint4 u, float (&f)[8]) {
    f[0] = bf_lo(u.x); f[1] = bf_hi(u.x); f[2] = bf_lo(u.y); f[3] = bf_hi(u.y); f[4] = bf_lo(u.z); f[5] = bf_hi(u.z); f[6] = bf_lo(u.w); f[7] = bf_hi(u.w);
}

struct EpiIn1 {
    Lay lay; HaloTile ht; const float *mu, *conv_w, *conv_b; bf16_t *zcm, *zg, *xc; float* dtr;
    struct SW { float2 k0, k1, k2, kb; };
    template <int NT>
    __device__ __forceinline__ SW staged_w(int nt) const {
        constexpr int BN = 128, NP = BN / 2;
        const bool mix = nt < 15;
        const int c = (mix ? nt * BN : nt * BN - 2432) + 2 * (TIDX % NP);
        const float2 z2 = make_float2(0.f, 0.f);
        SW w;
        w.k0 = mix ? z2 : *(const float2*)(conv_w + c); w.k1 = mix ? *(const float2*)(mu + c) : *(const float2*)(conv_w + 768 + c);
        w.k2 = mix ? z2 : *(const float2*)(conv_w + 2 * 768 + c); w.kb = mix ? z2 : *(const float2*)(conv_b + c);
        return w;
    }
    template <int NT>
    __device__ __forceinline__ void staged(const float* U, int nt, const SW& w) const {
        constexpr int BM = 256, BN = 128, LDU = BN + 4, NP = BN / 2, NG = NT / NP, RPG = BM / NG;
        const int n0 = nt * BN;
        const int tid = TIDX, fp = tid % NP, grp = tid / NP, r0 = grp * RPG;
        const bool mix = nt < 15;
        const int c = (mix ? n0 : n0 - 2432) + 2 * fp;
        const float2 z2 = make_float2(0.f, 0.f);
        const float2 k0 = w.k0, k1 = w.k1, k2 = w.k2, kb = w.kb;
        const float* Uc = U + 2 * fp;
        float2 xq[RPG + 2];
        {
            const int rm = r0 > 0 ? r0 - 1 : 0, rp = r0 + RPG < BM ? r0 + RPG : BM - 1;
            xq[0] = *(const float2*)(Uc + rm * LDU);
#pragma unroll
            for (int k = 0; k < RPG; ++k) xq[k + 1] = *(const float2*)(Uc + (r0 + k) * LDU);
            xq[RPG + 1] = *(const float2*)(Uc + rp * LDU);
            if (r0 == 0) xq[0] = z2;
            if (r0 + RPG == BM) xq[RPG + 1] = z2;
        }
        const size_t lrow0 = (size_t)(ht.t0 + ht.row0 + r0 - lay.tbase);
        const int ostr = mix ? CC : 768;
        bf16_t* op = zcm + ((mix ? (ptrdiff_t)0 : xc - zcm) + (ptrdiff_t)lrow0 * ostr + c);
#pragma unroll
        for (int k = 0; k < RPG; ++k) {
            const int r = r0 + k;
            if (r >= ht.lo && r < ht.hi) {
                const float2 xp = xq[k], xv = xq[k + 1], xn = xq[k + 2];
                float oa, ob;
                if (mix) { oa = xv.x + k1.x * (0.5f * (xp.x + xn.x) - xv.x); ob = xv.y + k1.y * (0.5f * (xp.y + xn.y) - xv.y); }
                else {
                    const float sa = k0.x * xp.x + k1.x * xv.x + k2.x * xn.x + kb.x, sb = k0.y * xp.y + k1.y * xv.y + k2.y * xn.y + kb.y;
                    oa = sa * __builtin_amdgcn_rcpf(1.f + __expf(-sa)); ob = sb * __builtin_amdgcn_rcpf(1.f + __expf(-sb));
                }
                *(unsigned*)(op + (size_t)k * ostr) = pk_bf16(oa, ob);
            }
        }
    }
    template <int BM, int BN, int NT>
    __device__ __forceinline__ void run(f32x4 (&acc)[4][4], int m0, int n0, int wr, int wc, int lane, char* lds) const {
        static_assert(BN == 128 && BM == 256, "tile");
        const int nt = n0 / BN, cq = (lane >> 4) * 4;
        if (nt >= 15 && nt < 19) {
#pragma unroll
            for (int i = 0; i < 4; ++i) {
                const int r = wr * 64 + i * 16 + (lane & 15);
                if (r >= ht.lo && r < ht.hi) {
                    bf16_t* dst = zg + (size_t)(ht.t0 + ht.row0 + r - lay.tbase) * 512 + (n0 - 1920) + wc * 64 + cq;
#pragma unroll
                    for (int j = 0; j < 4; ++j) *(uint2*)(dst + j * 16) = pk4(acc[i][j][0], acc[i][j][1], acc[i][j][2], acc[i][j][3]);
                }
            }
            return;
        }
        if (nt == 25) {
            if (wc == 0 && lane < 32) {
#pragma unroll
                for (int i = 0; i < 4; ++i) {
                    const int r = wr * 64 + i * 16 + (lane & 15);
                    if (r >= ht.lo && r < ht.hi)
                        *(float4*)(dtr + (size_t)(ht.t0 + ht.row0 + r - lay.tbase) * 8 + cq) = make_float4(acc[i][0][0], acc[i][0][1], acc[i][0][2], acc[i][0][3]);
                }
            }
            return;
        }
        constexpr int LDU = BN + 4;
        float* U = (float*)lds;
        const SW w = staged_w<NT>(nt);
#pragma unroll
        for (int i = 0; i < 4; ++i)
#pragma unroll
            for (int j = 0; j < 4; ++j)
                *(f32x4*)(U + (wr * 64 + i * 16 + (lane & 15)) * LDU + wc * 64 + j * 16 + cq) = acc[i][j];
        __syncthreads();
        staged<NT>(U, nt, w);
        __syncthreads();
    }
    template <int NT>
    __device__ __forceinline__ void run256(f32x4 (&acc)[2][2][4][2], int n0, int wr, int wc, int lane, char* lds) const {
        constexpr int LDU = 132;
        const int cq = (lane >> 4) * 4;
        float* U = (float*)lds;
#pragma unroll
        for (int bj = 0; bj < 2; ++bj) {
            const int nt = n0 / 128 + bj;
            if (nt >= 15 && nt < 19) {
#pragma unroll
                for (int ai = 0; ai < 2; ++ai)
#pragma unroll
                    for (int m = 0; m < 4; ++m) {
                        const int r = ai * 128 + wr * 64 + m * 16 + (lane & 15);
                        if (r >= ht.lo && r < ht.hi) {
                            bf16_t* dst = zg + (size_t)(ht.t0 + ht.row0 + r - lay.tbase) * 512 + (nt * 128 - 1920) + wc * 32 + cq;
#pragma unroll
                            for (int n = 0; n < 2; ++n) *(uint2*)(dst + n * 16) = pk4(acc[ai][bj][m][n][0], acc[ai][bj][m][n][1], acc[ai][bj][m][n][2], acc[ai][bj][m][n][3]);
                        }
                    }
            } else if (nt == 25) {
                if (wc == 0 && lane < 32) {
#pragma unroll
                    for (int ai = 0; ai < 2; ++ai)
#pragma unroll
                        for (int m = 0; m < 4; ++m) {
                            const int r = ai * 128 + wr * 64 + m * 16 + (lane & 15);
                            if (r >= ht.lo && r < ht.hi)
                                *(float4*)(dtr + (size_t)(ht.t0 + ht.row0 + r - lay.tbase) * 8 + cq) =
                                    make_float4(acc[ai][bj][m][0][0], acc[ai][bj][m][0][1], acc[ai][bj][m][0][2], acc[ai][bj][m][0][3]);
                        }
                }
            } else {
                const SW w = staged_w<NT>(nt);
#pragma unroll
                for (int ai = 0; ai < 2; ++ai)
#pragma unroll
                    for (int m = 0; m < 4; ++m)
#pragma unroll
                        for (int n = 0; n < 2; ++n)
                            *(f32x4*)(U + (ai * 128 + wr * 64 + m * 16 + (lane & 15)) * LDU + wc * 32 + n * 16 + cq) = acc[ai][bj][m][n];
                __syncthreads();
                staged<NT>(U, nt, w);
                __syncthreads();
            }
        }
    }
};


template <int KS, bool TRANS>
__device__ __forceinline__ f32x4 mm_tile(const bf16_t* A, int lda, const bf16_t* Bt, int ldb, f32x4 acc, int lane) {
#pragma unroll
    for (int ks = 0; ks < KS; ++ks) {
        const bf16x8 a = *(const bf16x8*)(A + (lane & 15) * lda + ks * 32 + (lane >> 4) * 8);
        const bf16x8 b = *(const bf16x8*)(Bt + (lane & 15) * ldb + ks * 32 + (lane >> 4) * 8);
        acc = TRANS ? __builtin_amdgcn_mfma_f32_16x16x32_bf16(b, a, acc, 0, 0, 0) : __builtin_amdgcn_mfma_f32_16x16x32_bf16(a, b, acc, 0, 0, 0);
    }
    return acc;
}
typedef __attribute__((ext_vector_type(2))) unsigned u32x2;
__device__ __forceinline__ bf16x8 ld_row(const bf16_t* A, int lda, int lane) { return *(const bf16x8*)(A + (lane & 15) * lda + (lane >> 4) * 8); }
__device__ __forceinline__ bf16x8 ld_row16(const bf16_t* A, int lane) {
    bf16x8 a = *(const bf16x8*)(A + (lane & 15) * 24 + ((lane >> 4) & 1) * 8);
    if (lane >= 32) a = (bf16x8){0, 0, 0, 0, 0, 0, 0, 0};
    return a;
}
template <bool K16>
__device__ __forceinline__ bf16x8 ld_tr(const bf16_t* X, int ld, int lane) {
    const int g = K16 ? ((lane >> 4) & 1) : (lane >> 4), q = (lane & 15) >> 2, p = lane & 3;
    const unsigned a0 = (unsigned)(size_t)(X + (8 * g + q) * ld + 4 * p), a1 = a0 + 8u * (unsigned)ld;
    u32x2 r0, r1;
    asm volatile("ds_read_b64_tr_b16 %0, %2\n\tds_read_b64_tr_b16 %1, %3\n\ts_waitcnt lgkmcnt(0)" : "=&v"(r0), "=&v"(r1) : "v"(a0), "v"(a1) : "memory");
    u32x4 v = {r0.x, r0.y, r1.x, r1.y};
    if (K16 && lane >= 32) v = (u32x4){0u, 0u, 0u, 0u};
    return __builtin_bit_cast(bf16x8, v);
}
template <bool K16>
__device__ __forceinline__ void ld_tr2(const bf16_t* X0, const bf16_t* X1, int ld, int lane, bf16x8& o0, bf16x8& o1) {
    const int g = K16 ? ((lane >> 4) & 1) : (lane >> 4), q = (lane & 15) >> 2, p = lane & 3;
    const unsigned off = (unsigned)(((8 * g + q) * ld + 4 * p) * 2), st = 8u * (unsigned)ld;
    const unsigned a0 = (unsigned)(size_t)X0 + off, a1 = (unsigned)(size_t)X1 + off;
    u32x2 r0, r1, r2, r3;
    asm volatile("ds_read_b64_tr_b16 %0, %4\n\tds_read_b64_tr_b16 %1, %5\n\tds_read_b64_tr_b16 %2, %6\n\tds_read_b64_tr_b16 %3, %7\n\ts_waitcnt lgkmcnt(0)"
                 : "=&v"(r0), "=&v"(r1), "=&v"(r2), "=&v"(r3) : "v"(a0), "v"(a0 + st), "v"(a1), "v"(a1 + st) : "memory");
    u32x4 v0 = {r0.x, r0.y, r1.x, r1.y}, v1 = {r2.x, r2.y, r3.x, r3.y};
    if (K16 && lane >= 32) { v0 = (u32x4){0u, 0u, 0u, 0u}; v1 = v0; }
    o0 = __builtin_bit_cast(bf16x8, v0); o1 = __builtin_bit_cast(bf16x8, v1);
}
template <bool K16>
__device__ __forceinline__ void ld_tr4(const bf16_t* X0, const bf16_t* X1, const bf16_t* X2, const bf16_t* X3, int ld, int lane, bf16x8& o0, bf16x8& o1, bf16x8& o2, bf16x8& o3) {
    const int g = K16 ? ((lane >> 4) & 1) : (lane >> 4), q = (lane & 15) >> 2, p = lane & 3;
    const unsigned off = (unsigned)(((8 * g + q) * ld + 4 * p) * 2), st = 8u * (unsigned)ld;
    const unsigned a0 = (unsigned)(size_t)X0 + off, a1 = (unsigned)(size_t)X1 + off, a2 = (unsigned)(size_t)X2 + off, a3 = (unsigned)(size_t)X3 + off;
    u32x2 r0, r1, r2, r3, r4, r5, r6, r7;
    asm volatile("ds_read_b64_tr_b16 %0, %8\n\tds_read_b64_tr_b16 %1, %9\n\tds_read_b64_tr_b16 %2, %10\n\tds_read_b64_tr_b16 %3, %11\n\t"
                 "ds_read_b64_tr_b16 %4, %12\n\tds_read_b64_tr_b16 %5, %13\n\tds_read_b64_tr_b16 %6, %14\n\tds_read_b64_tr_b16 %7, %15\n\ts_waitcnt lgkmcnt(0)"
                 : "=&v"(r0), "=&v"(r1), "=&v"(r2), "=&v"(r3), "=&v"(r4), "=&v"(r5), "=&v"(r6), "=&v"(r7)
                 : "v"(a0), "v"(a0 + st), "v"(a1), "v"(a1 + st), "v"(a2), "v"(a2 + st), "v"(a3), "v"(a3 + st) : "memory");
    u32x4 v0 = {r0.x, r0.y, r1.x, r1.y}, v1 = {r2.x, r2.y, r3.x, r3.y}, v2 = {r4.x, r4.y, r5.x, r5.y}, v3 = {r6.x, r6.y, r7.x, r7.y};
    if (K16 && lane >= 32) { v0 = (u32x4){0u, 0u, 0u, 0u}; v1 = v0; v2 = v0; v3 = v0; }
    o0 = __builtin_bit_cast(bf16x8, v0); o1 = __builtin_bit_cast(bf16x8, v1); o2 = __builtin_bit_cast(bf16x8, v2); o3 = __builtin_bit_cast(bf16x8, v3);
}
template <bool TRANS>
__device__ __forceinline__ f32x4 mma(const bf16x8 a, const bf16x8 b, const f32x4 acc) {
    return TRANS ? __builtin_amdgcn_mfma_f32_16x16x32_bf16(b, a, acc, 0, 0, 0) : __builtin_amdgcn_mfma_f32_16x16x32_bf16(a, b, acc, 0, 0, 0);
}

template <int NT>
__device__ __forceinline__ void n_ssd2(const Lay lay, const bf16_t* __restrict__ xc, const float* __restrict__ dtr, const float* __restrict__ A_log, const float* __restrict__ dt_bias,
                                       const float* __restrict__ Dp, const float* __restrict__ H0f, const float* __restrict__ H0b, bf16_t* __restrict__ yd,
                                       float* __restrict__ Hf_out, float* __restrict__ Hb_out, int item, char* lds,
                                       const int c0, const int c1, const float* __restrict__ Hinit, float* __restrict__ Hend) {
    static_assert(NT == 512, "n_ssd2 needs 8 waves");
    const int tid = TIDX, lane = tid & 63, wv = tid >> 6;
    const int dir = item & 1, h = (item >> 1) & 7, seq = lay.seqbase + (item >> 4), g = h >> 2;
    const bool latent = seq >= 16;
    const int L = latent ? 4096 : 256, row0 = (latent ? 4096 + (seq - 16) * 4096 : seq * 256) - lay.tbase;
    bf16_t* Cs = (bf16_t*)lds; bf16_t* Bs = Cs + 4608; bf16_t* Cd = Bs + 4608; bf16_t* Sc = Cd + 4608; bf16_t* Xs = Sc + 4608; bf16_t* Xd = Xs + 4608;
    bf16_t* Sb0 = Xd + 4608; bf16_t* Sb1 = Sb0 + 4608;
    float* acum = (float*)(Sb1 + 4608); float* dts = acum + 64;
    const int pt = tid >> 3, part = tid & 7;
    const int tT = wv >> 1, q0 = (wv & 1) * 2;
    const float A = -__expf(A_log[dir * 8 + h]), Dv = Dp[dir * 8 + h], dtb = dt_bias[dir * 8 + h];
    f32x4 S[2];
    __syncthreads();
    {
        const float* H0 = dir ? H0b : H0f;
#pragma unroll
        for (int q = 0; q < 2; ++q)
#pragma unroll
            for (int r = 0; r < 4; ++r) {
                const int p = tT * 16 + (lane >> 4) * 4 + r, n = (q0 + q) * 16 + (lane & 15);
                const float v = Hinit ? Hinit[p * 64 + n] : (latent ? H0[((size_t)((seq - 16) * 8 + h) * 64 + p) * 64 + n] : 0.f);
                S[q][r] = v; Sb0[p * 72 + n] = to_bf(v);
            }
    }
    uint4 g_b, g_c, g_x; float g_dt = 0.f;
#define SSD2_LOAD(cidx) { const int s_ = (cidx) * 64 + pt; const int pos_ = dir ? (L - 1 - s_) : s_; \
        const bf16_t* xr_ = xc + (size_t)(row0 + pos_) * 768; \
        g_b = *(const uint4*)(xr_ + 512 + g * 64 + part * 8); g_c = *(const uint4*)(xr_ + 640 + g * 64 + part * 8); g_x = *(const uint4*)(xr_ + h * 64 + part * 8); \
        if (part == 0) g_dt = dtr[(size_t)(row0 + pos_) * 8 + h]; }
    SSD2_LOAD(c0)
    int cur = 0;
    for (int c = c0; c < c1; ++c) {
        bf16_t* Sbc = cur ? Sb1 : Sb0; bf16_t* Sbn = cur ? Sb0 : Sb1;
        float fc[8], fx[8];
        {
            unpack8(g_c, fc); unpack8(g_x, fx);
            *(uint4*)(Cs + pt * 72 + part * 8) = g_c;
            *(uint4*)(Bs + pt * 72 + part * 8) = g_b;
            *(uint4*)(Xs + pt * 72 + part * 8) = g_x;
            if (part == 0) {
                const float xx = g_dt + dtb;
                const float dt = fmaxf(xx, 0.f) + __logf(1.f + __expf(-fabsf(xx)));
                dts[pt] = dt; acum[pt] = dt * A;
            }
        }
        if (c + 1 < c1) SSD2_LOAD(c + 1)
        __syncthreads();
        if (wv == 0) {
            float v = acum[lane];
#pragma unroll
            for (int o = 1; o < 64; o <<= 1) { const float u = __shfl_up(v, o); if (lane >= o) v += u; }
            acum[lane] = v;
        }
        __syncthreads();
        {
            const float ac = acum[pt], et = __expf(ac), sc = dts[pt] * __expf(acum[63] - ac);
            *(uint4*)(Cd + pt * 72 + part * 8) = make_uint4(pk_bf16(fc[0] * et, fc[1] * et), pk_bf16(fc[2] * et, fc[3] * et), pk_bf16(fc[4] * et, fc[5] * et), pk_bf16(fc[6] * et, fc[7] * et));
            *(uint4*)(Xd + pt * 72 + part * 8) = make_uint4(pk_bf16(fx[0] * sc, fx[1] * sc), pk_bf16(fx[2] * sc, fx[3] * sc), pk_bf16(fx[4] * sc, fx[5] * sc), pk_bf16(fx[6] * sc, fx[7] * sc));
        }
        __syncthreads();
        {
#pragma unroll
            for (int q = 0; q < 2; ++q) {
                f32x4 acc = mm_tile<2, false>(Cs + tT * 16 * 72, 72, Bs + (q0 + q) * 16 * 72, 72, (f32x4){0.f, 0.f, 0.f, 0.f}, lane);
                const int j = (q0 + q) * 16 + (lane & 15);
                const float aj = acum[j], dj = dts[j];
#pragma unroll
                for (int r = 0; r < 4; ++r) {
                    const int t = tT * 16 + (lane >> 4) * 4 + r;
                    Sc[t * 72 + j] = to_bf(j <= t ? acc[r] * __expf(acum[t] - aj) * dj : 0.f);
                }
            }
        }
        __syncthreads();
        {
#pragma unroll
            for (int q = 0; q < 2; ++q) {
                f32x4 acc = (f32x4){0.f, 0.f, 0.f, 0.f};
                bf16x8 x0, x1;
                ld_tr2<false>(Xs + (q0 + q) * 16, Xs + 32 * 72 + (q0 + q) * 16, 72, lane, x0, x1);
                acc = mma<true>(ld_row(Sc + tT * 16 * 72, 72, lane), x0, acc);
                acc = mma<true>(ld_row(Sc + tT * 16 * 72 + 32, 72, lane), x1, acc);
                acc = mm_tile<2, true>(Cd + tT * 16 * 72, 72, Sbc + (q0 + q) * 16 * 72, 72, acc, lane);
                const int t = tT * 16 + (lane & 15), p = (q0 + q) * 16 + (lane >> 4) * 4;
                const int s = c * 64 + t, pos = dir ? (L - 1 - s) : s;
                const uint2 ux = *(const uint2*)(xc + (size_t)(row0 + pos) * 768 + h * 64 + p);
                *(uint2*)(yd + ((size_t)dir * lay.Tloc + row0 + pos) * 512 + h * 64 + p) =
                    pk4(acc[0] + Dv * bf_lo(ux.x), acc[1] + Dv * bf_hi(ux.x), acc[2] + Dv * bf_lo(ux.y), acc[3] + Dv * bf_hi(ux.y));
            }
            const float eC = __expf(acum[63]);
            bf16x8 xd0, xd1, bb00, bb01, bb10, bb11;
            ld_tr2<false>(Xd + tT * 16, Xd + 32 * 72 + tT * 16, 72, lane, xd0, xd1);
            ld_tr4<false>(Bs + q0 * 16, Bs + (q0 + 1) * 16, Bs + 32 * 72 + q0 * 16, Bs + 32 * 72 + (q0 + 1) * 16, 72, lane, bb00, bb01, bb10, bb11);
#pragma unroll
            for (int q = 0; q < 2; ++q) {
                S[q] = S[q] * eC;
                S[q] = mma<false>(xd0, q ? bb01 : bb00, S[q]);
                S[q] = mma<false>(xd1, q ? bb11 : bb10, S[q]);
#pragma unroll
                for (int r = 0; r < 4; ++r) Sbn[(tT * 16 + (lane >> 4) * 4 + r) * 72 + (q0 + q) * 16 + (lane & 15)] = to_bf(S[q][r]);
            }
        }
        __syncthreads();
        cur ^= 1;
    }
    float* Ho = dir ? Hb_out : Hf_out;
    if (!latent) {
#pragma unroll
        for (int q = 0; q < 2; ++q)
#pragma unroll
            for (int r = 0; r < 4; ++r) Ho[((size_t)(seq * 8 + h) * 64 + tT * 16 + (lane >> 4) * 4 + r) * 64 + (q0 + q) * 16 + (lane & 15)] = S[q][r];
    }
    if (Hend) {
#pragma unroll
        for (int q = 0; q < 2; ++q)
#pragma unroll
            for (int r = 0; r < 4; ++r) Hend[(tT * 16 + (lane >> 4) * 4 + r) * 64 + (q0 + q) * 16 + (lane & 15)] = S[q][r];
    }
#undef SSD2_LOAD
}

template <int NT>
__device__ __forceinline__ void n_wkv2(const Lay lay, const bf16_t* __restrict__ zcm, const bf16_t* __restrict__ w2t, const bf16_t* __restrict__ a2t,
                                       const float* __restrict__ w0, const float* __restrict__ a0, const float* __restrict__ k_k, const float* __restrict__ k_a,
                                       const float* __restrict__ S0f, const float* __restrict__ S0b, bf16_t* __restrict__ y,
                                       float* __restrict__ Sf_out, float* __restrict__ Sb_out, int item, char* lds) {
    static_assert(NT == 512, "n_wkv2 needs 8 waves");
    const int tid = TIDX, lane = tid & 63, wv = tid >> 6;
    const int dir = item & 1, h = (item >> 1) & 7, seq = lay.seqbase + (item >> 4);
    const bool latent = seq >= 16;
    const int L = latent ? 4096 : 256, row0 = (latent ? 4096 + (seq - 16) * 4096 : seq * 256) - lay.tbase;
    bf16_t* W2s = (bf16_t*)lds; bf16_t* A2s = W2s + 4608; bf16_t* Sb0 = A2s + 4608; bf16_t* Sb1 = Sb0 + 4608;
    bf16_t* KR = Sb1 + 4608; bf16_t* RR = KR + 2304;
    constexpr int LG = 68;
    float* AA = (float*)(RR + 2304); float* GG = AA + 32 * LG; float* rsv = GG + 32 * LG; float* gC = rsv + 32;
    bf16_t* X1 = (bf16_t*)(gC + 128); bf16_t* X2 = X1 + 2304;
    bf16_t* OPS = X2 + 2304;
    constexpr int OPS_SC = 7 * 1152;
    bf16_t* TMP = OPS + 2 * OPS_SC;
    constexpr int TMP_SC = 512 + 4 * 384 + 1152 + 1152;
    bf16_t* Us = TMP + 2 * TMP_SC;
    __syncthreads();
    {
        const int c = tid >> 3, part = tid & 7;
        *(uint4*)(W2s + c * 72 + part * 8) = *(const uint4*)(w2t + ((size_t)dir * 512 + h * 64 + c) * 64 + part * 8);
        *(uint4*)(A2s + c * 72 + part * 8) = *(const uint4*)(a2t + ((size_t)dir * 512 + h * 64 + c) * 64 + part * 8);
    }
    const int pt = tid >> 4, part = tid & 15, ch0 = part * 4;
    const int psc = pt >> 4, ptl = pt & 15;
    float kkc[4], kac[4];
#pragma unroll
    for (int i = 0; i < 4; ++i) { kkc[i] = k_k[h * 64 + ch0 + i]; kac[i] = k_a[h * 64 + ch0 + i]; }
    const int lm = wv >> 2, lrt = (wv >> 1) & 1, lct0 = (wv & 1) * 2;
    float lc0[2];
#pragma unroll
    for (int q = 0; q < 2; ++q) { const int ch = dir * 512 + h * 64 + (lct0 + q) * 16 + (lane & 15); lc0[q] = lm ? a0[ch] : w0[ch]; }
    const int vT = wv >> 1, kT0 = (wv & 1) * 2;
    f32x4 S[2];
    f32x4 accU = (f32x4){0.f, 0.f, 0.f, 0.f};
    {
        const float* S0 = dir ? S0b : S0f;
#pragma unroll
        for (int q = 0; q < 2; ++q)
#pragma unroll
            for (int r = 0; r < 4; ++r) {
                const int v = vT * 16 + (lane >> 4) * 4 + r, k = (kT0 + q) * 16 + (lane & 15);
                const float x = latent ? S0[((size_t)((seq - 16) * 8 + h) * 64 + v) * 64 + k] : 0.f;
                S[q][r] = x; Sb0[v * 72 + k] = to_bf(x);
            }
    }
    uint2 g_r, g_k, g_wd, g_ad, g_v;
#define WKV2_LOAD(cidx) { const int s_ = (cidx) * 32 + pt; const int pos_ = dir ? (L - 1 - s_) : s_; \
        const bf16_t* zr_ = zcm + (size_t)(row0 + pos_) * CC; \
        g_r = *(const uint2*)(zr_ + h * 64 + ch0); g_k = *(const uint2*)(zr_ + 512 + h * 64 + ch0); g_v = *(const uint2*)(zr_ + 1024 + h * 64 + ch0); \
        g_wd = *(const uint2*)(zr_ + 1536 + dir * 64 + ch0); g_ad = *(const uint2*)(zr_ + 1664 + dir * 64 + ch0); }
    WKV2_LOAD(0)
    const int nb = L / 32;
    int cur = 0;
    for (int c = 0; c < nb; ++c) {
        float fr[4], fk[4];
        {
            fr[0] = bf_lo(g_r.x); fr[1] = bf_hi(g_r.x); fr[2] = bf_lo(g_r.y); fr[3] = bf_hi(g_r.y);
            fk[0] = bf_lo(g_k.x); fk[1] = bf_hi(g_k.x); fk[2] = bf_lo(g_k.y); fk[3] = bf_hi(g_k.y);
            float ss = 0.f;
#pragma unroll
            for (int i = 0; i < 4; ++i) { const float q = fk[i] * kkc[i]; ss += q * q; }
            ss = red16(ss);
            if (part == 0) rsv[pt] = rsqrtf(ss + 1e-12f);
            *(uint2*)(X1 + pt * 72 + ch0) = pk4(ftanh(bf_lo(g_wd.x)), ftanh(bf_hi(g_wd.x)), ftanh(bf_lo(g_wd.y)), ftanh(bf_hi(g_wd.y)));
            *(uint2*)(X2 + pt * 72 + ch0) = g_ad;
            *(uint2*)(OPS + psc * OPS_SC + 6 * 1152 + ptl * 72 + ch0) = g_v;
        }
        if (c + 1 < nb) WKV2_LOAD(c + 1)
        __syncthreads();
        for (int rp2_ = 0; rp2_ < REP_W2; ++rp2_) {
        {
            const bf16_t* Xm = lm ? X2 : X1; const bf16_t* Wm = lm ? A2s : W2s;
#pragma unroll
            for (int q = 0; q < 2; ++q) {
                const f32x4 acc = mm_tile<2, false>(Xm + lrt * 16 * 72, 72, Wm + (lct0 + q) * 16 * 72, 72, (f32x4){0.f, 0.f, 0.f, 0.f}, lane);
#pragma unroll
                for (int r = 0; r < 4; ++r) {
                    const int o = (lrt * 16 + (lane >> 4) * 4 + r) * LG + (lct0 + q) * 16 + (lane & 15);
                    const float sg = fsigmoid(lc0[q] + acc[r]);
                    if (lm == 0) GG[o] = -0.606531f * sg; else AA[o] = sg;
                }
            }
        }
        __syncthreads();
        }
        if (tid < 128) {
            const int sc = tid >> 6, ch = tid & 63;
            float lw[16];
#pragma unroll
            for (int t = 0; t < 16; ++t) lw[t] = GG[(sc * 16 + t) * LG + ch];
#pragma unroll
            for (int t = 1; t < 16; ++t) lw[t] += lw[t - 1];
#pragma unroll
            for (int t = 0; t < 16; ++t) GG[(sc * 16 + t) * LG + ch] = lw[t];
        }
        __syncthreads();
        for (int rp4_ = 0; rp4_ < REP_W4; ++rp4_) {
        {
            const float rs = rsv[pt];
            bf16_t* ops = OPS + psc * OPS_SC;
            float va[4], vb[4], vk[4], vr[4], vbh[4], vkh[4];
#pragma unroll
            for (int i = 0; i < 4; ++i) {
                const int ch = ch0 + i;
                const float G = GG[pt * LG + ch], Gp = ptl ? GG[(pt - 1) * LG + ch] : 0.f, GC = GG[(psc * 16 + 15) * LG + ch];
                const float a = AA[pt * LG + ch], kk = fk[i] * kkc[i] * rs, ki = fk[i] * (1.f + (a - 1.f) * kac[i]);
                const float enG = __expf(-G), gc = __expf(GC);
                va[i] = -kk * __expf(Gp); vb[i] = kk * a * enG; vk[i] = ki * enG; vr[i] = fr[i] * __expf(G);
                vbh[i] = vb[i] * gc; vkh[i] = vk[i] * gc;
                if (ptl == 15) gC[psc * 64 + ch] = gc;
            }
            *(uint2*)(ops + 0 * 1152 + ptl * 72 + ch0) = pk4(va[0], va[1], va[2], va[3]);
            *(uint2*)(ops + 1 * 1152 + ptl * 72 + ch0) = pk4(vb[0], vb[1], vb[2], vb[3]);
            *(uint2*)(ops + 2 * 1152 + ptl * 72 + ch0) = pk4(vk[0], vk[1], vk[2], vk[3]);
            *(uint2*)(ops + 3 * 1152 + ptl * 72 + ch0) = pk4(vr[0], vr[1], vr[2], vr[3]);
            *(uint2*)(ops + 4 * 1152 + ptl * 72 + ch0) = pk4(vbh[0], vbh[1], vbh[2], vbh[3]);
            *(uint2*)(ops + 5 * 1152 + ptl * 72 + ch0) = pk4(vkh[0], vkh[1], vkh[2], vkh[3]);
        }
        __syncthreads();
        }
        for (int rp5_ = 0; rp5_ < REP_W567; ++rp5_) {
        {
            const int sc = wv >> 2, prod = wv & 3;
            const bf16_t* ops = OPS + sc * OPS_SC;
            bf16_t* tmp = TMP + sc * TMP_SC;
            const f32x4 acc = mm_tile<2, false>(ops + (prod < 2 ? 0 : 3) * 1152, 72, ops + ((prod & 1) ? 2 : 1) * 1152, 72, (f32x4){0.f, 0.f, 0.f, 0.f}, lane);
            const int j = lane & 15;
#pragma unroll
            for (int r = 0; r < 4; ++r) {
                const int t = (lane >> 4) * 4 + r;
                const float v = (prod < 2 ? (j < t) : (j <= t)) ? acc[r] : 0.f;
                if (prod == 0) ((float*)tmp)[t * 16 + j] = v;
                else tmp[512 + (prod - 1) * 384 + t * 24 + j] = to_bf(v);
            }
        }
        __syncthreads();
        {
            const int sc = wv >> 2, vt = wv & 3;
            const bf16_t* ops = OPS + sc * OPS_SC;
            bf16_t* tmp = TMP + sc * TMP_SC;
            const f32x4 acc = mma<false>(ld_row16(tmp + 512 + 0 * 384, lane), ld_tr<true>(ops + 6 * 1152 + vt * 16, 72, lane), (f32x4){0.f, 0.f, 0.f, 0.f});
#pragma unroll
            for (int r = 0; r < 4; ++r) tmp[512 + 4 * 384 + ((lane >> 4) * 4 + r) * 72 + vt * 16 + (lane & 15)] = to_bf(acc[r]);
            if (tid < 32) {
                const int isc = tid >> 4, j = tid & 15;
                const float* N = (const float*)(TMP + isc * TMP_SC);
                bf16_t* Mb = TMP + isc * TMP_SC + 512 + 3 * 384;
                float m[16];
#pragma unroll
                for (int t = 0; t < 16; ++t) {
                    float p0 = (t == j) ? 1.f : 0.f, p1 = 0.f, p2 = 0.f, p3 = 0.f;
#pragma unroll
                    for (int s = 0; s < t; ++s) {
                        const float nv = N[t * 16 + s];
                        if ((s & 3) == 0) p0 += nv * m[s]; else if ((s & 3) == 1) p1 += nv * m[s]; else if ((s & 3) == 2) p2 += nv * m[s]; else p3 += nv * m[s];
                    }
                    m[t] = (t >= j) ? (p0 + p1) + (p2 + p3) : 0.f;
                    Mb[t * 24 + j] = to_bf(m[t]);
                }
            }
        }
        __syncthreads();
        {
            const int sc = wv >> 2, tl = wv & 3;
            const bf16_t* ops = OPS + sc * OPS_SC;
            bf16_t* tmp = TMP + sc * TMP_SC;
            const bf16_t* Mb = tmp + 512 + 3 * 384;
            const bf16x8 mrow = ld_row16(Mb, lane);
            bf16x8 tA, tT1;
            ld_tr2<true>(ops + 0 * 1152 + tl * 16, tmp + 512 + 4 * 384 + tl * 16, 72, lane, tA, tT1);
            const f32x4 accW = mma<false>(mrow, tA, (f32x4){0.f, 0.f, 0.f, 0.f});
            bf16_t* Wt = tmp + 512 + 4 * 384 + 1152;
#pragma unroll
            for (int r = 0; r < 4; ++r) Wt[((lane >> 4) * 4 + r) * 72 + tl * 16 + (lane & 15)] = to_bf(accW[r]);
            accU = mma<false>(mrow, tT1, (f32x4){0.f, 0.f, 0.f, 0.f});
        }
        __syncthreads();
        }
#pragma unroll
        for (int sc = 0; sc < 2; ++sc) {
            bf16_t* Sbc = cur ? Sb1 : Sb0; bf16_t* Sbn = cur ? Sb0 : Sb1;
            const bf16_t* ops = OPS + sc * OPS_SC;
            const bf16_t* tmp = TMP + sc * TMP_SC;
            if ((wv >> 2) == sc) {
                const int vt = wv & 3;
                const f32x4 u = mm_tile<2, false>(tmp + 512 + 4 * 384 + 1152, 72, Sbc + vt * 16 * 72, 72, accU, lane);
#pragma unroll
                for (int r = 0; r < 4; ++r) Us[((lane >> 4) * 4 + r) * 72 + vt * 16 + (lane & 15)] = to_bf(u[r]);
            }
            __syncthreads();
            if (wv < 4) {
                const int vt = wv;
                f32x4 yv = mm_tile<2, true>(ops + 3 * 1152, 72, Sbc + vt * 16 * 72, 72, (f32x4){0.f, 0.f, 0.f, 0.f}, lane);
                bf16x8 tU, tV;
                ld_tr2<true>(Us + vt * 16, ops + 6 * 1152 + vt * 16, 72, lane, tU, tV);
                yv = mma<true>(ld_row16(tmp + 512 + 1 * 384, lane), tU, yv);
                yv = mma<true>(ld_row16(tmp + 512 + 2 * 384, lane), tV, yv);
                const int s = c * 32 + sc * 16 + (lane & 15), pos = dir ? (L - 1 - s) : s;
                *(uint2*)(y + ((size_t)dir * lay.Tloc + row0 + pos) * 512 + h * 64 + vt * 16 + (lane >> 4) * 4) = pk4(yv[0], yv[1], yv[2], yv[3]);
            }
            {
                bf16x8 aU, aV, b0, b1, k0_, k1_;
                ld_tr2<true>(Us + vT * 16, ops + 6 * 1152 + vT * 16, 72, lane, aU, aV);
                ld_tr4<true>(ops + 4 * 1152 + kT0 * 16, ops + 4 * 1152 + (kT0 + 1) * 16, ops + 5 * 1152 + kT0 * 16, ops + 5 * 1152 + (kT0 + 1) * 16, 72, lane, b0, b1, k0_, k1_);
#pragma unroll
                for (int q = 0; q < 2; ++q) {
                    const int kt = kT0 + q;
                    S[q] = S[q] * gC[sc * 64 + kt * 16 + (lane & 15)];
                    S[q] = mma<false>(aU, q ? b1 : b0, S[q]);
                    S[q] = mma<false>(aV, q ? k1_ : k0_, S[q]);
#pragma unroll
                    for (int r = 0; r < 4; ++r) Sbn[(vT * 16 + (lane >> 4) * 4 + r) * 72 + kt * 16 + (lane & 15)] = to_bf(S[q][r]);
                }
            }
            __syncthreads();
            cur ^= 1;
        }
    }
    float* So = dir ? Sb_out : Sf_out;
    if (!latent) {
#pragma unroll
        for (int q = 0; q < 2; ++q)
#pragma unroll
            for (int r = 0; r < 4; ++r) So[((size_t)(seq * 8 + h) * 64 + vT * 16 + (lane >> 4) * 4 + r) * 64 + (kT0 + q) * 16 + (lane & 15)] = S[q][r];
    }
#undef WKV2_LOAD
}

template <int NT>
__device__ __forceinline__ void n_wkv3(const Lay lay, const bf16_t* __restrict__ zcm, const bf16_t* __restrict__ w2t, const bf16_t* __restrict__ a2t,
                                       const float* __restrict__ w0, const float* __restrict__ a0, const float* __restrict__ k_k, const float* __restrict__ k_a,
                                       const float* __restrict__ S0f, const float* __restrict__ S0b, bf16_t* __restrict__ y,
                                       float* __restrict__ Sf_out, float* __restrict__ Sb_out, int item, char* lds,
                                       const int c0, const int c1, const float* __restrict__ Sinit, const int pq, float* __restrict__ Send) {
    static_assert(NT == 512, "n_wkv3 needs 8 waves");
    const int tid = TIDX, lane = tid & 63, wv = tid >> 6;
    const int dir = item & 1, h = (item >> 1) & 7, seq = lay.seqbase + (item >> 4);
    const bool latent = seq >= 16;
    const int L = latent ? 4096 : 256, row0 = (latent ? 4096 + (seq - 16) * 4096 : seq * 256) - lay.tbase;
    constexpr int OPS_SC = 7 * 1152;
    constexpr int TMP_SC = 512 + 4 * 384 + 1152 + 1152;
    constexpr int LG = 68;
    bf16_t* W2s = (bf16_t*)lds; bf16_t* A2s = W2s + 4608; bf16_t* Sb0 = A2s + 4608; bf16_t* Sb1 = Sb0 + 4608;
    float* rsv = (float*)(Sb1 + 4608); float* gC = rsv + 64;
    bf16_t* OPS = (bf16_t*)(gC + 256);
    bf16_t* TMP = OPS + 4 * OPS_SC;
    bf16_t* Us = TMP + 4 * TMP_SC;
    float* AA = (float*)TMP; float* GG = AA + 64 * LG;
    bf16_t* X1 = OPS; bf16_t* X2 = OPS + OPS_SC;
    static_assert(2 * 64 * LG * 4 <= 4 * TMP_SC * 2, "staging must fit in TMP");
    __syncthreads();
    {
        const int c = tid >> 3, part = tid & 7;
        *(uint4*)(W2s + c * 72 + part * 8) = *(const uint4*)(w2t + ((size_t)dir * 512 + h * 64 + c) * 64 + part * 8);
        *(uint4*)(A2s + c * 72 + part * 8) = *(const uint4*)(a2t + ((size_t)dir * 512 + h * 64 + c) * 64 + part * 8);
    }
    const int pt = tid >> 3, part = tid & 7, ch0 = part * 8;
    const int psc = pt >> 4, ptl = pt & 15;
    const int jsc = wv >> 2, jq = wv & 3;
    float lc0[2];
    lc0[0] = w0[dir * 512 + h * 64 + jq * 16 + (lane & 15)]; lc0[1] = a0[dir * 512 + h * 64 + jq * 16 + (lane & 15)];
    const int vT = wv >> 1, kT0 = (wv & 1) * 2;
    f32x4 S[2];
    f32x4 accU[2];
    {
        const float* S0 = dir ? S0b : S0f;
#pragma unroll
        for (int q = 0; q < 2; ++q)
#pragma unroll
            for (int r = 0; r < 4; ++r) {
                const int v = vT * 16 + (lane >> 4) * 4 + r, k = (kT0 + q) * 16 + (lane & 15);
                const float x = Sinit ? Sinit[v * 64 + k] : (latent ? S0[((size_t)((seq - 16) * 8 + h) * 64 + v) * 64 + k] : 0.f);
                S[q][r] = x; Sb0[v * 72 + k] = to_bf(x);
            }
    }
    uint4 g_r, g_k, g_wd, g_ad, g_v;
#define WKV3_LOAD(cidx) { const int s_ = (cidx) * 64 + pt; const int pos_ = dir ? (L - 1 - s_) : s_; \
        const bf16_t* zr_ = zcm + (size_t)(row0 + pos_) * CC; \
        g_r = *(const uint4*)(zr_ + h * 64 + ch0); g_k = *(const uint4*)(zr_ + 512 + h * 64 + ch0); g_v = *(const uint4*)(zr_ + 1024 + h * 64 + ch0); \
        g_wd = *(const uint4*)(zr_ + 1536 + dir * 64 + ch0); g_ad = *(const uint4*)(zr_ + 1664 + dir * 64 + ch0); \
        if (pq == 1) g_v = make_uint4(0u, 0u, 0u, 0u); }
    WKV3_LOAD(c0)
    int cur = 0;
    for (int c = c0; c < c1; ++c) {
        const int tid = TIDX, lane = tid & 63, wv = tid >> 6;
        const int pt = tid >> 3, part = tid & 7, ch0 = part * 8, psc = pt >> 4, ptl = pt & 15;
        const int jsc = wv >> 2, jq = wv & 3, vT = wv >> 1, kT0 = (wv & 1) * 2;
        {
            float fk[8], fw[8];
            unpack8(g_k, fk); unpack8(g_wd, fw);
            const float4 kk0 = *(const float4*)(k_k + h * 64 + ch0), kk1 = *(const float4*)(k_k + h * 64 + ch0 + 4);
            const float kkc[8] = {kk0.x, kk0.y, kk0.z, kk0.w, kk1.x, kk1.y, kk1.z, kk1.w};
            float ss = 0.f;
#pragma unroll
            for (int i = 0; i < 8; ++i) { const float q = fk[i] * kkc[i]; ss += q * q; }
            ss = red8(ss);
            if (part == 0) rsv[pt] = rsqrtf(ss + 1e-12f);
            *(uint4*)(X1 + pt * 72 + ch0) = make_uint4(pk_bf16(ftanh(fw[0]), ftanh(fw[1])), pk_bf16(ftanh(fw[2]), ftanh(fw[3])), pk_bf16(ftanh(fw[4]), ftanh(fw[5])), pk_bf16(ftanh(fw[6]), ftanh(fw[7])));
            *(uint4*)(X2 + pt * 72 + ch0) = g_ad;
            *(uint4*)(OPS + psc * OPS_SC + 6 * 1152 + ptl * 72 + ch0) = g_v;
        }
        __syncthreads();
        {
#pragma unroll
            for (int lm = 0; lm < 2; ++lm)
#pragma unroll
                for (int ri = 0; ri < 2; ++ri) {
                    const int rt = jsc + 2 * ri;
                    const f32x4 acc = mm_tile<2, false>((lm ? X2 : X1) + rt * 16 * 72, 72, (lm ? A2s : W2s) + jq * 16 * 72, 72, (f32x4){0.f, 0.f, 0.f, 0.f}, lane);
                    float sg[4];
#pragma unroll
                    for (int r = 0; r < 4; ++r) sg[r] = fsigmoid(lc0[lm] + acc[r]);
                    asm volatile("" ::: "memory");
#pragma unroll
                    for (int r = 0; r < 4; ++r) {
                        const int o = (rt * 16 + (lane >> 4) * 4 + r) * LG + jq * 16 + (lane & 15);
                        if (lm == 0) GG[o] = -0.606531f * sg[r]; else AA[o] = sg[r];
                    }
                }
        }
        __syncthreads();
        if (tid < 256) {
            const int sc = tid >> 6, ch = tid & 63;
            float lw[16];
#pragma unroll
            for (int t = 0; t < 16; ++t) lw[t] = GG[(sc * 16 + t) * LG + ch];
#pragma unroll
            for (int t = 1; t < 16; ++t) lw[t] += lw[t - 1];
#pragma unroll
            for (int t = 0; t < 16; ++t) GG[(sc * 16 + t) * LG + ch] = lw[t];
        }
        __syncthreads();
        {
            const float rs = rsv[pt];
            bf16_t* ops = OPS + psc * OPS_SC;
            float fr[8], fk[8];
            unpack8(g_r, fr); unpack8(g_k, fk);
#pragma unroll
            for (int hf = 0; hf < 2; ++hf) {
                float va[4], vb[4], vk[4], vr[4], vbh[4], vkh[4];
                const float4 kk4 = *(const float4*)(k_k + h * 64 + ch0 + hf * 4), ka4 = *(const float4*)(k_a + h * 64 + ch0 + hf * 4);
                const float kkc[4] = {kk4.x, kk4.y, kk4.z, kk4.w}, kac[4] = {ka4.x, ka4.y, ka4.z, ka4.w};
#pragma unroll
                for (int i = 0; i < 4; ++i) {
                    const int ii = hf * 4 + i, ch = ch0 + ii;
                    const float G = GG[pt * LG + ch], Gp = ptl ? GG[(pt - 1) * LG + ch] : 0.f, GC = GG[(psc * 16 + 15) * LG + ch];
                    const float a = AA[pt * LG + ch], kk = fk[ii] * kkc[i] * rs, ki = fk[ii] * (1.f + (a - 1.f) * kac[i]);
                    const float enG = __expf(-G), gc = __expf(GC);
                    va[i] = -kk * __expf(Gp); vb[i] = kk * a * enG; vk[i] = ki * enG; vr[i] = fr[ii] * __expf(G);
                    vbh[i] = vb[i] * gc; vkh[i] = vk[i] * gc;
                    if (ptl == 15) gC[psc * 64 + ch] = gc;
                }
                bf16_t* o4 = ops + ptl * 72 + ch0 + hf * 4;
                *(uint2*)(o4 + 0 * 1152) = pk4(va[0], va[1], va[2], va[3]);
                *(uint2*)(o4 + 1 * 1152) = pk4(vb[0], vb[1], vb[2], vb[3]);
                *(uint2*)(o4 + 2 * 1152) = pk4(vk[0], vk[1], vk[2], vk[3]);
                *(uint2*)(o4 + 3 * 1152) = pk4(vr[0], vr[1], vr[2], vr[3]);
                *(uint2*)(o4 + 4 * 1152) = pk4(vbh[0], vbh[1], vbh[2], vbh[3]);
                *(uint2*)(o4 + 5 * 1152) = pk4(vkh[0], vkh[1], vkh[2], vkh[3]);
            }
            if (c + 1 < c1) WKV3_LOAD(c + 1)
        }
        __syncthreads();
#pragma unroll
        for (int si = 0; si < 2; ++si) {
            const int sc = jsc + 2 * si, prod = jq;
            const bf16_t* ops = OPS + sc * OPS_SC;
            bf16_t* tmp = TMP + sc * TMP_SC;
            const f32x4 acc = mm_tile<2, false>(ops + (prod < 2 ? 0 : 3) * 1152, 72, ops + ((prod & 1) ? 2 : 1) * 1152, 72, (f32x4){0.f, 0.f, 0.f, 0.f}, lane);
            const int j = lane & 15;
#pragma unroll
            for (int r = 0; r < 4; ++r) {
                const int t = (lane >> 4) * 4 + r;
                const float v = (prod < 2 ? (j < t) : (j <= t)) ? acc[r] : 0.f;
                if (prod == 0) ((float*)tmp)[t * 16 + j] = v;
                else tmp[512 + (prod - 1) * 384 + t * 24 + j] = to_bf(v);
            }
        }
        __syncthreads();
        {
#pragma unroll
            for (int si = 0; si < 2; ++si) {
                const int sc = jsc + 2 * si, vt = jq;
                const bf16_t* ops = OPS + sc * OPS_SC;
                bf16_t* tmp = TMP + sc * TMP_SC;
                const f32x4 acc = mma<false>(ld_row16(tmp + 512 + 0 * 384, lane), ld_tr<true>(ops + 6 * 1152 + vt * 16, 72, lane), (f32x4){0.f, 0.f, 0.f, 0.f});
#pragma unroll
                for (int r = 0; r < 4; ++r) tmp[512 + 4 * 384 + ((lane >> 4) * 4 + r) * 72 + vt * 16 + (lane & 15)] = to_bf(acc[r]);
            }
            if (tid < 64) {
                const int isc = tid >> 4, j = tid & 15;
                const float* N = (const float*)(TMP + isc * TMP_SC);
                bf16_t* Mb = TMP + isc * TMP_SC + 512 + 3 * 384;
                float m[16];
#pragma unroll
                for (int t = 0; t < 16; ++t) {
                    float p0 = (t == j) ? 1.f : 0.f, p1 = 0.f, p2 = 0.f, p3 = 0.f;
#pragma unroll
                    for (int s = 0; s < t; ++s) {
                        const float nv = N[t * 16 + s];
                        if ((s & 3) == 0) p0 += nv * m[s]; else if ((s & 3) == 1) p1 += nv * m[s]; else if ((s & 3) == 2) p2 += nv * m[s]; else p3 += nv * m[s];
                    }
                    m[t] = (t >= j) ? (p0 + p1) + (p2 + p3) : 0.f;
                    Mb[t * 24 + j] = to_bf(m[t]);
                }
            }
        }
        __syncthreads();
#pragma unroll
        for (int si = 0; si < 2; ++si) {
            const int sc = jsc + 2 * si, tl = jq;
            const bf16_t* ops = OPS + sc * OPS_SC;
            bf16_t* tmp = TMP + sc * TMP_SC;
            const bf16x8 mrow = ld_row16(tmp + 512 + 3 * 384, lane);
            bf16x8 tA, tT1;
            ld_tr2<true>(ops + 0 * 1152 + tl * 16, tmp + 512 + 4 * 384 + tl * 16, 72, lane, tA, tT1);
            const f32x4 accW = mma<false>(mrow, tA, (f32x4){0.f, 0.f, 0.f, 0.f});
            bf16_t* Wt = tmp + 512 + 4 * 384 + 1152;
#pragma unroll
            for (int r = 0; r < 4; ++r) Wt[((lane >> 4) * 4 + r) * 72 + tl * 16 + (lane & 15)] = to_bf(accW[r]);
            accU[si] = mma<false>(mrow, tT1, (f32x4){0.f, 0.f, 0.f, 0.f});
        }
        __syncthreads();
#pragma unroll
        for (int sc = 0; sc < 4; ++sc) {
            bf16_t* Sbc = cur ? Sb1 : Sb0; bf16_t* Sbn = cur ? Sb0 : Sb1;
            const bf16_t* ops = OPS + sc * OPS_SC;
            const bf16_t* tmp = TMP + sc * TMP_SC;
            if (jsc == (sc & 1)) {
                const int vt = jq;
                const f32x4 u = mm_tile<2, false>(tmp + 512 + 4 * 384 + 1152, 72, Sbc + vt * 16 * 72, 72, accU[sc >> 1], lane);
#pragma unroll
                for (int r = 0; r < 4; ++r) Us[((lane >> 4) * 4 + r) * 72 + vt * 16 + (lane & 15)] = to_bf(u[r]);
            }
            __syncthreads();
            if (wv < 4 && pq == 0) {
                const int vt = wv;
                f32x4 yv = mm_tile<2, true>(ops + 3 * 1152, 72, Sbc + vt * 16 * 72, 72, (f32x4){0.f, 0.f, 0.f, 0.f}, lane);
                bf16x8 tU, tV;
                ld_tr2<true>(Us + vt * 16, ops + 6 * 1152 + vt * 16, 72, lane, tU, tV);
                yv = mma<true>(ld_row16(tmp + 512 + 1 * 384, lane), tU, yv);
                yv = mma<true>(ld_row16(tmp + 512 + 2 * 384, lane), tV, yv);
                const int s = c * 64 + sc * 16 + (lane & 15), pos = dir ? (L - 1 - s) : s;
                *(uint2*)(y + ((size_t)dir * lay.Tloc + row0 + pos) * 512 + h * 64 + vt * 16 + (lane >> 4) * 4) = pk4(yv[0], yv[1], yv[2], yv[3]);
            }
            {
                bf16x8 aU, aV, b0, b1, k0_, k1_;
                ld_tr2<true>(Us + vT * 16, ops + 6 * 1152 + vT * 16, 72, lane, aU, aV);
                ld_tr4<true>(ops + 4 * 1152 + kT0 * 16, ops + 4 * 1152 + (kT0 + 1) * 16, ops + 5 * 1152 + kT0 * 16, ops + 5 * 1152 + (kT0 + 1) * 16, 72, lane, b0, b1, k0_, k1_);
#pragma unroll
                for (int q = 0; q < 2; ++q) {
                    const int kt = kT0 + q;
                    S[q] = S[q] * gC[sc * 64 + kt * 16 + (lane & 15)];
                    S[q] = mma<false>(aU, q ? b1 : b0, S[q]);
                    S[q] = mma<false>(aV, q ? k1_ : k0_, S[q]);
#pragma unroll
                    for (int r = 0; r < 4; ++r) Sbn[(vT * 16 + (lane >> 4) * 4 + r) * 72 + kt * 16 + (lane & 15)] = to_bf(S[q][r]);
                }
            }
            __syncthreads();
            cur ^= 1;
        }
    }
    float* So = dir ? Sb_out : Sf_out;
    if (!latent) {
#pragma unroll
        for (int q = 0; q < 2; ++q)
#pragma unroll
            for (int r = 0; r < 4; ++r) So[((size_t)(seq * 8 + h) * 64 + vT * 16 + (lane >> 4) * 4 + r) * 64 + (kT0 + q) * 16 + (lane & 15)] = S[q][r];
    }
    if (Send) {
#pragma unroll
        for (int q = 0; q < 2; ++q)
#pragma unroll
            for (int r = 0; r < 4; ++r) Send[(vT * 16 + (lane >> 4) * 4 + r) * 64 + (kT0 + q) * 16 + (lane & 15)] = S[q][r];
    }
#undef WKV3_LOAD
}

template <int NT>
__device__ __forceinline__ void wkv_seg_init(const float* __restrict__ E0, const float* __restrict__ PQ, int nst, float* __restrict__ out, char* lds) {
    static_assert(NT == 512, "wkv_seg_init needs 512 threads");
    const int tid = TIDX, v = tid >> 3, kg = (tid & 7) * 8;
    float* Sl = (float*)lds;
    __syncthreads();
    {
        const float4 a = *(const float4*)(E0 + v * 64 + kg), b = *(const float4*)(E0 + v * 64 + kg + 4);
        float* d = Sl + v * 65 + kg;
        d[0] = a.x; d[1] = a.y; d[2] = a.z; d[3] = a.w; d[4] = b.x; d[5] = b.y; d[6] = b.z; d[7] = b.w;
    }
    __syncthreads();
    float* Pl = Sl + 64 * 65;
    for (int st = 0; st < nst; ++st) {
        const float* Pm = PQ + (size_t)st * 8192; const float* Qm = Pm + 4096;
        {
            const float4 p0 = *(const float4*)(Pm + tid * 8), p1 = *(const float4*)(Pm + tid * 8 + 4);
            *(float4*)(Pl + v * 68 + kg) = p0; *(float4*)(Pl + v * 68 + kg + 4) = p1;
        }
        float4 a0 = *(const float4*)(Qm + v * 64 + kg), a1 = *(const float4*)(Qm + v * 64 + kg + 4);
        __syncthreads();
#pragma unroll 8
        for (int j = 0; j < 64; ++j) {
            const float s = Sl[v * 65 + j];
            const float4 p0 = *(const float4*)(Pl + j * 68 + kg), p1 = *(const float4*)(Pl + j * 68 + kg + 4);
            a0.x += s * p0.x; a0.y += s * p0.y; a0.z += s * p0.z; a0.w += s * p0.w;
            a1.x += s * p1.x; a1.y += s * p1.y; a1.z += s * p1.z; a1.w += s * p1.w;
        }
        __syncthreads();
        float* d = Sl + v * 65 + kg;
        d[0] = a0.x; d[1] = a0.y; d[2] = a0.z; d[3] = a0.w; d[4] = a1.x; d[5] = a1.y; d[6] = a1.z; d[7] = a1.w;
        if (st + 1 == nst) { *(float4*)(out + v * 64 + kg) = a0; *(float4*)(out + v * 64 + kg + 4) = a1; }
        __syncthreads();
    }
}

template <int NT, int NI = 4>
__device__ __forceinline__ void n_combine1(const Lay lay, const bf16_t* __restrict__ zcm, const bf16_t* __restrict__ g2t, const bf16_t* __restrict__ y, const bf16_t* __restrict__ yd,
                                           const bf16_t* __restrict__ zg, const float* __restrict__ r_k, const float* __restrict__ ln_w, const float* __restrict__ ln_b,
                                           const float* __restrict__ gnorm, bf16_t* __restrict__ merged, int item, char* lds) {
    static_assert(NT == 512, "n_combine1 needs 8 waves");
    const int tid = TIDX, lane = tid & 63, wv = tid >> 6, cq = (lane >> 4) * 4;
    bf16_t* As = (bf16_t*)lds;
    float* red = (float*)(lds + 64 * 136 * 2);
    const int m0 = item * (16 * NI);
    __syncthreads();
    if ((tid >> 3) < 16 * NI) {
        const int t = tid >> 3, part = tid & 7;
        const bf16_t* src = zcm + (size_t)(m0 + t) * CC + 1792 + part * 16;
        float f0[8], f1[8];
        unpack8(*(const uint4*)src, f0); unpack8(*(const uint4*)(src + 8), f1);
        *(uint4*)(As + t * 136 + part * 16) = make_uint4(pk_bf16(fsigmoid(f0[0]), fsigmoid(f0[1])), pk_bf16(fsigmoid(f0[2]), fsigmoid(f0[3])),
                                                         pk_bf16(fsigmoid(f0[4]), fsigmoid(f0[5])), pk_bf16(fsigmoid(f0[6]), fsigmoid(f0[7])));
        *(uint4*)(As + t * 136 + part * 16 + 8) = make_uint4(pk_bf16(fsigmoid(f1[0]), fsigmoid(f1[1])), pk_bf16(fsigmoid(f1[2]), fsigmoid(f1[3])),
                                                             pk_bf16(fsigmoid(f1[4]), fsigmoid(f1[5])), pk_bf16(fsigmoid(f1[6]), fsigmoid(f1[7])));
    }
    __syncthreads();
    f32x4 acc[NI][4];
#pragma unroll
    for (int i = 0; i < NI; ++i)
#pragma unroll
        for (int j = 0; j < 4; ++j) acc[i][j] = (f32x4){0.f, 0.f, 0.f, 0.f};
    const int brow = wv * 64 + ((lane & 15) >> 2) * 16 + (lane & 3);
#pragma unroll
    for (int ks = 0; ks < 4; ++ks) {
        bf16x8 a[NI], b[4];
#pragma unroll
        for (int i = 0; i < NI; ++i) a[i] = *(const bf16x8*)(As + (i * 16 + (lane & 15)) * 136 + ks * 32 + (lane >> 4) * 8);
#pragma unroll
        for (int j = 0; j < 4; ++j) b[j] = *(const bf16x8*)(g2t + (size_t)(brow + j * 4) * 128 + ks * 32 + (lane >> 4) * 8);
#pragma unroll
        for (int i = 0; i < NI; ++i)
#pragma unroll
            for (int j = 0; j < 4; ++j) acc[i][j] = __builtin_amdgcn_mfma_f32_16x16x32_bf16(b[j], a[i], acc[i][j], 0, 0, 0);
    }
    const int e0 = wv * 64 + cq * 4;
#pragma unroll
    for (int i = 0; i < NI; ++i) {
        const size_t lrow = (size_t)m0 + i * 16 + (lane & 15);
        float yy[16], vv[16], rk = 0.f, sm = 0.f, zsq = 0.f;
#pragma unroll
        for (int hf = 0; hf < 2; ++hf) {
            const int e = e0 + hf * 8;
            const uint4 ya = *(const uint4*)(y + lrow * 512 + e), yb = *(const uint4*)(y + ((size_t)lay.Tloc + lrow) * 512 + e);
            const uint4 ur = *(const uint4*)(zcm + lrow * CC + e), uk = *(const uint4*)(zcm + lrow * CC + 512 + e), uv = *(const uint4*)(zcm + lrow * CC + 1024 + e);
            const uint4 da = *(const uint4*)(yd + lrow * 512 + e), db = *(const uint4*)(yd + ((size_t)lay.Tloc + lrow) * 512 + e), uz = *(const uint4*)(zg + lrow * 512 + e);
            const float4 rka = *(const float4*)(r_k + e), rkb = *(const float4*)(r_k + e + 4);
            const float rkk[8] = {rka.x, rka.y, rka.z, rka.w, rkb.x, rkb.y, rkb.z, rkb.w};
            float fa[8], fb[8], fr[8], fk[8], fv[8], fd[8], fe[8], fz[8];
            unpack8(ya, fa); unpack8(yb, fb); unpack8(ur, fr); unpack8(uk, fk); unpack8(uv, fv); unpack8(da, fd); unpack8(db, fe); unpack8(uz, fz);
#pragma unroll
            for (int c = 0; c < 8; ++c) {
                yy[hf * 8 + c] = fa[c] + fb[c]; vv[hf * 8 + c] = fv[c];
                rk += fr[c] * fk[c] * rkk[c];
                sm += yy[hf * 8 + c];
                const float q = (fd[c] + fe[c]) * fz[c] * fsigmoid(fz[c]);
                zsq += q * q;
            }
        }
        sm += __shfl_xor(sm, 16); sm += __shfl_xor(sm, 32);
        rk += __shfl_xor(rk, 16); rk += __shfl_xor(rk, 32);
        const float mean = sm * (1.f / 64.f);
        float var = 0.f, zs = zsq;
#pragma unroll
        for (int c = 0; c < 16; ++c) { const float d = yy[c] - mean; var += d * d; }
        var += __shfl_xor(var, 16); var += __shfl_xor(var, 32);
        zs += __shfl_xor(zs, 16); zs += __shfl_xor(zs, 32);
        const float rstd = rsqrtf(var * (1.f / 64.f) + 64e-5f);
        if (lane < 16) red[wv * 64 + i * 16 + lane] = zs;
#pragma unroll
        for (int hf = 0; hf < 2; ++hf) {
            float o[8];
#pragma unroll
            for (int jj = 0; jj < 2; ++jj) {
                const int j = hf * 2 + jj;
                const float4 lw4 = *(const float4*)(ln_w + e0 + j * 4), lb4 = *(const float4*)(ln_b + e0 + j * 4);
                o[jj * 4 + 0] = ((yy[j * 4 + 0] - mean) * rstd * lw4.x + lb4.x + rk * vv[j * 4 + 0]) * acc[i][j][0];
                o[jj * 4 + 1] = ((yy[j * 4 + 1] - mean) * rstd * lw4.y + lb4.y + rk * vv[j * 4 + 1]) * acc[i][j][1];
                o[jj * 4 + 2] = ((yy[j * 4 + 2] - mean) * rstd * lw4.z + lb4.z + rk * vv[j * 4 + 2]) * acc[i][j][2];
                o[jj * 4 + 3] = ((yy[j * 4 + 3] - mean) * rstd * lw4.w + lb4.w + rk * vv[j * 4 + 3]) * acc[i][j][3];
            }
            *(uint4*)(merged + lrow * DM + e0 + hf * 8) = make_uint4(pk_bf16(o[0], o[1]), pk_bf16(o[2], o[3]), pk_bf16(o[4], o[5]), pk_bf16(o[6], o[7]));
        }
    }
    __syncthreads();
#pragma unroll
    for (int i = 0; i < NI; ++i) {
        const int tk = i * 16 + (lane & 15);
        float ss = 0.f;
#pragma unroll
        for (int w = 0; w < 8; ++w) ss += red[w * 64 + tk];
        const float rs = rsqrtf(ss * (1.f / 512.f) + EPS);
        const size_t lrow = (size_t)m0 + tk;
#pragma unroll
        for (int hf = 0; hf < 2; ++hf) {
            const int e = e0 + hf * 8;
            const float4 gna = *(const float4*)(gnorm + e), gnb = *(const float4*)(gnorm + e + 4);
            const float gn[8] = {gna.x, gna.y, gna.z, gna.w, gnb.x, gnb.y, gnb.z, gnb.w};
            const uint4 da = *(const uint4*)(yd + lrow * 512 + e), db = *(const uint4*)(yd + ((size_t)lay.Tloc + lrow) * 512 + e), uz = *(const uint4*)(zg + lrow * 512 + e);
            float fd[8], fe[8], fz[8], o[8];
            unpack8(da, fd); unpack8(db, fe); unpack8(uz, fz);
#pragma unroll
            for (int c = 0; c < 8; ++c) o[c] = (fd[c] + fe[c]) * fz[c] * fsigmoid(fz[c]) * rs * gn[c];
            *(uint4*)(merged + lrow * DM + 512 + e) = make_uint4(pk_bf16(o[0], o[1]), pk_bf16(o[2], o[3]), pk_bf16(o[4], o[5]), pk_bf16(o[6], o[7]));
        }
    }
    __syncthreads();
}

template <int NT>
__device__ __forceinline__ void n_final(const Lay lay, const float* __restrict__ h, const float* __restrict__ g, float* __restrict__ out, int vb, float* lds) {
    const int lrow = vb * (NT / 256) + (TIDX >> 8), tid = TIDX & 255;
    const float4 x = *(const float4*)(h + (size_t)lrow * DM + tid * 4);
    const float ss = group_sum256<NT>(x.x * x.x + x.y * x.y + x.z * x.z + x.w * x.w, lds);
    const float rstd = rsqrtf(ss * (1.f / DM) + EPS);
    const float4 gg = *(const float4*)(g + tid * 4);
    *(float4*)(out + (size_t)(lay.tbase + lrow) * DM + tid * 4) = make_float4(x.x * rstd * gg.x, x.y * rstd * gg.y, x.z * rstd * gg.z, x.w * rstd * gg.w);
}

template <int NT>
__device__ __forceinline__ void n_final_w2(const Lay lay, const bf16_t* __restrict__ h, const float* __restrict__ g, float* __restrict__ out, int vb) {
    const int lane = TIDX & 63, lrow0 = vb * (NT / 64) * 2 + (TIDX >> 6) * 2;
    float4 x[2][4];
#pragma unroll
    for (int k = 0; k < 2; ++k)
#pragma unroll
        for (int q = 0; q < 4; ++q) { const uint2 u = *(const uint2*)(h + (size_t)(lrow0 + k) * DM + q * 256 + lane * 4); x[k][q] = make_float4(bf_lo(u.x), bf_hi(u.x), bf_lo(u.y), bf_hi(u.y)); }
#pragma unroll
    for (int k = 0; k < 2; ++k) {
        float ss = 0.f;
#pragma unroll
        for (int q = 0; q < 4; ++q) ss += (x[k][q].x * x[k][q].x + x[k][q].y * x[k][q].y) + (x[k][q].z * x[k][q].z + x[k][q].w * x[k][q].w);
        ss = wave_sum(ss);
        const float rstd = rsqrtf(ss * (1.f / DM) + EPS);
#pragma unroll
        for (int q = 0; q < 4; ++q) {
            const int c = q * 256 + lane * 4;
            const float4 gg = *(const float4*)(g + c);
            *(float4*)(out + (size_t)(lay.tbase + lrow0 + k) * DM + c) = make_float4(x[k][q].x * rstd * gg.x, x[k][q].y * rstd * gg.y, x[k][q].z * rstd * gg.z, x[k][q].w * rstd * gg.w);
        }
    }
}

template <int NT>
__device__ __forceinline__ void n_cache_k4(const Lay lay, const float* __restrict__ ck, bf16_t* __restrict__ Ka, int vb) {
    const int e4 = vb * NT + TIDX;
    const int bb = e4 >> 16, rem = e4 & 65535, p = rem >> 7, c = (rem & 127) * 4, h = c >> 7, j = c & 127;
    if (bb >= lay.nb) return;
    const int b = lay.b0 + bb;
    const float4 v = *(const float4*)(ck + (((size_t)b * 4 + h) * 512 + p) * 128 + j);
    *(uint2*)(Ka + ((size_t)lay.Tloc + bb * 512 + p) * 512 + c) = pk4(v.x, v.y, v.z, v.w);
}
template <int NT>
__device__ __forceinline__ void n_cache_kv(const Lay lay, const float* __restrict__ ck, const float* __restrict__ cv, bf16_t* __restrict__ Ka, bf16_t* __restrict__ VtA, int vb) {
    const int idx = vb * NT + TIDX;
    const int per = 4 * 512 * 128;
    const int bb = idx / (2 * per), r = idx % (2 * per);
    if (bb >= lay.nb) return;
    const int b = lay.b0 + bb;
    if (r < per) {
        const int p = r / 512, c = r % 512, h = c >> 7, j = c & 127;
        Ka[((size_t)lay.Tloc + bb * 512 + p) * 512 + c] = to_bf(ck[(((size_t)b * 4 + h) * 512 + p) * 128 + j]);
    } else {
        const int q = r - per, key = q % 512, dv = (q / 512) % 128, h = q / (512 * 128);
        VtA[vt_off(lay, 16 + b, h) + (size_t)dv * VLD + key] = to_bf(cv[(((size_t)b * 4 + h) * 512 + key) * 128 + dv]);
    }
}

struct Args { const void* p[24]; int i[16]; };
enum { PH_CACHE = 11, PH_GEMM_IN1, PH_SCAN, PH_COMBINE1, PH_FINAL, PH_WCONV = 0, PH_ROPE, PH_RESNORM, PH_GEMM_IN0, PH_TAIL, PH_GEMM_UQ, PH_GEMM_UKV, PH_FLASH, PH_COMBINE0, PH_GEMM_RES, PH_FFN_UP };
template <int NT, int BNB, int PH>
__device__ __forceinline__ void phase_body(const Args& a, int vb, float* lds) {
    const Lay lay{a.i[0], a.i[1], a.i[2], a.i[3], a.i[4]};
    if constexpr (PH == PH_GEMM_IN1) {
        const HaloTile ht = halo_tile(a.i[5] + vb / 26);
        gemm_tile<256, BNB, NT>(ALoadHalo{(const bf16_t*)a.p[0], DM, ht.t0 - lay.tbase, ht.row0, ht.L}, (const bf16_t*)a.p[1], DM, 0, (vb % 26) * BNB,
                                EpiIn1{lay, ht, (const float*)a.p[2], (const float*)a.p[3], (const float*)a.p[4], (bf16_t*)a.p[5], (bf16_t*)a.p[6], (bf16_t*)a.p[7], (float*)a.p[8]}, (char*)lds);
    } else if constexpr (PH == PH_COMBINE1) {
        n_combine1<NT>(lay, (const bf16_t*)a.p[0], (const bf16_t*)a.p[1], (const bf16_t*)a.p[2], (const bf16_t*)a.p[3], (const bf16_t*)a.p[4], (const float*)a.p[5], (const float*)a.p[6],
                       (const float*)a.p[7], (const float*)a.p[8], (bf16_t*)a.p[9], vb, (char*)lds);
    } else if constexpr (PH == PH_FINAL) {
        n_final<NT>(lay, (const float*)a.p[0], (const float*)a.p[1], (float*)a.p[2], vb, lds);
    } else if constexpr (PH == PH_CACHE) {
        n_cache_kv<NT>(lay, (const float*)a.p[0], (const float*)a.p[1], (bf16_t*)a.p[2], (bf16_t*)a.p[3], vb);
    } else if constexpr (PH == PH_WCONV) {
        n_wconv<NT>((const float*)a.p[0], a.i[5], a.i[6], (bf16_t*)a.p[1], a.i[7], a.i[8], a.i[9], vb, lds);
    } else if constexpr (PH == PH_ROPE) {
        n_rope_tables((float*)a.p[0], (float*)a.p[1], (float*)a.p[2], (float*)a.p[3]);
    } else if constexpr (PH == PH_RESNORM) {
        n_resnorm<NT>(lay, (const float*)a.p[0], (const float*)a.p[1], (const float*)a.p[2], (const float*)a.p[3], (const float*)a.p[4], a.i[5], a.i[6], (bf16_t*)a.p[5], vb, lds);
    } else if constexpr (PH == PH_GEMM_IN0) {
        gemm_tile<256, BNB, NT>(ALoadBF{(const bf16_t*)a.p[0], DM}, (const bf16_t*)a.p[1], DM, (vb / (1920 / BNB)) * 256, (vb % (1920 / BNB)) * BNB,
                                EpiIn0{lay, (bf16_t*)a.p[2], (bf16_t*)a.p[3], (bf16_t*)a.p[4], (bf16_t*)a.p[5], (float*)a.p[6], (float*)a.p[7], (const float*)a.p[8], (const float*)a.p[9]}, (char*)lds);
    } else if constexpr (PH == PH_TAIL) {
        n_l0_tail<NT>(lay, (const bf16_t*)a.p[0], (const float*)a.p[1], (const float*)a.p[2], (const float*)a.p[3], (const float*)a.p[4], (const float*)a.p[5], (const float*)a.p[6],
                      (bf16_t*)a.p[7], (bf16_t*)a.p[8], (bf16_t*)a.p[9], (float*)a.p[10], (float*)a.p[11], vb, lds);
    } else if constexpr (PH == PH_GEMM_UQ) {
        gemm_tile<256, BNB, NT>(ALoadBF{(const bf16_t*)a.p[0], 192}, (const bf16_t*)a.p[1], 192, (vb / (384 / BNB)) * 256, (vb % (384 / BNB)) * BNB,
                                EpiQb{lay, (bf16_t*)a.p[2], (const float*)a.p[3], (const float*)a.p[4]}, (char*)lds);
    } else if constexpr (PH == PH_GEMM_UKV) {
        gemm_tile<256, BNB, NT>(ALoadBF{(const bf16_t*)a.p[0], 128}, (const bf16_t*)a.p[1], 128, (vb / (768 / BNB)) * 256, (vb % (768 / BNB)) * BNB,
                                EpiKV{lay, (bf16_t*)a.p[2], (bf16_t*)a.p[3]}, (char*)lds);
    } else if constexpr (PH == PH_FLASH) {
        const bf16_t *Qa = (const bf16_t*)a.p[0], *Ka = (const bf16_t*)a.p[1], *VtA = (const bf16_t*)a.p[2], *Qb = (const bf16_t*)a.p[3], *Kb = (const bf16_t*)a.p[4], *VtB = (const bf16_t*)a.p[5];
        bf16_t *oa1h = (bf16_t*)a.p[6], *oa2h = (bf16_t*)a.p[7], *mrg16 = (bf16_t*)a.p[8];
        const int nqb = lay.Tloc / 128;
        const int mp = vb / (4 * nqb), hd = (vb / nqb) & 3, q0 = (vb % nqb) * 128;
        const TokInfo ti = tokinfo(lay.tbase + q0);
        const int tok0 = ti.t0 - lay.tbase, crow = lay.Tloc + (ti.latent ? (ti.seq - 16 - lay.b0) * 512 : 0);
        FlashP p;
        p.n0 = ti.latent ? 512 : 0; p.Lk = ti.L + p.n0; p.O = nullptr;
        if (mp < 2) {
            p.Q = Qa + hd * 128 + mp * 64; p.q_ld = 512;
            p.K0 = Ka + (size_t)crow * 512 + hd * 128 + mp * 64;
            p.K1 = Ka + (size_t)tok0 * 512 + hd * 128 + mp * 64; p.k_ld = 512;
            p.Vt = VtA + vt_off(lay, ti.seq, hd); p.vt_ld = ti.latent ? VLD : 256;
            p.Ob = (mp ? oa2h : oa1h) + hd * 128; p.o_ld = 512;
            p.c = 0.125f * 1.4426950408889634f;
            flash_item<64, NT, true>(p, q0, (char*)lds);
        } else {
            p.Q = Qb + hd * 96; p.q_ld = 384;
            p.K0 = Kb + (size_t)crow * 384 + hd * 96;
            p.K1 = Kb + (size_t)tok0 * 384 + hd * 96; p.k_ld = 384;
            p.Vt = VtB + vt_off(lay, ti.seq, hd); p.vt_ld = ti.latent ? VLD : 256;
            p.Ob = mrg16 + 512 + hd * 128; p.o_ld = DM;
            p.c = 0.10206207261596577f * 1.4426950408889634f;
            flash_item<96, NT, true>(p, q0, (char*)lds);
        }
    } else if constexpr (PH == PH_COMBINE0) {
        n_combine0<NT>((const bf16_t*)a.p[0], (const bf16_t*)a.p[1], (const float*)a.p[2], (const float*)a.p[3], (const float*)a.p[4], (const float*)a.p[5], (const float*)a.p[6], (bf16_t*)a.p[7], vb);
    } else if constexpr (PH == PH_GEMM_RES) {
        const EpiResid ep{lay, (const float*)a.p[2], (const float*)a.p[3], (const bf16_t*)a.p[4], (bf16_t*)a.p[5], (const float*)a.p[6], a.i[6]};
        const int m0 = (vb / (1024 / BNB)) * 256, n0 = (vb % (1024 / BNB)) * BNB;
        if (a.i[5] == DM) gemm_tile<256, BNB, NT>(ALoadBF{(const bf16_t*)a.p[0], DM}, (const bf16_t*)a.p[1], DM, m0, n0, ep, (char*)lds);
        else              gemm_tile<256, BNB, NT>(ALoadBF{(const bf16_t*)a.p[0], FF}, (const bf16_t*)a.p[1], FF, m0, n0, ep, (char*)lds);
    } else if constexpr (PH == PH_FFN_UP) {
        const HaloTile ht = halo_tile(a.i[5] + vb / (FF2 / BNB));
        gemm_tile<256, BNB, NT>(ALoadHalo{(const bf16_t*)a.p[0], DM, ht.t0 - lay.tbase, ht.row0, ht.L}, (const bf16_t*)a.p[1], DM, 0, (vb % (FF2 / BNB)) * BNB,
                                EpiFFNUp{lay, ht, (const float*)a.p[2], (const float*)a.p[3], (bf16_t*)a.p[4]}, (char*)lds);
    }
}

constexpr size_t al(size_t x) { return (x + 255) & ~(size_t)255; }
struct WS {
    static constexpr size_t BAR = 0;
    static constexpr size_t ZERO = al(BAR + 16384);
    static constexpr size_t MOD = al(ZERO + 4096);
    static constexpr size_t ROPE = al(MOD + 2 * 3 * 6144 * 4);
    static constexpr size_t H = al(ROPE + 3072 * 4);
    static constexpr size_t WT_IN0 = al(H + (size_t)TT * DM * 4);
    static constexpr size_t WT_OUT0 = al(WT_IN0 + (size_t)1920 * 1024 * 2);
    static constexpr size_t WT_OUT1 = al(WT_OUT0 + (size_t)1024 * 1024 * 2);
    static constexpr size_t WT_UP0 = al(WT_OUT1 + (size_t)1024 * 1024 * 2);
    static constexpr size_t WT_UP1 = al(WT_UP0 + (size_t)FF2 * 1024 * 2);
    static constexpr size_t WT_DN0 = al(WT_UP1 + (size_t)FF2 * 1024 * 2);
    static constexpr size_t WT_DN1 = al(WT_DN0 + (size_t)1024 * FF * 2);
    static constexpr size_t WT_UQ = al(WT_DN1 + (size_t)1024 * FF * 2);
    static constexpr size_t WT_UKV = al(WT_UQ + (size_t)384 * 192 * 2);
    static constexpr size_t WT_IN1 = al(WT_UKV + (size_t)768 * 128 * 2);
    static constexpr size_t W2T = al(WT_IN1 + (size_t)3328 * 1024 * 2);
    static constexpr size_t A2T = al(W2T + (size_t)2 * 512 * 64 * 2);
    static constexpr size_t G2T = al(A2T + (size_t)2 * 512 * 64 * 2);
    static constexpr size_t HN = al(G2T + (size_t)512 * 128 * 2);
    static constexpr size_t BIG = al(HN + (size_t)TT * DM * 2);
    static constexpr size_t TAIL = BIG;
    static constexpr size_t QA = al(TAIL + (size_t)TT * 384 * 2);
    static constexpr size_t KA = al(QA + (size_t)TT * 512 * 2);
    static constexpr size_t VTA = al(KA + (size_t)(TT + 1024) * 512 * 2);
    static constexpr size_t VT_ELEMS = (size_t)16 * 4 * 128 * 256 + (size_t)2 * 4 * 128 * VLD;
    static constexpr size_t QDN = al(VTA + VT_ELEMS * 2);
    static constexpr size_t CKVN = al(QDN + (size_t)TT * 192 * 2);
    static constexpr size_t QB = al(CKVN + (size_t)(TT + 1024) * 128 * 2);
    static constexpr size_t KB = al(QB + (size_t)TT * 384 * 2);
    static constexpr size_t VTB = al(KB + (size_t)(TT + 1024) * 384 * 2);
    static constexpr size_t OA1 = al(VTB + VT_ELEMS * 2);
    static constexpr size_t OA2 = al(OA1 + (size_t)TT * 512 * 2);
    static constexpr size_t END0 = al(OA2 + (size_t)TT * 512 * 2);
    static constexpr size_t ZCM = BIG;
    static constexpr size_t ZG = al(ZCM + (size_t)TT * CC * 2);
    static constexpr size_t XC = al(ZG + (size_t)TT * 512 * 2);
    static constexpr size_t DTR = al(XC + (size_t)TT * 768 * 2);
    static constexpr size_t Y16 = al(DTR + (size_t)TT * 8 * 4);
    static constexpr size_t YD16 = al(Y16 + (size_t)2 * TT * 512 * 2);
    static constexpr size_t SEG_IZ = al(YD16 + (size_t)2 * TT * 512 * 2);
    static constexpr size_t SEG_E0 = al(SEG_IZ + 2 * 16384);
    static constexpr size_t SEG_PQ = al(SEG_E0 + 32 * 16384);
    static constexpr size_t SEG_SI = al(SEG_PQ + 192 * 16384);
    static constexpr size_t SEG_HS = al(SEG_SI + 128 * 16384);
    static constexpr size_t END1 = al(SEG_HS + 32 * 16384);
    static constexpr size_t ACT = BIG;
    static constexpr size_t END2 = al(ACT + (size_t)TT * FF * 2);
    static constexpr size_t TOTAL = END0 > END1 ? (END0 > END2 ? END0 : END2) : (END1 > END2 ? END1 : END2);
};
static_assert(WS::TOTAL <= (size_t)256 * 1024 * 1024, "workspace map exceeds the guaranteed 256 MiB");


__device__ __forceinline__ int xcd_remap(int vb, int n) {
    const int q = n >> 3, r = n & 7, x = vb & 7, o = vb >> 3;
    return (x < r ? x * (q + 1) : r * (q + 1) + (x - r) * q) + o;
}

struct MP { const float* in[59]; float* out; char* ws; };


__device__ __forceinline__ char* launder_c(char* p) { size_t z = 0; asm volatile("" : "+s"(z)); return p + z; }
__device__ __forceinline__ float* launder_f(float* p) { size_t z = 0; asm volatile("" : "+s"(z)); return p + z; }
__device__ __forceinline__ int bid_opaque() { int b = blockIdx.x; asm volatile("" : "+s"(b)); return b; }
typedef const __attribute__((address_space(1))) float* gcfptr;
struct InTab {
    const char* base;
    __device__ __forceinline__ const float* operator[](int k) const { return (const float*)(gcfptr)(((const float* const*)base)[k]); }
};
__device__ __forceinline__ InTab in_tab() { size_t z = 0; asm volatile("" : "+s"(z)); return InTab{(const char*)__builtin_amdgcn_kernarg_segment_ptr() + z}; }
#define PH_BEGIN(NVB) for (int vb = bid_opaque(); vb < (NVB); vb += gridDim.x) { char* ws = launder_c(ws0); float* out = launder_f(out0); const InTab in = in_tab(); (void)ws; (void)out; (void)in;
#define PH_END } xcd_barrier(xb);
#define PH_NEXT(NVB) } for (int vb = bid_opaque(); vb < (NVB); vb += gridDim.x) { char* ws = launder_c(ws0); float* out = launder_f(out0); const InTab in = in_tab(); (void)ws; (void)out; (void)in;

#define mod ((float*)(ws + WS::MOD))
#define h ((bf16_t*)(ws + WS::H))
#define wt_in0 ((bf16_t*)(ws + WS::WT_IN0))
#define wt_uq ((bf16_t*)(ws + WS::WT_UQ))
#define wt_ukv ((bf16_t*)(ws + WS::WT_UKV))
#define wt_in1 ((bf16_t*)(ws + WS::WT_IN1))
#define w2t ((bf16_t*)(ws + WS::W2T))
#define a2t ((bf16_t*)(ws + WS::A2T))
#define g2t ((bf16_t*)(ws + WS::G2T))
#define hn16 ((bf16_t*)(ws + WS::HN))
#define act16 ((bf16_t*)(ws + WS::ACT))
#define tail16 ((bf16_t*)(ws + WS::TAIL))
#define Qa ((bf16_t*)(ws + WS::QA))
#define Ka ((bf16_t*)(ws + WS::KA))
#define VtA ((bf16_t*)(ws + WS::VTA))
#define qdn16 ((bf16_t*)(ws + WS::QDN))
#define ckvn16 ((bf16_t*)(ws + WS::CKVN))
#define Qb ((bf16_t*)(ws + WS::QB))
#define Kb ((bf16_t*)(ws + WS::KB))
#define VtB ((bf16_t*)(ws + WS::VTB))
#define oa1h ((bf16_t*)(ws + WS::OA1))
#define oa2h ((bf16_t*)(ws + WS::OA2))
#define zcm16 ((bf16_t*)(ws + WS::ZCM))
#define zg16 ((bf16_t*)(ws + WS::ZG))
#define xc16 ((bf16_t*)(ws + WS::XC))
#define dtr ((float*)(ws + WS::DTR))
#define y16 ((bf16_t*)(ws + WS::Y16))
#define yd16 ((bf16_t*)(ws + WS::YD16))
#define c64 ((float*)(ws + WS::ROPE))
#define s64 ((float*)(ws + WS::ROPE) + 1024)
#define c32 ((float*)(ws + WS::ROPE) + 2048)
#define s32 ((float*)(ws + WS::ROPE) + 2560)
#define mrg16 ((bf16_t*)(ws + WS::HN))
#define o_k (out + (size_t)TT * DM)
#define o_v (o_k + 16 * 4 * 256 * 128)
#define o_ckv (o_v + 16 * 4 * 256 * 128)
#define o_kpe (o_ckv + 16 * 256 * 128)
#define o_wf (o_kpe + 16 * 256 * 32)
#define o_wb (o_wf + 16 * 8 * 64 * 64)
#define o_sf (o_wb + 16 * 8 * 64 * 64)
#define o_sb (o_sf + 16 * 8 * 64 * 64)
__global__ void __launch_bounds__(512) mega(MP P) {
    constexpr int NT = 512, BNB = 128, TPB = 2;
    __shared__ __attribute__((aligned(16))) float lds[LDS_BYTES / 4];
    volatile LAS unsigned* st = (volatile LAS unsigned*)(lds + LDS_BYTES / 4 - 4);
    if (TIDX == 0) { st[0] = 0u; st[1] = 0u; st[2] = 0u; st[3] = 0u; }
    __syncthreads();
    XcdBarrier xb = xcd_barrier_post((unsigned*)P.ws, st);
    const InTab in = in_tab();
    char* const ws0 = P.ws;
    float* const out0 = P.out;
    char* ws = ws0;
    float* out = out0;
    const Lay lay{0, TT, 0, 0, 2};
    constexpr int NCR = 1024, MT = TT / 256, MTC = (TT + NCR) / 256, NHT = 50;

    for (int rp0_ = 0; rp0_ < REP_P0; ++rp0_) {
    constexpr int P_IN0 = 16 * 30 / TPB / 2, P_UP0 = 16 * 88 / TPB / 2, P_DN0 = 44 * 16 / TPB / 2, P_OUT0 = 16 * 16 / TPB / 2, P_UQ = 5, P_UKV = 6, P_W2 = 4, P_A2 = 4, P_G2 = 4, P_CV = 32;
    constexpr int Q1 = P_IN0, Q2 = Q1 + P_UP0, Q3 = Q2 + P_DN0, Q4 = Q3 + P_OUT0, Q5 = Q4 + P_UQ, Q6 = Q5 + P_UKV, Q7 = Q6 + P_W2, Q8 = Q7 + P_A2, Q9 = Q8 + P_G2, Q10 = Q9 + P_CV;
    constexpr int QA = Q10 + 2 * 96, QK = QA + 2 * 512 * 128 / NT, QT = QK + 1;
    PH_BEGIN(QT)
        if (vb < Q10) {
            const float* W; bf16_t* Wt; int K_, N_, Np_, mode_ = 0, gh_ = 0, it_, ldo_ = 0;
            if (vb < Q1)      { W = in[20]; Wt = wt_in0; K_ = 1024; N_ = N0; Np_ = 1920; it_ = vb * 2; }
            else if (vb < Q2) { W = in[16]; Wt = (bf16_t*)(ws + WS::WT_UP0); K_ = 1024; N_ = FF2; Np_ = FF2; mode_ = 1; gh_ = BNB / 2; it_ = (vb - Q1) * 2; }
            else if (vb < Q3) { W = in[19]; Wt = (bf16_t*)(ws + WS::WT_DN0); K_ = FF; N_ = 1024; Np_ = 1024; it_ = (vb - Q2) * 2; }
            else if (vb < Q4) { W = in[30]; Wt = (bf16_t*)(ws + WS::WT_OUT0); K_ = 1024; N_ = 1024; Np_ = 1024; it_ = (vb - Q3) * 2; }
            else if (vb < Q5) { W = in[27]; Wt = wt_uq; K_ = 192; N_ = 384; Np_ = 384; it_ = (vb - Q4) * 2; }
            else if (vb < Q6) { W = in[29]; Wt = wt_ukv; K_ = 128; N_ = 768; Np_ = 768; mode_ = 2; it_ = (vb - Q5) * 2; }
            else if (vb < Q7) { const int j = vb - Q6; W = in[42] + (size_t)(j >> 1) * 64 * 512; Wt = w2t + (size_t)(j >> 1) * 512 * 64; K_ = 64; N_ = 512; Np_ = 512; it_ = (j & 1) * 2; }
            else if (vb < Q8) { const int j = vb - Q7; W = in[44] + (size_t)(j >> 1) * 64 * 512; Wt = a2t + (size_t)(j >> 1) * 512 * 64; K_ = 64; N_ = 512; Np_ = 512; it_ = (j & 1) * 2; }
            else if (vb < Q9) { W = in[45]; Wt = g2t; K_ = 128; N_ = 512; Np_ = 512; it_ = (vb - Q8) * 2; }
            else {
                const int j = vb - Q9; W = in[3] + (size_t)(j >> 2) * 512 * 128; Wt = VtA + vt_off(lay, 16 + (j >> 4), (j >> 2) & 3); K_ = 512; N_ = 128; Np_ = 128; it_ = (j & 3) * 2; ldo_ = VLD;
            }
            n_wconv_multi<NT, 2>(W, K_, N_, Wt, Np_, mode_, gh_, it_, lds, ldo_);
        } else if (vb < QA) n_ada<NT>(in[10], in[11], in[12], in[13], in[31], in[32], mod, vb - Q10, lds);
        else if (vb < QK) n_cache_k4<NT>(lay, in[2], Ka, vb - QA);
        else n_rope_tables(c64, s64, c32, s32);
    PH_END

    }
    constexpr int CV_IN1 = 16 * 52 / TPB, CV_OUT = 16 * 16 / TPB, CV_UP = 16 * 88 / TPB, CV_DN = 44 * 16 / TPB;
    static_assert(CV_IN1 % 2 == 0 && CV_OUT % 2 == 0 && CV_UP % 2 == 0 && CV_DN % 2 == 0, "item pairs must not straddle two weights");
#define CONV_PAIR(c_) { const int cc_ = (c_); \
        const float* W; bf16_t* Wt; int K_, N_, Np_, mode_, gh_, it_; \
        if (cc_ < CV_IN1) { W = in[39]; Wt = wt_in1; K_ = 1024; N_ = N1; Np_ = 3328; mode_ = 0; gh_ = 0; it_ = cc_; } \
        else if (cc_ < CV_IN1 + CV_OUT) { W = in[57]; Wt = (bf16_t*)(ws + WS::WT_OUT1); K_ = 1024; N_ = 1024; Np_ = 1024; mode_ = 0; gh_ = 0; it_ = cc_ - CV_IN1; } \
        else if (cc_ < CV_IN1 + CV_OUT + CV_UP) { W = in[35]; Wt = (bf16_t*)(ws + WS::WT_UP1); K_ = 1024; N_ = FF2; Np_ = FF2; mode_ = 1; gh_ = BNB / 2; it_ = cc_ - CV_IN1 - CV_OUT; } \
        else { W = in[38]; Wt = (bf16_t*)(ws + WS::WT_DN1); K_ = FF; N_ = 1024; Np_ = 1024; mode_ = 0; gh_ = 0; it_ = cc_ - CV_IN1 - CV_OUT - CV_UP; } \
        n_wconv_multi<NT, 2>(W, K_, N_, Wt, Np_, mode_, gh_, it_, lds); }
    for (int l = 0; l < 2; ++l) {
        const float* modl = mod + (size_t)l * 3 * 6144;
        const int cb = l ? 31 : 12;
#define wt_out ((const bf16_t*)(ws + (l ? WS::WT_OUT1 : WS::WT_OUT0)))
#define wt_up ((const bf16_t*)(ws + (l ? WS::WT_UP1 : WS::WT_UP0)))
#define wt_dn ((const bf16_t*)(ws + (l ? WS::WT_DN1 : WS::WT_DN0)))
        PH_BEGIN(TT / 16)
            n_resnorm_w2<NT>(lay, in[0], in[1], l ? h : nullptr, in[cb + 2], modl, 0, 1024, hn16, vb);
        PH_END
        if (l == 0) {
            PH_BEGIN(MT * (1920 / BNB))
                const int tb = xcd_remap(vb, MT * (1920 / BNB));
                gemm_tile<256, BNB, NT>(ALoadBF{hn16, DM}, wt_in0, DM, (tb / (1920 / BNB)) * 256, (tb % (1920 / BNB)) * BNB,
                                        EpiIn0{lay, Qa, Ka, VtA, tail16, o_k, o_v, c64, s64}, (char*)lds);
            PH_END
            PH_BEGIN((TT + NCR) / 8)
                n_l0_tail_w<NT>(lay, tail16, in[26], in[28], in[4], in[5], c32, s32, qdn16, ckvn16, Kb, o_ckv, o_kpe, vb);
            PH_END
            constexpr int UQT = MT * (384 / BNB), UKT = MTC * (768 / BNB);
            PH_BEGIN(UQT + UKT)
                if (vb < UKT) gemm_tile<256, BNB, NT>(ALoadBF{ckvn16, 128}, wt_ukv, 128, (vb / (768 / BNB)) * 256, (vb % (768 / BNB)) * BNB, EpiKV{lay, Kb, VtB}, (char*)lds);
                else { const int u = vb - UKT; gemm_tile<256, BNB, NT>(ALoadBF{qdn16, 192}, wt_uq, 192, (u / (384 / BNB)) * 256, (u % (384 / BNB)) * BNB, EpiQb{lay, Qb, c32, s32}, (char*)lds); }
            PH_END
            for (int rep_ = 0; rep_ < REP_FLASH; ++rep_) {
            for (int vb = bid_opaque(); vb < 1152; vb += gridDim.x) { char* ws = launder_c(ws0); float* out = launder_f(out0); const InTab in = in_tab(); (void)ws; (void)out; (void)in;
                int mp, hd, q0;
                if (vb < 768) {
                    const int r = vb >> 8, b = vb & 255, x = b & 7, j = b >> 3;
                    int batch;
                    if (r == 0) { mp = 2; hd = x & 3; batch = x >> 2; }
                    else { const int a = 2 * x + (r - 1); batch = a >> 3; hd = (a >> 1) & 3; mp = a & 1; }
                    q0 = 4096 + batch * 4096 + j * 128;
                } else { const int j = vb - 768; mp = j >> 7; hd = (j >> 5) & 3; q0 = (j & 31) * 128; }
                const TokInfo ti = tokinfo(q0);
                const int crow = TT + (ti.latent ? (ti.seq - 16) * 512 : 0);
                FlashP p;
                p.n0 = ti.latent ? 512 : 0; p.Lk = ti.L + p.n0; p.O = nullptr;
                if (mp < 2) {
                    p.Q = Qa + hd * 128 + mp * 64; p.q_ld = 512;
                    p.K0 = Ka + (size_t)crow * 512 + hd * 128 + mp * 64;
                    p.K1 = Ka + (size_t)ti.t0 * 512 + hd * 128 + mp * 64; p.k_ld = 512;
                    p.Vt = VtA + vt_off(lay, ti.seq, hd); p.vt_ld = ti.latent ? VLD : 256;
                    p.Ob = (mp ? oa2h : oa1h) + hd * 128; p.o_ld = 512;
                    p.c = 0.125f * 1.4426950408889634f;
                    flash_item<64, NT, true>(p, q0, (char*)lds);
                } else {
                    p.Q = Qb + hd * 96; p.q_ld = 384;
                    p.K0 = Kb + (size_t)crow * 384 + hd * 96;
                    p.K1 = Kb + (size_t)ti.t0 * 384 + hd * 96; p.k_ld = 384;
                    p.Vt = VtB + vt_off(lay, ti.seq, hd); p.vt_ld = ti.latent ? VLD : 256;
                    p.Ob = mrg16 + 512 + hd * 128; p.o_ld = DM;
                    p.c = 0.10206207261596577f * 1.4426950408889634f;
                    flash_item<96, NT, true>(p, q0, (char*)lds);
                }
            PH_END
            }
            PH_BEGIN(TT / (NT / 64) / 6)
                n_combine0_m<NT, 6>(oa1h, oa2h, in[21], in[22], in[23], in[24], in[25], mrg16, vb);
            PH_END
        } else {
            {
                float* segf = (float*)(ws + WS::SEG_IZ);
                for (int i = blockIdx.x * NT + TIDX; i < 8192; i += gridDim.x * NT) segf[i] = (i < 4096 && (i >> 6) == (i & 63)) ? 1.f : 0.f;
            }
            constexpr int IN1T = NHT * 13, IN1L = IN1T - 512, IN1F = 256 - IN1L, CVP = (CV_OUT + CV_UP + CV_DN) / 2;
            PH_BEGIN(256 * (2 + (CVP + IN1F - 1) / IN1F))
                const int slot = vb & 255, rnd = vb >> 8;
                if (vb < IN1T) {
                    const int tb = xcd_remap(vb, IN1T);
                    const HaloTile ht = halo_tile(tb / 13);
                    gemm256_tile<NT>(ALoadHalo{hn16, DM, ht.t0, ht.row0, ht.L, (const bf16_t*)(ws + WS::ZERO)}, wt_in1, DM, (tb % 13) * 256,
                                     EpiIn1{lay, ht, in[40], in[51], in[52], zcm16, zg16, xc16, dtr}, (char*)lds);
                } else if (slot >= IN1L) {
                    const int p = (slot - IN1L) + IN1F * (rnd - 2);
                    if (p < CVP) CONV_PAIR(CV_IN1 + 2 * p)
                }
            PH_END
            for (int rep_ = 0; rep_ < REP_SCAN; ++rep_)
            for (int pass = 0; pass < 2; ++pass) {
            for (int vb = bid_opaque();; vb += gridDim.x) { char* ws = launder_c(ws0); float* out = launder_f(out0); const InTab in = in_tab(); (void)ws; (void)out; (void)in;
                if (pass == 1) {
                    __syncthreads();
                    if (TIDX == 0) st[3] = xb_add((unsigned*)ws0, 1u);
                    __syncthreads();
                    vb = __builtin_amdgcn_readfirstlane((int)st[3]);
                }
                if (vb >= (pass == 0 ? 256 : 672)) break;
                const int slot = vb & 255, rnd = vb >> 8;
                int kind = 0, item = 0, c0 = 0, c1 = 0, pq = 0, nst = 0;
                const float* sinit = nullptr; float* send = nullptr; const float* pqsrc = nullptr; const float* e0src = nullptr; float* siout = nullptr;
                float* segf = (float*)(ws + WS::SEG_IZ);
                float* e0b = (float*)(ws + WS::SEG_E0); float* pqb = (float*)(ws + WS::SEG_PQ); float* sib = (float*)(ws + WS::SEG_SI); float* hsb = (float*)(ws + WS::SEG_HS);
                constexpr int SSD_CUT = 31;
                if (pass == 0) {
                    if (slot < 32) { kind = 1; item = ((16 + (slot >> 4)) << 4) | (slot & 15); c0 = 0; c1 = 12; send = e0b + (size_t)slot * 4096; }
                    else if (slot < 224) {
                        const int j = slot - 32, chain = j / 6, rem = j - chain * 6, seg = 1 + (rem >> 1); pq = 1 + (rem & 1);
                        kind = 1; item = ((16 + (chain >> 4)) << 4) | (chain & 15); c0 = 12 + 13 * (seg - 1); c1 = c0 + 13;
                        sinit = segf + (pq == 1 ? 0 : 4096); send = pqb + ((size_t)(chain * 3 + seg - 1) * 2 + (pq - 1)) * 4096;
                    } else { const int chain = slot - 224; kind = 2; item = ((16 + (chain >> 4)) << 4) | (chain & 15); c0 = 0; c1 = SSD_CUT; send = hsb + (size_t)chain * 4096; }
                } else {
                    if (vb < 128) {
                        const int chain = vb & 31, seg = 4 - (vb >> 5);
                        kind = 1; item = ((16 + (chain >> 4)) << 4) | (chain & 15); c0 = 12 + 13 * (seg - 1); c1 = c0 + 13;
                        e0src = e0b + (size_t)chain * 4096; pqsrc = pqb + (size_t)chain * 6 * 4096; nst = seg - 1; siout = sib + (size_t)vb * 4096;
                        sinit = nst ? siout : e0src;
                    } else if (vb < 160) { const int chain = vb - 128; kind = 2; item = ((16 + (chain >> 4)) << 4) | (chain & 15); c0 = SSD_CUT; c1 = 64; sinit = hsb + (size_t)chain * 4096; }
                    else if (vb < 416) { kind = 1; item = vb - 160; c0 = 0; c1 = 4; }
                    else { kind = 2; item = vb - 416; c0 = 0; c1 = 4; }
                }
                if (kind == 1) {
                    if (nst) wkv_seg_init<NT>(e0src, pqsrc, nst, siout, (char*)lds);
                    n_wkv3<NT>(lay, zcm16, w2t, a2t, in[41], in[43], in[46], in[47], in[6], in[7], y16, o_wf, o_wb, item, (char*)lds, c0, c1, sinit, pq, send);
                } else if (kind == 2) {
                    n_ssd2<NT>(lay, xc16, dtr, in[53], in[54], in[55], in[8], in[9], yd16, o_sf, o_sb, item, (char*)lds, c0, c1, sinit, send);
                }
            PH_END
            }
            PH_BEGIN(TT / 48)
                n_combine1<NT, 3>(lay, zcm16, g2t, y16, yd16, zg16, in[48], in[49], in[50], in[56], mrg16, vb, (char*)lds);
            PH_END
        }
        PH_BEGIN((TT / 128) * 8)
            const int tb = xcd_remap(vb, (TT / 128) * 8);
            gemm_tile<128, 128, NT, ALoadBF, EpiResid, 4>(ALoadBF{mrg16, DM}, wt_out, DM, (tb >> 3) * 128, (tb & 7) * 128,
                                    EpiResid{lay, in[0], in[1], l ? h : nullptr, h, modl, 2048}, (char*)lds);
        PH_END
        PH_BEGIN(TT / 16)
            n_resnorm_w2<NT>(lay, in[0], in[1], h, in[cb + 3], modl, 3072, 4096, hn16, vb);
        PH_END
        for (int rep_ = 0; rep_ < REP_UP; ++rep_) {
        constexpr int UPT = NHT * (FF2 / 256), UPF = (UPT / 256) * 256;
        PH_BEGIN(l == 0 ? 256 * 6 : UPF + 2 * (UPT - UPF))
            const int slot = vb & 255, rnd = vb >> 8;
            if (vb < UPF) {
                const int tb = xcd_remap(vb, UPF);
                const HaloTile ht = halo_tile(tb / (FF2 / 256));
                gemm256_tile<NT>(ALoadHalo{hn16, DM, ht.t0, ht.row0, ht.L, (const bf16_t*)(ws + WS::ZERO)}, wt_up, DM, (tb % (FF2 / 256)) * 256,
                                 EpiFFNUp{lay, ht, in[cb + 5], in[cb + 6], act16}, (char*)lds);
            } else if (rnd == 4 && slot < 2 * (UPT - UPF)) {
                const int v2 = slot, tb = UPF + (v2 >> 1);
                const HaloTile ht = halo_tile(tb / (FF2 / 256));
                gemm_tile<256, BNB, NT>(ALoadHalo{hn16, DM, ht.t0, ht.row0, ht.L, (const bf16_t*)(ws + WS::ZERO)}, wt_up, DM, 0, ((tb % (FF2 / 256)) * 2 + (v2 & 1)) * BNB,
                                        EpiFFNUp{lay, ht, in[cb + 5], in[cb + 6], act16}, (char*)lds);
            } else if (slot >= 2 * (UPT - UPF)) {
                const int p = (slot - 2 * (UPT - UPF)) + (256 - 2 * (UPT - UPF)) * (rnd - 4);
                if (p < CV_IN1 / 2) CONV_PAIR(2 * p)
            }
        PH_END
        }
        PH_BEGIN(256)
            const int tb = xcd_remap(vb, 256);
            gemm256_tile<NT, ALoadBF, EpiResid256<96>, 96>(ALoadBF{act16 + (size_t)(tb >> 2) * 192 * FF, FF}, wt_dn, FF, (tb & 3) * 256,
                             EpiResid256<96>{EpiResid{lay, in[0], in[1], h, h, modl, 5120}, (tb >> 2) * 192}, (char*)lds);
        PH_END
    }
    PH_BEGIN(TT / 16)
        n_final_w2<NT>(lay, h, in[58], out, vb);
    }
}
#undef mod
#undef h
#undef wt_in0
#undef wt_uq
#undef wt_ukv
#undef wt_in1
#undef w2t
#undef a2t
#undef g2t
#undef hn16
#undef act16
#undef tail16
#undef Qa
#undef Ka
#undef VtA
#undef qdn16
#undef ckvn16
#undef Qb
#undef Kb
#undef VtB
#undef oa1h
#undef oa2h
#undef zcm16
#undef zg16
#undef xc16
#undef dtr
#undef y16
#undef yd16
#undef c64
#undef s64
#undef c32
#undef s32
#undef mrg16
#undef o_k
#undef o_v
#undef o_ckv
#undef o_kpe
#undef o_wf
#undef o_wb
#undef o_sf
#undef o_sb
#undef wt_out
#undef wt_up
#undef wt_dn
}

extern "C" void kernel_launch(void* const* d_in, const int* in_sizes, int n_in, void* d_out, int out_size, void* d_ws, size_t ws_size,
                              hipStream_t stream) {
    if (n_in != 59 || ws_size < WS::TOTAL) return;
    static int grid = 0;
    if (grid == 0) {
        int dev = 0, cus = 0, per_cu = 0;
        (void)hipGetDevice(&dev);
        (void)hipDeviceGetAttribute(&cus, hipDeviceAttributeMultiprocessorCount, dev);
        (void)hipOccupancyMaxActiveBlocksPerMultiprocessor(&per_cu, (const void*)mega, 512, 0);
        grid = (per_cu >= 1) ? cus : 0;
        if (grid <= 0) grid = -1;
    }
    if (grid < 0) return;
    MP P{};
    for (int i = 0; i < 59; ++i) P.in[i] = (const float*)d_in[i];
    P.out = (float*)d_out;
    P.ws = (char*)d_ws;
    (void)hipMemsetAsync(d_ws, 0, WS::ZERO + 4096, stream);
    hipLaunchKernelGGL(mega, dim3(grid), dim3(512), 0, stream, P);
}
```
